# Optimizing an MI355X kernel written in HIP

```python
import math
import jax, jax.numpy as jnp
from jax import lax
import numpy as np

D_MODEL = 1024
BATCH = 8
SEQ = 2048
DEPTH = 2

EPS = 1e-6
POOL_WINDOWS = (2, 4, 8, 16)
N_POOL_GROUPS = len(POOL_WINDOWS)
POOL_GROUP_DIM = D_MODEL // N_POOL_GROUPS
HEAD_DIM = 64
HEADS_PER_GROUP = D_MODEL // HEAD_DIM
DILATED_PATTERNS = ((128, 1), (512, 4), (2048, 16))
N_ATT_GROUPS = len(DILATED_PATTERNS)
N_HEADS_TOTAL = N_ATT_GROUPS * HEADS_PER_GROUP
Q_WIDTH = N_HEADS_TOTAL * HEAD_DIM
KV_WIDTH = 2 * Q_WIDTH
MERGED_WIDTH = HEADS_PER_GROUP * HEAD_DIM
QBLK = 128
NEG_INF = -1e30
N_BUCKETS = 32
MAX_EXACT = N_BUCKETS // 2
MAX_DISTANCE = 2048
D_FF_DENSE = ((8 * D_MODEL // 3 + 255) // 256) * 256
N_EXPERTS = 8
TOP_K = 2
D_FF_EXPERT = 7 * D_MODEL // 2
MOE_BLOCK = 256
N_A_LAYERS = DEPTH // 2
N_B_LAYERS = DEPTH - N_A_LAYERS
N_DENSE = (DEPTH + 1) // 2
N_MOE = DEPTH // 2

kernel_name = "yoco_pool_dilated_moe_hybrid"


def rmsnorm(x, g):
    xf = x.astype(jnp.float32)
    y = xf * lax.rsqrt(jnp.mean(xf * xf, axis=-1, keepdims=True) + EPS)
    return (y * g.astype(jnp.float32)).astype(x.dtype)


def pool_mixer(xn, proj, scale):
    B, S, D = xn.shape
    xg = xn.astype(jnp.float32).reshape(B, S, N_POOL_GROUPS, POOL_GROUP_DIM)
    c = jnp.pad(jnp.cumsum(xg, axis=1), ((0, 0), (1, 0), (0, 0), (0, 0)))
    hi = jnp.arange(1, S + 1, dtype=jnp.int32)
    win = jnp.array(POOL_WINDOWS, dtype=jnp.int32)[:, None]
    lo = jnp.maximum(hi[None, :] - win, 0)
    c_lo = c[:, lo.T, jnp.arange(N_POOL_GROUPS)[None, :], :]
    cnt = (hi[None, :] - lo).astype(jnp.float32).T
    pooled = (c[:, 1:] - c_lo) / cnt[None, :, :, None] - xg
    out = jnp.einsum('bsgc,gcd->bsgd', pooled, proj.astype(jnp.float32))
    out = out.reshape(B, S, D) * scale.astype(jnp.float32)
    return out.astype(xn.dtype)


def t5_bucket(n):
    nf = jnp.maximum(n, 1).astype(jnp.float32)
    large = MAX_EXACT + (jnp.log(nf / MAX_EXACT) / math.log(MAX_DISTANCE / MAX_EXACT)
                         * (N_BUCKETS - MAX_EXACT)).astype(jnp.int32)
    large = jnp.minimum(large, N_BUCKETS - 1)
    return jnp.where(n < MAX_EXACT, n, large)


def dilated_group_attention(q, k, v, bias_table, window, dilation):
    B, S, H, Dh = q.shape
    W = window // dilation
    assert W <= QBLK
    L = S // dilation
    n = -(-L // QBLK)
    Lp = n * QBLK

    def to_sub(t, left):
        t = t.reshape(B, L, dilation, H, Dh).transpose(0, 2, 1, 3, 4)
        return jnp.pad(t, ((0, 0), (0, 0), (left, Lp - L), (0, 0), (0, 0)))

    def key_blocks(t):
        t = to_sub(t, QBLK).reshape(B, dilation, n + 1, QBLK, H, Dh)
        return jnp.concatenate([t[:, :, :-1], t[:, :, 1:]], axis=3)

    qs = to_sub(q, 0).reshape(B, dilation, n, QBLK, H, Dh)
    kb = key_blocks(k)
    vb = key_blocks(v)

    a = jnp.arange(QBLK, dtype=jnp.int32)[:, None]
    c = jnp.arange(2 * QBLK, dtype=jnp.int32)[None, :]
    m = a + QBLK - c
    band = (m >= 0) & (m <= W)
    kpos = jnp.arange(n, dtype=jnp.int32)[:, None, None] * QBLK - QBLK + c[None]
    valid = band[None] & (kpos >= 0) & (kpos < L)
    bias = bias_table[t5_bucket(jnp.maximum(m, 0) * dilation)]
    bias = bias.transpose(2, 0, 1).astype(jnp.float32)

    logits = jnp.einsum('brnqhd,brnkhd->brnhqk', qs, kb,
                        preferred_element_type=jnp.float32) * (HEAD_DIM ** -0.5)
    logits = jnp.where(valid[None, None, :, None], logits + bias[None, None, None], NEG_INF)
    mx = jnp.max(logits, axis=-1, keepdims=True)
    p = jnp.exp(logits - mx)
    s = jnp.sum(p, axis=-1)
    o = jnp.einsum('brnhqk,brnkhd->brnqhd', p, vb.astype(jnp.float32))
    s_t = s.transpose(0, 1, 2, 4, 3)
    o = o / s_t[..., None]
    lse = (mx[..., 0] + jnp.log(s)).transpose(0, 1, 2, 4, 3)

    o = o.reshape(B, dilation, Lp, H, Dh)[:, :, :L].transpose(0, 2, 1, 3, 4).reshape(B, S, H, Dh)
    lse = lse.reshape(B, dilation, Lp, H)[:, :, :L].transpose(0, 2, 1, 3).reshape(B, S, H)
    return o, lse


def dilated_attention_layer(hn, w_q, w_o, k_sh, v_sh, rel_bias):
    B, S, _ = hn.shape
    q = (hn @ w_q).reshape(B, S, N_ATT_GROUPS, HEADS_PER_GROUP, HEAD_DIM)
    outs, lses = [], []
    for g, (window, dilation) in enumerate(DILATED_PATTERNS):
        o, lse = dilated_group_attention(
            q[:, :, g], k_sh[:, :, g], v_sh[:, :, g],
            rel_bias[:, g * HEADS_PER_GROUP:(g + 1) * HEADS_PER_GROUP], window, dilation)
        outs.append(o)
        lses.append(lse)
    alpha = jax.nn.softmax(jnp.stack(lses, axis=0), axis=0)
    o = jnp.einsum('gbsh,gbshd->bshd', alpha, jnp.stack(outs, axis=0))
    return o.reshape(B, S, MERGED_WIDTH).astype(hn.dtype) @ w_o


def dense_swiglu(xn, w_gate, w_up, w_down):
    return (jax.nn.silu(xn @ w_gate) * (xn @ w_up)) @ w_down


def moe_swiglu(xn, w_router, w_gate, w_up, w_down):
    B, S, D = xn.shape
    T = B * S
    xf = xn.reshape(T, D)
    logits = (xf @ w_router).astype(jnp.float32)
    top_val, top_idx = lax.top_k(logits, TOP_K)
    gates = jax.nn.softmax(top_val, axis=-1)
    e_flat = top_idx.reshape(-1).astype(jnp.int32)
    tok = jnp.repeat(jnp.arange(T, dtype=jnp.int32), TOP_K)
    g_flat = gates.reshape(-1)
    order = jnp.argsort(e_flat)
    e_s, tok_s, g_s = e_flat[order], tok[order], g_flat[order]

    n_assign = T * TOP_K
    n_pad = n_assign + N_EXPERTS * MOE_BLOCK
    n_blocks = n_pad // MOE_BLOCK
    counts = jnp.zeros((N_EXPERTS,), jnp.int32).at[e_flat].add(1)
    padded = ((counts + MOE_BLOCK - 1) // MOE_BLOCK) * MOE_BLOCK
    ends_pad = jnp.cumsum(padded)
    starts_pad = ends_pad - padded
    starts_raw = jnp.cumsum(counts) - counts
    rank = jnp.arange(n_assign, dtype=jnp.int32) - starts_raw[e_s]
    dest = starts_pad[e_s] + rank
    block_start = jnp.arange(n_blocks, dtype=jnp.int32) * MOE_BLOCK
    blk_e = jnp.minimum(jnp.searchsorted(ends_pad, block_start, side='right'),
                        N_EXPERTS - 1).astype(jnp.int32)
    xs = jnp.zeros((n_pad, D), xn.dtype).at[dest].set(xf[tok_s])

    def expert_block(args):
        xb, e = args
        h = jax.nn.silu(xb @ w_gate[e]) * (xb @ w_up[e])
        return h @ w_down[e]

    ys = lax.map(expert_block, (xs.reshape(n_blocks, MOE_BLOCK, D), blk_e)).reshape(n_pad, D)
    y = jnp.zeros((T, D), jnp.float32).at[tok_s].add(
        g_s[:, None] * ys[dest].astype(jnp.float32))
    return y.reshape(B, S, D).astype(xn.dtype)


def setup_inputs(seed: int = 0) -> dict:
    key = jax.random.key(seed)
    ks = jax.random.split(key, 20)

    def nrm(k, shape, fan_in):
        return jax.random.normal(k, shape, jnp.float32) * (fan_in ** -0.5)

    def gain(k, shape):
        return 1.0 + 0.05 * jax.random.normal(k, shape, jnp.float32)

    return {
        "x": jax.random.normal(ks[0], (BATCH, SEQ, D_MODEL), jnp.float32),
        "a_norm": gain(ks[1], (N_A_LAYERS, D_MODEL)),
        "a_proj": nrm(ks[2], (N_A_LAYERS, N_POOL_GROUPS, POOL_GROUP_DIM, POOL_GROUP_DIM), POOL_GROUP_DIM),
        "a_scale": gain(ks[3], (N_A_LAYERS, D_MODEL)),
        "kv_norm": gain(ks[4], (D_MODEL,)),
        "w_kv": nrm(ks[5], (D_MODEL, KV_WIDTH), D_MODEL),
        "b_norm": gain(ks[6], (N_B_LAYERS, D_MODEL)),
        "w_q": nrm(ks[7], (N_B_LAYERS, D_MODEL, Q_WIDTH), D_MODEL),
        "w_o": nrm(ks[8], (N_B_LAYERS, MERGED_WIDTH, D_MODEL), MERGED_WIDTH),
        "rel_bias": 0.5 * jax.random.normal(ks[9], (N_BUCKETS, N_HEADS_TOTAL), jnp.float32),
        "ffn_norm": gain(ks[10], (DEPTH, D_MODEL)),
        "dense_w_gate": nrm(ks[11], (N_DENSE, D_MODEL, D_FF_DENSE), D_MODEL),
        "dense_w_up": nrm(ks[12], (N_DENSE, D_MODEL, D_FF_DENSE), D_MODEL),
        "dense_w_down": nrm(ks[13], (N_DENSE, D_FF_DENSE, D_MODEL), D_FF_DENSE),
        "moe_router": nrm(ks[14], (N_MOE, D_MODEL, N_EXPERTS), D_MODEL),
        "moe_w_gate": nrm(ks[15], (N_MOE, N_EXPERTS, D_MODEL, D_FF_EXPERT), D_MODEL),
        "moe_w_up": nrm(ks[16], (N_MOE, N_EXPERTS, D_MODEL, D_FF_EXPERT), D_MODEL),
        "moe_w_down": nrm(ks[17], (N_MOE, N_EXPERTS, D_FF_EXPERT, D_MODEL), D_FF_EXPERT),
        "final_norm": gain(ks[18], (D_MODEL,)),
    }


def reference(x, a_norm, a_proj, a_scale, kv_norm, w_kv, b_norm, w_q, w_o, rel_bias,
              ffn_norm, dense_w_gate, dense_w_up, dense_w_down,
              moe_router, moe_w_gate, moe_w_up, moe_w_down, final_norm):
    B, S, _ = x.shape
    h = x
    k_sh = v_sh = None
    for l in range(DEPTH):
        if l < N_A_LAYERS:
            h = h + pool_mixer(rmsnorm(h, a_norm[l]), a_proj[l], a_scale[l])
        else:
            if l == N_A_LAYERS:
                kv = (rmsnorm(h, kv_norm) @ w_kv).reshape(
                    B, S, 2, N_ATT_GROUPS, HEADS_PER_GROUP, HEAD_DIM)
                k_sh, v_sh = kv[:, :, 0], kv[:, :, 1]
            j = l - N_A_LAYERS
            h = h + dilated_attention_layer(rmsnorm(h, b_norm[j]), w_q[j], w_o[j],
                                            k_sh, v_sh, rel_bias)
        hn = rmsnorm(h, ffn_norm[l])
        if l % 2 == 0:
            i = l // 2
            h = h + dense_swiglu(hn, dense_w_gate[i], dense_w_up[i], dense_w_down[i])
        else:
            i = l // 2
            h = h + moe_swiglu(hn, moe_router[i], moe_w_gate[i], moe_w_up[i], moe_w_down[i])
    return rmsnorm(h, final_norm)
```

```cpp
#include <hip/hip_runtime.h>
#include <cstdio>
#include <cstdint>

namespace nv {
constexpr int T = 16384, D = 1024, S = 2048, NB = 8;
constexpr int FF0 = 2816, FF1 = 3584, NE = 8;
constexpr float EPS = 1e-6f;

__device__ __forceinline__ float wave_sum(float v) {
#pragma unroll
    for (int o = 1; o < 64; o <<= 1) v += __shfl_xor(v, o);
    return v;
}
__device__ __forceinline__ float silu(float x) { return x / (1.f + expf(-x)); }

__global__ void k_rstd(const float* __restrict__ x, float* __restrict__ rstd) {
    const int row = blockIdx.x * 4 + (threadIdx.x >> 6), lane = threadIdx.x & 63;
    const float4* p = (const float4*)(x + (size_t)row * D);
    float s = 0.f;
#pragma unroll
    for (int j = 0; j < 4; ++j) { const float4 v = p[lane + 64 * j]; s += v.x * v.x + v.y * v.y + v.z * v.z + v.w * v.w; }
    s = wave_sum(s);
    if (lane == 0) rstd[row] = 1.0f / sqrtf(s * (1.f / D) + EPS);
}

__global__ void k_pool(const float* __restrict__ x, const float* __restrict__ rstd, const float* __restrict__ gain, float* __restrict__ pooled) {
    const int t = blockIdx.x, c = threadIdx.x * 4;
    const int s = t % S, g = c >> 8, w = 2 << g;
    const int cnt = (s + 1 < w) ? (s + 1) : w;
    const float4 gn = *(const float4*)(gain + c);
    float4 acc = {0.f, 0.f, 0.f, 0.f}, self = {0.f, 0.f, 0.f, 0.f};
    for (int j = 0; j < cnt; ++j) {
        const float r = rstd[t - j]; const float4 v = *(const float4*)(x + (size_t)(t - j) * D + c);
        const float4 xn = {v.x * r * gn.x, v.y * r * gn.y, v.z * r * gn.z, v.w * r * gn.w};
        acc.x += xn.x; acc.y += xn.y; acc.z += xn.z; acc.w += xn.w;
        if (j == 0) self = xn;
    }
    const float inv = 1.f / (float)cnt;
    float4 o = {acc.x * inv - self.x, acc.y * inv - self.y, acc.z * inv - self.z, acc.w * inv - self.w};
    *(float4*)(pooled + (size_t)t * D + c) = o;
}

struct GemmP {
    const float* A; int lda; const float* B1; const float* B2; int ldb; float* C; int ldc; int M, N, K;
    const float* rowscale; const float* kgain;
    const float* R; int ldr; const float* cs; const float* rowgate; int rg_stride; int mode;
};
template <int MODE>
__global__ void __launch_bounds__(256) k_gemm(GemmP p) {
    __shared__ float As[16][68], Bs[16][68], Bs2[MODE == 2 ? 16 : 1][68];
    const int tx = threadIdx.x & 15, ty = threadIdx.x >> 4, m0 = blockIdx.y * 64, n0 = blockIdx.x * 64;
    float acc[4][4] = {}, acc2[4][4] = {};
    const int ar = threadIdx.x >> 2, ac = (threadIdx.x & 3) * 4;
    const int br = threadIdx.x >> 4, bc = (threadIdx.x & 15) * 4;
    const float rs = p.rowscale ? p.rowscale[m0 + ar] : 1.f;
    for (int k0 = 0; k0 < p.K; k0 += 16) {
        float4 a = *(const float4*)(p.A + (size_t)(m0 + ar) * p.lda + k0 + ac);
        if (p.kgain) { const float4 g = *(const float4*)(p.kgain + k0 + ac); a.x *= g.x; a.y *= g.y; a.z *= g.z; a.w *= g.w; }
        As[ac + 0][ar] = a.x * rs; As[ac + 1][ar] = a.y * rs; As[ac + 2][ar] = a.z * rs; As[ac + 3][ar] = a.w * rs;
        const float4 b = *(const float4*)(p.B1 + (size_t)(k0 + br) * p.ldb + n0 + bc);
        *(float4*)&Bs[br][bc] = b;
        if (MODE == 2) { const float4 b2 = *(const float4*)(p.B2 + (size_t)(k0 + br) * p.ldb + n0 + bc); *(float4*)&Bs2[br][bc] = b2; }
        __syncthreads();
#pragma unroll
        for (int k = 0; k < 16; ++k) {
            const float4 av = *(const float4*)&As[k][ty * 4]; const float4 bv = *(const float4*)&Bs[k][tx * 4];
            const float aa[4] = {av.x, av.y, av.z, av.w}, bb[4] = {bv.x, bv.y, bv.z, bv.w};
#pragma unroll
            for (int i = 0; i < 4; ++i)
#pragma unroll
                for (int j = 0; j < 4; ++j) acc[i][j] += aa[i] * bb[j];
            if (MODE == 2) { const float4 cv = *(const float4*)&Bs2[k][tx * 4]; const float cc[4] = {cv.x, cv.y, cv.z, cv.w};
#pragma unroll
                for (int i = 0; i < 4; ++i)
#pragma unroll
                    for (int j = 0; j < 4; ++j) acc2[i][j] += aa[i] * cc[j]; }
        }
        __syncthreads();
    }
#pragma unroll
    for (int i = 0; i < 4; ++i) {
        const int row = m0 + ty * 4 + i;
#pragma unroll
        for (int j = 0; j < 4; ++j) {
            const int col = n0 + tx * 4 + j; float v = acc[i][j];
            float* c = p.C + (size_t)row * p.ldc + col;
            if (MODE == 1) v = p.R[(size_t)row * p.ldr + col] + v * p.cs[col];
            if (MODE == 2) v = silu(v) * acc2[i][j];
            if (MODE == 3) v = p.R[(size_t)row * p.ldr + col] + v;
            if (MODE == 4) v = *c + p.rowgate[(size_t)row * p.rg_stride] * v;
            *c = v;
        }
    }
}

__device__ __forceinline__ int t5_bucket(int n) {
    if (n < 16) return n;
    int large = 16 + (int)(log((double)n / 16.0) / log(128.0) * 16.0);
    return large < 31 ? large : 31;
}

__global__ void k_attn(const float* __restrict__ q, const float* __restrict__ k, const float* __restrict__ v, const float* __restrict__ rel_bias,
                       float* __restrict__ acc, float* __restrict__ mbuf, float* __restrict__ lbuf, int g, int dil) {
    const int wid = blockIdx.x * 4 + (threadIdx.x >> 6), lane = threadIdx.x & 63;
    const int t = wid >> 4, h = wid & 15, s = t % S, i = s / dil;
    const float qv = q[(size_t)t * D + h * 64 + lane] * 0.125f;
    float m = g == 0 ? -1e30f : mbuf[wid], l = g == 0 ? 0.f : lbuf[wid], a = g == 0 ? 0.f : acc[(size_t)t * D + h * 64 + lane];
    const int mmax = i < 128 ? i : 128;
    for (int mm = 0; mm <= mmax; ++mm) {
        const int tk = t - mm * dil;
        const float kv = k[(size_t)tk * D + h * 64 + lane];
        float logit = wave_sum(qv * kv) + rel_bias[t5_bucket(mm * dil) * 48 + g * 16 + h];
        const float mn = fmaxf(m, logit), f = expf(m - mn), pexp = expf(logit - mn);
        l = l * f + pexp; a = a * f + pexp * v[(size_t)tk * D + h * 64 + lane]; m = mn;
    }
    if (g == 2) a = a / l;
    acc[(size_t)t * D + h * 64 + lane] = a;
    if (lane == 0) { mbuf[wid] = m; lbuf[wid] = l; }
}

__global__ void k_router(const float* __restrict__ h, const float* __restrict__ rstd, const float* __restrict__ gain, const float* __restrict__ wr, float* __restrict__ gates) {
    const int t = blockIdx.x * 4 + (threadIdx.x >> 6), lane = threadIdx.x & 63;
    float lg[8] = {};
    const float r = rstd[t];
    for (int j = 0; j < 16; ++j) {
        const int c = lane + 64 * j; const float xv = h[(size_t)t * D + c] * r * gain[c];
#pragma unroll
        for (int e = 0; e < 8; ++e) lg[e] += xv * wr[c * 8 + e];
    }
#pragma unroll
    for (int e = 0; e < 8; ++e) lg[e] = wave_sum(lg[e]);
    if (lane == 0) {
        float b1 = lg[0]; int i1 = 0;
#pragma unroll
        for (int e = 1; e < 8; ++e) if (lg[e] > b1) { b1 = lg[e]; i1 = e; }
        float b2 = -3.0e38f; int i2 = 0;
#pragma unroll
        for (int e = 0; e < 8; ++e) if (e != i1 && lg[e] > b2) { b2 = lg[e]; i2 = e; }
        const float e2 = expf(b2 - b1), g1 = 1.f / (1.f + e2), g2 = e2 / (1.f + e2);
        for (int e = 0; e < 8; ++e) gates[(size_t)t * 8 + e] = (e == i1) ? g1 : (e == i2) ? g2 : 0.f;
    }
}

__global__ void k_final(const float* h, const float* __restrict__ gain, float* out) {
    const int row = blockIdx.x * 4 + (threadIdx.x >> 6), lane = threadIdx.x & 63;
    const float4* p = (const float4*)(h + (size_t)row * D);
    float4 v[4]; float s = 0.f;
#pragma unroll
    for (int j = 0; j < 4; ++j) { v[j] = p[lane + 64 * j]; s += v[j].x * v[j].x + v[j].y * v[j].y + v[j].z * v[j].z + v[j].w * v[j].w; }
    s = wave_sum(s);
    const float r = 1.0f / sqrtf(s * (1.f / D) + EPS);
#pragma unroll
    for (int j = 0; j < 4; ++j) { const float4 g = *(const float4*)(gain + 4 * (lane + 64 * j));
        float4 o = {v[j].x * r * g.x, v[j].y * r * g.y, v[j].z * r * g.z, v[j].w * r * g.w};
        ((float4*)(out + (size_t)row * D))[lane + 64 * j] = o; }
}

template <int MODE> static void gemm(hipStream_t st, const GemmP& p) {
    hipLaunchKernelGGL(k_gemm<MODE>, dim3(p.N / 64, p.M / 64), dim3(256), 0, st, p);
}
}

extern "C" void kernel_launch(void* const* d_in, const int* in_sizes, int n_in, void* d_out, int out_size, void* d_ws, size_t ws_size, hipStream_t stream) {
    using namespace nv;
    const float* x = (const float*)d_in[0]; const float* a_norm = (const float*)d_in[1]; const float* a_proj = (const float*)d_in[2]; const float* a_scale = (const float*)d_in[3];
    const float* kv_norm = (const float*)d_in[4]; const float* w_kv = (const float*)d_in[5]; const float* b_norm = (const float*)d_in[6]; const float* w_q = (const float*)d_in[7];
    const float* w_o = (const float*)d_in[8]; const float* rel_bias = (const float*)d_in[9]; const float* ffn_norm = (const float*)d_in[10];
    const float* dwg = (const float*)d_in[11]; const float* dwu = (const float*)d_in[12]; const float* dwd = (const float*)d_in[13];
    const float* router = (const float*)d_in[14]; const float* mwg = (const float*)d_in[15]; const float* mwu = (const float*)d_in[16]; const float* mwd = (const float*)d_in[17];
    const float* final_norm = (const float*)d_in[18];
    float* h = (float*)d_out;
    const size_t MiB = 1u << 20;
    char* ws = (char*)d_ws;
    if (ws_size < 470 * MiB) { fprintf(stderr, "ws too small: %zu\n", ws_size); return; }
    float* rstd = (float*)(ws);
    float* mbuf = (float*)(ws + 1 * MiB); float* lbuf = (float*)(ws + 2 * MiB);
    float* gates = (float*)(ws + 3 * MiB);
    float* buf0 = (float*)(ws + 4 * MiB);
    float* big = (float*)(ws + 68 * MiB);
    GemmP p{};
    hipLaunchKernelGGL(k_rstd, dim3(T / 4), dim3(256), 0, stream, x, rstd);
    hipLaunchKernelGGL(k_pool, dim3(T), dim3(256), 0, stream, x, rstd, a_norm, buf0);
    for (int g = 0; g < 4; ++g) {
        p = GemmP{}; p.A = buf0 + g * 256; p.lda = D; p.B1 = a_proj + (size_t)g * 256 * 256; p.ldb = 256; p.C = h + g * 256; p.ldc = D; p.M = T; p.N = 256; p.K = 256;
        p.R = x + g * 256; p.ldr = D; p.cs = a_scale + g * 256; p.mode = 1; gemm<1>(stream, p);
    }
    hipLaunchKernelGGL(k_rstd, dim3(T / 4), dim3(256), 0, stream, h, rstd);
    p = GemmP{}; p.A = h; p.lda = D; p.B1 = dwg; p.B2 = dwu; p.ldb = FF0; p.C = big; p.ldc = FF0; p.M = T; p.N = FF0; p.K = D; p.rowscale = rstd; p.kgain = ffn_norm; gemm<2>(stream, p);
    p = GemmP{}; p.A = big; p.lda = FF0; p.B1 = dwd; p.ldb = D; p.C = h; p.ldc = D; p.M = T; p.N = D; p.K = FF0; p.R = h; p.ldr = D; gemm<3>(stream, p);
    hipLaunchKernelGGL(k_rstd, dim3(T / 4), dim3(256), 0, stream, h, rstd);
    float* qg = big; float* kg = big + (size_t)T * D; float* vg = big + (size_t)2 * T * D;
    const int dil[3] = {1, 4, 16};
    for (int g = 0; g < 3; ++g) {
        p = GemmP{}; p.A = h; p.lda = D; p.B1 = w_q + g * 1024; p.ldb = 3072; p.C = qg; p.ldc = D; p.M = T; p.N = D; p.K = D; p.rowscale = rstd; p.kgain = b_norm; gemm<0>(stream, p);
        p.B1 = w_kv + g * 1024; p.ldb = 6144; p.C = kg; p.kgain = kv_norm; gemm<0>(stream, p);
        p.B1 = w_kv + 3072 + g * 1024; p.C = vg; gemm<0>(stream, p);
        hipLaunchKernelGGL(k_attn, dim3(T * 16 / 4), dim3(256), 0, stream, qg, kg, vg, rel_bias, buf0, mbuf, lbuf, g, dil[g]);
    }
    p = GemmP{}; p.A = buf0; p.lda = D; p.B1 = w_o; p.ldb = D; p.C = h; p.ldc = D; p.M = T; p.N = D; p.K = D; p.R = h; p.ldr = D; gemm<3>(stream, p);
    hipLaunchKernelGGL(k_rstd, dim3(T / 4), dim3(256), 0, stream, h, rstd);
    hipLaunchKernelGGL(k_router, dim3(T / 4), dim3(256), 0, stream, h, rstd, ffn_norm + D, router, gates);
    hipMemcpyAsync(buf0, h, (size_t)T * D * 4, hipMemcpyDeviceToDevice, stream);
    for (int e = 0; e < NE; ++e) {
        p = GemmP{}; p.A = buf0; p.lda = D; p.B1 = mwg + (size_t)e * D * FF1; p.B2 = mwu + (size_t)e * D * FF1; p.ldb = FF1; p.C = big; p.ldc = FF1; p.M = T; p.N = FF1; p.K = D;
        p.rowscale = rstd; p.kgain = ffn_norm + D; gemm<2>(stream, p);
        p = GemmP{}; p.A = big; p.lda = FF1; p.B1 = mwd + (size_t)e * FF1 * D; p.ldb = D; p.C = h; p.ldc = D; p.M = T; p.N = D; p.K = FF1; p.rowgate = gates + e; p.rg_stride = 8; gemm<4>(stream, p);
    }
    hipLaunchKernelGGL(k_final, dim3(T / 4), dim3(256), 0, stream, h, final_norm, h);
}
```

```cpp
#include <hip/hip_runtime.h>
#include <cstdio>
#include <cstdint>
#define MK_STEP 3
namespace nv {
constexpr int T = 16384, D = 1024, S = 2048, NB = 8;
constexpr int FF0 = 2816, FF1 = 3584, NE = 8;
constexpr float EPS = 1e-6f;

__device__ __forceinline__ float wave_sum(float v) {
#pragma unroll
    for (int o = 1; o < 64; o <<= 1) v += __shfl_xor(v, o);
    return v;
}
__device__ __forceinline__ float silu(float x) { return x / (1.f + expf(-x)); }

__global__ void k_rstd(const float* __restrict__ x, float* __restrict__ rstd) {
    const int row = blockIdx.x * 4 + (threadIdx.x >> 6), lane = threadIdx.x & 63;
    const float4* p = (const float4*)(x + (size_t)row * D);
    float s = 0.f;
#pragma unroll
    for (int j = 0; j < 4; ++j) { const float4 v = p[lane + 64 * j]; s += v.x * v.x + v.y * v.y + v.z * v.z + v.w * v.w; }
    s = wave_sum(s);
    if (lane == 0) rstd[row] = 1.0f / sqrtf(s * (1.f / D) + EPS);
}

__global__ void k_pool(const float* __restrict__ x, const float* __restrict__ rstd, const float* __restrict__ gain, float* __restrict__ pooled) {
    const int t = blockIdx.x, c = threadIdx.x * 4;
    const int s = t % S, g = c >> 8, w = 2 << g;
    const int cnt = (s + 1 < w) ? (s + 1) : w;
    const float4 gn = *(const float4*)(gain + c);
    float4 acc = {0.f, 0.f, 0.f, 0.f}, self = {0.f, 0.f, 0.f, 0.f};
    for (int j = 0; j < cnt; ++j) {
        const float r = rstd[t - j]; const float4 v = *(const float4*)(x + (size_t)(t - j) * D + c);
        const float4 xn = {v.x * r * gn.x, v.y * r * gn.y, v.z * r * gn.z, v.w * r * gn.w};
        acc.x += xn.x; acc.y += xn.y; acc.z += xn.z; acc.w += xn.w;
        if (j == 0) self = xn;
    }
    const float inv = 1.f / (float)cnt;
    float4 o = {acc.x * inv - self.x, acc.y * inv - self.y, acc.z * inv - self.z, acc.w * inv - self.w};
    *(float4*)(pooled + (size_t)t * D + c) = o;
}

struct GemmP {
    const float* A; int lda; const float* B1; const float* B2; int ldb; float* C; int ldc; int M, N, K;
    const float* rowscale; const float* kgain;
    const float* R; int ldr; const float* cs; const float* rowgate; int rg_stride; int mode;
};
template <int MODE>
__global__ void __launch_bounds__(256) k_gemm(GemmP p) {
    __shared__ float As[16][68], Bs[16][68], Bs2[MODE == 2 ? 16 : 1][68];
    const int tx = threadIdx.x & 15, ty = threadIdx.x >> 4, m0 = blockIdx.y * 64, n0 = blockIdx.x * 64;
    float acc[4][4] = {}, acc2[4][4] = {};
    const int ar = threadIdx.x >> 2, ac = (threadIdx.x & 3) * 4;
    const int br = threadIdx.x >> 4, bc = (threadIdx.x & 15) * 4;
    const float rs = p.rowscale ? p.rowscale[m0 + ar] : 1.f;
    for (int k0 = 0; k0 < p.K; k0 += 16) {
        float4 a = *(const float4*)(p.A + (size_t)(m0 + ar) * p.lda + k0 + ac);
        if (p.kgain) { const float4 g = *(const float4*)(p.kgain + k0 + ac); a.x *= g.x; a.y *= g.y; a.z *= g.z; a.w *= g.w; }
        As[ac + 0][ar] = a.x * rs; As[ac + 1][ar] = a.y * rs; As[ac + 2][ar] = a.z * rs; As[ac + 3][ar] = a.w * rs;
        const float4 b = *(const float4*)(p.B1 + (size_t)(k0 + br) * p.ldb + n0 + bc);
        *(float4*)&Bs[br][bc] = b;
        if (MODE == 2) { const float4 b2 = *(const float4*)(p.B2 + (size_t)(k0 + br) * p.ldb + n0 + bc); *(float4*)&Bs2[br][bc] = b2; }
        __syncthreads();
#pragma unroll
        for (int k = 0; k < 16; ++k) {
            const float4 av = *(const float4*)&As[k][ty * 4]; const float4 bv = *(const float4*)&Bs[k][tx * 4];
            const float aa[4] = {av.x, av.y, av.z, av.w}, bb[4] = {bv.x, bv.y, bv.z, bv.w};
#pragma unroll
            for (int i = 0; i < 4; ++i)
#pragma unroll
                for (int j = 0; j < 4; ++j) acc[i][j] += aa[i] * bb[j];
            if (MODE == 2) { const float4 cv = *(const float4*)&Bs2[k][tx * 4]; const float cc[4] = {cv.x, cv.y, cv.z, cv.w};
#pragma unroll
                for (int i = 0; i < 4; ++i)
#pragma unroll
                    for (int j = 0; j < 4; ++j) acc2[i][j] += aa[i] * cc[j]; }
        }
        __syncthreads();
    }
#pragma unroll
    for (int i = 0; i < 4; ++i) {
        const int row = m0 + ty * 4 + i;
#pragma unroll
        for (int j = 0; j < 4; ++j) {
            const int col = n0 + tx * 4 + j; float v = acc[i][j];
            float* c = p.C + (size_t)row * p.ldc + col;
            if (MODE == 1) v = p.R[(size_t)row * p.ldr + col] + v * p.cs[col];
            if (MODE == 2) v = silu(v) * acc2[i][j];
            if (MODE == 3) v = p.R[(size_t)row * p.ldr + col] + v;
            if (MODE == 4) v = *c + p.rowgate[(size_t)row * p.rg_stride] * v;
            *c = v;
        }
    }
}

__device__ __forceinline__ int t5_bucket(int n) {
    if (n < 16) return n;
    int large = 16 + (int)(log((double)n / 16.0) / log(128.0) * 16.0);
    return large < 31 ? large : 31;
}

__global__ void k_attn(const float* __restrict__ q, const float* __restrict__ k, const float* __restrict__ v, const float* __restrict__ rel_bias,
                       float* __restrict__ acc, float* __restrict__ mbuf, float* __restrict__ lbuf, int g, int dil) {
    const int wid = blockIdx.x * 4 + (threadIdx.x >> 6), lane = threadIdx.x & 63;
    const int t = wid >> 4, h = wid & 15, s = t % S, i = s / dil;
    const float qv = q[(size_t)t * D + h * 64 + lane] * 0.125f;
    float m = g == 0 ? -1e30f : mbuf[wid], l = g == 0 ? 0.f : lbuf[wid], a = g == 0 ? 0.f : acc[(size_t)t * D + h * 64 + lane];
    const int mmax = i < 128 ? i : 128;
    for (int mm = 0; mm <= mmax; ++mm) {
        const int tk = t - mm * dil;
        const float kv = k[(size_t)tk * D + h * 64 + lane];
        float logit = wave_sum(qv * kv) + rel_bias[t5_bucket(mm * dil) * 48 + g * 16 + h];
        const float mn = fmaxf(m, logit), f = expf(m - mn), pexp = expf(logit - mn);
        l = l * f + pexp; a = a * f + pexp * v[(size_t)tk * D + h * 64 + lane]; m = mn;
    }
    if (g == 2) a = a / l;
    acc[(size_t)t * D + h * 64 + lane] = a;
    if (lane == 0) { mbuf[wid] = m; lbuf[wid] = l; }
}

__global__ void k_router(const float* __restrict__ h, const float* __restrict__ rstd, const float* __restrict__ gain, const float* __restrict__ wr, float* __restrict__ gates) {
    const int t = blockIdx.x * 4 + (threadIdx.x >> 6), lane = threadIdx.x & 63;
    float lg[8] = {};
    const float r = rstd[t];
    for (int j = 0; j < 16; ++j) {
        const int c = lane + 64 * j; const float xv = h[(size_t)t * D + c] * r * gain[c];
#pragma unroll
        for (int e = 0; e < 8; ++e) lg[e] += xv * wr[c * 8 + e];
    }
#pragma unroll
    for (int e = 0; e < 8; ++e) lg[e] = wave_sum(lg[e]);
    if (lane == 0) {
        float b1 = lg[0]; int i1 = 0;
#pragma unroll
        for (int e = 1; e < 8; ++e) if (lg[e] > b1) { b1 = lg[e]; i1 = e; }
        float b2 = -3.0e38f; int i2 = 0;
#pragma unroll
        for (int e = 0; e < 8; ++e) if (e != i1 && lg[e] > b2) { b2 = lg[e]; i2 = e; }
        const float e2 = expf(b2 - b1), g1 = 1.f / (1.f + e2), g2 = e2 / (1.f + e2);
        for (int e = 0; e < 8; ++e) gates[(size_t)t * 8 + e] = (e == i1) ? g1 : (e == i2) ? g2 : 0.f;
    }
}

__global__ void k_final(const float* h, const float* __restrict__ gain, float* out) {
    const int row = blockIdx.x * 4 + (threadIdx.x >> 6), lane = threadIdx.x & 63;
    const float4* p = (const float4*)(h + (size_t)row * D);
    float4 v[4]; float s = 0.f;
#pragma unroll
    for (int j = 0; j < 4; ++j) { v[j] = p[lane + 64 * j]; s += v[j].x * v[j].x + v[j].y * v[j].y + v[j].z * v[j].z + v[j].w * v[j].w; }
    s = wave_sum(s);
    const float r = 1.0f / sqrtf(s * (1.f / D) + EPS);
#pragma unroll
    for (int j = 0; j < 4; ++j) { const float4 g = *(const float4*)(gain + 4 * (lane + 64 * j));
        float4 o = {v[j].x * r * g.x, v[j].y * r * g.y, v[j].z * r * g.z, v[j].w * r * g.w};
        ((float4*)(out + (size_t)row * D))[lane + 64 * j] = o; }
}

template <int MODE> static void gemm(hipStream_t st, const GemmP& p) {
    hipLaunchKernelGGL(k_gemm<MODE>, dim3(p.N / 64, p.M / 64), dim3(256), 0, st, p);
}
}

namespace mk {
#define LAS __attribute__((address_space(3)))
#define GAS __attribute__((address_space(1)))
typedef unsigned short bf16_t;
typedef short bf16x8 __attribute__((ext_vector_type(8)));
typedef float f32x4 __attribute__((ext_vector_type(4)));
typedef float f32x2 __attribute__((ext_vector_type(2)));
typedef unsigned u32x4 __attribute__((ext_vector_type(4)));
typedef unsigned u32x2 __attribute__((ext_vector_type(2)));

constexpr int T = 16384, D = 1024, SEQ = 2048, NBATCH = 8;
constexpr int FF0 = 2816, FF1 = 3584, NE = 8, NQKV = 9216;
constexpr float EPS = 1e-6f;
constexpr int NWAVES = 8, NTHREADS = 512;

constexpr size_t MiB = 1u << 20;
constexpr size_t WS_CTL = 0, CTL_ZERO_BYTES = 1 * MiB;
constexpr size_t WS_SSQ = 1 * MiB;
constexpr size_t WS_LTOK = 2 * MiB;
constexpr size_t WS_LRS = 2 * MiB + 512 * 1024;
constexpr size_t WS_TOKINFO = 3 * MiB;
constexpr size_t WS_APT = 3 * MiB + 512 * 1024;
constexpr size_t WS_WGU0 = 4 * MiB;
constexpr size_t WS_WD0 = 15 * MiB;
constexpr size_t WS_WQKV = WS_WD0 + (size_t)D * FF0 * 2;
constexpr size_t WS_WO = WS_WQKV + (size_t)NQKV * D * 2;
constexpr size_t WS_S0 = 41 * MiB;
constexpr size_t WS_S1 = 73 * MiB;
constexpr size_t WS_POOL = 105 * MiB;
constexpr size_t WS_ACT0 = WS_POOL;
constexpr size_t WS_QKV = WS_POOL;
constexpr int CH_TILES = 34;
constexpr size_t ACT1_CHUNK = (size_t)CH_TILES * 256 * FF1 * 2;
constexpr size_t WS_ACT1 = WS_POOL;
constexpr size_t WS_Y = 224 * MiB;
constexpr size_t WS_WGU1 = 306 * MiB;
constexpr size_t WS_WD1 = 418 * MiB;
constexpr size_t WS_END = 474 * MiB;
static_assert(WS_WO + (size_t)D * D * 2 <= WS_S0, "small weights");
static_assert(WS_ACT1 + 2 * ACT1_CHUNK <= WS_Y && WS_Y + (size_t)34816 * D * 2 <= WS_WGU1, "moe map");
static_assert(WS_WGU1 + (size_t)NE * 7168 * D * 2 <= WS_WD1 && WS_WD1 + (size_t)NE * D * FF1 * 2 <= WS_END, "moe weights");
static_assert(WS_QKV + (size_t)T * NQKV * 2 <= WS_END, "qkv");

constexpr int CW_TMO = 0;
constexpr int CW_CNT = 64;
constexpr int CW_Q = 128;
constexpr int CW_BAR = 4096;

constexpr int RING_OFF = 0, RING_BYTES = 131072;
constexpr int MISC_OFF = RING_BYTES;
constexpr int RTAB_OFF = MISC_OFF + 1024;
constexpr int SCR_OFF = MISC_OFF + 2048;
constexpr int LDS_BYTES = 147456;

#define RLX_AGENT __ATOMIC_RELAXED, __HIP_MEMORY_SCOPE_AGENT
#define LDS_WAIT() asm volatile("s_waitcnt lgkmcnt(0)" ::: "memory")
#define VM_WAIT() asm volatile("s_waitcnt vmcnt(0)" ::: "memory")
__device__ __forceinline__ unsigned f2bf(float f) { unsigned u = __builtin_bit_cast(unsigned, f); return (u + 0x7fffu + ((u >> 16) & 1u)) >> 16; }
__device__ __forceinline__ unsigned pk2(float lo, float hi) { return f2bf(lo) | (f2bf(hi) << 16); }
__device__ __forceinline__ unsigned cvt_pk_bf16(float lo, float hi) { unsigned r; asm volatile("v_cvt_pk_bf16_f32 %0, %1, %2" : "=v"(r) : "v"(lo), "v"(hi)); return r; }
__device__ __forceinline__ float bf2f(unsigned short b) { return __builtin_bit_cast(float, ((unsigned)b) << 16); }
__device__ __forceinline__ float wave_sum(float v) {
#pragma unroll
    for (int o = 1; o < 64; o <<= 1) v += __shfl_xor(v, o);
    return v;
}
__device__ __forceinline__ float silu_f(float x) { return x * __builtin_amdgcn_rcpf(1.f + __builtin_amdgcn_exp2f(-1.4426950408889634f * x)); }
#define XB_TMO      128
#define XB_XCNT(j)  (256  + 64 * (j))
#define XB_XSUB(j)  (1280 + 64 * (j))
#define XB_XGEN(j)  (2304 + 64 * (j))
#define XB_TOP      3328
#define XB_TOPGEN   3392
#define XCD_BAR_WORDS 3456
#define XB_SPIN_CAP (1u << 18)
__device__ __forceinline__ unsigned xb_ld(unsigned* p)              { return __hip_atomic_load(p, __ATOMIC_RELAXED, __HIP_MEMORY_SCOPE_AGENT); }
__device__ __forceinline__ unsigned xb_add(unsigned* p, unsigned v) { return __hip_atomic_fetch_add(p, v, __ATOMIC_RELAXED, __HIP_MEMORY_SCOPE_AGENT); }
__device__ __forceinline__ unsigned xb_xcc_id() { return (unsigned)__builtin_amdgcn_s_getreg((3 << 11) | 20) & 0xFu; }
#define XB_SPIN(cond, bar) do { unsigned _sp = 0; while (cond) { __builtin_amdgcn_s_sleep(1); \
    if ((++_sp & 255u) == 0u) { if (xb_ld(&(bar)[XB_TMO])) break; if (_sp > XB_SPIN_CAP) { atomicAdd(&(bar)[XB_TMO], 1u); break; } } } } while (0)
struct XcdBarrier { unsigned* bar; unsigned x; volatile LAS unsigned* st; };
__device__ __forceinline__ XcdBarrier xcd_barrier_post(unsigned* bar, volatile LAS unsigned* st) {
    XcdBarrier b; b.bar = bar; b.x = xb_xcc_id(); b.st = st;
    if (threadIdx.x == 0) (void)xb_add(&bar[XB_XCNT(b.x)], 1u);
    return b;
}
__device__ __forceinline__ void xcd_barrier_complete(unsigned* bar, unsigned x, unsigned& nloc, unsigned& nx) {
    const unsigned G = gridDim.x * gridDim.y * gridDim.z;
    unsigned sum, cnt, mine, sp = 0u;
    for (;;) {
        sum = 0u; cnt = 0u; mine = 0u;
#pragma unroll
        for (unsigned j = 0; j < 16; ++j) { const unsigned c = xb_ld(&bar[XB_XCNT(j)]); sum += c; cnt += (c > 0u) ? 1u : 0u; mine = (j == x) ? c : mine; }
        if (sum == G) break;
        __builtin_amdgcn_s_sleep(1);
        if ((++sp & 255u) == 0u) { if (xb_ld(&bar[XB_TMO])) break; if (sp > XB_SPIN_CAP) { atomicAdd(&bar[XB_TMO], 1u); break; } }
    }
    nloc = mine > 0u ? mine : 1u; nx = cnt > 0u ? cnt : 1u;
}
__device__ __forceinline__ void xcd_barrier(const XcdBarrier& b) {
    asm volatile("s_waitcnt vmcnt(0)" ::: "memory");
    __syncthreads();
    if (threadIdx.x == 0) {
        unsigned* bar = b.bar;
        __builtin_amdgcn_s_waitcnt(0);
        unsigned nloc = b.st[0], nx = b.st[1];
        if (nloc == 0u) { xcd_barrier_complete(bar, b.x, nloc, nx); b.st[0] = nloc; b.st[1] = nx; }
        const unsigned old = xb_add(&bar[XB_XSUB(b.x)], 1u);
        const unsigned gen = old / nloc;
        if (old + 1u == (gen + 1u) * nloc) {
            __builtin_amdgcn_fence(__ATOMIC_RELEASE, "agent");
            asm volatile("s_waitcnt vmcnt(0)" ::: "memory");
            const unsigned og = xb_add(&bar[XB_TOP], 1u);
            const unsigned tg = og / nx;
            if (og + 1u == (tg + 1u) * nx) xb_add(&bar[XB_TOPGEN], 1u);
            else XB_SPIN(xb_ld(&bar[XB_TOPGEN]) == tg, bar);
            __builtin_amdgcn_fence(__ATOMIC_ACQUIRE, "agent");
            xb_add(&bar[XB_XGEN(b.x)], 1u);
            asm volatile("s_waitcnt vmcnt(0)" ::: "memory");
        } else {
            XB_SPIN(xb_ld(&bar[XB_XGEN(b.x)]) == gen, bar);
            __builtin_amdgcn_fence(__ATOMIC_ACQUIRE, "agent");
            asm volatile("s_waitcnt vmcnt(0)" ::: "memory");
        }
    }
    __syncthreads();
}
namespace pg8 {
constexpr int BM = 256, BK = 64, HALF = 128, HTB = HALF * BK * 2, STAGE_BYTES = 8 * HTB, NXCD = 8, WGM = 8;
__host__ __device__ __forceinline__ int lds_byte(int r, int c) { const int st = (r >> 4) * 2 + (c >> 5), rr = r & 15, cc = c & 31, ob = rr * 64 + cc * 2; return st * 1024 + (ob ^ (((ob >> 9) & 1) << 5)); }
__host__ __device__ __forceinline__ void stage_rc(int b, int& R, int& C) { const int st = b / 1024, sb = b % 1024, swz = sb ^ (((sb >> 9) & 1) << 5); R = (st >> 1) * 16 + swz / 64; C = (st & 1) * 32 + (swz % 64) / 2; }
__host__ __device__ __forceinline__ int perm32(int rho) { const int n = rho >> 4, i = rho & 15; return 8 * (i >> 2) + 4 * n + (i & 3); }

struct Unit { int pm, pn, arow, brow, e, orow; };
struct Gemm { const bf16_t* A; const bf16_t* Bt; int K; };

struct StaticOrder {
    int nM, nN, nwg, G, c;
    __device__ void init(int M, int N, int G_, int c_) { nM = M / BM; nN = N / BM; nwg = nM * nN; G = G_; c = c_; }
    __device__ __forceinline__ void start() const {}
    __device__ __forceinline__ bool next(int i, Unit& u) const {
        const long L = (long)i * G + c; if (L >= nwg) return false;
        int wgid = (int)L; { const int q = nwg / NXCD, r = nwg % NXCD, xcd = wgid % NXCD, off = wgid / NXCD; wgid = (xcd < r ? xcd * (q + 1) : r * (q + 1) + (xcd - r) * q) + off; }
        const int nig = WGM * nN, gid = wgid / nig, fm = gid * WGM, gsz = (nM - fm) < WGM ? (nM - fm) : WGM;
        u.pm = fm + ((wgid % nig) % gsz); u.pn = (wgid % nig) / gsz; u.arow = u.pm * BM; u.brow = u.pn * BM; u.e = 0; u.orow = u.arow; return true;
    }
    __device__ __forceinline__ void refill(int) const {}
    __device__ __forceinline__ unsigned gather_row(const Unit&, int) const { return 0u; }
};

template <class Epi, class Sched, bool GATHER>
__device__ __forceinline__ void gemm_phase(LAS unsigned char* lds, const Gemm g, Sched& S, const Epi& E) {
    const int tid = threadIdx.x, wid = __builtin_amdgcn_readfirstlane(tid >> 6), lane = tid & 63, wr = wid >> 2, wc = wid & 3, fr = lane & 15, fq = lane >> 4;
    const int K = g.K, nt = K / BK;
    unsigned voffB[2]; unsigned va[2][2];
    const size_t kstep = (size_t)(BK * 2);
    const size_t hstep = (size_t)HALF * K * 2;
#pragma unroll
    for (int i = 0; i < 2; ++i) { int R, C; stage_rc(tid * 16 + i * 8192, R, C); const int Rb = Epi::PERM ? ((R & ~31) + perm32(R & 31)) : R;
        voffB[i] = (unsigned)(Rb * K + C) * 2u;
        va[0][i] = (unsigned)(R * K + C) * 2u; va[1][i] = va[0][i] + (unsigned)hstep; }
    const unsigned ldsw = (unsigned)wid * 1024u;
    const int aoff = lds_byte(wr * 64 + fr, fq * 8), boff = lds_byte(wc * 32 + fr, fq * 8);
#define PG8_SA(b, h) (((b) * 2 + (h)) * HTB)
#define PG8_SB(b, h) ((4 + (b) * 2 + (h)) * HTB)
#define PG8_STAGEB(bufoff, gbase) do { _Pragma("unroll") for (int _i = 0; _i < 2; ++_i) \
        __builtin_amdgcn_global_load_lds((const unsigned*)((const char*)(gbase) + voffB[_i]), (LAS unsigned*)(lds + (bufoff) + ldsw + _i * 8192), 16, 0, 0); } while (0)
#define PG8_STAGEA(bufoff, gbase, vo, h) do { _Pragma("unroll") for (int _i = 0; _i < 2; ++_i) \
        __builtin_amdgcn_global_load_lds((const unsigned*)((const char*)(gbase) + (vo)[h][_i]), (LAS unsigned*)(lds + (bufoff) + ldsw + _i * 8192), 16, 0, 0); } while (0)
#define PG8_LDA(dst, b, h) do { _Pragma("unroll") for (int m = 0; m < 4; ++m) _Pragma("unroll") for (int k = 0; k < 2; ++k) dst[m][k] = *(const LAS bf16x8*)(lds + PG8_SA(b, h) + aoff + m * 2048 + k * 1024); } while (0)
#define PG8_LDB(dst, b, h) do { _Pragma("unroll") for (int n = 0; n < 2; ++n) _Pragma("unroll") for (int k = 0; k < 2; ++k) dst[n][k] = *(const LAS bf16x8*)(lds + PG8_SB(b, h) + boff + n * 2048 + k * 1024); } while (0)
#define PG8_MMA(ai, bj, At, Bt) do { __builtin_amdgcn_s_setprio(1); _Pragma("unroll") for (int m = 0; m < 4; ++m) _Pragma("unroll") for (int n = 0; n < 2; ++n) _Pragma("unroll") for (int k = 0; k < 2; ++k) \
        acc[ai][bj][m][n] = __builtin_amdgcn_mfma_f32_16x16x32_bf16(Bt[n][k], At[m][k], acc[ai][bj][m][n], 0, 0, 0); __builtin_amdgcn_s_setprio(0); } while (0)
#define PG8_WAIT_V(n) asm volatile("s_waitcnt vmcnt(" #n ")" ::: "memory")
#define PG8_WAIT_L(n) asm volatile("s_waitcnt lgkmcnt(" #n ")" ::: "memory")
#define PG8_BAR __builtin_amdgcn_s_barrier()
#define PG8_SCHED __builtin_amdgcn_sched_barrier(0)
    Unit cur, nxt; int ui = 0;
    S.start();
    if (!S.next(0, cur)) return;
    f32x4 acc[2][2][4][2];
#pragma unroll
    for (int a = 0; a < 2; ++a)
#pragma unroll
        for (int b = 0; b < 2; ++b)
#pragma unroll
            for (int m = 0; m < 4; ++m)
#pragma unroll
                for (int n = 0; n < 2; ++n) acc[a][b][m][n] = (f32x4){0.f, 0.f, 0.f, 0.f};
    bf16x8 At[4][2], B0[2][2], B1[2][2];
    const char* cA; const char* cB = (const char*)g.Bt + (size_t)cur.brow * K * 2;
    if constexpr (GATHER) { cA = (const char*)g.A;
#pragma unroll
        for (int h = 0; h < 2; ++h)
#pragma unroll
            for (int i = 0; i < 2; ++i) { int R, C; stage_rc(tid * 16 + i * 8192, R, C); va[h][i] = (S.gather_row(cur, h * HALF + R) * (unsigned)K + (unsigned)C) * 2u; }
    } else cA = (const char*)g.A + (size_t)cur.arow * K * 2;
    PG8_STAGEB(PG8_SB(0, 0), cB); PG8_STAGEB(PG8_SB(0, 1), cB + hstep); PG8_STAGEA(PG8_SA(0, 0), cA, va, 0); PG8_STAGEA(PG8_SA(0, 1), cA, va, 1);
    if (wr == 1) PG8_BAR;
    PG8_WAIT_V(2); PG8_BAR;
    PG8_STAGEB(PG8_SB(1, 0), cB + kstep); PG8_STAGEA(PG8_SA(1, 0), cA + kstep, va, 0); PG8_STAGEB(PG8_SB(1, 1), cB + hstep + kstep);
    PG8_WAIT_V(6); PG8_BAR;
    for (;;) {
        bool has_next = false; const char* nA = cA; const char* nB = cB;
        unsigned vnx[2][2] = {{0u, 0u}, {0u, 0u}};
        for (int t = 0; t < nt; t += 2) {
            const bool last = (t == nt - 2);
            unsigned v2[2][2];
#pragma unroll
            for (int h = 0; h < 2; ++h)
#pragma unroll
                for (int i = 0; i < 2; ++i) v2[h][i] = va[h][i];
            if (last) {
                has_next = S.next(ui + 1, nxt);
                if (has_next) { nB = (const char*)g.Bt + (size_t)nxt.brow * K * 2;
                    if constexpr (GATHER) {
#pragma unroll
                        for (int h = 0; h < 2; ++h)
#pragma unroll
                            for (int i = 0; i < 2; ++i) { int R, C; stage_rc(tid * 16 + i * 8192, R, C); v2[h][i] = (S.gather_row(nxt, h * HALF + R) * (unsigned)K + (unsigned)C) * 2u; }
                    } else nA = (const char*)g.A + (size_t)nxt.arow * K * 2;
                }
            }
            if constexpr (GATHER) { if (last) {
#pragma unroll
                for (int h = 0; h < 2; ++h)
#pragma unroll
                    for (int i = 0; i < 2; ++i) vnx[h][i] = v2[h][i]; } }
            const char* a1 = cA + (size_t)(t + 1) * kstep;
            const char* a2 = last ? nA : cA + (size_t)(t + 2) * kstep; const char* b2 = last ? nB : cB + (size_t)(t + 2) * kstep;
            const char* a3 = a2 + kstep; const char* b3 = b2 + kstep;
            PG8_LDB(B0, 0, 0); PG8_LDB(B1, 0, 1); PG8_SCHED; PG8_LDA(At, 0, 0); PG8_STAGEA(PG8_SA(1, 1), a1, va, 1);
            PG8_WAIT_V(8); PG8_WAIT_L(0); PG8_BAR; PG8_MMA(0, 0, At, B0); PG8_MMA(0, 1, At, B1); PG8_BAR; PG8_SCHED;
            PG8_LDA(At, 0, 1); PG8_STAGEB(PG8_SB(0, 0), b2); PG8_STAGEB(PG8_SB(0, 1), b2 + hstep); PG8_STAGEA(PG8_SA(0, 0), a2, v2, 0);
            PG8_WAIT_V(8); PG8_WAIT_L(0); PG8_BAR; PG8_MMA(1, 0, At, B0); PG8_MMA(1, 1, At, B1); PG8_BAR; PG8_SCHED;
            PG8_LDB(B0, 1, 0); PG8_LDB(B1, 1, 1); PG8_SCHED; PG8_LDA(At, 1, 0); PG8_STAGEA(PG8_SA(0, 1), a2, v2, 1);
            PG8_WAIT_V(8); PG8_WAIT_L(0); PG8_BAR; PG8_MMA(0, 0, At, B0); PG8_MMA(0, 1, At, B1); PG8_BAR; PG8_SCHED;
            PG8_LDA(At, 1, 1); PG8_STAGEB(PG8_SB(1, 0), b3); PG8_STAGEB(PG8_SB(1, 1), b3 + hstep); PG8_STAGEA(PG8_SA(1, 0), a3, v2, 0);
            PG8_WAIT_V(8); PG8_WAIT_L(0); PG8_BAR; PG8_MMA(1, 0, At, B0); PG8_MMA(1, 1, At, B1); PG8_BAR; PG8_SCHED;
        }
        if (wr == 0) PG8_BAR;
        S.refill(ui);
        E(acc, cur, wr, wc, fr, fq, lds);
        if (!has_next) break;
#pragma unroll
        for (int a = 0; a < 2; ++a)
#pragma unroll
            for (int b = 0; b < 2; ++b)
#pragma unroll
                for (int m = 0; m < 4; ++m)
#pragma unroll
                    for (int n = 0; n < 2; ++n) acc[a][b][m][n] = (f32x4){0.f, 0.f, 0.f, 0.f};
        cur = nxt; cA = nA; cB = nB; ++ui;
        if constexpr (GATHER) {
#pragma unroll
            for (int h = 0; h < 2; ++h)
#pragma unroll
                for (int i = 0; i < 2; ++i) va[h][i] = vnx[h][i];
        }
        if (wr == 1) PG8_BAR;
    }
    PG8_WAIT_V(0);
    PG8_BAR;
#undef PG8_SA
#undef PG8_SB
#undef PG8_STAGEA
#undef PG8_STAGEB
#undef PG8_LDA
#undef PG8_LDB
#undef PG8_MMA
#undef PG8_WAIT_V
#undef PG8_WAIT_L
#undef PG8_BAR
#undef PG8_SCHED
}
}
struct EpiSwiGLU {
    static constexpr bool PERM = true;
    bf16_t* O; int ldo; const float* lrs;
    __device__ __forceinline__ void operator()(const f32x4 (&acc)[2][2][4][2], const pg8::Unit& u, int wr, int wc, int fr, int fq, LAS unsigned char*) const {
        const int r0 = wr * 64 + fr, col0 = u.pn * 128 + wc * 32 + 8 * fq;
#pragma unroll
        for (int ai = 0; ai < 2; ++ai) {
            float rs[4];
#pragma unroll
            for (int m = 0; m < 4; ++m) rs[m] = lrs ? lrs[(size_t)u.e * T + u.arow + ai * 128 + m * 16 + r0] : 1.f;
#pragma unroll
            for (int m = 0; m < 4; ++m) {
                const float s = rs[m]; float o[8];
#pragma unroll
                for (int n = 0; n < 2; ++n)
#pragma unroll
                    for (int j = 0; j < 4; ++j) { const float gv = acc[ai][0][m][n][j] * s, uv = acc[ai][1][m][n][j] * s; o[n * 4 + j] = silu_f(gv) * uv; }
                u32x4 w; w.x = cvt_pk_bf16(o[0], o[1]); w.y = cvt_pk_bf16(o[2], o[3]); w.z = cvt_pk_bf16(o[4], o[5]); w.w = cvt_pk_bf16(o[6], o[7]);
                *(u32x4*)(O + (size_t)(u.orow + ai * 128 + m * 16 + r0) * ldo + col0) = w;
            }
        }
    }
};
struct EpiRes {
    static constexpr bool PERM = false;
    float* H; bf16_t* HB; float* ssq;
    __device__ __forceinline__ void operator()(const f32x4 (&acc)[2][2][4][2], const pg8::Unit& u, int wr, int wc, int fr, int fq, LAS unsigned char*) const {
        const int r0 = u.orow + wr * 64 + fr, col0 = u.pn * 256 + wc * 32 + 4 * fq;
#pragma unroll
        for (int ai = 0; ai < 2; ++ai)
#pragma unroll
            for (int m = 0; m < 4; ++m) {
                const size_t off = (size_t)(r0 + ai * 128 + m * 16) * D + col0; float sq = 0.f;
#pragma unroll
                for (int bj = 0; bj < 2; ++bj)
#pragma unroll
                    for (int n = 0; n < 2; ++n) {
                        const f32x4 hv = *(const f32x4*)(H + off + bj * 128 + n * 16) + acc[ai][bj][m][n];
                        *(f32x4*)(H + off + bj * 128 + n * 16) = hv;
                        u32x2 w; w.x = cvt_pk_bf16(hv[0], hv[1]); w.y = cvt_pk_bf16(hv[2], hv[3]);
                        *(u32x2*)(HB + off + bj * 128 + n * 16) = w;
                        sq += (hv[0] * hv[0] + hv[1] * hv[1]) + (hv[2] * hv[2] + hv[3] * hv[3]);
                    }
                if (ssq) { sq += __shfl_xor(sq, 16); sq += __shfl_xor(sq, 32);
                    if (fq == 0) ssq[(size_t)(r0 + ai * 128 + m * 16) * 16 + u.pn * 4 + wc] = sq; }
            }
    }
};
struct EpiQKV {
    static constexpr bool PERM = true;
    bf16_t* O; const float* ssq;
    __device__ __forceinline__ void operator()(const f32x4 (&acc)[2][2][4][2], const pg8::Unit& u, int wr, int wc, int fr, int fq, LAS unsigned char* lds) const {
        LAS float* rtab = (LAS float*)(lds + RTAB_OFF);
        { const int tid = threadIdx.x, row = tid >> 1, part = tid & 1;
          const f32x4* p = (const f32x4*)(ssq + (size_t)(u.orow + row) * 16 + part * 8);
          const f32x4 a = p[0], b = p[1]; float s = ((a[0] + a[1]) + (a[2] + a[3])) + ((b[0] + b[1]) + (b[2] + b[3]));
          s += __shfl_xor(s, 1);
          if (part == 0) rtab[row] = 1.0f / sqrtf(s * (1.f / D) + EPS); }
        asm volatile("s_waitcnt lgkmcnt(0)" ::: "memory"); __builtin_amdgcn_s_barrier(); asm volatile("" ::: "memory");
        const float qs = (u.pn * 256 < 3072) ? 0.125f : 1.f;
        const int r0 = wr * 64 + fr, col0 = u.pn * 256 + wc * 32 + 8 * fq;
#pragma unroll
        for (int ai = 0; ai < 2; ++ai)
#pragma unroll
            for (int m = 0; m < 4; ++m) {
                const float s = rtab[ai * 128 + m * 16 + r0] * qs;
#pragma unroll
                for (int bj = 0; bj < 2; ++bj) {
                    const f32x4 v0 = acc[ai][bj][m][0] * s, v1 = acc[ai][bj][m][1] * s;
                    u32x4 w; w.x = cvt_pk_bf16(v0[0], v0[1]); w.y = cvt_pk_bf16(v0[2], v0[3]); w.z = cvt_pk_bf16(v1[0], v1[1]); w.w = cvt_pk_bf16(v1[2], v1[3]);
                    *(u32x4*)(O + (size_t)(u.orow + ai * 128 + m * 16 + r0) * NQKV + col0 + bj * 128) = w;
                }
            }
    }
};
struct EpiY {
    static constexpr bool PERM = true;
    bf16_t* Y;
    __device__ __forceinline__ void operator()(const f32x4 (&acc)[2][2][4][2], const pg8::Unit& u, int wr, int wc, int fr, int fq, LAS unsigned char*) const {
        const int r0 = u.orow + wr * 64 + fr, col0 = u.pn * 256 + wc * 32 + 8 * fq;
#pragma unroll
        for (int ai = 0; ai < 2; ++ai)
#pragma unroll
            for (int m = 0; m < 4; ++m)
#pragma unroll
                for (int bj = 0; bj < 2; ++bj) {
                    const f32x4 v0 = acc[ai][bj][m][0], v1 = acc[ai][bj][m][1];
                    u32x4 w; w.x = cvt_pk_bf16(v0[0], v0[1]); w.y = cvt_pk_bf16(v0[2], v0[3]); w.z = cvt_pk_bf16(v1[0], v1[1]); w.w = cvt_pk_bf16(v1[2], v1[3]);
                    *(u32x4*)(Y + (size_t)(r0 + ai * 128 + m * 16) * D + col0 + bj * 128) = w;
                }
    }
};

constexpr int MI_CNT = 0, MI_TB = 8, MI_NT = 17;
__device__ __forceinline__ void moe_info_build(LAS unsigned char* lds, const unsigned* ctl) {
    volatile LAS int* mi = (volatile LAS int*)(lds + SCR_OFF);
    if (threadIdx.x == 0) { int tb = 0;
        for (int e = 0; e < NE; ++e) { const int c = (int)__hip_atomic_load(ctl + CW_CNT + e, RLX_AGENT); mi[MI_CNT + e] = c; mi[MI_TB + e] = tb; tb += (c + 255) >> 8; }
        mi[MI_TB + NE] = tb; mi[MI_NT] = tb; }
    LDS_WAIT(); __syncthreads();
}
struct DynQ {
    unsigned* ctr; volatile LAS unsigned* slot;
    __device__ __forceinline__ void start() const { if (threadIdx.x == 0) { slot[0] = atomicAdd(ctr, 1u); slot[1] = atomicAdd(ctr, 1u); } LDS_WAIT(); __syncthreads(); }
#ifdef MK_STATICQ
    __device__ __forceinline__ int fetch(int i) const { return i * (int)gridDim.x + (int)blockIdx.x; }
#else
    __device__ __forceinline__ int fetch(int i) const { return __builtin_amdgcn_readfirstlane((int)slot[i & 3]); }
#endif
    __device__ __forceinline__ void refill(int ui) const { if (threadIdx.x == 0) { slot[(ui + 2) & 3] = atomicAdd(ctr, 1u); } }
};
template <int NN, bool G1>
struct MoeOrder {
    DynQ q; volatile LAS int* mi; int c0, ntc; const int* ltok;
    __device__ __forceinline__ void start() const { q.start(); }
    __device__ __forceinline__ void refill(int ui) const { q.refill(ui); }
    __device__ __forceinline__ bool next(int i, pg8::Unit& u) const {
        const int idx = q.fetch(i); if (idx >= ntc * NN) return false;
        const int grp = idx / (8 * NN), r = idx - grp * (8 * NN), gsz = (ntc - grp * 8) < 8 ? (ntc - grp * 8) : 8;
        const int pml = grp * 8 + r % gsz, pn = r / gsz, pmg = c0 + pml;
        int e = 0;
#pragma unroll
        for (int k = 1; k < NE; ++k) e += (pmg >= mi[MI_TB + k]) ? 1 : 0;
        e = __builtin_amdgcn_readfirstlane(e);
        u.pm = pmg; u.pn = pn; u.e = e;
        if (G1) { u.arow = (pmg - __builtin_amdgcn_readfirstlane(mi[MI_TB + e])) * 256; u.brow = e * (2 * FF1) + pn * 256; u.orow = pml * 256; }
        else { u.arow = pml * 256; u.brow = e * D + pn * 256; u.orow = pmg * 256; }
        return true;
    }
    __device__ __forceinline__ unsigned gather_row(const pg8::Unit& u, int r) const {
        const int lr = u.arow + r; const int c = mi[MI_CNT + u.e];
        return lr < c ? (unsigned)ltok[(size_t)u.e * T + lr] : 0u;
    }
};
struct Args { const float* in[19]; float* out; unsigned char* ws; int ph_lo, ph_hi, li, pad; };
enum { I_X = 0, I_ANORM, I_APROJ, I_ASCALE, I_KVNORM, I_WKV, I_BNORM, I_WQ, I_WO, I_RELB, I_FFNORM, I_DWG, I_DWU, I_DWD, I_ROUTER, I_MWG, I_MWU, I_MWD, I_FNORM };
struct Frame {
    LAS unsigned char* lds; unsigned* ctl; int tid, lane, wave, G, bid;
    float* h; unsigned char* ws;
};
__device__ __forceinline__ void conv_item(const float* W, int ldw, const float* gain, bf16_t* WT, int K, int dst_row0, LAS float* scr, int k0, int n0, int lane) {
#pragma unroll 8
    for (int i = 0; i < 32; ++i) { const int kk = 2 * i + (lane >> 5); float v = W[(size_t)(k0 + kk) * ldw + n0 + (lane & 31)]; if (gain) v *= gain[k0 + kk]; scr[kk * 33 + (lane & 31)] = v; }
    LDS_WAIT(); asm volatile("" ::: "memory");
    const int c = lane & 7;
#pragma unroll
    for (int j = 0; j < 4; ++j) { const int n = (lane >> 3) + 8 * j; const LAS float* s = scr + (8 * c) * 33 + n;
        u32x4 o; o.x = pk2(s[0 * 33], s[1 * 33]); o.y = pk2(s[2 * 33], s[3 * 33]); o.z = pk2(s[4 * 33], s[5 * 33]); o.w = pk2(s[6 * 33], s[7 * 33]);
        *(u32x4*)(WT + (size_t)(dst_row0 + n) * K + k0 + 8 * c) = o; }
    LDS_WAIT(); asm volatile("" ::: "memory");
}
__device__ __forceinline__ void conv_job(const Frame& F, int& it0, const float* W, int K, int N, int ldw, const float* gain, bf16_t* WT, int mode, int row_off, LAS float* scr) {
    const int nblk = N / 32, items = (K / 64) * nblk, NGW = F.G * NWAVES;
    int it = it0;
    for (; it < items; it += NGW) {
        const int kb = it / nblk, nb = it - kb * nblk, n0 = nb * 32;
        const int dr = (mode == 0) ? (row_off + n0) : (row_off + (n0 >> 7) * 256 + (n0 & 127) + (mode == 2 ? 128 : 0));
        conv_item(W, ldw, gain, WT, K, dr, scr, kb * 64, n0, F.lane);
    }
    it0 = it - items;
}
__device__ __forceinline__ void conv_small(const Frame& F, const Args& A) {
    LAS float* scr = (LAS float*)(F.lds + RING_OFF + F.wave * 16384);
    int it = F.bid * NWAVES + F.wave;
    unsigned char* ws = F.ws;
    for (int g = 0; g < 4; ++g) conv_job(F, it, A.in[I_APROJ] + (size_t)g * 65536, 256, 256, 256, nullptr, (bf16_t*)(ws + WS_APT) + (size_t)g * 65536, 0, 0, scr);
    conv_job(F, it, A.in[I_DWG], D, FF0, FF0, nullptr, (bf16_t*)(ws + WS_WGU0), 1, 0, scr);
    conv_job(F, it, A.in[I_DWU], D, FF0, FF0, nullptr, (bf16_t*)(ws + WS_WGU0), 2, 0, scr);
    conv_job(F, it, A.in[I_DWD], FF0, D, D, nullptr, (bf16_t*)(ws + WS_WD0), 0, 0, scr);
    conv_job(F, it, A.in[I_WQ], D, 3072, 3072, A.in[I_BNORM], (bf16_t*)(ws + WS_WQKV), 0, 0, scr);
    conv_job(F, it, A.in[I_WKV], D, 6144, 6144, A.in[I_KVNORM], (bf16_t*)(ws + WS_WQKV), 0, 3072, scr);
    conv_job(F, it, A.in[I_WO], D, D, D, nullptr, (bf16_t*)(ws + WS_WO), 0, 0, scr);
}
__device__ __forceinline__ void conv_moe(const Frame& F, const Args& A) {
    LAS float* scr = (LAS float*)(F.lds + RING_OFF + F.wave * 16384);
    int it = F.bid * NWAVES + F.wave;
    unsigned char* ws = F.ws;
    for (int e = 0; e < NE; ++e) {
        conv_job(F, it, A.in[I_MWG] + (size_t)e * D * FF1, D, FF1, FF1, A.in[I_FFNORM] + D, (bf16_t*)(ws + WS_WGU1) + (size_t)e * 2 * FF1 * D, 1, 0, scr);
        conv_job(F, it, A.in[I_MWU] + (size_t)e * D * FF1, D, FF1, FF1, A.in[I_FFNORM] + D, (bf16_t*)(ws + WS_WGU1) + (size_t)e * 2 * FF1 * D, 2, 0, scr);
        conv_job(F, it, A.in[I_MWD] + (size_t)e * FF1 * D, FF1, D, D, nullptr, (bf16_t*)(ws + WS_WD1) + (size_t)e * D * FF1, 0, 0, scr);
    }
}

__device__ __forceinline__ void mixer_phase(const Frame& F, const Args& A) {
    LAS float* rs = (LAS float*)(F.lds + 0);
    LAS float* xn = (LAS float*)(F.lds + 512);
    LAS bf16_t* pl = (LAS bf16_t*)(F.lds + 512 + 80896);
    LAS float* sw = (LAS float*)(F.lds + 512 + 80896 + 33792);
    const int lane = F.lane, w = F.wave, tid = F.tid, fr = lane & 15, fq = lane >> 4;
    const bf16_t* apt = (const bf16_t*)(F.ws + WS_APT);
    bf16_t* hn0 = (bf16_t*)(F.ws + WS_S0);
    for (int tile = F.bid; tile < T / 64; tile += F.G) {
        const int t0 = tile * 64, s0 = t0 % SEQ, halo = s0 ? 15 : 0, nrows = 64 + halo;
        for (int j = w; j < nrows; j += NWAVES) {
            const f32x4* p = (const f32x4*)(A.in[I_X] + (size_t)(t0 - halo + j) * D); float s = 0.f;
#pragma unroll
            for (int q = 0; q < 4; ++q) { const f32x4 v = p[lane + 64 * q]; s += (v[0] * v[0] + v[1] * v[1]) + (v[2] * v[2] + v[3] * v[3]); }
            s = wave_sum(s);
            if (lane == 0) rs[j] = 1.0f / sqrtf(s * (1.f / D) + EPS);
        }
        LDS_WAIT(); __syncthreads();
        float ss[4] = {0.f, 0.f, 0.f, 0.f};
        for (int g = 0; g < 4; ++g) {
            { const f32x4 gn = *(const f32x4*)(A.in[I_ANORM] + g * 256 + 4 * lane);
              for (int j = w; j < nrows; j += NWAVES) {
                  const f32x4 v = *(const f32x4*)(A.in[I_X] + (size_t)(t0 - halo + j) * D + g * 256 + 4 * lane); const float r = rs[j];
                  *(LAS f32x4*)(xn + j * 256 + 4 * lane) = (f32x4){v[0] * r * gn[0], v[1] * r * gn[1], v[2] * r * gn[2], v[3] * r * gn[3]}; } }
            LDS_WAIT(); __syncthreads();
            { const int c4 = (tid & 63) * 4, win = 2 << g;
#pragma unroll 1
              for (int i = 0; i < 8; ++i) { const int r = (tid >> 6) + 8 * i, s = s0 + r, cnt = (s + 1 < win) ? (s + 1) : win;
                  f32x4 a = {0.f, 0.f, 0.f, 0.f};
                  for (int jj = 0; jj < cnt; ++jj) a += *(const LAS f32x4*)(xn + (halo + r - jj) * 256 + c4);
                  const f32x4 self = *(const LAS f32x4*)(xn + (halo + r) * 256 + c4); const float inv = 1.f / (float)cnt;
                  u32x2 o; o.x = pk2(a[0] * inv - self[0], a[1] * inv - self[1]); o.y = pk2(a[2] * inv - self[2], a[3] * inv - self[3]);
                  *(LAS u32x2*)(pl + r * 264 + c4) = o; } }
            LDS_WAIT(); __syncthreads();
            f32x4 acc[4][2];
#pragma unroll
            for (int m = 0; m < 4; ++m) { acc[m][0] = (f32x4){0.f, 0.f, 0.f, 0.f}; acc[m][1] = (f32x4){0.f, 0.f, 0.f, 0.f}; }
#pragma unroll
            for (int ks = 0; ks < 8; ++ks) {
                bf16x8 bfr[2], afr[4];
#pragma unroll
                for (int n = 0; n < 2; ++n) bfr[n] = *(const bf16x8*)(apt + (size_t)g * 65536 + (size_t)(32 * w + 16 * n + fr) * 256 + 32 * ks + 8 * fq);
#pragma unroll
                for (int m = 0; m < 4; ++m) afr[m] = *(const LAS bf16x8*)(pl + (16 * m + fr) * 264 + 32 * ks + 8 * fq);
#pragma unroll
                for (int m = 0; m < 4; ++m)
#pragma unroll
                    for (int n = 0; n < 2; ++n) acc[m][n] = __builtin_amdgcn_mfma_f32_16x16x32_bf16(bfr[n], afr[m], acc[m][n], 0, 0, 0);
            }
#pragma unroll
            for (int m = 0; m < 4; ++m)
#pragma unroll
                for (int n = 0; n < 2; ++n) { const int col = g * 256 + 32 * w + 16 * n + 4 * fq; const size_t off = (size_t)(t0 + 16 * m + fr) * D + col;
                    const f32x4 sc = *(const f32x4*)(A.in[I_ASCALE] + col); const f32x4 hv = *(const f32x4*)(A.in[I_X] + off) + acc[m][n] * sc;
                    *(f32x4*)(F.h + off) = hv; ss[m] += (hv[0] * hv[0] + hv[1] * hv[1]) + (hv[2] * hv[2] + hv[3] * hv[3]); }
        }
#pragma unroll
        for (int m = 0; m < 4; ++m) { float s = ss[m]; s += __shfl_xor(s, 16); s += __shfl_xor(s, 32); if (fq == 0) sw[(16 * m + fr) * 8 + w] = s; }
        VM_WAIT(); LDS_WAIT(); __syncthreads();
        for (int j = w; j < 64; j += NWAVES) {
            float s = 0.f;
#pragma unroll
            for (int q = 0; q < 8; ++q) s += sw[j * 8 + q];
            const float r1 = 1.0f / sqrtf(s * (1.f / D) + EPS);
            const f32x4* p = (const f32x4*)(F.h + (size_t)(t0 + j) * D); u32x2* o = (u32x2*)(hn0 + (size_t)(t0 + j) * D);
#pragma unroll
            for (int q = 0; q < 4; ++q) { const f32x4 v = p[lane + 64 * q]; const f32x4 gn = *(const f32x4*)(A.in[I_FFNORM] + 4 * (lane + 64 * q));
                u32x2 ov; ov.x = pk2(v[0] * r1 * gn[0], v[1] * r1 * gn[1]); ov.y = pk2(v[2] * r1 * gn[2], v[3] * r1 * gn[3]); o[lane + 64 * q] = ov; }
        }
        LDS_WAIT(); __syncthreads();
    }
}

__device__ __forceinline__ void router_phase(const Frame& F, const Args& A) {
    volatile LAS int* li = (volatile LAS int*)(F.lds + 0);
    volatile LAS float* lf = (volatile LAS float*)(F.lds + 2048);
    int* ltok = (int*)(F.ws + WS_LTOK); float* lrs = (float*)(F.ws + WS_LRS); u32x4* tinfo = (u32x4*)(F.ws + WS_TOKINFO);
    const int lane = F.lane, w = F.wave, tid = F.tid;
    const float* gain = A.in[I_FFNORM] + D;
    for (int tile = F.bid; tile < T / 64; tile += F.G) {
        const int t0 = tile * 64;
        if (tid < 8) li[tid] = 0;
        LDS_WAIT(); __syncthreads();
        for (int k = 0; k < 8; ++k) {
            const int tl = 8 * w + k, t = t0 + tl;
            const f32x4* p = (const f32x4*)(F.h + (size_t)t * D);
            f32x4 v[4]; float s = 0.f;
#pragma unroll
            for (int q = 0; q < 4; ++q) { v[q] = p[lane + 64 * q]; s += (v[q][0] * v[q][0] + v[q][1] * v[q][1]) + (v[q][2] * v[q][2] + v[q][3] * v[q][3]); }
            s = wave_sum(s);
            const float r = 1.0f / sqrtf(s * (1.f / D) + EPS);
            float lg[8] = {0.f, 0.f, 0.f, 0.f, 0.f, 0.f, 0.f, 0.f};
#pragma unroll
            for (int q = 0; q < 4; ++q) { const int c0 = 4 * (lane + 64 * q); const f32x4 gn = *(const f32x4*)(gain + c0);
#pragma unroll
                for (int j = 0; j < 4; ++j) { const float xv = v[q][j] * r * gn[j]; const f32x4 w0 = *(const f32x4*)(A.in[I_ROUTER] + (size_t)(c0 + j) * 8), w1 = *(const f32x4*)(A.in[I_ROUTER] + (size_t)(c0 + j) * 8 + 4);
                    lg[0] += xv * w0[0]; lg[1] += xv * w0[1]; lg[2] += xv * w0[2]; lg[3] += xv * w0[3]; lg[4] += xv * w1[0]; lg[5] += xv * w1[1]; lg[6] += xv * w1[2]; lg[7] += xv * w1[3]; } }
#pragma unroll
            for (int e = 0; e < 8; ++e) lg[e] = wave_sum(lg[e]);
            if (lane == 0) {
                float b1 = lg[0]; int i1 = 0;
#pragma unroll
                for (int e = 1; e < 8; ++e) if (lg[e] > b1) { b1 = lg[e]; i1 = e; }
                float b2 = -3.0e38f; int i2 = 0;
#pragma unroll
                for (int e = 0; e < 8; ++e) if (e != i1 && lg[e] > b2) { b2 = lg[e]; i2 = e; }
                const float e2 = expf(b2 - b1), g1 = 1.f / (1.f + e2), g2 = e2 / (1.f + e2);
                const int r1 = __hip_atomic_fetch_add((LAS int*)&li[i1], 1, __ATOMIC_RELAXED, __HIP_MEMORY_SCOPE_WORKGROUP), r2 = __hip_atomic_fetch_add((LAS int*)&li[i2], 1, __ATOMIC_RELAXED, __HIP_MEMORY_SCOPE_WORKGROUP);
                li[16 + tl * 4 + 0] = i1; li[16 + tl * 4 + 1] = i2; li[16 + tl * 4 + 2] = r1; li[16 + tl * 4 + 3] = r2;
                lf[tl * 4 + 0] = g1; lf[tl * 4 + 1] = g2; lf[tl * 4 + 2] = r;
            }
        }
        LDS_WAIT(); __syncthreads();
        if (tid < 8) li[8 + tid] = (int)atomicAdd(F.ctl + CW_CNT + tid, (unsigned)li[tid]);
        LDS_WAIT(); __syncthreads();
        if (tid < 64) {
            const int i1 = li[16 + tid * 4 + 0], i2 = li[16 + tid * 4 + 1], s1 = li[8 + i1] + li[16 + tid * 4 + 2], s2 = li[8 + i2] + li[16 + tid * 4 + 3];
            const float g1 = lf[tid * 4 + 0], g2 = lf[tid * 4 + 1], r = lf[tid * 4 + 2];
            ltok[(size_t)i1 * T + s1] = t0 + tid; lrs[(size_t)i1 * T + s1] = r;
            ltok[(size_t)i2 * T + s2] = t0 + tid; lrs[(size_t)i2 * T + s2] = r;
            u32x4 ti; ti.x = (unsigned)(s1 << 3 | i1); ti.y = (unsigned)(s2 << 3 | i2); ti.z = __builtin_bit_cast(unsigned, g1); ti.w = __builtin_bit_cast(unsigned, g2);
            tinfo[t0 + tid] = ti;
        }
        LDS_WAIT(); __syncthreads();
    }
}

__device__ __forceinline__ void final_phase(const Frame& F, const Args& A) {
    volatile LAS int* mi = (volatile LAS int*)(F.lds + SCR_OFF);
    const u32x4* tinfo = (const u32x4*)(F.ws + WS_TOKINFO); const bf16_t* Y = (const bf16_t*)(F.ws + WS_Y);
    const int lane = F.lane;
    for (int t = F.bid * NWAVES + F.wave; t < T; t += F.G * NWAVES) {
        const u32x4 ti = tinfo[t];
        const int e1 = ti.x & 7, s1 = ti.x >> 3, e2 = ti.y & 7, s2 = ti.y >> 3; const unsigned gz = ti.z, gw = ti.w; const float g1 = __uint_as_float(gz), g2 = __uint_as_float(gw);
        const size_t r1 = (size_t)mi[MI_TB + e1] * 256 + s1, r2 = (size_t)mi[MI_TB + e2] * 256 + s2;
        f32x4* p = (f32x4*)(F.h + (size_t)t * D); const u32x2* y1 = (const u32x2*)(Y + r1 * D); const u32x2* y2 = (const u32x2*)(Y + r2 * D);
        f32x4 v[4]; float s = 0.f;
#pragma unroll
        for (int q = 0; q < 4; ++q) { const f32x4 hv = p[lane + 64 * q]; const u32x2 a = y1[lane + 64 * q], b = y2[lane + 64 * q];
            f32x4 o;
            o[0] = hv[0] + g1 * bf2f((unsigned short)(a.x & 0xffff)) + g2 * bf2f((unsigned short)(b.x & 0xffff));
            o[1] = hv[1] + g1 * bf2f((unsigned short)(a.x >> 16)) + g2 * bf2f((unsigned short)(b.x >> 16));
            o[2] = hv[2] + g1 * bf2f((unsigned short)(a.y & 0xffff)) + g2 * bf2f((unsigned short)(b.y & 0xffff));
            o[3] = hv[3] + g1 * bf2f((unsigned short)(a.y >> 16)) + g2 * bf2f((unsigned short)(b.y >> 16));
            v[q] = o; s += (o[0] * o[0] + o[1] * o[1]) + (o[2] * o[2] + o[3] * o[3]); }
        s = wave_sum(s);
        const float r = 1.0f / sqrtf(s * (1.f / D) + EPS);
#pragma unroll
        for (int q = 0; q < 4; ++q) { const f32x4 gn = *(const f32x4*)(A.in[I_FNORM] + 4 * (lane + 64 * q)); p[lane + 64 * q] = (f32x4){v[q][0] * r * gn[0], v[q][1] * r * gn[1], v[q][2] * r * gn[2], v[q][3] * r * gn[3]}; }
    }
}

__device__ __forceinline__ int t5_bucket(int n) {
    if (n < 16) return n;
    int large = 16 + (int)(log((double)n / 16.0) / log(128.0) * 16.0);
    return large < 31 ? large : 31;
}
__device__ __forceinline__ void attn_valu_phase(const Frame& F, const Args& A) {
    LAS float* btab = (LAS float*)(F.lds + 0);
    for (int i = F.tid; i < 3 * 16 * 129; i += NTHREADS) { const int g = i / (16 * 129), r = i - g * 16 * 129, hh = r / 129, m = r - hh * 129; const int dil = g == 0 ? 1 : (g == 1 ? 4 : 16);
        btab[i] = A.in[I_RELB][t5_bucket(m * dil) * 48 + g * 16 + hh]; }
    LDS_WAIT(); __syncthreads();
    const bf16_t* qkv = (const bf16_t*)(F.ws + WS_QKV); bf16_t* mo = (bf16_t*)(F.ws + WS_S0);
    const int lane = F.lane;
    for (int u = F.bid * NWAVES + F.wave; u < T * 16; u += F.G * NWAVES) {
        const int t = u >> 4, hh = u & 15, s = t % SEQ;
        float m = -1e30f, l = 0.f, a = 0.f;
        for (int g = 0; g < 3; ++g) {
            const int dil = g == 0 ? 1 : (g == 1 ? 4 : 16), i = s / dil, mmax = i < 128 ? i : 128;
            const float qv = bf2f(qkv[(size_t)t * NQKV + g * 1024 + hh * 64 + lane]);
            for (int mm = 0; mm <= mmax; ++mm) {
                const size_t tk = (size_t)(t - mm * dil) * NQKV + g * 1024 + hh * 64 + lane;
                const float kv = bf2f(qkv[tk + 3072]);
                const float logit = wave_sum(qv * kv) + btab[(g * 16 + hh) * 129 + mm];
                const float mn = fmaxf(m, logit), f = expf(m - mn), pe = expf(logit - mn);
                l = l * f + pe; a = a * f + pe * bf2f(qkv[tk + 6144]); m = mn;
            }
        }
        mo[(size_t)t * D + hh * 64 + lane] = (bf16_t)f2bf(a / l);
    }
    __syncthreads();
}
constexpr int PH_MIX = 0, PH_FF1 = 1, PH_FF2 = 2, PH_QKV = 3, PH_ATT = 4, PH_WO = 5, PH_ROUTE = 6, PH_MOE0 = 7, PH_FINAL = 12, PH_END = 13;

__global__ void __launch_bounds__(NTHREADS, 2) mk_fwd(Args args) {
    extern __shared__ __attribute__((aligned(16))) unsigned char lds_raw[];
    Frame F;
    F.lds = (LAS unsigned char*)lds_raw;
    F.tid = threadIdx.x; F.lane = F.tid & 63; F.wave = __builtin_amdgcn_readfirstlane(F.tid >> 6); F.G = gridDim.x; F.bid = blockIdx.x;
    F.ws = args.ws; F.ctl = (unsigned*)(args.ws + WS_CTL); F.h = args.out;
    volatile LAS unsigned* MISC = (volatile LAS unsigned*)(F.lds + MISC_OFF);
    for (int u = F.tid; u < 64; u += NTHREADS) MISC[u] = 0u;
    __syncthreads();
    XcdBarrier bar = xcd_barrier_post(F.ctl + CW_BAR + args.li * XCD_BAR_WORDS, MISC + 8);
    const int lo = args.ph_lo, hi = args.ph_hi;
#ifndef MK_MASK
#define MK_MASK 0xffffffffu
#endif
#define IN(k) (((MK_MASK >> (k)) & 1u) && lo <= (k) && (k) < hi)
#define SEAM(k) do { if (IN(k) && IN((k) + 1)) xcd_barrier(bar); } while (0)
    unsigned char* ws = args.ws;
    LAS unsigned char* ring = F.lds + RING_OFF;

    if (IN(PH_MIX)) { conv_small(F, args); VM_WAIT(); __syncthreads(); }
    if (IN(PH_MIX)) { xcd_barrier(bar); mixer_phase(F, args); }
    SEAM(PH_MIX);

    if (IN(PH_FF1)) {
        pg8::Gemm g{(const bf16_t*)(ws + WS_S0), (const bf16_t*)(ws + WS_WGU0), D}; pg8::StaticOrder S; S.init(T, 2 * FF0, F.G, F.bid);
        EpiSwiGLU E{(bf16_t*)(ws + WS_ACT0), FF0, nullptr};
        pg8::gemm_phase<EpiSwiGLU, pg8::StaticOrder, false>(ring, g, S, E);
    }
    SEAM(PH_FF1);
    if (IN(PH_FF2)) {
        pg8::Gemm g{(const bf16_t*)(ws + WS_ACT0), (const bf16_t*)(ws + WS_WD0), FF0}; pg8::StaticOrder S; S.init(T, D, F.G, F.bid);
        EpiRes E{F.h, (bf16_t*)(ws + WS_S1), (float*)(ws + WS_SSQ)};
        pg8::gemm_phase<EpiRes, pg8::StaticOrder, false>(ring, g, S, E);
    }
    SEAM(PH_FF2);
    if (IN(PH_QKV)) {
        pg8::Gemm g{(const bf16_t*)(ws + WS_S1), (const bf16_t*)(ws + WS_WQKV), D}; pg8::StaticOrder S; S.init(T, NQKV, F.G, F.bid);
        EpiQKV E{(bf16_t*)(ws + WS_QKV), (const float*)(ws + WS_SSQ)};
        pg8::gemm_phase<EpiQKV, pg8::StaticOrder, false>(ring, g, S, E);
    }
    SEAM(PH_QKV);
    if (IN(PH_ATT)) { attn_valu_phase(F, args); }
    SEAM(PH_ATT);
    if (IN(PH_WO)) {
        pg8::Gemm g{(const bf16_t*)(ws + WS_S0), (const bf16_t*)(ws + WS_WO), D}; pg8::StaticOrder S; S.init(T, D, F.G, F.bid);
        EpiRes E{F.h, (bf16_t*)(ws + WS_S1), nullptr};
        pg8::gemm_phase<EpiRes, pg8::StaticOrder, false>(ring, g, S, E);
        conv_moe(F, args);
    }
    SEAM(PH_WO);
    if (IN(PH_ROUTE)) { router_phase(F, args); }
    SEAM(PH_ROUTE);
#pragma unroll 1
    for (int j = 0; j < 5; ++j) {
        if (IN(PH_MOE0 + j)) {
            moe_info_build(F.lds, F.ctl);
            volatile LAS int* mi = (volatile LAS int*)(F.lds + SCR_OFF);
            const int ntiles = __builtin_amdgcn_readfirstlane(mi[MI_NT]);
            if (j >= 1) {
                const int c0 = (j - 1) * CH_TILES; int ntc = ntiles - c0; ntc = ntc < 0 ? 0 : (ntc > CH_TILES ? CH_TILES : ntc);
                pg8::Gemm g{(const bf16_t*)(ws + WS_ACT1 + (size_t)((j - 1) & 1) * ACT1_CHUNK), (const bf16_t*)(ws + WS_WD1), FF1};
                MoeOrder<4, false> S{{F.ctl + CW_Q + 64 * (2 * j), MISC + 16}, mi, c0, ntc, nullptr};
                EpiY E{(bf16_t*)(ws + WS_Y)};
                pg8::gemm_phase<EpiY, MoeOrder<4, false>, false>(ring, g, S, E);
            }
            if (j <= 3) {
                const int c0 = j * CH_TILES; int ntc = ntiles - c0; ntc = ntc < 0 ? 0 : (ntc > CH_TILES ? CH_TILES : ntc);
                pg8::Gemm g{(const bf16_t*)(ws + WS_S1), (const bf16_t*)(ws + WS_WGU1), D};
                MoeOrder<28, true> S{{F.ctl + CW_Q + 64 * (2 * j + 1), MISC + 16}, mi, c0, ntc, (const int*)(ws + WS_LTOK)};
                EpiSwiGLU E{(bf16_t*)(ws + WS_ACT1 + (size_t)(j & 1) * ACT1_CHUNK), FF1, (const float*)(ws + WS_LRS)};
                pg8::gemm_phase<EpiSwiGLU, MoeOrder<28, true>, true>(ring, g, S, E);
            }
        }
        SEAM(PH_MOE0 + j);
    }
    if (IN(PH_FINAL)) { moe_info_build(F.lds, F.ctl); final_phase(F, args); }
#undef IN
#undef SEAM
}
}
#ifndef MK_STEP
#define MK_STEP 1
#endif
static void naive_dense_ffn(hipStream_t stream, float* h, float* rstd, float* big, const float* ffn_norm, const float* dwg, const float* dwu, const float* dwd) {
    using namespace nv; GemmP p{};
    hipLaunchKernelGGL(k_rstd, dim3(T / 4), dim3(256), 0, stream, h, rstd);
    p = GemmP{}; p.A = h; p.lda = D; p.B1 = dwg; p.B2 = dwu; p.ldb = FF0; p.C = big; p.ldc = FF0; p.M = T; p.N = FF0; p.K = D; p.rowscale = rstd; p.kgain = ffn_norm; gemm<2>(stream, p);
    p = GemmP{}; p.A = big; p.lda = FF0; p.B1 = dwd; p.ldb = D; p.C = h; p.ldc = D; p.M = T; p.N = D; p.K = FF0; p.R = h; p.ldr = D; gemm<3>(stream, p);
}
static void naive_mixer_b(hipStream_t stream, float* h, float* rstd, float* big, float* buf0, float* mbuf, float* lbuf, const float* w_q, const float* w_kv, const float* w_o, const float* b_norm, const float* kv_norm, const float* rel_bias) {
    using namespace nv; GemmP p{};
    hipLaunchKernelGGL(k_rstd, dim3(T / 4), dim3(256), 0, stream, h, rstd);
    float* qg = big; float* kg = big + (size_t)T * D; float* vg = big + (size_t)2 * T * D;
    const int dil[3] = {1, 4, 16};
    for (int g = 0; g < 3; ++g) {
        p = GemmP{}; p.A = h; p.lda = D; p.B1 = w_q + g * 1024; p.ldb = 3072; p.C = qg; p.ldc = D; p.M = T; p.N = D; p.K = D; p.rowscale = rstd; p.kgain = b_norm; gemm<0>(stream, p);
        p.B1 = w_kv + g * 1024; p.ldb = 6144; p.C = kg; p.kgain = kv_norm; gemm<0>(stream, p);
        p.B1 = w_kv + 3072 + g * 1024; p.C = vg; gemm<0>(stream, p);
        hipLaunchKernelGGL(k_attn, dim3(T * 16 / 4), dim3(256), 0, stream, qg, kg, vg, rel_bias, buf0, mbuf, lbuf, g, dil[g]);
    }
    p = GemmP{}; p.A = buf0; p.lda = D; p.B1 = w_o; p.ldb = D; p.C = h; p.ldc = D; p.M = T; p.N = D; p.K = D; p.R = h; p.ldr = D; gemm<3>(stream, p);
}
static void naive_moe_final(hipStream_t stream, float* h, float* rstd, float* big, float* buf0, float* gates, const float* ffn_norm, const float* router, const float* mwg, const float* mwu, const float* mwd, const float* final_norm) {
    using namespace nv; GemmP p{};
    hipLaunchKernelGGL(k_rstd, dim3(T / 4), dim3(256), 0, stream, h, rstd);
    hipLaunchKernelGGL(k_router, dim3(T / 4), dim3(256), 0, stream, h, rstd, ffn_norm + D, router, gates);
    (void)hipMemcpyAsync(buf0, h, (size_t)T * D * 4, hipMemcpyDeviceToDevice, stream);
    for (int e = 0; e < NE; ++e) {
        p = GemmP{}; p.A = buf0; p.lda = D; p.B1 = mwg + (size_t)e * D * FF1; p.B2 = mwu + (size_t)e * D * FF1; p.ldb = FF1; p.C = big; p.ldc = FF1; p.M = T; p.N = FF1; p.K = D;
        p.rowscale = rstd; p.kgain = ffn_norm + D; gemm<2>(stream, p);
        p = GemmP{}; p.A = big; p.lda = FF1; p.B1 = mwd + (size_t)e * FF1 * D; p.ldb = D; p.C = h; p.ldc = D; p.M = T; p.N = D; p.K = FF1; p.rowgate = gates + e; p.rg_stride = 8; gemm<4>(stream, p);
    }
    hipLaunchKernelGGL(k_final, dim3(T / 4), dim3(256), 0, stream, h, final_norm, h);
}

extern "C" void kernel_launch(void* const* d_in, const int* in_sizes, int n_in, void* d_out, int out_size, void* d_ws, size_t ws_size, hipStream_t stream) {
    static int grid = 0;
    if (grid == 0) {
        if (n_in != 19 || out_size != mk::T * mk::D || ws_size < mk::WS_END) { fprintf(stderr, "kernel_launch: unexpected shapes / workspace (%d inputs, out %d, ws %zu)\n", n_in, out_size, ws_size); grid = -1; return; }
        int dev = 0, cus = 0;
        if (hipGetDevice(&dev) != hipSuccess || hipDeviceGetAttribute(&cus, hipDeviceAttributeMultiprocessorCount, dev) != hipSuccess) { grid = -1; return; }
        if (hipFuncSetAttribute((const void*)mk::mk_fwd, hipFuncAttributeMaxDynamicSharedMemorySize, mk::LDS_BYTES) != hipSuccess) { fprintf(stderr, "kernel_launch: hipFuncSetAttribute failed\n"); grid = -1; return; }
        int per_cu = 0;
        if (hipOccupancyMaxActiveBlocksPerMultiprocessor(&per_cu, (const void*)mk::mk_fwd, mk::NTHREADS, mk::LDS_BYTES) != hipSuccess || per_cu < 1) { fprintf(stderr, "kernel_launch: occupancy query says %d blocks per CU\n", per_cu); }
        (void)hipGetLastError();
        grid = cus;
    }
    if (grid < 0) return;
    const float* in[19]; for (int i = 0; i < 19; ++i) in[i] = (const float*)d_in[i];
    (void)hipMemsetAsync((char*)d_ws + mk::WS_CTL, 0, mk::CTL_ZERO_BYTES, stream);
    mk::Args a{};
    for (int i = 0; i < 19; ++i) a.in[i] = in[i];
    a.out = (float*)d_out; a.ws = (unsigned char*)d_ws;
    float* h = (float*)d_out; char* ws = (char*)d_ws; const size_t MiB = 1u << 20;
    float* rstd = (float*)(ws + 1 * MiB); float* mbuf = (float*)(ws + 2 * MiB); float* lbuf = (float*)(ws + 3 * MiB); float* gates = (float*)(ws + 4 * MiB);
    float* buf0 = (float*)(ws + 5 * MiB); float* big = (float*)(ws + 69 * MiB);
#if MK_STEP == 1
    a.ph_lo = 0; a.ph_hi = 3; a.li = 0;
    hipLaunchKernelGGL(mk::mk_fwd, dim3(grid), dim3(mk::NTHREADS), mk::LDS_BYTES, stream, a);
    naive_mixer_b(stream, h, rstd, big, buf0, mbuf, lbuf, in[7], in[5], in[8], in[6], in[4], in[9]);
    naive_moe_final(stream, h, rstd, big, buf0, gates, in[10], in[14], in[15], in[16], in[17], in[18]);
#elif MK_STEP == 2
    a.ph_lo = 0; a.ph_hi = 6; a.li = 0;
    hipLaunchKernelGGL(mk::mk_fwd, dim3(grid), dim3(mk::NTHREADS), mk::LDS_BYTES, stream, a);
    naive_moe_final(stream, h, rstd, big, buf0, gates, in[10], in[14], in[15], in[16], in[17], in[18]);
#else
    a.ph_lo = 0; a.ph_hi = mk::PH_END; a.li = 0;
    hipLaunchKernelGGL(mk::mk_fwd, dim3(grid), dim3(mk::NTHREADS), mk::LDS_BYTES, stream, a);
#endif
}
```

```cpp
#include <hip/hip_runtime.h>
#include <cstdio>
#include <cstdint>
#define MK_STEP 3
namespace nv {
constexpr int T = 16384, D = 1024, S = 2048, NB = 8;
constexpr int FF0 = 2816, FF1 = 3584, NE = 8;
constexpr float EPS = 1e-6f;

__device__ __forceinline__ float wave_sum(float v) {
#pragma unroll
    for (int o = 1; o < 64; o <<= 1) v += __shfl_xor(v, o);
    return v;
}
__device__ __forceinline__ float silu(float x) { return x / (1.f + expf(-x)); }

__global__ void k_rstd(const float* __restrict__ x, float* __restrict__ rstd) {
    const int row = blockIdx.x * 4 + (threadIdx.x >> 6), lane = threadIdx.x & 63;
    const float4* p = (const float4*)(x + (size_t)row * D);
    float s = 0.f;
#pragma unroll
    for (int j = 0; j < 4; ++j) { const float4 v = p[lane + 64 * j]; s += v.x * v.x + v.y * v.y + v.z * v.z + v.w * v.w; }
    s = wave_sum(s);
    if (lane == 0) rstd[row] = 1.0f / sqrtf(s * (1.f / D) + EPS);
}

__global__ void k_pool(const float* __restrict__ x, const float* __restrict__ rstd, const float* __restrict__ gain, float* __restrict__ pooled) {
    const int t = blockIdx.x, c = threadIdx.x * 4;
    const int s = t % S, g = c >> 8, w = 2 << g;
    const int cnt = (s + 1 < w) ? (s + 1) : w;
    const float4 gn = *(const float4*)(gain + c);
    float4 acc = {0.f, 0.f, 0.f, 0.f}, self = {0.f, 0.f, 0.f, 0.f};
    for (int j = 0; j < cnt; ++j) {
        const float r = rstd[t - j]; const float4 v = *(const float4*)(x + (size_t)(t - j) * D + c);
        const float4 xn = {v.x * r * gn.x, v.y * r * gn.y, v.z * r * gn.z, v.w * r * gn.w};
        acc.x += xn.x; acc.y += xn.y; acc.z += xn.z; acc.w += xn.w;
        if (j == 0) self = xn;
    }
    const float inv = 1.f / (float)cnt;
    float4 o = {acc.x * inv - self.x, acc.y * inv - self.y, acc.z * inv - self.z, acc.w * inv - self.w};
    *(float4*)(pooled + (size_t)t * D + c) = o;
}

struct GemmP {
    const float* A; int lda; const float* B1; const float* B2; int ldb; float* C; int ldc; int M, N, K;
    const float* rowscale; const float* kgain;
    const float* R; int ldr; const float* cs; const float* rowgate; int rg_stride; int mode;
};
template <int MODE>
__global__ void __launch_bounds__(256) k_gemm(GemmP p) {
    __shared__ float As[16][68], Bs[16][68], Bs2[MODE == 2 ? 16 : 1][68];
    const int tx = threadIdx.x & 15, ty = threadIdx.x >> 4, m0 = blockIdx.y * 64, n0 = blockIdx.x * 64;
    float acc[4][4] = {}, acc2[4][4] = {};
    const int ar = threadIdx.x >> 2, ac = (threadIdx.x & 3) * 4;
    const int br = threadIdx.x >> 4, bc = (threadIdx.x & 15) * 4;
    const float rs = p.rowscale ? p.rowscale[m0 + ar] : 1.f;
    for (int k0 = 0; k0 < p.K; k0 += 16) {
        float4 a = *(const float4*)(p.A + (size_t)(m0 + ar) * p.lda + k0 + ac);
        if (p.kgain) { const float4 g = *(const float4*)(p.kgain + k0 + ac); a.x *= g.x; a.y *= g.y; a.z *= g.z; a.w *= g.w; }
        As[ac + 0][ar] = a.x * rs; As[ac + 1][ar] = a.y * rs; As[ac + 2][ar] = a.z * rs; As[ac + 3][ar] = a.w * rs;
        const float4 b = *(const float4*)(p.B1 + (size_t)(k0 + br) * p.ldb + n0 + bc);
        *(float4*)&Bs[br][bc] = b;
        if (MODE == 2) { const float4 b2 = *(const float4*)(p.B2 + (size_t)(k0 + br) * p.ldb + n0 + bc); *(float4*)&Bs2[br][bc] = b2; }
        __syncthreads();
#pragma unroll
        for (int k = 0; k < 16; ++k) {
            const float4 av = *(const float4*)&As[k][ty * 4]; const float4 bv = *(const float4*)&Bs[k][tx * 4];
            const float aa[4] = {av.x, av.y, av.z, av.w}, bb[4] = {bv.x, bv.y, bv.z, bv.w};
#pragma unroll
            for (int i = 0; i < 4; ++i)
#pragma unroll
                for (int j = 0; j < 4; ++j) acc[i][j] += aa[i] * bb[j];
            if (MODE == 2) { const float4 cv = *(const float4*)&Bs2[k][tx * 4]; const float cc[4] = {cv.x, cv.y, cv.z, cv.w};
#pragma unroll
                for (int i = 0; i < 4; ++i)
#pragma unroll
                    for (int j = 0; j < 4; ++j) acc2[i][j] += aa[i] * cc[j]; }
        }
        __syncthreads();
    }
#pragma unroll
    for (int i = 0; i < 4; ++i) {
        const int row = m0 + ty * 4 + i;
#pragma unroll
        for (int j = 0; j < 4; ++j) {
            const int col = n0 + tx * 4 + j; float v = acc[i][j];
            float* c = p.C + (size_t)row * p.ldc + col;
            if (MODE == 1) v = p.R[(size_t)row * p.ldr + col] + v * p.cs[col];
            if (MODE == 2) v = silu(v) * acc2[i][j];
            if (MODE == 3) v = p.R[(size_t)row * p.ldr + col] + v;
            if (MODE == 4) v = *c + p.rowgate[(size_t)row * p.rg_stride] * v;
            *c = v;
        }
    }
}

__device__ __forceinline__ int t5_bucket(int n) {
    if (n < 16) return n;
    int large = 16 + (int)(log((double)n / 16.0) / log(128.0) * 16.0);
    return large < 31 ? large : 31;
}

__global__ void k_attn(const float* __restrict__ q, const float* __restrict__ k, const float* __restrict__ v, const float* __restrict__ rel_bias,
                       float* __restrict__ acc, float* __restrict__ mbuf, float* __restrict__ lbuf, int g, int dil) {
    const int wid = blockIdx.x * 4 + (threadIdx.x >> 6), lane = threadIdx.x & 63;
    const int t = wid >> 4, h = wid & 15, s = t % S, i = s / dil;
    const float qv = q[(size_t)t * D + h * 64 + lane] * 0.125f;
    float m = g == 0 ? -1e30f : mbuf[wid], l = g == 0 ? 0.f : lbuf[wid], a = g == 0 ? 0.f : acc[(size_t)t * D + h * 64 + lane];
    const int mmax = i < 128 ? i : 128;
    for (int mm = 0; mm <= mmax; ++mm) {
        const int tk = t - mm * dil;
        const float kv = k[(size_t)tk * D + h * 64 + lane];
        float logit = wave_sum(qv * kv) + rel_bias[t5_bucket(mm * dil) * 48 + g * 16 + h];
        const float mn = fmaxf(m, logit), f = expf(m - mn), pexp = expf(logit - mn);
        l = l * f + pexp; a = a * f + pexp * v[(size_t)tk * D + h * 64 + lane]; m = mn;
    }
    if (g == 2) a = a / l;
    acc[(size_t)t * D + h * 64 + lane] = a;
    if (lane == 0) { mbuf[wid] = m; lbuf[wid] = l; }
}

__global__ void k_router(const float* __restrict__ h, const float* __restrict__ rstd, const float* __restrict__ gain, const float* __restrict__ wr, float* __restrict__ gates) {
    const int t = blockIdx.x * 4 + (threadIdx.x >> 6), lane = threadIdx.x & 63;
    float lg[8] = {};
    const float r = rstd[t];
    for (int j = 0; j < 16; ++j) {
        const int c = lane + 64 * j; const float xv = h[(size_t)t * D + c] * r * gain[c];
#pragma unroll
        for (int e = 0; e < 8; ++e) lg[e] += xv * wr[c * 8 + e];
    }
#pragma unroll
    for (int e = 0; e < 8; ++e) lg[e] = wave_sum(lg[e]);
    if (lane == 0) {
        float b1 = lg[0]; int i1 = 0;
#pragma unroll
        for (int e = 1; e < 8; ++e) if (lg[e] > b1) { b1 = lg[e]; i1 = e; }
        float b2 = -3.0e38f; int i2 = 0;
#pragma unroll
        for (int e = 0; e < 8; ++e) if (e != i1 && lg[e] > b2) { b2 = lg[e]; i2 = e; }
        const float e2 = expf(b2 - b1), g1 = 1.f / (1.f + e2), g2 = e2 / (1.f + e2);
        for (int e = 0; e < 8; ++e) gates[(size_t)t * 8 + e] = (e == i1) ? g1 : (e == i2) ? g2 : 0.f;
    }
}

__global__ void k_final(const float* h, const float* __restrict__ gain, float* out) {
    const int row = blockIdx.x * 4 + (threadIdx.x >> 6), lane = threadIdx.x & 63;
    const float4* p = (const float4*)(h + (size_t)row * D);
    float4 v[4]; float s = 0.f;
#pragma unroll
    for (int j = 0; j < 4; ++j) { v[j] = p[lane + 64 * j]; s += v[j].x * v[j].x + v[j].y * v[j].y + v[j].z * v[j].z + v[j].w * v[j].w; }
    s = wave_sum(s);
    const float r = 1.0f / sqrtf(s * (1.f / D) + EPS);
#pragma unroll
    for (int j = 0; j < 4; ++j) { const float4 g = *(const float4*)(gain + 4 * (lane + 64 * j));
        float4 o = {v[j].x * r * g.x, v[j].y * r * g.y, v[j].z * r * g.z, v[j].w * r * g.w};
        ((float4*)(out + (size_t)row * D))[lane + 64 * j] = o; }
}

template <int MODE> static void gemm(hipStream_t st, const GemmP& p) {
    hipLaunchKernelGGL(k_gemm<MODE>, dim3(p.N / 64, p.M / 64), dim3(256), 0, st, p);
}
}

namespace mk {
#define LAS __attribute__((address_space(3)))
#define GAS __attribute__((address_space(1)))
typedef unsigned short bf16_t;
typedef short bf16x8 __attribute__((ext_vector_type(8)));
typedef float f32x4 __attribute__((ext_vector_type(4)));
typedef float f32x2 __attribute__((ext_vector_type(2)));
typedef unsigned u32x4 __attribute__((ext_vector_type(4)));
typedef unsigned u32x2 __attribute__((ext_vector_type(2)));

constexpr int T = 16384, D = 1024, SEQ = 2048, NBATCH = 8;
constexpr int FF0 = 2816, FF1 = 3584, NE = 8, NQKV = 9216;
constexpr float EPS = 1e-6f;
constexpr int NWAVES = 8, NTHREADS = 512;

constexpr size_t MiB = 1u << 20;
constexpr size_t WS_CTL = 0, CTL_ZERO_BYTES = 1 * MiB;
constexpr size_t WS_SSQ = 1 * MiB;
constexpr size_t WS_LTOK = 2 * MiB;
constexpr size_t WS_LRS = 2 * MiB + 512 * 1024;
constexpr size_t WS_TOKINFO = 3 * MiB;
constexpr size_t WS_APT = 3 * MiB + 512 * 1024;
constexpr size_t WS_WGU0 = 4 * MiB;
constexpr size_t WS_WD0 = 15 * MiB;
constexpr size_t WS_WQKV = WS_WD0 + (size_t)D * FF0 * 2;
constexpr size_t WS_WO = WS_WQKV + (size_t)NQKV * D * 2;
constexpr size_t WS_S0 = 41 * MiB;
constexpr size_t WS_S1 = 73 * MiB;
constexpr size_t WS_POOL = 105 * MiB;
constexpr size_t WS_ACT0 = WS_POOL;
constexpr size_t WS_QKV = WS_POOL;
constexpr int CH_TILES = 34;
constexpr size_t ACT1_CHUNK = (size_t)CH_TILES * 256 * FF1 * 2;
constexpr size_t WS_ACT1 = WS_POOL;
constexpr size_t WS_Y = 224 * MiB;
constexpr size_t WS_WGU1 = 306 * MiB;
constexpr size_t WS_WD1 = 418 * MiB;
constexpr size_t WS_END = 474 * MiB;
static_assert(WS_WO + (size_t)D * D * 2 <= WS_S0, "small weights");
static_assert(WS_ACT1 + 2 * ACT1_CHUNK <= WS_Y && WS_Y + (size_t)34816 * D * 2 <= WS_WGU1, "moe map");
static_assert(WS_WGU1 + (size_t)NE * 7168 * D * 2 <= WS_WD1 && WS_WD1 + (size_t)NE * D * FF1 * 2 <= WS_END, "moe weights");
static_assert(WS_QKV + (size_t)T * NQKV * 2 <= WS_END, "qkv");

constexpr int CW_TMO = 0;
constexpr int CW_CNT = 64;
constexpr int CW_Q = 128;
constexpr int CW_BAR = 4096;

constexpr int RING_OFF = 0, RING_BYTES = 131072;
constexpr int MISC_OFF = RING_BYTES;
constexpr int RTAB_OFF = MISC_OFF + 1024;
constexpr int SCR_OFF = MISC_OFF + 2048;
constexpr int LDS_BYTES = 147456;

#define RLX_AGENT __ATOMIC_RELAXED, __HIP_MEMORY_SCOPE_AGENT
#define LDS_WAIT() asm volatile("s_waitcnt lgkmcnt(0)" ::: "memory")
#define VM_WAIT() asm volatile("s_waitcnt vmcnt(0)" ::: "memory")
__device__ __forceinline__ unsigned f2bf(float f) { unsigned u = __builtin_bit_cast(unsigned, f); return (u + 0x7fffu + ((u >> 16) & 1u)) >> 16; }
__device__ __forceinline__ unsigned pk2(float lo, float hi) { return f2bf(lo) | (f2bf(hi) << 16); }
__device__ __forceinline__ unsigned cvt_pk_bf16(float lo, float hi) { unsigned r; asm volatile("v_cvt_pk_bf16_f32 %0, %1, %2" : "=v"(r) : "v"(lo), "v"(hi)); return r; }
__device__ __forceinline__ float bf2f(unsigned short b) { return __builtin_bit_cast(float, ((unsigned)b) << 16); }
__device__ __forceinline__ float wave_sum(float v) {
#pragma unroll
    for (int o = 1; o < 64; o <<= 1) v += __shfl_xor(v, o);
    return v;
}
__device__ __forceinline__ float silu_f(float x) { return x * __builtin_amdgcn_rcpf(1.f + __builtin_amdgcn_exp2f(-1.4426950408889634f * x)); }
#define XB_TMO      128
#define XB_XCNT(j)  (256  + 64 * (j))
#define XB_XSUB(j)  (1280 + 64 * (j))
#define XB_XGEN(j)  (2304 + 64 * (j))
#define XB_TOP      3328
#define XB_TOPGEN   3392
#define XCD_BAR_WORDS 3456
#define XB_SPIN_CAP (1u << 18)
__device__ __forceinline__ unsigned xb_ld(unsigned* p)              { return __hip_atomic_load(p, __ATOMIC_RELAXED, __HIP_MEMORY_SCOPE_AGENT); }
__device__ __forceinline__ unsigned xb_add(unsigned* p, unsigned v) { return __hip_atomic_fetch_add(p, v, __ATOMIC_RELAXED, __HIP_MEMORY_SCOPE_AGENT); }
__device__ __forceinline__ unsigned xb_xcc_id() { return (unsigned)__builtin_amdgcn_s_getreg((3 << 11) | 20) & 0xFu; }
#define XB_SPIN(cond, bar) do { unsigned _sp = 0; while (cond) { __builtin_amdgcn_s_sleep(1); \
    if ((++_sp & 255u) == 0u) { if (xb_ld(&(bar)[XB_TMO])) break; if (_sp > XB_SPIN_CAP) { atomicAdd(&(bar)[XB_TMO], 1u); break; } } } } while (0)
struct XcdBarrier { unsigned* bar; unsigned x; volatile LAS unsigned* st; };
__device__ __forceinline__ XcdBarrier xcd_barrier_post(unsigned* bar, volatile LAS unsigned* st) {
    XcdBarrier b; b.bar = bar; b.x = xb_xcc_id(); b.st = st;
    if (threadIdx.x == 0) (void)xb_add(&bar[XB_XCNT(b.x)], 1u);
    return b;
}
__device__ __forceinline__ void xcd_barrier_complete(unsigned* bar, unsigned x, unsigned& nloc, unsigned& nx) {
    const unsigned G = gridDim.x * gridDim.y * gridDim.z;
    unsigned sum, cnt, mine, sp = 0u;
    for (;;) {
        sum = 0u; cnt = 0u; mine = 0u;
#pragma unroll
        for (unsigned j = 0; j < 16; ++j) { const unsigned c = xb_ld(&bar[XB_XCNT(j)]); sum += c; cnt += (c > 0u) ? 1u : 0u; mine = (j == x) ? c : mine; }
        if (sum == G) break;
        __builtin_amdgcn_s_sleep(1);
        if ((++sp & 255u) == 0u) { if (xb_ld(&bar[XB_TMO])) break; if (sp > XB_SPIN_CAP) { atomicAdd(&bar[XB_TMO], 1u); break; } }
    }
    nloc = mine > 0u ? mine : 1u; nx = cnt > 0u ? cnt : 1u;
}
__device__ __forceinline__ void xcd_barrier(const XcdBarrier& b) {
    asm volatile("s_waitcnt vmcnt(0)" ::: "memory");
    __syncthreads();
    if (threadIdx.x == 0) {
        unsigned* bar = b.bar;
        __builtin_amdgcn_s_waitcnt(0);
        unsigned nloc = b.st[0], nx = b.st[1];
        if (nloc == 0u) { xcd_barrier_complete(bar, b.x, nloc, nx); b.st[0] = nloc; b.st[1] = nx; }
        const unsigned old = xb_add(&bar[XB_XSUB(b.x)], 1u);
        const unsigned gen = old / nloc;
        if (old + 1u == (gen + 1u) * nloc) {
            __builtin_amdgcn_fence(__ATOMIC_RELEASE, "agent");
            asm volatile("s_waitcnt vmcnt(0)" ::: "memory");
            const unsigned og = xb_add(&bar[XB_TOP], 1u);
            const unsigned tg = og / nx;
            if (og + 1u == (tg + 1u) * nx) xb_add(&bar[XB_TOPGEN], 1u);
            else XB_SPIN(xb_ld(&bar[XB_TOPGEN]) == tg, bar);
            __builtin_amdgcn_fence(__ATOMIC_ACQUIRE, "agent");
            xb_add(&bar[XB_XGEN(b.x)], 1u);
            asm volatile("s_waitcnt vmcnt(0)" ::: "memory");
        } else {
            XB_SPIN(xb_ld(&bar[XB_XGEN(b.x)]) == gen, bar);
            __builtin_amdgcn_fence(__ATOMIC_ACQUIRE, "agent");
            asm volatile("s_waitcnt vmcnt(0)" ::: "memory");
        }
    }
    __syncthreads();
}
namespace pg8 {
constexpr int BM = 256, BK = 64, HALF = 128, HTB = HALF * BK * 2, STAGE_BYTES = 8 * HTB, NXCD = 8, WGM = 8;
__host__ __device__ __forceinline__ int lds_byte(int r, int c) { const int st = (r >> 4) * 2 + (c >> 5), rr = r & 15, cc = c & 31, ob = rr * 64 + cc * 2; return st * 1024 + (ob ^ (((ob >> 9) & 1) << 5)); }
__host__ __device__ __forceinline__ void stage_rc(int b, int& R, int& C) { const int st = b / 1024, sb = b % 1024, swz = sb ^ (((sb >> 9) & 1) << 5); R = (st >> 1) * 16 + swz / 64; C = (st & 1) * 32 + (swz % 64) / 2; }
__host__ __device__ __forceinline__ int perm32(int rho) { const int n = rho >> 4, i = rho & 15; return 8 * (i >> 2) + 4 * n + (i & 3); }

struct Unit { int pm, pn, arow, brow, e, orow; };
struct Gemm { const bf16_t* A; const bf16_t* Bt; int K; };

struct StaticOrder {
    int nM, nN, nwg, G, c;
    __device__ void init(int M, int N, int G_, int c_) { nM = M / BM; nN = N / BM; nwg = nM * nN; G = G_; c = c_; }
    __device__ __forceinline__ void start() const {}
    __device__ __forceinline__ bool next(int i, Unit& u) const {
        const long L = (long)i * G + c; if (L >= nwg) return false;
        int wgid = (int)L; { const int q = nwg / NXCD, r = nwg % NXCD, xcd = wgid % NXCD, off = wgid / NXCD; wgid = (xcd < r ? xcd * (q + 1) : r * (q + 1) + (xcd - r) * q) + off; }
        const int nig = WGM * nN, gid = wgid / nig, fm = gid * WGM, gsz = (nM - fm) < WGM ? (nM - fm) : WGM;
        u.pm = fm + ((wgid % nig) % gsz); u.pn = (wgid % nig) / gsz; u.arow = u.pm * BM; u.brow = u.pn * BM; u.e = 0; u.orow = u.arow; return true;
    }
    __device__ __forceinline__ void refill(int) const {}
    __device__ __forceinline__ unsigned gather_row(const Unit&, int) const { return 0u; }
};

template <class Epi, class Sched, bool GATHER>
__device__ __forceinline__ void gemm_phase(LAS unsigned char* lds, const Gemm g, Sched& S, const Epi& E) {
    const int tid = threadIdx.x, wid = __builtin_amdgcn_readfirstlane(tid >> 6), lane = tid & 63, wr = wid >> 2, wc = wid & 3, fr = lane & 15, fq = lane >> 4;
    const int K = g.K, nt = K / BK;
    unsigned voffB[2]; unsigned va[2][2];
    const size_t kstep = (size_t)(BK * 2);
    const size_t hstep = (size_t)HALF * K * 2;
#pragma unroll
    for (int i = 0; i < 2; ++i) { int R, C; stage_rc(tid * 16 + i * 8192, R, C); const int Rb = Epi::PERM ? ((R & ~31) + perm32(R & 31)) : R;
        voffB[i] = (unsigned)(Rb * K + C) * 2u;
        va[0][i] = (unsigned)(R * K + C) * 2u; va[1][i] = va[0][i] + (unsigned)hstep; }
    const unsigned ldsw = (unsigned)wid * 1024u;
    const int aoff = lds_byte(wr * 64 + fr, fq * 8), boff = lds_byte(wc * 32 + fr, fq * 8);
#define PG8_SA(b, h) (((b) * 2 + (h)) * HTB)
#define PG8_SB(b, h) ((4 + (b) * 2 + (h)) * HTB)
#define PG8_STAGEB(bufoff, gbase) do { _Pragma("unroll") for (int _i = 0; _i < 2; ++_i) \
        __builtin_amdgcn_global_load_lds((const unsigned*)((const char*)(gbase) + voffB[_i]), (LAS unsigned*)(lds + (bufoff) + ldsw + _i * 8192), 16, 0, 0); } while (0)
#define PG8_STAGEA(bufoff, gbase, vo, h) do { _Pragma("unroll") for (int _i = 0; _i < 2; ++_i) \
        __builtin_amdgcn_global_load_lds((const unsigned*)((const char*)(gbase) + (vo)[h][_i]), (LAS unsigned*)(lds + (bufoff) + ldsw + _i * 8192), 16, 0, 0); } while (0)
#define PG8_LDA(dst, b, h) do { _Pragma("unroll") for (int m = 0; m < 4; ++m) _Pragma("unroll") for (int k = 0; k < 2; ++k) dst[m][k] = *(const LAS bf16x8*)(lds + PG8_SA(b, h) + aoff + m * 2048 + k * 1024); } while (0)
#define PG8_LDB(dst, b, h) do { _Pragma("unroll") for (int n = 0; n < 2; ++n) _Pragma("unroll") for (int k = 0; k < 2; ++k) dst[n][k] = *(const LAS bf16x8*)(lds + PG8_SB(b, h) + boff + n * 2048 + k * 1024); } while (0)
#define PG8_MMA(ai, bj, At, Bt) do { __builtin_amdgcn_s_setprio(1); _Pragma("unroll") for (int m = 0; m < 4; ++m) _Pragma("unroll") for (int n = 0; n < 2; ++n) _Pragma("unroll") for (int k = 0; k < 2; ++k) \
        acc[ai][bj][m][n] = __builtin_amdgcn_mfma_f32_16x16x32_bf16(Bt[n][k], At[m][k], acc[ai][bj][m][n], 0, 0, 0); __builtin_amdgcn_s_setprio(0); } while (0)
#define PG8_WAIT_V(n) asm volatile("s_waitcnt vmcnt(" #n ")" ::: "memory")
#define PG8_WAIT_L(n) asm volatile("s_waitcnt lgkmcnt(" #n ")" ::: "memory")
#define PG8_BAR __builtin_amdgcn_s_barrier()
#define PG8_SCHED __builtin_amdgcn_sched_barrier(0)
    Unit cur, nxt; int ui = 0;
    S.start();
    if (!S.next(0, cur)) return;
    f32x4 acc[2][2][4][2];
#pragma unroll
    for (int a = 0; a < 2; ++a)
#pragma unroll
        for (int b = 0; b < 2; ++b)
#pragma unroll
            for (int m = 0; m < 4; ++m)
#pragma unroll
                for (int n = 0; n < 2; ++n) acc[a][b][m][n] = (f32x4){0.f, 0.f, 0.f, 0.f};
    bf16x8 At[4][2], B0[2][2], B1[2][2];
    const char* cA; const char* cB = (const char*)g.Bt + (size_t)cur.brow * K * 2;
    if constexpr (GATHER) { cA = (const char*)g.A;
#pragma unroll
        for (int h = 0; h < 2; ++h)
#pragma unroll
            for (int i = 0; i < 2; ++i) { int R, C; stage_rc(tid * 16 + i * 8192, R, C); va[h][i] = (S.gather_row(cur, h * HALF + R) * (unsigned)K + (unsigned)C) * 2u; }
    } else cA = (const char*)g.A + (size_t)cur.arow * K * 2;
    PG8_STAGEB(PG8_SB(0, 0), cB); PG8_STAGEB(PG8_SB(0, 1), cB + hstep); PG8_STAGEA(PG8_SA(0, 0), cA, va, 0); PG8_STAGEA(PG8_SA(0, 1), cA, va, 1);
    if (wr == 1) PG8_BAR;
    PG8_WAIT_V(2); PG8_BAR;
    PG8_STAGEB(PG8_SB(1, 0), cB + kstep); PG8_STAGEA(PG8_SA(1, 0), cA + kstep, va, 0); PG8_STAGEB(PG8_SB(1, 1), cB + hstep + kstep);
    PG8_WAIT_V(6); PG8_BAR;
    for (;;) {
        bool has_next = false; const char* nA = cA; const char* nB = cB;
        unsigned vnx[2][2] = {{0u, 0u}, {0u, 0u}};
        for (int t = 0; t < nt; t += 2) {
            const bool last = (t == nt - 2);
            unsigned v2[2][2];
#pragma unroll
            for (int h = 0; h < 2; ++h)
#pragma unroll
                for (int i = 0; i < 2; ++i) v2[h][i] = va[h][i];
            if (last) {
                has_next = S.next(ui + 1, nxt);
                if (has_next) { nB = (const char*)g.Bt + (size_t)nxt.brow * K * 2;
                    if constexpr (GATHER) {
#pragma unroll
                        for (int h = 0; h < 2; ++h)
#pragma unroll
                            for (int i = 0; i < 2; ++i) { int R, C; stage_rc(tid * 16 + i * 8192, R, C); v2[h][i] = (S.gather_row(nxt, h * HALF + R) * (unsigned)K + (unsigned)C) * 2u; }
                    } else nA = (const char*)g.A + (size_t)nxt.arow * K * 2;
                }
            }
            if constexpr (GATHER) { if (last) {
#pragma unroll
                for (int h = 0; h < 2; ++h)
#pragma unroll
                    for (int i = 0; i < 2; ++i) vnx[h][i] = v2[h][i]; } }
            const char* a1 = cA + (size_t)(t + 1) * kstep;
            const char* a2 = last ? nA : cA + (size_t)(t + 2) * kstep; const char* b2 = last ? nB : cB + (size_t)(t + 2) * kstep;
            const char* a3 = a2 + kstep; const char* b3 = b2 + kstep;
            PG8_LDB(B0, 0, 0); PG8_LDB(B1, 0, 1); PG8_SCHED; PG8_LDA(At, 0, 0); PG8_STAGEA(PG8_SA(1, 1), a1, va, 1);
            PG8_WAIT_V(8); PG8_WAIT_L(0); PG8_BAR; PG8_MMA(0, 0, At, B0); PG8_MMA(0, 1, At, B1); PG8_BAR; PG8_SCHED;
            PG8_LDA(At, 0, 1); PG8_STAGEB(PG8_SB(0, 0), b2); PG8_STAGEB(PG8_SB(0, 1), b2 + hstep); PG8_STAGEA(PG8_SA(0, 0), a2, v2, 0);
            PG8_WAIT_V(8); PG8_WAIT_L(0); PG8_BAR; PG8_MMA(1, 0, At, B0); PG8_MMA(1, 1, At, B1); PG8_BAR; PG8_SCHED;
            PG8_LDB(B0, 1, 0); PG8_LDB(B1, 1, 1); PG8_SCHED; PG8_LDA(At, 1, 0); PG8_STAGEA(PG8_SA(0, 1), a2, v2, 1);
            PG8_WAIT_V(8); PG8_WAIT_L(0); PG8_BAR; PG8_MMA(0, 0, At, B0); PG8_MMA(0, 1, At, B1); PG8_BAR; PG8_SCHED;
            PG8_LDA(At, 1, 1); PG8_STAGEB(PG8_SB(1, 0), b3); PG8_STAGEB(PG8_SB(1, 1), b3 + hstep); PG8_STAGEA(PG8_SA(1, 0), a3, v2, 0);
            PG8_WAIT_V(8); PG8_WAIT_L(0); PG8_BAR; PG8_MMA(1, 0, At, B0); PG8_MMA(1, 1, At, B1); PG8_BAR; PG8_SCHED;
        }
        if (wr == 0) PG8_BAR;
        S.refill(ui);
        E(acc, cur, wr, wc, fr, fq, lds);
        if (!has_next) break;
#pragma unroll
        for (int a = 0; a < 2; ++a)
#pragma unroll
            for (int b = 0; b < 2; ++b)
#pragma unroll
                for (int m = 0; m < 4; ++m)
#pragma unroll
                    for (int n = 0; n < 2; ++n) acc[a][b][m][n] = (f32x4){0.f, 0.f, 0.f, 0.f};
        cur = nxt; cA = nA; cB = nB; ++ui;
        if constexpr (GATHER) {
#pragma unroll
            for (int h = 0; h < 2; ++h)
#pragma unroll
                for (int i = 0; i < 2; ++i) va[h][i] = vnx[h][i];
        }
        if (wr == 1) PG8_BAR;
    }
    PG8_WAIT_V(0);
    PG8_BAR;
#undef PG8_SA
#undef PG8_SB
#undef PG8_STAGEA
#undef PG8_STAGEB
#undef PG8_LDA
#undef PG8_LDB
#undef PG8_MMA
#undef PG8_WAIT_V
#undef PG8_WAIT_L
#undef PG8_BAR
#undef PG8_SCHED
}
}
struct EpiSwiGLU {
    static constexpr bool PERM = true;
    bf16_t* O; int ldo; const float* lrs;
    __device__ __forceinline__ void operator()(const f32x4 (&acc)[2][2][4][2], const pg8::Unit& u, int wr, int wc, int fr, int fq, LAS unsigned char*) const {
        const int r0 = wr * 64 + fr, col0 = u.pn * 128 + wc * 32 + 8 * fq;
#pragma unroll
        for (int ai = 0; ai < 2; ++ai) {
            float rs[4];
#pragma unroll
            for (int m = 0; m < 4; ++m) rs[m] = lrs ? lrs[(size_t)u.e * T + u.arow + ai * 128 + m * 16 + r0] : 1.f;
#pragma unroll
            for (int m = 0; m < 4; ++m) {
                const float s = rs[m]; float o[8];
#pragma unroll
                for (int n = 0; n < 2; ++n)
#pragma unroll
                    for (int j = 0; j < 4; ++j) { const float gv = acc[ai][0][m][n][j] * s, uv = acc[ai][1][m][n][j] * s; o[n * 4 + j] = silu_f(gv) * uv; }
                u32x4 w; w.x = cvt_pk_bf16(o[0], o[1]); w.y = cvt_pk_bf16(o[2], o[3]); w.z = cvt_pk_bf16(o[4], o[5]); w.w = cvt_pk_bf16(o[6], o[7]);
                *(u32x4*)(O + (size_t)(u.orow + ai * 128 + m * 16 + r0) * ldo + col0) = w;
            }
        }
    }
};
struct EpiRes {
    static constexpr bool PERM = false;
    float* H; bf16_t* HB; float* ssq;
    __device__ __forceinline__ void operator()(const f32x4 (&acc)[2][2][4][2], const pg8::Unit& u, int wr, int wc, int fr, int fq, LAS unsigned char*) const {
        const int r0 = u.orow + wr * 64 + fr, col0 = u.pn * 256 + wc * 32 + 4 * fq;
#pragma unroll
        for (int ai = 0; ai < 2; ++ai)
#pragma unroll
            for (int m = 0; m < 4; ++m) {
                const size_t off = (size_t)(r0 + ai * 128 + m * 16) * D + col0; float sq = 0.f;
#pragma unroll
                for (int bj = 0; bj < 2; ++bj)
#pragma unroll
                    for (int n = 0; n < 2; ++n) {
                        const f32x4 hv = *(const f32x4*)(H + off + bj * 128 + n * 16) + acc[ai][bj][m][n];
                        *(f32x4*)(H + off + bj * 128 + n * 16) = hv;
                        u32x2 w; w.x = cvt_pk_bf16(hv[0], hv[1]); w.y = cvt_pk_bf16(hv[2], hv[3]);
                        *(u32x2*)(HB + off + bj * 128 + n * 16) = w;
                        sq += (hv[0] * hv[0] + hv[1] * hv[1]) + (hv[2] * hv[2] + hv[3] * hv[3]);
                    }
                if (ssq) { sq += __shfl_xor(sq, 16); sq += __shfl_xor(sq, 32);
                    if (fq == 0) ssq[(size_t)(r0 + ai * 128 + m * 16) * 16 + u.pn * 4 + wc] = sq; }
            }
    }
};
struct EpiQKV {
    static constexpr bool PERM = true;
    bf16_t* O; const float* ssq;
    __device__ __forceinline__ void operator()(const f32x4 (&acc)[2][2][4][2], const pg8::Unit& u, int wr, int wc, int fr, int fq, LAS unsigned char* lds) const {
        LAS float* rtab = (LAS float*)(lds + RTAB_OFF);
        { const int tid = threadIdx.x, row = tid >> 1, part = tid & 1;
          const f32x4* p = (const f32x4*)(ssq + (size_t)(u.orow + row) * 16 + part * 8);
          const f32x4 a = p[0], b = p[1]; float s = ((a[0] + a[1]) + (a[2] + a[3])) + ((b[0] + b[1]) + (b[2] + b[3]));
          s += __shfl_xor(s, 1);
          if (part == 0) rtab[row] = 1.0f / sqrtf(s * (1.f / D) + EPS); }
        asm volatile("s_waitcnt lgkmcnt(0)" ::: "memory"); __builtin_amdgcn_s_barrier(); asm volatile("" ::: "memory");
        const float qs = (u.pn * 256 < 3072) ? 0.125f : 1.f;
        const int r0 = wr * 64 + fr, col0 = u.pn * 256 + wc * 32 + 8 * fq;
#pragma unroll
        for (int ai = 0; ai < 2; ++ai)
#pragma unroll
            for (int m = 0; m < 4; ++m) {
                const float s = rtab[ai * 128 + m * 16 + r0] * qs;
#pragma unroll
                for (int bj = 0; bj < 2; ++bj) {
                    const f32x4 v0 = acc[ai][bj][m][0] * s, v1 = acc[ai][bj][m][1] * s;
                    u32x4 w; w.x = cvt_pk_bf16(v0[0], v0[1]); w.y = cvt_pk_bf16(v0[2], v0[3]); w.z = cvt_pk_bf16(v1[0], v1[1]); w.w = cvt_pk_bf16(v1[2], v1[3]);
                    *(u32x4*)(O + (size_t)(u.orow + ai * 128 + m * 16 + r0) * NQKV + col0 + bj * 128) = w;
                }
            }
    }
};
struct EpiY {
    static constexpr bool PERM = true;
    bf16_t* Y;
    __device__ __forceinline__ void operator()(const f32x4 (&acc)[2][2][4][2], const pg8::Unit& u, int wr, int wc, int fr, int fq, LAS unsigned char*) const {
        const int r0 = u.orow + wr * 64 + fr, col0 = u.pn * 256 + wc * 32 + 8 * fq;
#pragma unroll
        for (int ai = 0; ai < 2; ++ai)
#pragma unroll
            for (int m = 0; m < 4; ++m)
#pragma unroll
                for (int bj = 0; bj < 2; ++bj) {
                    const f32x4 v0 = acc[ai][bj][m][0], v1 = acc[ai][bj][m][1];
                    u32x4 w; w.x = cvt_pk_bf16(v0[0], v0[1]); w.y = cvt_pk_bf16(v0[2], v0[3]); w.z = cvt_pk_bf16(v1[0], v1[1]); w.w = cvt_pk_bf16(v1[2], v1[3]);
                    *(u32x4*)(Y + (size_t)(r0 + ai * 128 + m * 16) * D + col0 + bj * 128) = w;
                }
    }
};

constexpr int MI_CNT = 0, MI_TB = 8, MI_NT = 17;
__device__ __forceinline__ void moe_info_build(LAS unsigned char* lds, const unsigned* ctl) {
    volatile LAS int* mi = (volatile LAS int*)(lds + SCR_OFF);
    if (threadIdx.x == 0) { int tb = 0;
        for (int e = 0; e < NE; ++e) { const int c = (int)__hip_atomic_load(ctl + CW_CNT + e, RLX_AGENT); mi[MI_CNT + e] = c; mi[MI_TB + e] = tb; tb += (c + 255) >> 8; }
        mi[MI_TB + NE] = tb; mi[MI_NT] = tb; }
    LDS_WAIT(); __syncthreads();
}
struct DynQ {
    unsigned* ctr; volatile LAS unsigned* slot;
    __device__ __forceinline__ void start() const { if (threadIdx.x == 0) { slot[0] = atomicAdd(ctr, 1u); slot[1] = atomicAdd(ctr, 1u); } LDS_WAIT(); __syncthreads(); }
#ifdef MK_STATICQ
    __device__ __forceinline__ int fetch(int i) const { return i * (int)gridDim.x + (int)blockIdx.x; }
#else
    __device__ __forceinline__ int fetch(int i) const { return __builtin_amdgcn_readfirstlane((int)slot[i & 3]); }
#endif
    __device__ __forceinline__ void refill(int ui) const { if (threadIdx.x == 0) { slot[(ui + 2) & 3] = atomicAdd(ctr, 1u); } }
};
template <int NN, bool G1>
struct MoeOrder {
    DynQ q; volatile LAS int* mi; int c0, ntc; const int* ltok;
    __device__ __forceinline__ void start() const { q.start(); }
    __device__ __forceinline__ void refill(int ui) const { q.refill(ui); }
    __device__ __forceinline__ bool next(int i, pg8::Unit& u) const {
        const int idx = q.fetch(i); if (idx >= ntc * NN) return false;
        const int grp = idx / (8 * NN), r = idx - grp * (8 * NN), gsz = (ntc - grp * 8) < 8 ? (ntc - grp * 8) : 8;
        const int pml = grp * 8 + r % gsz, pn = r / gsz, pmg = c0 + pml;
        int e = 0;
#pragma unroll
        for (int k = 1; k < NE; ++k) e += (pmg >= mi[MI_TB + k]) ? 1 : 0;
        e = __builtin_amdgcn_readfirstlane(e);
        u.pm = pmg; u.pn = pn; u.e = e;
        if (G1) { u.arow = (pmg - __builtin_amdgcn_readfirstlane(mi[MI_TB + e])) * 256; u.brow = e * (2 * FF1) + pn * 256; u.orow = pml * 256; }
        else { u.arow = pml * 256; u.brow = e * D + pn * 256; u.orow = pmg * 256; }
        return true;
    }
    __device__ __forceinline__ unsigned gather_row(const pg8::Unit& u, int r) const {
        const int lr = u.arow + r; const int c = mi[MI_CNT + u.e];
        return lr < c ? (unsigned)ltok[(size_t)u.e * T + lr] : 0u;
    }
};
struct Args { const float* in[19]; float* out; unsigned char* ws; int ph_lo, ph_hi, li, pad; };
enum { I_X = 0, I_ANORM, I_APROJ, I_ASCALE, I_KVNORM, I_WKV, I_BNORM, I_WQ, I_WO, I_RELB, I_FFNORM, I_DWG, I_DWU, I_DWD, I_ROUTER, I_MWG, I_MWU, I_MWD, I_FNORM };
struct Frame {
    LAS unsigned char* lds; unsigned* ctl; int tid, lane, wave, G, bid;
    float* h; unsigned char* ws;
};
__device__ __forceinline__ void conv_item(const float* W, int ldw, const float* gain, bf16_t* WT, int K, int dst_row0, LAS float* scr, int k0, int n0, int lane) {
#pragma unroll 8
    for (int i = 0; i < 32; ++i) { const int kk = 2 * i + (lane >> 5); float v = W[(size_t)(k0 + kk) * ldw + n0 + (lane & 31)]; if (gain) v *= gain[k0 + kk]; scr[kk * 33 + (lane & 31)] = v; }
    LDS_WAIT(); asm volatile("" ::: "memory");
    const int c = lane & 7;
#pragma unroll
    for (int j = 0; j < 4; ++j) { const int n = (lane >> 3) + 8 * j; const LAS float* s = scr + (8 * c) * 33 + n;
        u32x4 o; o.x = pk2(s[0 * 33], s[1 * 33]); o.y = pk2(s[2 * 33], s[3 * 33]); o.z = pk2(s[4 * 33], s[5 * 33]); o.w = pk2(s[6 * 33], s[7 * 33]);
        *(u32x4*)(WT + (size_t)(dst_row0 + n) * K + k0 + 8 * c) = o; }
    LDS_WAIT(); asm volatile("" ::: "memory");
}
__device__ __forceinline__ void conv_job(const Frame& F, int& it0, const float* W, int K, int N, int ldw, const float* gain, bf16_t* WT, int mode, int row_off, LAS float* scr) {
    const int nblk = N / 32, items = (K / 64) * nblk, NGW = F.G * NWAVES;
    int it = it0;
    for (; it < items; it += NGW) {
        const int kb = it / nblk, nb = it - kb * nblk, n0 = nb * 32;
        const int dr = (mode == 0) ? (row_off + n0) : (row_off + (n0 >> 7) * 256 + (n0 & 127) + (mode == 2 ? 128 : 0));
        conv_item(W, ldw, gain, WT, K, dr, scr, kb * 64, n0, F.lane);
    }
    it0 = it - items;
}
__device__ __forceinline__ void conv_small(const Frame& F, const Args& A) {
    LAS float* scr = (LAS float*)(F.lds + RING_OFF + F.wave * 16384);
    int it = F.bid * NWAVES + F.wave;
    unsigned char* ws = F.ws;
    for (int g = 0; g < 4; ++g) conv_job(F, it, A.in[I_APROJ] + (size_t)g * 65536, 256, 256, 256, nullptr, (bf16_t*)(ws + WS_APT) + (size_t)g * 65536, 0, 0, scr);
    conv_job(F, it, A.in[I_DWG], D, FF0, FF0, nullptr, (bf16_t*)(ws + WS_WGU0), 1, 0, scr);
    conv_job(F, it, A.in[I_DWU], D, FF0, FF0, nullptr, (bf16_t*)(ws + WS_WGU0), 2, 0, scr);
    conv_job(F, it, A.in[I_DWD], FF0, D, D, nullptr, (bf16_t*)(ws + WS_WD0), 0, 0, scr);
    conv_job(F, it, A.in[I_WQ], D, 3072, 3072, A.in[I_BNORM], (bf16_t*)(ws + WS_WQKV), 0, 0, scr);
    conv_job(F, it, A.in[I_WKV], D, 6144, 6144, A.in[I_KVNORM], (bf16_t*)(ws + WS_WQKV), 0, 3072, scr);
    conv_job(F, it, A.in[I_WO], D, D, D, nullptr, (bf16_t*)(ws + WS_WO), 0, 0, scr);
}
__device__ __forceinline__ void conv_moe(const Frame& F, const Args& A) {
    LAS float* scr = (LAS float*)(F.lds + RING_OFF + F.wave * 16384);
    int it = F.bid * NWAVES + F.wave;
    unsigned char* ws = F.ws;
    for (int e = 0; e < NE; ++e) {
        conv_job(F, it, A.in[I_MWG] + (size_t)e * D * FF1, D, FF1, FF1, A.in[I_FFNORM] + D, (bf16_t*)(ws + WS_WGU1) + (size_t)e * 2 * FF1 * D, 1, 0, scr);
        conv_job(F, it, A.in[I_MWU] + (size_t)e * D * FF1, D, FF1, FF1, A.in[I_FFNORM] + D, (bf16_t*)(ws + WS_WGU1) + (size_t)e * 2 * FF1 * D, 2, 0, scr);
        conv_job(F, it, A.in[I_MWD] + (size_t)e * FF1 * D, FF1, D, D, nullptr, (bf16_t*)(ws + WS_WD1) + (size_t)e * D * FF1, 0, 0, scr);
    }
}

__device__ __forceinline__ void mixer_phase(const Frame& F, const Args& A) {
    LAS float* rs = (LAS float*)(F.lds + 0);
    LAS float* xn = (LAS float*)(F.lds + 512);
    LAS bf16_t* pl = (LAS bf16_t*)(F.lds + 512 + 80896);
    LAS float* sw = (LAS float*)(F.lds + 512 + 80896 + 33792);
    const int lane = F.lane, w = F.wave, tid = F.tid, fr = lane & 15, fq = lane >> 4;
    const bf16_t* apt = (const bf16_t*)(F.ws + WS_APT);
    bf16_t* hn0 = (bf16_t*)(F.ws + WS_S0);
    for (int tile = F.bid; tile < T / 64; tile += F.G) {
        const int t0 = tile * 64, s0 = t0 % SEQ, halo = s0 ? 15 : 0, nrows = 64 + halo;
        for (int j = w; j < nrows; j += NWAVES) {
            const f32x4* p = (const f32x4*)(A.in[I_X] + (size_t)(t0 - halo + j) * D); float s = 0.f;
#pragma unroll
            for (int q = 0; q < 4; ++q) { const f32x4 v = p[lane + 64 * q]; s += (v[0] * v[0] + v[1] * v[1]) + (v[2] * v[2] + v[3] * v[3]); }
            s = wave_sum(s);
            if (lane == 0) rs[j] = 1.0f / sqrtf(s * (1.f / D) + EPS);
        }
        LDS_WAIT(); __syncthreads();
        float ss[4] = {0.f, 0.f, 0.f, 0.f};
        for (int g = 0; g < 4; ++g) {
            { const f32x4 gn = *(const f32x4*)(A.in[I_ANORM] + g * 256 + 4 * lane);
              for (int j = w; j < nrows; j += NWAVES) {
                  const f32x4 v = *(const f32x4*)(A.in[I_X] + (size_t)(t0 - halo + j) * D + g * 256 + 4 * lane); const float r = rs[j];
                  *(LAS f32x4*)(xn + j * 256 + 4 * lane) = (f32x4){v[0] * r * gn[0], v[1] * r * gn[1], v[2] * r * gn[2], v[3] * r * gn[3]}; } }
            LDS_WAIT(); __syncthreads();
            { const int c4 = (tid & 63) * 4, win = 2 << g;
#pragma unroll 1
              for (int i = 0; i < 8; ++i) { const int r = (tid >> 6) + 8 * i, s = s0 + r, cnt = (s + 1 < win) ? (s + 1) : win;
                  f32x4 a = {0.f, 0.f, 0.f, 0.f};
                  for (int jj = 0; jj < cnt; ++jj) a += *(const LAS f32x4*)(xn + (halo + r - jj) * 256 + c4);
                  const f32x4 self = *(const LAS f32x4*)(xn + (halo + r) * 256 + c4); const float inv = 1.f / (float)cnt;
                  u32x2 o; o.x = pk2(a[0] * inv - self[0], a[1] * inv - self[1]); o.y = pk2(a[2] * inv - self[2], a[3] * inv - self[3]);
                  *(LAS u32x2*)(pl + r * 264 + c4) = o; } }
            LDS_WAIT(); __syncthreads();
            f32x4 acc[4][2];
#pragma unroll
            for (int m = 0; m < 4; ++m) { acc[m][0] = (f32x4){0.f, 0.f, 0.f, 0.f}; acc[m][1] = (f32x4){0.f, 0.f, 0.f, 0.f}; }
#pragma unroll
            for (int ks = 0; ks < 8; ++ks) {
                bf16x8 bfr[2], afr[4];
#pragma unroll
                for (int n = 0; n < 2; ++n) bfr[n] = *(const bf16x8*)(apt + (size_t)g * 65536 + (size_t)(32 * w + 16 * n + fr) * 256 + 32 * ks + 8 * fq);
#pragma unroll
                for (int m = 0; m < 4; ++m) afr[m] = *(const LAS bf16x8*)(pl + (16 * m + fr) * 264 + 32 * ks + 8 * fq);
#pragma unroll
                for (int m = 0; m < 4; ++m)
#pragma unroll
                    for (int n = 0; n < 2; ++n) acc[m][n] = __builtin_amdgcn_mfma_f32_16x16x32_bf16(bfr[n], afr[m], acc[m][n], 0, 0, 0);
            }
#pragma unroll
            for (int m = 0; m < 4; ++m)
#pragma unroll
                for (int n = 0; n < 2; ++n) { const int col = g * 256 + 32 * w + 16 * n + 4 * fq; const size_t off = (size_t)(t0 + 16 * m + fr) * D + col;
                    const f32x4 sc = *(const f32x4*)(A.in[I_ASCALE] + col); const f32x4 hv = *(const f32x4*)(A.in[I_X] + off) + acc[m][n] * sc;
                    *(f32x4*)(F.h + off) = hv; ss[m] += (hv[0] * hv[0] + hv[1] * hv[1]) + (hv[2] * hv[2] + hv[3] * hv[3]); }
        }
#pragma unroll
        for (int m = 0; m < 4; ++m) { float s = ss[m]; s += __shfl_xor(s, 16); s += __shfl_xor(s, 32); if (fq == 0) sw[(16 * m + fr) * 8 + w] = s; }
        VM_WAIT(); LDS_WAIT(); __syncthreads();
        for (int j = w; j < 64; j += NWAVES) {
            float s = 0.f;
#pragma unroll
            for (int q = 0; q < 8; ++q) s += sw[j * 8 + q];
            const float r1 = 1.0f / sqrtf(s * (1.f / D) + EPS);
            const f32x4* p = (const f32x4*)(F.h + (size_t)(t0 + j) * D); u32x2* o = (u32x2*)(hn0 + (size_t)(t0 + j) * D);
#pragma unroll
            for (int q = 0; q < 4; ++q) { const f32x4 v = p[lane + 64 * q]; const f32x4 gn = *(const f32x4*)(A.in[I_FFNORM] + 4 * (lane + 64 * q));
                u32x2 ov; ov.x = pk2(v[0] * r1 * gn[0], v[1] * r1 * gn[1]); ov.y = pk2(v[2] * r1 * gn[2], v[3] * r1 * gn[3]); o[lane + 64 * q] = ov; }
        }
        LDS_WAIT(); __syncthreads();
    }
}

__device__ __forceinline__ void router_phase(const Frame& F, const Args& A) {
    volatile LAS int* li = (volatile LAS int*)(F.lds + 0);
    volatile LAS float* lf = (volatile LAS float*)(F.lds + 2048);
    int* ltok = (int*)(F.ws + WS_LTOK); float* lrs = (float*)(F.ws + WS_LRS); u32x4* tinfo = (u32x4*)(F.ws + WS_TOKINFO);
    const int lane = F.lane, w = F.wave, tid = F.tid;
    const float* gain = A.in[I_FFNORM] + D;
    for (int tile = F.bid; tile < T / 64; tile += F.G) {
        const int t0 = tile * 64;
        if (tid < 8) li[tid] = 0;
        LDS_WAIT(); __syncthreads();
        for (int k = 0; k < 8; ++k) {
            const int tl = 8 * w + k, t = t0 + tl;
            const f32x4* p = (const f32x4*)(F.h + (size_t)t * D);
            f32x4 v[4]; float s = 0.f;
#pragma unroll
            for (int q = 0; q < 4; ++q) { v[q] = p[lane + 64 * q]; s += (v[q][0] * v[q][0] + v[q][1] * v[q][1]) + (v[q][2] * v[q][2] + v[q][3] * v[q][3]); }
            s = wave_sum(s);
            const float r = 1.0f / sqrtf(s * (1.f / D) + EPS);
            float lg[8] = {0.f, 0.f, 0.f, 0.f, 0.f, 0.f, 0.f, 0.f};
#pragma unroll
            for (int q = 0; q < 4; ++q) { const int c0 = 4 * (lane + 64 * q); const f32x4 gn = *(const f32x4*)(gain + c0);
#pragma unroll
                for (int j = 0; j < 4; ++j) { const float xv = v[q][j] * r * gn[j]; const f32x4 w0 = *(const f32x4*)(A.in[I_ROUTER] + (size_t)(c0 + j) * 8), w1 = *(const f32x4*)(A.in[I_ROUTER] + (size_t)(c0 + j) * 8 + 4);
                    lg[0] += xv * w0[0]; lg[1] += xv * w0[1]; lg[2] += xv * w0[2]; lg[3] += xv * w0[3]; lg[4] += xv * w1[0]; lg[5] += xv * w1[1]; lg[6] += xv * w1[2]; lg[7] += xv * w1[3]; } }
#pragma unroll
            for (int e = 0; e < 8; ++e) lg[e] = wave_sum(lg[e]);
            if (lane == 0) {
                float b1 = lg[0]; int i1 = 0;
#pragma unroll
                for (int e = 1; e < 8; ++e) if (lg[e] > b1) { b1 = lg[e]; i1 = e; }
                float b2 = -3.0e38f; int i2 = 0;
#pragma unroll
                for (int e = 0; e < 8; ++e) if (e != i1 && lg[e] > b2) { b2 = lg[e]; i2 = e; }
                const float e2 = expf(b2 - b1), g1 = 1.f / (1.f + e2), g2 = e2 / (1.f + e2);
                const int r1 = __hip_atomic_fetch_add((LAS int*)&li[i1], 1, __ATOMIC_RELAXED, __HIP_MEMORY_SCOPE_WORKGROUP), r2 = __hip_atomic_fetch_add((LAS int*)&li[i2], 1, __ATOMIC_RELAXED, __HIP_MEMORY_SCOPE_WORKGROUP);
                li[16 + tl * 4 + 0] = i1; li[16 + tl * 4 + 1] = i2; li[16 + tl * 4 + 2] = r1; li[16 + tl * 4 + 3] = r2;
                lf[tl * 4 + 0] = g1; lf[tl * 4 + 1] = g2; lf[tl * 4 + 2] = r;
            }
        }
        LDS_WAIT(); __syncthreads();
        if (tid < 8) li[8 + tid] = (int)atomicAdd(F.ctl + CW_CNT + tid, (unsigned)li[tid]);
        LDS_WAIT(); __syncthreads();
        if (tid < 64) {
            const int i1 = li[16 + tid * 4 + 0], i2 = li[16 + tid * 4 + 1], s1 = li[8 + i1] + li[16 + tid * 4 + 2], s2 = li[8 + i2] + li[16 + tid * 4 + 3];
            const float g1 = lf[tid * 4 + 0], g2 = lf[tid * 4 + 1], r = lf[tid * 4 + 2];
            ltok[(size_t)i1 * T + s1] = t0 + tid; lrs[(size_t)i1 * T + s1] = r;
            ltok[(size_t)i2 * T + s2] = t0 + tid; lrs[(size_t)i2 * T + s2] = r;
            u32x4 ti; ti.x = (unsigned)(s1 << 3 | i1); ti.y = (unsigned)(s2 << 3 | i2); ti.z = __builtin_bit_cast(unsigned, g1); ti.w = __builtin_bit_cast(unsigned, g2);
            tinfo[t0 + tid] = ti;
        }
        LDS_WAIT(); __syncthreads();
    }
}

__device__ __forceinline__ void final_phase(const Frame& F, const Args& A) {
    volatile LAS int* mi = (volatile LAS int*)(F.lds + SCR_OFF);
    const u32x4* tinfo = (const u32x4*)(F.ws + WS_TOKINFO); const bf16_t* Y = (const bf16_t*)(F.ws + WS_Y);
    const int lane = F.lane;
    for (int t = F.bid * NWAVES + F.wave; t < T; t += F.G * NWAVES) {
        const u32x4 ti = tinfo[t];
        const int e1 = ti.x & 7, s1 = ti.x >> 3, e2 = ti.y & 7, s2 = ti.y >> 3; const unsigned gz = ti.z, gw = ti.w; const float g1 = __uint_as_float(gz), g2 = __uint_as_float(gw);
        const size_t r1 = (size_t)mi[MI_TB + e1] * 256 + s1, r2 = (size_t)mi[MI_TB + e2] * 256 + s2;
        f32x4* p = (f32x4*)(F.h + (size_t)t * D); const u32x2* y1 = (const u32x2*)(Y + r1 * D); const u32x2* y2 = (const u32x2*)(Y + r2 * D);
        f32x4 v[4]; float s = 0.f;
#pragma unroll
        for (int q = 0; q < 4; ++q) { const f32x4 hv = p[lane + 64 * q]; const u32x2 a = y1[lane + 64 * q], b = y2[lane + 64 * q];
            f32x4 o;
            o[0] = hv[0] + g1 * bf2f((unsigned short)(a.x & 0xffff)) + g2 * bf2f((unsigned short)(b.x & 0xffff));
            o[1] = hv[1] + g1 * bf2f((unsigned short)(a.x >> 16)) + g2 * bf2f((unsigned short)(b.x >> 16));
            o[2] = hv[2] + g1 * bf2f((unsigned short)(a.y & 0xffff)) + g2 * bf2f((unsigned short)(b.y & 0xffff));
            o[3] = hv[3] + g1 * bf2f((unsigned short)(a.y >> 16)) + g2 * bf2f((unsigned short)(b.y >> 16));
            v[q] = o; s += (o[0] * o[0] + o[1] * o[1]) + (o[2] * o[2] + o[3] * o[3]); }
        s = wave_sum(s);
        const float r = 1.0f / sqrtf(s * (1.f / D) + EPS);
#pragma unroll
        for (int q = 0; q < 4; ++q) { const f32x4 gn = *(const f32x4*)(A.in[I_FNORM] + 4 * (lane + 64 * q)); p[lane + 64 * q] = (f32x4){v[q][0] * r * gn[0], v[q][1] * r * gn[1], v[q][2] * r * gn[2], v[q][3] * r * gn[3]}; }
    }
}

__device__ __forceinline__ int t5_bucket(int n) {
    if (n < 16) return n;
    int large = 16 + (int)(log((double)n / 16.0) / log(128.0) * 16.0);
    return large < 31 ? large : 31;
}
__device__ __forceinline__ void attn_valu_phase(const Frame& F, const Args& A) {
    LAS float* btab = (LAS float*)(F.lds + 0);
    for (int i = F.tid; i < 3 * 16 * 129; i += NTHREADS) { const int g = i / (16 * 129), r = i - g * 16 * 129, hh = r / 129, m = r - hh * 129; const int dil = g == 0 ? 1 : (g == 1 ? 4 : 16);
        btab[i] = A.in[I_RELB][t5_bucket(m * dil) * 48 + g * 16 + hh]; }
    LDS_WAIT(); __syncthreads();
    const bf16_t* qkv = (const bf16_t*)(F.ws + WS_QKV); bf16_t* mo = (bf16_t*)(F.ws + WS_S0);
    const int lane = F.lane;
    for (int u = F.bid * NWAVES + F.wave; u < T * 16; u += F.G * NWAVES) {
        const int t = u >> 4, hh = u & 15, s = t % SEQ;
        float m = -1e30f, l = 0.f, a = 0.f;
        for (int g = 0; g < 3; ++g) {
            const int dil = g == 0 ? 1 : (g == 1 ? 4 : 16), i = s / dil, mmax = i < 128 ? i : 128;
            const float qv = bf2f(qkv[(size_t)t * NQKV + g * 1024 + hh * 64 + lane]);
            for (int mm = 0; mm <= mmax; ++mm) {
                const size_t tk = (size_t)(t - mm * dil) * NQKV + g * 1024 + hh * 64 + lane;
                const float kv = bf2f(qkv[tk + 3072]);
                const float logit = wave_sum(qv * kv) + btab[(g * 16 + hh) * 129 + mm];
                const float mn = fmaxf(m, logit), f = expf(m - mn), pe = expf(logit - mn);
                l = l * f + pe; a = a * f + pe * bf2f(qkv[tk + 6144]); m = mn;
            }
        }
        mo[(size_t)t * D + hh * 64 + lane] = (bf16_t)f2bf(a / l);
    }
    __syncthreads();
}
typedef float f32x16 __attribute__((ext_vector_type(16)));
typedef short s16x4 __attribute__((ext_vector_type(4)));
constexpr int AT_TAB = 0;
constexpr int AT_V = 8192;
constexpr float L2E = 1.4426950408889634f;
__device__ __forceinline__ s16x4 vtr(const LAS unsigned char* p) { return __builtin_bit_cast(s16x4, __builtin_amdgcn_ds_read_tr16_b64_v4i16((LAS s16x4*)p)); }

__device__ __forceinline__ void attn_phase(const Frame& F, const Args& A) {
    LAS float* tab = (LAS float*)(F.lds + AT_TAB);
    const bf16_t* qkv = (const bf16_t*)(F.ws + WS_QKV); bf16_t* mo = (bf16_t*)(F.ws + WS_S0);
    const int lane = F.lane, w = F.wave, j = lane & 31, hi = lane >> 5;
    LAS unsigned char* vbuf = F.lds + AT_V + w * 4096;
    for (int u = F.bid; u < NBATCH * 16 * 2; u += F.G) {
        const int b = u >> 5, h = (u >> 1) & 15, cp = u & 1, tb = b * SEQ;
        __syncthreads();
        for (int i = F.tid; i < 3 * 640; i += NTHREADS) { const int g = i / 640, m = i - g * 640 - 256; const int dil = g == 0 ? 1 : (g == 1 ? 4 : 16);
            tab[i] = (m >= 0 && m <= 128) ? A.in[I_RELB][t5_bucket(m * dil) * 48 + g * 16 + h] * L2E : -1e30f; }
        LDS_WAIT(); __syncthreads();
        const int c = 2 * cp + (w & 1);
#pragma unroll 1
        for (int rd = 0; rd < 4; ++rd) {
            const int i0 = 32 * (4 * rd + (w >> 1));
            const int ktlo0 = (4 - i0 / 8) > 0 ? (4 - i0 / 8) : 0, n0 = 8 - ktlo0;
            const int ktlo1 = (4 - i0 / 32) > 0 ? (4 - i0 / 32) : 0, n1 = 5 - ktlo1;
            const int nk2 = ((i0 / 4 + 7) >> 5) + 1, ntl = n0 + n1 + 4 * nk2;
            const size_t tq = (size_t)(tb + 4 * (i0 + j) + c);
            f32x16 o0, o1;
#pragma unroll
            for (int r = 0; r < 16; ++r) { o0[r] = 0.f; o1[r] = 0.f; }
            float M = -1e29f, l = 0.f;
#define AT_DESC(n, g_, kb_, ks_, bq_) do { int n_ = (n); if (n_ < n0) { g_ = 0; const int kt = ktlo0 + n_; kb_ = 4 * i0 - 128 + 32 * kt; ks_ = 1; bq_ = 4 * (i0 + j) + c - kb_; } \
                else if (n_ < n0 + n1) { g_ = 1; const int kt = ktlo1 + n_ - n0; kb_ = 4 * (i0 - 128 + 32 * kt) + c; ks_ = 4; bq_ = i0 + j - (i0 - 128 + 32 * kt); } \
                else { g_ = 2; const int r_ = n_ - n0 - n1, sub = r_ / nk2, kt = r_ - sub * nk2; kb_ = 16 * 32 * kt + 4 * sub + c; ks_ = 16; bq_ = ((j & 3) == sub) ? (i0 / 4 + (j >> 2) - 32 * kt) : -200; } } while (0)
            int g, kb, ks, bq; AT_DESC(0, g, kb, ks, bq);
            bf16x8 qf[4], kf[4]; u32x4 vr[4];
            { const bf16_t* qp = qkv + tq * NQKV + g * 1024 + h * 64 + 8 * hi;
#pragma unroll
              for (int d0 = 0; d0 < 4; ++d0) qf[d0] = *(const bf16x8*)(qp + 16 * d0); }
            { const bf16_t* kp = qkv + (size_t)(tb + kb + ks * j) * NQKV + 3072 + g * 1024 + h * 64 + 8 * hi;
#pragma unroll
              for (int d0 = 0; d0 < 4; ++d0) kf[d0] = *(const bf16x8*)(kp + 16 * d0);
#pragma unroll
              for (int i = 0; i < 4; ++i) vr[i] = *(const u32x4*)(qkv + (size_t)(tb + kb + ks * (8 * i + (lane >> 3))) * NQKV + 6144 + g * 1024 + h * 64 + 8 * (lane & 7)); }
#pragma unroll 1
            for (int n = 0; n < ntl; ++n) {
#pragma unroll
                for (int i = 0; i < 4; ++i) { const int kk = 8 * i + (lane >> 3), cch = lane & 7;
                    *(LAS u32x4*)(vbuf + (cch >> 2) * 2048 + (kk >> 4) * 1024 + (kk & 15) * 64 + (cch & 3) * 16) = vr[i]; }
                const LAS float* tl = tab + g * 640 + 256 + bq - 4 * hi - 27;
                f32x16 s;
#pragma unroll
                for (int r = 0; r < 16; ++r) s[r] = 0.f;
#pragma unroll
                for (int d0 = 0; d0 < 4; ++d0) s = __builtin_amdgcn_mfma_f32_32x32x16_bf16(kf[d0], qf[d0], s, 0, 0, 0);
                int gn = g, kbn = kb, ksn = ks, bqn = bq;
                if (n + 1 < ntl) { AT_DESC(n + 1, gn, kbn, ksn, bqn);
                    const bf16_t* kp = qkv + (size_t)(tb + kbn + ksn * j) * NQKV + 3072 + gn * 1024 + h * 64 + 8 * hi;
#pragma unroll
                    for (int d0 = 0; d0 < 4; ++d0) kf[d0] = *(const bf16x8*)(kp + 16 * d0);
#pragma unroll
                    for (int i = 0; i < 4; ++i) vr[i] = *(const u32x4*)(qkv + (size_t)(tb + kbn + ksn * (8 * i + (lane >> 3))) * NQKV + 6144 + gn * 1024 + h * 64 + 8 * (lane & 7));
                    if (gn != g) { const bf16_t* qp = qkv + tq * NQKV + gn * 1024 + h * 64 + 8 * hi;
#pragma unroll
                        for (int d0 = 0; d0 < 4; ++d0) qf[d0] = *(const bf16x8*)(qp + 16 * d0); }
                }
                float rm = -3.0e38f;
#pragma unroll
                for (int r = 0; r < 16; ++r) { s[r] = s[r] * L2E + tl[27 - ((r & 3) + 8 * (r >> 2))]; rm = fmaxf(rm, s[r]); }
                rm = fmaxf(rm, __shfl_xor(rm, 32));
                const float Mn = fmaxf(M, rm), al = __builtin_amdgcn_exp2f(M - Mn); M = Mn;
                float ps = 0.f;
#pragma unroll
                for (int r = 0; r < 16; ++r) { s[r] = __builtin_amdgcn_exp2f(s[r] - Mn); ps += s[r]; }
                l = l * al + ps;
#pragma unroll
                for (int r = 0; r < 16; ++r) { o0[r] *= al; o1[r] *= al; }
                u32x4 pw0, pw1;
                pw0.x = cvt_pk_bf16(s[0], s[1]); pw0.y = cvt_pk_bf16(s[2], s[3]); pw0.z = cvt_pk_bf16(s[4], s[5]); pw0.w = cvt_pk_bf16(s[6], s[7]);
                pw1.x = cvt_pk_bf16(s[8], s[9]); pw1.y = cvt_pk_bf16(s[10], s[11]); pw1.z = cvt_pk_bf16(s[12], s[13]); pw1.w = cvt_pk_bf16(s[14], s[15]);
                const bf16x8 pa0 = __builtin_bit_cast(bf16x8, pw0), pa1 = __builtin_bit_cast(bf16x8, pw1);
                const LAS unsigned char* vp = vbuf + (4 * hi + ((lane & 15) >> 2)) * 64 + ((lane >> 4) & 1) * 32 + (lane & 3) * 8;
                LDS_WAIT();
#pragma unroll
                for (int dh = 0; dh < 2; ++dh) {
                    const s16x4 a0 = vtr(vp + dh * 2048), a1 = vtr(vp + dh * 2048 + 512), b0 = vtr(vp + dh * 2048 + 1024), b1 = vtr(vp + dh * 2048 + 1536);
                    const bf16x8 v0 = (bf16x8){a0[0], a0[1], a0[2], a0[3], a1[0], a1[1], a1[2], a1[3]}, v1 = (bf16x8){b0[0], b0[1], b0[2], b0[3], b1[0], b1[1], b1[2], b1[3]};
                    if (dh == 0) { o0 = __builtin_amdgcn_mfma_f32_32x32x16_bf16(v0, pa0, o0, 0, 0, 0); o0 = __builtin_amdgcn_mfma_f32_32x32x16_bf16(v1, pa1, o0, 0, 0, 0); }
                    else { o1 = __builtin_amdgcn_mfma_f32_32x32x16_bf16(v0, pa0, o1, 0, 0, 0); o1 = __builtin_amdgcn_mfma_f32_32x32x16_bf16(v1, pa1, o1, 0, 0, 0); }
                }
                g = gn; kb = kbn; ks = ksn; bq = bqn;
            }
#undef AT_DESC
            l += __shfl_xor(l, 32);
            const float il = 1.0f / l;
            bf16_t* op = mo + tq * D + h * 64 + 4 * hi;
#pragma unroll
            for (int gq = 0; gq < 4; ++gq) {
                u32x2 w0, w1;
                w0.x = cvt_pk_bf16(o0[4 * gq] * il, o0[4 * gq + 1] * il); w0.y = cvt_pk_bf16(o0[4 * gq + 2] * il, o0[4 * gq + 3] * il);
                w1.x = cvt_pk_bf16(o1[4 * gq] * il, o1[4 * gq + 1] * il); w1.y = cvt_pk_bf16(o1[4 * gq + 2] * il, o1[4 * gq + 3] * il);
                *(u32x2*)(op + 8 * gq) = w0; *(u32x2*)(op + 32 + 8 * gq) = w1;
            }
        }
    }
    __syncthreads();
}
constexpr int PH_MIX = 0, PH_FF1 = 1, PH_FF2 = 2, PH_QKV = 3, PH_ATT = 4, PH_WO = 5, PH_ROUTE = 6, PH_MOE0 = 7, PH_FINAL = 12, PH_END = 13;

__global__ void __launch_bounds__(NTHREADS, 2) mk_fwd(Args args) {
    extern __shared__ __attribute__((aligned(16))) unsigned char lds_raw[];
    Frame F;
    F.lds = (LAS unsigned char*)lds_raw;
    F.tid = threadIdx.x; F.lane = F.tid & 63; F.wave = __builtin_amdgcn_readfirstlane(F.tid >> 6); F.G = gridDim.x; F.bid = blockIdx.x;
    F.ws = args.ws; F.ctl = (unsigned*)(args.ws + WS_CTL); F.h = args.out;
    volatile LAS unsigned* MISC = (volatile LAS unsigned*)(F.lds + MISC_OFF);
    for (int u = F.tid; u < 64; u += NTHREADS) MISC[u] = 0u;
    __syncthreads();
    XcdBarrier bar = xcd_barrier_post(F.ctl + CW_BAR + args.li * XCD_BAR_WORDS, MISC + 8);
    const int lo = args.ph_lo, hi = args.ph_hi;
#ifndef MK_MASK
#define MK_MASK 0xffffffffu
#endif
#define IN(k) (((MK_MASK >> (k)) & 1u) && lo <= (k) && (k) < hi)
#define SEAM(k) do { if (IN(k) && IN((k) + 1)) xcd_barrier(bar); } while (0)
    unsigned char* ws = args.ws;
    LAS unsigned char* ring = F.lds + RING_OFF;

    if (IN(PH_MIX)) { conv_small(F, args); VM_WAIT(); __syncthreads(); }
    if (IN(PH_MIX)) { xcd_barrier(bar); mixer_phase(F, args); }
    SEAM(PH_MIX);

    if (IN(PH_FF1)) {
        pg8::Gemm g{(const bf16_t*)(ws + WS_S0), (const bf16_t*)(ws + WS_WGU0), D}; pg8::StaticOrder S; S.init(T, 2 * FF0, F.G, F.bid);
        EpiSwiGLU E{(bf16_t*)(ws + WS_ACT0), FF0, nullptr};
        pg8::gemm_phase<EpiSwiGLU, pg8::StaticOrder, false>(ring, g, S, E);
    }
    SEAM(PH_FF1);
    if (IN(PH_FF2)) {
        pg8::Gemm g{(const bf16_t*)(ws + WS_ACT0), (const bf16_t*)(ws + WS_WD0), FF0}; pg8::StaticOrder S; S.init(T, D, F.G, F.bid);
        EpiRes E{F.h, (bf16_t*)(ws + WS_S1), (float*)(ws + WS_SSQ)};
        pg8::gemm_phase<EpiRes, pg8::StaticOrder, false>(ring, g, S, E);
    }
    SEAM(PH_FF2);
    if (IN(PH_QKV)) {
        pg8::Gemm g{(const bf16_t*)(ws + WS_S1), (const bf16_t*)(ws + WS_WQKV), D}; pg8::StaticOrder S; S.init(T, NQKV, F.G, F.bid);
        EpiQKV E{(bf16_t*)(ws + WS_QKV), (const float*)(ws + WS_SSQ)};
        pg8::gemm_phase<EpiQKV, pg8::StaticOrder, false>(ring, g, S, E);
    }
    SEAM(PH_QKV);
    #ifdef MK_VALU_ATTN
    if (IN(PH_ATT)) { attn_valu_phase(F, args); }
#else
    if (IN(PH_ATT)) { attn_phase(F, args); }
#endif
    SEAM(PH_ATT);
    if (IN(PH_WO)) {
        pg8::Gemm g{(const bf16_t*)(ws + WS_S0), (const bf16_t*)(ws + WS_WO), D}; pg8::StaticOrder S; S.init(T, D, F.G, F.bid);
        EpiRes E{F.h, (bf16_t*)(ws + WS_S1), nullptr};
        pg8::gemm_phase<EpiRes, pg8::StaticOrder, false>(ring, g, S, E);
        conv_moe(F, args);
    }
    SEAM(PH_WO);
    if (IN(PH_ROUTE)) { router_phase(F, args); }
    SEAM(PH_ROUTE);
#pragma unroll 1
    for (int j = 0; j < 5; ++j) {
        if (IN(PH_MOE0 + j)) {
            moe_info_build(F.lds, F.ctl);
            volatile LAS int* mi = (volatile LAS int*)(F.lds + SCR_OFF);
            const int ntiles = __builtin_amdgcn_readfirstlane(mi[MI_NT]);
            if (j >= 1) {
                const int c0 = (j - 1) * CH_TILES; int ntc = ntiles - c0; ntc = ntc < 0 ? 0 : (ntc > CH_TILES ? CH_TILES : ntc);
                pg8::Gemm g{(const bf16_t*)(ws + WS_ACT1 + (size_t)((j - 1) & 1) * ACT1_CHUNK), (const bf16_t*)(ws + WS_WD1), FF1};
                MoeOrder<4, false> S{{F.ctl + CW_Q + 64 * (2 * j), MISC + 16}, mi, c0, ntc, nullptr};
                EpiY E{(bf16_t*)(ws + WS_Y)};
                pg8::gemm_phase<EpiY, MoeOrder<4, false>, false>(ring, g, S, E);
            }
            if (j <= 3) {
                const int c0 = j * CH_TILES; int ntc = ntiles - c0; ntc = ntc < 0 ? 0 : (ntc > CH_TILES ? CH_TILES : ntc);
                pg8::Gemm g{(const bf16_t*)(ws + WS_S1), (const bf16_t*)(ws + WS_WGU1), D};
                MoeOrder<28, true> S{{F.ctl + CW_Q + 64 * (2 * j + 1), MISC + 16}, mi, c0, ntc, (const int*)(ws + WS_LTOK)};
                EpiSwiGLU E{(bf16_t*)(ws + WS_ACT1 + (size_t)(j & 1) * ACT1_CHUNK), FF1, (const float*)(ws + WS_LRS)};
                pg8::gemm_phase<EpiSwiGLU, MoeOrder<28, true>, true>(ring, g, S, E);
            }
        }
        SEAM(PH_MOE0 + j);
    }
    if (IN(PH_FINAL)) { moe_info_build(F.lds, F.ctl); final_phase(F, args); }
#undef IN
#undef SEAM
}
}
#ifndef MK_STEP
#define MK_STEP 1
#endif
static void naive_dense_ffn(hipStream_t stream, float* h, float* rstd, float* big, const float* ffn_norm, const float* dwg, const float* dwu, const float* dwd) {
    using namespace nv; GemmP p{};
    hipLaunchKernelGGL(k_rstd, dim3(T / 4), dim3(256), 0, stream, h, rstd);
    p = GemmP{}; p.A = h; p.lda = D; p.B1 = dwg; p.B2 = dwu; p.ldb = FF0; p.C = big; p.ldc = FF0; p.M = T; p.N = FF0; p.K = D; p.rowscale = rstd; p.kgain = ffn_norm; gemm<2>(stream, p);
    p = GemmP{}; p.A = big; p.lda = FF0; p.B1 = dwd; p.ldb = D; p.C = h; p.ldc = D; p.M = T; p.N = D; p.K = FF0; p.R = h; p.ldr = D; gemm<3>(stream, p);
}
static void naive_mixer_b(hipStream_t stream, float* h, float* rstd, float* big, float* buf0, float* mbuf, float* lbuf, const float* w_q, const float* w_kv, const float* w_o, const float* b_norm, const float* kv_norm, const float* rel_bias) {
    using namespace nv; GemmP p{};
    hipLaunchKernelGGL(k_rstd, dim3(T / 4), dim3(256), 0, stream, h, rstd);
    float* qg = big; float* kg = big + (size_t)T * D; float* vg = big + (size_t)2 * T * D;
    const int dil[3] = {1, 4, 16};
    for (int g = 0; g < 3; ++g) {
        p = GemmP{}; p.A = h; p.lda = D; p.B1 = w_q + g * 1024; p.ldb = 3072; p.C = qg; p.ldc = D; p.M = T; p.N = D; p.K = D; p.rowscale = rstd; p.kgain = b_norm; gemm<0>(stream, p);
        p.B1 = w_kv + g * 1024; p.ldb = 6144; p.C = kg; p.kgain = kv_norm; gemm<0>(stream, p);
        p.B1 = w_kv + 3072 + g * 1024; p.C = vg; gemm<0>(stream, p);
        hipLaunchKernelGGL(k_attn, dim3(T * 16 / 4), dim3(256), 0, stream, qg, kg, vg, rel_bias, buf0, mbuf, lbuf, g, dil[g]);
    }
    p = GemmP{}; p.A = buf0; p.lda = D; p.B1 = w_o; p.ldb = D; p.C = h; p.ldc = D; p.M = T; p.N = D; p.K = D; p.R = h; p.ldr = D; gemm<3>(stream, p);
}
static void naive_moe_final(hipStream_t stream, float* h, float* rstd, float* big, float* buf0, float* gates, const float* ffn_norm, const float* router, const float* mwg, const float* mwu, const float* mwd, const float* final_norm) {
    using namespace nv; GemmP p{};
    hipLaunchKernelGGL(k_rstd, dim3(T / 4), dim3(256), 0, stream, h, rstd);
    hipLaunchKernelGGL(k_router, dim3(T / 4), dim3(256), 0, stream, h, rstd, ffn_norm + D, router, gates);
    (void)hipMemcpyAsync(buf0, h, (size_t)T * D * 4, hipMemcpyDeviceToDevice, stream);
    for (int e = 0; e < NE; ++e) {
        p = GemmP{}; p.A = buf0; p.lda = D; p.B1 = mwg + (size_t)e * D * FF1; p.B2 = mwu + (size_t)e * D * FF1; p.ldb = FF1; p.C = big; p.ldc = FF1; p.M = T; p.N = FF1; p.K = D;
        p.rowscale = rstd; p.kgain = ffn_norm + D; gemm<2>(stream, p);
        p = GemmP{}; p.A = big; p.lda = FF1; p.B1 = mwd + (size_t)e * FF1 * D; p.ldb = D; p.C = h; p.ldc = D; p.M = T; p.N = D; p.K = FF1; p.rowgate = gates + e; p.rg_stride = 8; gemm<4>(stream, p);
    }
    hipLaunchKernelGGL(k_final, dim3(T / 4), dim3(256), 0, stream, h, final_norm, h);
}

extern "C" void kernel_launch(void* const* d_in, const int* in_sizes, int n_in, void* d_out, int out_size, void* d_ws, size_t ws_size, hipStream_t stream) {
    static int grid = 0;
    if (grid == 0) {
        if (n_in != 19 || out_size != mk::T * mk::D || ws_size < mk::WS_END) { fprintf(stderr, "kernel_launch: unexpected shapes / workspace (%d inputs, out %d, ws %zu)\n", n_in, out_size, ws_size); grid = -1; return; }
        int dev = 0, cus = 0;
        if (hipGetDevice(&dev) != hipSuccess || hipDeviceGetAttribute(&cus, hipDeviceAttributeMultiprocessorCount, dev) != hipSuccess) { grid = -1; return; }
        if (hipFuncSetAttribute((const void*)mk::mk_fwd, hipFuncAttributeMaxDynamicSharedMemorySize, mk::LDS_BYTES) != hipSuccess) { fprintf(stderr, "kernel_launch: hipFuncSetAttribute failed\n"); grid = -1; return; }
        int per_cu = 0;
        if (hipOccupancyMaxActiveBlocksPerMultiprocessor(&per_cu, (const void*)mk::mk_fwd, mk::NTHREADS, mk::LDS_BYTES) != hipSuccess || per_cu < 1) { fprintf(stderr, "kernel_launch: occupancy query says %d blocks per CU\n", per_cu); }
        (void)hipGetLastError();
        grid = cus;
    }
    if (grid < 0) return;
    const float* in[19]; for (int i = 0; i < 19; ++i) in[i] = (const float*)d_in[i];
    (void)hipMemsetAsync((char*)d_ws + mk::WS_CTL, 0, mk::CTL_ZERO_BYTES, stream);
    mk::Args a{};
    for (int i = 0; i < 19; ++i) a.in[i] = in[i];
    a.out = (float*)d_out; a.ws = (unsigned char*)d_ws;
    float* h = (float*)d_out; char* ws = (char*)d_ws; const size_t MiB = 1u << 20;
    float* rstd = (float*)(ws + 1 * MiB); float* mbuf = (float*)(ws + 2 * MiB); float* lbuf = (float*)(ws + 3 * MiB); float* gates = (float*)(ws + 4 * MiB);
    float* buf0 = (float*)(ws + 5 * MiB); float* big = (float*)(ws + 69 * MiB);
#if MK_STEP == 1
    a.ph_lo = 0; a.ph_hi = 3; a.li = 0;
    hipLaunchKernelGGL(mk::mk_fwd, dim3(grid), dim3(mk::NTHREADS), mk::LDS_BYTES, stream, a);
    naive_mixer_b(stream, h, rstd, big, buf0, mbuf, lbuf, in[7], in[5], in[8], in[6], in[4], in[9]);
    naive_moe_final(stream, h, rstd, big, buf0, gates, in[10], in[14], in[15], in[16], in[17], in[18]);
#elif MK_STEP == 2
    a.ph_lo = 0; a.ph_hi = 6; a.li = 0;
    hipLaunchKernelGGL(mk::mk_fwd, dim3(grid), dim3(mk::NTHREADS), mk::LDS_BYTES, stream, a);
    naive_moe_final(stream, h, rstd, big, buf0, gates, in[10], in[14], in[15], in[16], in[17], in[18]);
#else
    a.ph_lo = 0; a.ph_hi = mk::PH_END; a.li = 0;
    hipLaunchKernelGGL(mk::mk_fwd, dim3(grid), dim3(mk::NTHREADS), mk::LDS_BYTES, stream, a);
#endif
}
```

```cpp
#include <hip/hip_runtime.h>
#include <cstdio>
#include <cstdint>
#define MK_STEP 3
namespace nv {
constexpr int T = 16384, D = 1024, S = 2048, NB = 8;
constexpr int FF0 = 2816, FF1 = 3584, NE = 8;
constexpr float EPS = 1e-6f;

__device__ __forceinline__ float wave_sum(float v) {
#pragma unroll
    for (int o = 1; o < 64; o <<= 1) v += __shfl_xor(v, o);
    return v;
}
__device__ __forceinline__ float silu(float x) { return x / (1.f + expf(-x)); }

__global__ void k_rstd(const float* __restrict__ x, float* __restrict__ rstd) {
    const int row = blockIdx.x * 4 + (threadIdx.x >> 6), lane = threadIdx.x & 63;
    const float4* p = (const float4*)(x + (size_t)row * D);
    float s = 0.f;
#pragma unroll
    for (int j = 0; j < 4; ++j) { const float4 v = p[lane + 64 * j]; s += v.x * v.x + v.y * v.y + v.z * v.z + v.w * v.w; }
    s = wave_sum(s);
    if (lane == 0) rstd[row] = 1.0f / sqrtf(s * (1.f / D) + EPS);
}

__global__ void k_pool(const float* __restrict__ x, const float* __restrict__ rstd, const float* __restrict__ gain, float* __restrict__ pooled) {
    const int t = blockIdx.x, c = threadIdx.x * 4;
    const int s = t % S, g = c >> 8, w = 2 << g;
    const int cnt = (s + 1 < w) ? (s + 1) : w;
    const float4 gn = *(const float4*)(gain + c);
    float4 acc = {0.f, 0.f, 0.f, 0.f}, self = {0.f, 0.f, 0.f, 0.f};
    for (int j = 0; j < cnt; ++j) {
        const float r = rstd[t - j]; const float4 v = *(const float4*)(x + (size_t)(t - j) * D + c);
        const float4 xn = {v.x * r * gn.x, v.y * r * gn.y, v.z * r * gn.z, v.w * r * gn.w};
        acc.x += xn.x; acc.y += xn.y; acc.z += xn.z; acc.w += xn.w;
        if (j == 0) self = xn;
    }
    const float inv = 1.f / (float)cnt;
    float4 o = {acc.x * inv - self.x, acc.y * inv - self.y, acc.z * inv - self.z, acc.w * inv - self.w};
    *(float4*)(pooled + (size_t)t * D + c) = o;
}

struct GemmP {
    const float* A; int lda; const float* B1; const float* B2; int ldb; float* C; int ldc; int M, N, K;
    const float* rowscale; const float* kgain;
    const float* R; int ldr; const float* cs; const float* rowgate; int rg_stride; int mode;
};
template <int MODE>
__global__ void __launch_bounds__(256) k_gemm(GemmP p) {
    __shared__ float As[16][68], Bs[16][68], Bs2[MODE == 2 ? 16 : 1][68];
    const int tx = threadIdx.x & 15, ty = threadIdx.x >> 4, m0 = blockIdx.y * 64, n0 = blockIdx.x * 64;
    float acc[4][4] = {}, acc2[4][4] = {};
    const int ar = threadIdx.x >> 2, ac = (threadIdx.x & 3) * 4;
    const int br = threadIdx.x >> 4, bc = (threadIdx.x & 15) * 4;
    const float rs = p.rowscale ? p.rowscale[m0 + ar] : 1.f;
    for (int k0 = 0; k0 < p.K; k0 += 16) {
        float4 a = *(const float4*)(p.A + (size_t)(m0 + ar) * p.lda + k0 + ac);
        if (p.kgain) { const float4 g = *(const float4*)(p.kgain + k0 + ac); a.x *= g.x; a.y *= g.y; a.z *= g.z; a.w *= g.w; }
        As[ac + 0][ar] = a.x * rs; As[ac + 1][ar] = a.y * rs; As[ac + 2][ar] = a.z * rs; As[ac + 3][ar] = a.w * rs;
        const float4 b = *(const float4*)(p.B1 + (size_t)(k0 + br) * p.ldb + n0 + bc);
        *(float4*)&Bs[br][bc] = b;
        if (MODE == 2) { const float4 b2 = *(const float4*)(p.B2 + (size_t)(k0 + br) * p.ldb + n0 + bc); *(float4*)&Bs2[br][bc] = b2; }
        __syncthreads();
#pragma unroll
        for (int k = 0; k < 16; ++k) {
            const float4 av = *(const float4*)&As[k][ty * 4]; const float4 bv = *(const float4*)&Bs[k][tx * 4];
            const float aa[4] = {av.x, av.y, av.z, av.w}, bb[4] = {bv.x, bv.y, bv.z, bv.w};
#pragma unroll
            for (int i = 0; i < 4; ++i)
#pragma unroll
                for (int j = 0; j < 4; ++j) acc[i][j] += aa[i] * bb[j];
            if (MODE == 2) { const float4 cv = *(const float4*)&Bs2[k][tx * 4]; const float cc[4] = {cv.x, cv.y, cv.z, cv.w};
#pragma unroll
                for (int i = 0; i < 4; ++i)
#pragma unroll
                    for (int j = 0; j < 4; ++j) acc2[i][j] += aa[i] * cc[j]; }
        }
        __syncthreads();
    }
#pragma unroll
    for (int i = 0; i < 4; ++i) {
        const int row = m0 + ty * 4 + i;
#pragma unroll
        for (int j = 0; j < 4; ++j) {
            const int col = n0 + tx * 4 + j; float v = acc[i][j];
            float* c = p.C + (size_t)row * p.ldc + col;
            if (MODE == 1) v = p.R[(size_t)row * p.ldr + col] + v * p.cs[col];
            if (MODE == 2) v = silu(v) * acc2[i][j];
            if (MODE == 3) v = p.R[(size_t)row * p.ldr + col] + v;
            if (MODE == 4) v = *c + p.rowgate[(size_t)row * p.rg_stride] * v;
            *c = v;
        }
    }
}

__device__ __forceinline__ int t5_bucket(int n) {
    if (n < 16) return n;
    int large = 16 + (int)(log((double)n / 16.0) / log(128.0) * 16.0);
    return large < 31 ? large : 31;
}

__global__ void k_attn(const float* __restrict__ q, const float* __restrict__ k, const float* __restrict__ v, const float* __restrict__ rel_bias,
                       float* __restrict__ acc, float* __restrict__ mbuf, float* __restrict__ lbuf, int g, int dil) {
    const int wid = blockIdx.x * 4 + (threadIdx.x >> 6), lane = threadIdx.x & 63;
    const int t = wid >> 4, h = wid & 15, s = t % S, i = s / dil;
    const float qv = q[(size_t)t * D + h * 64 + lane] * 0.125f;
    float m = g == 0 ? -1e30f : mbuf[wid], l = g == 0 ? 0.f : lbuf[wid], a = g == 0 ? 0.f : acc[(size_t)t * D + h * 64 + lane];
    const int mmax = i < 128 ? i : 128;
    for (int mm = 0; mm <= mmax; ++mm) {
        const int tk = t - mm * dil;
        const float kv = k[(size_t)tk * D + h * 64 + lane];
        float logit = wave_sum(qv * kv) + rel_bias[t5_bucket(mm * dil) * 48 + g * 16 + h];
        const float mn = fmaxf(m, logit), f = expf(m - mn), pexp = expf(logit - mn);
        l = l * f + pexp; a = a * f + pexp * v[(size_t)tk * D + h * 64 + lane]; m = mn;
    }
    if (g == 2) a = a / l;
    acc[(size_t)t * D + h * 64 + lane] = a;
    if (lane == 0) { mbuf[wid] = m; lbuf[wid] = l; }
}

__global__ void k_router(const float* __restrict__ h, const float* __restrict__ rstd, const float* __restrict__ gain, const float* __restrict__ wr, float* __restrict__ gates) {
    const int t = blockIdx.x * 4 + (threadIdx.x >> 6), lane = threadIdx.x & 63;
    float lg[8] = {};
    const float r = rstd[t];
    for (int j = 0; j < 16; ++j) {
        const int c = lane + 64 * j; const float xv = h[(size_t)t * D + c] * r * gain[c];
#pragma unroll
        for (int e = 0; e < 8; ++e) lg[e] += xv * wr[c * 8 + e];
    }
#pragma unroll
    for (int e = 0; e < 8; ++e) lg[e] = wave_sum(lg[e]);
    if (lane == 0) {
        float b1 = lg[0]; int i1 = 0;
#pragma unroll
        for (int e = 1; e < 8; ++e) if (lg[e] > b1) { b1 = lg[e]; i1 = e; }
        float b2 = -3.0e38f; int i2 = 0;
#pragma unroll
        for (int e = 0; e < 8; ++e) if (e != i1 && lg[e] > b2) { b2 = lg[e]; i2 = e; }
        const float e2 = expf(b2 - b1), g1 = 1.f / (1.f + e2), g2 = e2 / (1.f + e2);
        for (int e = 0; e < 8; ++e) gates[(size_t)t * 8 + e] = (e == i1) ? g1 : (e == i2) ? g2 : 0.f;
    }
}

__global__ void k_final(const float* h, const float* __restrict__ gain, float* out) {
    const int row = blockIdx.x * 4 + (threadIdx.x >> 6), lane = threadIdx.x & 63;
    const float4* p = (const float4*)(h + (size_t)row * D);
    float4 v[4]; float s = 0.f;
#pragma unroll
    for (int j = 0; j < 4; ++j) { v[j] = p[lane + 64 * j]; s += v[j].x * v[j].x + v[j].y * v[j].y + v[j].z * v[j].z + v[j].w * v[j].w; }
    s = wave_sum(s);
    const float r = 1.0f / sqrtf(s * (1.f / D) + EPS);
#pragma unroll
    for (int j = 0; j < 4; ++j) { const float4 g = *(const float4*)(gain + 4 * (lane + 64 * j));
        float4 o = {v[j].x * r * g.x, v[j].y * r * g.y, v[j].z * r * g.z, v[j].w * r * g.w};
        ((float4*)(out + (size_t)row * D))[lane + 64 * j] = o; }
}

template <int MODE> static void gemm(hipStream_t st, const GemmP& p) {
    hipLaunchKernelGGL(k_gemm<MODE>, dim3(p.N / 64, p.M / 64), dim3(256), 0, st, p);
}
}

namespace mk {
#define LAS __attribute__((address_space(3)))
#define GAS __attribute__((address_space(1)))
typedef unsigned short bf16_t;
typedef short bf16x8 __attribute__((ext_vector_type(8)));
typedef float f32x4 __attribute__((ext_vector_type(4)));
typedef float f32x2 __attribute__((ext_vector_type(2)));
typedef unsigned u32x4 __attribute__((ext_vector_type(4)));
typedef unsigned u32x2 __attribute__((ext_vector_type(2)));

constexpr int T = 16384, D = 1024, SEQ = 2048, NBATCH = 8;
constexpr int FF0 = 2816, FF1 = 3584, NE = 8, NQKV = 9216;
constexpr int ACT0_LD = FF0 + 64;
constexpr int QKV_LD = NQKV + 64;
constexpr float EPS = 1e-6f;
constexpr int NWAVES = 8, NTHREADS = 512;

constexpr size_t MiB = 1u << 20;
constexpr size_t WS_CTL = 0, CTL_ZERO_BYTES = 1 * MiB;
constexpr size_t WS_SSQ = 1 * MiB;
constexpr size_t WS_LTOK = 2 * MiB;
constexpr size_t WS_LRS = 2 * MiB + 512 * 1024;
constexpr size_t WS_TOKINFO = 3 * MiB;
constexpr size_t WS_ZERO = 3 * MiB + 256 * 1024;
constexpr size_t WS_APT = 3 * MiB + 512 * 1024;
constexpr size_t WS_WGU0 = 4 * MiB;
constexpr size_t WS_WD0 = 15 * MiB;
constexpr size_t WS_WQKV = WS_WD0 + (size_t)D * FF0 * 2;
constexpr size_t WS_WO = WS_WQKV + (size_t)NQKV * D * 2;
constexpr size_t WS_S0 = 41 * MiB;
constexpr size_t WS_S1 = 73 * MiB;
constexpr size_t WS_POOL = 105 * MiB;
constexpr size_t WS_ACT0 = WS_POOL;
constexpr size_t WS_QKV = WS_POOL;
constexpr int CH_TILES = 46;
constexpr size_t ACT1_CHUNK = (size_t)CH_TILES * 256 * FF1 * 2;
constexpr size_t WS_ACT1 = WS_POOL;
constexpr size_t WS_Y = 4 * MiB;
constexpr size_t WS_Y2 = WS_S1;
constexpr size_t WS_WGU1 = 306 * MiB;
constexpr size_t WS_WD1 = 418 * MiB;
constexpr size_t WS_END = 474 * MiB;
static_assert(WS_WO + (size_t)D * D * 2 <= WS_S0, "small weights");
static_assert(WS_ACT1 + 2 * ACT1_CHUNK <= WS_WGU1 && WS_Y + (size_t)34816 * D * 2 <= WS_S1 && (size_t)CH_TILES * 256 * D * 2 <= 32 * MiB && 3 * CH_TILES >= 136, "moe map");
static_assert(WS_WGU1 + (size_t)NE * 7168 * D * 2 <= WS_WD1 && WS_WD1 + (size_t)NE * D * FF1 * 2 <= WS_END, "moe weights");
static_assert(WS_QKV + (size_t)T * QKV_LD * 2 <= WS_END, "qkv");

constexpr int CW_TMO = 0;
constexpr int CW_CNT = 64;
constexpr int CW_Q = 128;
constexpr int CW_BAR = 4096;

constexpr int RING_OFF = 0, RING_BYTES = 131072;
constexpr int MISC_OFF = RING_BYTES;
constexpr int RTAB_OFF = MISC_OFF + 1024;
constexpr int SCR_OFF = MISC_OFF + 2048;
constexpr int LDS_BYTES = 147456;

#define RLX_AGENT __ATOMIC_RELAXED, __HIP_MEMORY_SCOPE_AGENT
#define LDS_WAIT() asm volatile("s_waitcnt lgkmcnt(0)" ::: "memory")
#define VM_WAIT() asm volatile("s_waitcnt vmcnt(0)" ::: "memory")
__device__ __forceinline__ unsigned f2bf(float f) { unsigned u = __builtin_bit_cast(unsigned, f); return (u + 0x7fffu + ((u >> 16) & 1u)) >> 16; }
__device__ __forceinline__ unsigned pk2(float lo, float hi) { return f2bf(lo) | (f2bf(hi) << 16); }
__device__ __forceinline__ unsigned cvt_pk_bf16(float lo, float hi) { unsigned r; asm volatile("v_cvt_pk_bf16_f32 %0, %1, %2" : "=v"(r) : "v"(lo), "v"(hi)); return r; }
__device__ __forceinline__ float bf2f(unsigned short b) { return __builtin_bit_cast(float, ((unsigned)b) << 16); }
__device__ __forceinline__ float wave_sum(float v) {
#pragma unroll
    for (int o = 1; o < 64; o <<= 1) v += __shfl_xor(v, o);
    return v;
}
__device__ __forceinline__ float silu_f(float x) { return x * __builtin_amdgcn_rcpf(1.f + __builtin_amdgcn_exp2f(-1.4426950408889634f * x)); }
#define XB_TMO      128
#define XB_XCNT(j)  (256  + 64 * (j))
#define XB_XSUB(j)  (1280 + 64 * (j))
#define XB_XGEN(j)  (2304 + 64 * (j))
#define XB_TOP      3328
#define XB_TOPGEN   3392
#define XCD_BAR_WORDS 3456
#define XB_SPIN_CAP (1u << 18)
__device__ __forceinline__ unsigned xb_ld(unsigned* p)              { return __hip_atomic_load(p, __ATOMIC_RELAXED, __HIP_MEMORY_SCOPE_AGENT); }
__device__ __forceinline__ unsigned xb_add(unsigned* p, unsigned v) { return __hip_atomic_fetch_add(p, v, __ATOMIC_RELAXED, __HIP_MEMORY_SCOPE_AGENT); }
__device__ __forceinline__ unsigned xb_xcc_id() { return (unsigned)__builtin_amdgcn_s_getreg((3 << 11) | 20) & 0xFu; }
#define XB_SPIN(cond, bar) do { unsigned _sp = 0; while (cond) { __builtin_amdgcn_s_sleep(1); \
    if ((++_sp & 255u) == 0u) { if (xb_ld(&(bar)[XB_TMO])) break; if (_sp > XB_SPIN_CAP) { atomicAdd(&(bar)[XB_TMO], 1u); break; } } } } while (0)
struct XcdBarrier { unsigned* bar; unsigned x; volatile LAS unsigned* st; };
__device__ __forceinline__ XcdBarrier xcd_barrier_post(unsigned* bar, volatile LAS unsigned* st) {
    XcdBarrier b; b.bar = bar; b.x = xb_xcc_id(); b.st = st;
    if (threadIdx.x == 0) (void)xb_add(&bar[XB_XCNT(b.x)], 1u);
    return b;
}
__device__ __forceinline__ void xcd_barrier_complete(unsigned* bar, unsigned x, unsigned& nloc, unsigned& nx) {
    const unsigned G = gridDim.x * gridDim.y * gridDim.z;
    unsigned sum, cnt, mine, sp = 0u;
    for (;;) {
        sum = 0u; cnt = 0u; mine = 0u;
#pragma unroll
        for (unsigned j = 0; j < 16; ++j) { const unsigned c = xb_ld(&bar[XB_XCNT(j)]); sum += c; cnt += (c > 0u) ? 1u : 0u; mine = (j == x) ? c : mine; }
        if (sum == G) break;
        __builtin_amdgcn_s_sleep(1);
        if ((++sp & 255u) == 0u) { if (xb_ld(&bar[XB_TMO])) break; if (sp > XB_SPIN_CAP) { atomicAdd(&bar[XB_TMO], 1u); break; } }
    }
    nloc = mine > 0u ? mine : 1u; nx = cnt > 0u ? cnt : 1u;
}
__device__ __forceinline__ void xcd_barrier(const XcdBarrier& b) {
    asm volatile("s_waitcnt vmcnt(0)" ::: "memory");
    __syncthreads();
    if (threadIdx.x == 0) {
        unsigned* bar = b.bar;
        __builtin_amdgcn_s_waitcnt(0);
        unsigned nloc = b.st[0], nx = b.st[1];
        if (nloc == 0u) { xcd_barrier_complete(bar, b.x, nloc, nx); b.st[0] = nloc; b.st[1] = nx; }
        const unsigned old = xb_add(&bar[XB_XSUB(b.x)], 1u);
        const unsigned gen = old / nloc;
        if (old + 1u == (gen + 1u) * nloc) {
            __builtin_amdgcn_fence(__ATOMIC_RELEASE, "agent");
            asm volatile("s_waitcnt vmcnt(0)" ::: "memory");
            const unsigned og = xb_add(&bar[XB_TOP], 1u);
            const unsigned tg = og / nx;
            if (og + 1u == (tg + 1u) * nx) xb_add(&bar[XB_TOPGEN], 1u);
            else XB_SPIN(xb_ld(&bar[XB_TOPGEN]) == tg, bar);
            __builtin_amdgcn_fence(__ATOMIC_ACQUIRE, "agent");
            xb_add(&bar[XB_XGEN(b.x)], 1u);
            asm volatile("s_waitcnt vmcnt(0)" ::: "memory");
        } else {
            XB_SPIN(xb_ld(&bar[XB_XGEN(b.x)]) == gen, bar);
            __builtin_amdgcn_fence(__ATOMIC_ACQUIRE, "agent");
            asm volatile("s_waitcnt vmcnt(0)" ::: "memory");
        }
    }
    __syncthreads();
}
namespace pg8 {
constexpr int BM = 256, BK = 64, HALF = 128, HTB = HALF * BK * 2, STAGE_BYTES = 8 * HTB, NXCD = 8, WGM = 4;
__host__ __device__ __forceinline__ int lds_byte(int r, int c) { const int st = (r >> 4) * 2 + (c >> 5), rr = r & 15, cc = c & 31, ob = rr * 64 + cc * 2; return st * 1024 + (ob ^ (((ob >> 9) & 1) << 5)); }
__host__ __device__ __forceinline__ void stage_rc(int b, int& R, int& C) { const int st = b / 1024, sb = b % 1024, swz = sb ^ (((sb >> 9) & 1) << 5); R = (st >> 1) * 16 + swz / 64; C = (st & 1) * 32 + (swz % 64) / 2; }
__host__ __device__ __forceinline__ int perm32(int rho) { const int n = rho >> 4, i = rho & 15; return 8 * (i >> 2) + 4 * n + (i & 3); }

struct Unit { int pm, pn, arow, brow, e, orow, koff; };
struct Gemm { const bf16_t* A; const bf16_t* Bt; int K; int lda; int ldb; };

struct StaticOrder {
    int nM, nN, nwg, G, c;
    __device__ void init(int M, int N, int G_, int c_) { nM = M / BM; nN = N / BM; nwg = nM * nN; G = G_; c = c_; }
    __device__ __forceinline__ void start() const {}
    __device__ __forceinline__ bool next(int i, Unit& u) const {
        const long L = (long)i * G + c; if (L >= nwg) return false;
        int wgid = (int)L; { const int q = nwg / NXCD, r = nwg % NXCD, xcd = wgid % NXCD, off = wgid / NXCD; wgid = (xcd < r ? xcd * (q + 1) : r * (q + 1) + (xcd - r) * q) + off; }
        const int nig = WGM * nN, gid = wgid / nig, fm = gid * WGM, gsz = (nM - fm) < WGM ? (nM - fm) : WGM;
        u.pm = fm + ((wgid % nig) % gsz); u.pn = (wgid % nig) / gsz; u.arow = u.pm * BM; u.brow = u.pn * BM; u.e = 0; u.orow = u.arow; u.koff = 0; return true;
    }
    __device__ __forceinline__ unsigned refill_issue() const { return 0u; }
    __device__ __forceinline__ void refill_commit(int, unsigned) const {}
    __device__ __forceinline__ unsigned gather_row(const Unit&, int) const { return 0u; }
};

template <class Epi, class Sched, bool GATHER>
__device__ __forceinline__ void gemm_phase(LAS unsigned char* lds, const Gemm g, Sched& S, const Epi& E) {
    int tid_ = threadIdx.x; asm volatile("" : "+v"(tid_));
    const int tid = tid_, wid = __builtin_amdgcn_readfirstlane(tid >> 6), lane = tid & 63, wr = wid >> 2, wc = wid & 3, fr = lane & 15, fq = lane >> 4;
    const int K = g.K, nt = K / BK, LDA = g.lda, LDB = g.ldb;
    unsigned voffB[2]; unsigned va[2][2];
    const size_t kstep = (size_t)(BK * 2);
    const size_t hstep = (size_t)HALF * LDB * 2, hstepA = (size_t)HALF * LDA * 2;
#pragma unroll
    for (int i = 0; i < 2; ++i) { int R, C; stage_rc(tid * 16 + i * 8192, R, C); const int Rb = Epi::PERM ? ((R & ~31) + perm32(R & 31)) : R;
        voffB[i] = (unsigned)(Rb * LDB + C) * 2u;
        va[0][i] = (unsigned)(R * LDA + C) * 2u; va[1][i] = va[0][i] + (unsigned)hstepA; }
    const unsigned ldsw = (unsigned)wid * 1024u;
    const int aoff = lds_byte(wr * 64 + fr, fq * 8), boff = lds_byte(wc * 32 + fr, fq * 8);
#define PG8_SA(b, h) (((b) * 2 + (h)) * HTB)
#define PG8_SB(b, h) ((4 + (b) * 2 + (h)) * HTB)
#define PG8_STAGEB(bufoff, gbase) do { _Pragma("unroll") for (int _i = 0; _i < 2; ++_i) \
        __builtin_amdgcn_global_load_lds((const unsigned*)((const char*)(gbase) + voffB[_i]), (LAS unsigned*)(lds + (bufoff) + ldsw + _i * 8192), 16, 0, 0); } while (0)
#define PG8_STAGEA(bufoff, gbase, vo, h) do { _Pragma("unroll") for (int _i = 0; _i < 2; ++_i) \
        __builtin_amdgcn_global_load_lds((const unsigned*)((const char*)(gbase) + (vo)[h][_i]), (LAS unsigned*)(lds + (bufoff) + ldsw + _i * 8192), 16, 0, 0); } while (0)
#define PG8_LDA(dst, b, h) do { _Pragma("unroll") for (int m = 0; m < 4; ++m) _Pragma("unroll") for (int k = 0; k < 2; ++k) dst[m][k] = *(const LAS bf16x8*)(lds + PG8_SA(b, h) + aoff + m * 2048 + k * 1024); } while (0)
#define PG8_LDB(dst, b, h) do { _Pragma("unroll") for (int n = 0; n < 2; ++n) _Pragma("unroll") for (int k = 0; k < 2; ++k) dst[n][k] = *(const LAS bf16x8*)(lds + PG8_SB(b, h) + boff + n * 2048 + k * 1024); } while (0)
#define PG8_MMA(ai, bj, At, Bt) do { __builtin_amdgcn_s_setprio(3); _Pragma("unroll") for (int m = 0; m < 4; ++m) _Pragma("unroll") for (int n = 0; n < 2; ++n) _Pragma("unroll") for (int k = 0; k < 2; ++k) \
        acc[ai][bj][m][n] = __builtin_amdgcn_mfma_f32_16x16x32_bf16(Bt[n][k], At[m][k], acc[ai][bj][m][n], 0, 0, 0); __builtin_amdgcn_s_setprio(0); } while (0)
#define PG8_WAIT_V(n) asm volatile("s_waitcnt vmcnt(" #n ")" ::: "memory")
#define PG8_WAIT_L(n) asm volatile("s_waitcnt lgkmcnt(" #n ")" ::: "memory")
#define PG8_BAR __builtin_amdgcn_s_barrier()
#define PG8_SCHED __builtin_amdgcn_sched_barrier(0)
    Unit cur, nxt; int ui = 0;
    typename Epi::Pre pre{};
#ifdef MK_STAGGER
    { const unsigned long long dt = (unsigned long long)((blockIdx.x >> 3) & 7) * MK_STAGGER, ts = __builtin_amdgcn_s_memrealtime(); while (__builtin_amdgcn_s_memrealtime() - ts < dt) __builtin_amdgcn_s_sleep(4); }
#endif
    S.start();
    if (!S.next(0, cur)) return;
    f32x4 acc[2][2][4][2];
#pragma unroll
    for (int a = 0; a < 2; ++a)
#pragma unroll
        for (int b = 0; b < 2; ++b)
#pragma unroll
            for (int m = 0; m < 4; ++m)
#pragma unroll
                for (int n = 0; n < 2; ++n) acc[a][b][m][n] = (f32x4){0.f, 0.f, 0.f, 0.f};
    bf16x8 At[4][2], B0[2][2], B1[2][2];
    const char* cA; const char* cB = (const char*)g.Bt + ((size_t)cur.brow * LDB + cur.koff) * 2;
    if constexpr (GATHER) { cA = (const char*)g.A;
#pragma unroll
        for (int h = 0; h < 2; ++h)
#pragma unroll
            for (int i = 0; i < 2; ++i) { int R, C; stage_rc(tid * 16 + i * 8192, R, C); va[h][i] = (S.gather_row(cur, h * HALF + R) * (unsigned)LDA + (unsigned)C) * 2u; }
    } else cA = (const char*)g.A + ((size_t)cur.arow * LDA + cur.koff) * 2;
    PG8_STAGEB(PG8_SB(0, 0), cB); PG8_STAGEB(PG8_SB(0, 1), cB + hstep); PG8_STAGEA(PG8_SA(0, 0), cA, va, 0); PG8_STAGEA(PG8_SA(0, 1), cA, va, 1);
    if (wr == 1) PG8_BAR;
    PG8_WAIT_V(2); PG8_BAR;
    PG8_STAGEB(PG8_SB(1, 0), cB + kstep); PG8_STAGEA(PG8_SA(1, 0), cA + kstep, va, 0); PG8_STAGEB(PG8_SB(1, 1), cB + hstep + kstep);
    PG8_WAIT_V(6); PG8_BAR;
    for (;;) {
        bool has_next = false; const char* nA = cA; const char* nB = cB;
        unsigned vnx[2][2] = {{0u, 0u}, {0u, 0u}};
        for (int t = 0; t < nt; t += 2) {
            const bool last = (t == nt - 2);
            unsigned v2[2][2];
#pragma unroll
            for (int h = 0; h < 2; ++h)
#pragma unroll
                for (int i = 0; i < 2; ++i) v2[h][i] = va[h][i];
            if (last) {
                pre = E.pre(cur, wr, fr);
                has_next = S.next(ui + 1, nxt);
                if (has_next) { nB = (const char*)g.Bt + ((size_t)nxt.brow * LDB + nxt.koff) * 2;
                    if constexpr (GATHER) {
#pragma unroll
                        for (int h = 0; h < 2; ++h)
#pragma unroll
                            for (int i = 0; i < 2; ++i) { int R, C; stage_rc(tid * 16 + i * 8192, R, C); v2[h][i] = (S.gather_row(nxt, h * HALF + R) * (unsigned)LDA + (unsigned)C) * 2u; }
                    } else nA = (const char*)g.A + ((size_t)nxt.arow * LDA + nxt.koff) * 2;
                }
            }
            if constexpr (GATHER) { if (last) {
#pragma unroll
                for (int h = 0; h < 2; ++h)
#pragma unroll
                    for (int i = 0; i < 2; ++i) vnx[h][i] = v2[h][i]; } }
            const char* a1 = cA + (size_t)(t + 1) * kstep;
            const char* a2 = last ? nA : cA + (size_t)(t + 2) * kstep; const char* b2 = last ? nB : cB + (size_t)(t + 2) * kstep;
            const char* a3 = a2 + kstep; const char* b3 = b2 + kstep;
            PG8_LDB(B0, 0, 0); PG8_LDB(B1, 0, 1); PG8_SCHED; PG8_LDA(At, 0, 0); PG8_STAGEA(PG8_SA(1, 1), a1, va, 1);
            PG8_WAIT_V(8); PG8_WAIT_L(0); PG8_BAR; PG8_MMA(0, 0, At, B0); PG8_MMA(0, 1, At, B1); PG8_BAR; PG8_SCHED;
            PG8_LDA(At, 0, 1); PG8_STAGEB(PG8_SB(0, 0), b2); PG8_STAGEB(PG8_SB(0, 1), b2 + hstep); PG8_STAGEA(PG8_SA(0, 0), a2, v2, 0);
            PG8_WAIT_V(8); PG8_WAIT_L(0); PG8_BAR; PG8_MMA(1, 0, At, B0); PG8_MMA(1, 1, At, B1); PG8_BAR; PG8_SCHED;
            PG8_LDB(B0, 1, 0); PG8_LDB(B1, 1, 1); PG8_SCHED; PG8_LDA(At, 1, 0); PG8_STAGEA(PG8_SA(0, 1), a2, v2, 1);
            PG8_WAIT_V(8); PG8_WAIT_L(0); PG8_BAR; PG8_MMA(0, 0, At, B0); PG8_MMA(0, 1, At, B1); PG8_BAR; PG8_SCHED;
            PG8_LDA(At, 1, 1); PG8_STAGEB(PG8_SB(1, 0), b3); PG8_STAGEB(PG8_SB(1, 1), b3 + hstep); PG8_STAGEA(PG8_SA(1, 0), a3, v2, 0);
            PG8_WAIT_V(8); PG8_WAIT_L(0); PG8_BAR; PG8_MMA(1, 0, At, B0); PG8_MMA(1, 1, At, B1); PG8_BAR; PG8_SCHED;
        }
        if (wr == 0) PG8_BAR;
        const unsigned rf = S.refill_issue();
        E(acc, cur, wr, wc, fr, fq, lds, pre);
        S.refill_commit(ui, rf);
        if (!has_next) break;
#pragma unroll
        for (int a = 0; a < 2; ++a)
#pragma unroll
            for (int b = 0; b < 2; ++b)
#pragma unroll
                for (int m = 0; m < 4; ++m)
#pragma unroll
                    for (int n = 0; n < 2; ++n) acc[a][b][m][n] = (f32x4){0.f, 0.f, 0.f, 0.f};
        cur = nxt; cA = nA; cB = nB; ++ui;
        if constexpr (GATHER) {
#pragma unroll
            for (int h = 0; h < 2; ++h)
#pragma unroll
                for (int i = 0; i < 2; ++i) va[h][i] = vnx[h][i];
        }
        if (wr == 1) PG8_BAR;
    }
    PG8_WAIT_V(0);
    PG8_BAR;
#undef PG8_SA
#undef PG8_SB
#undef PG8_STAGEA
#undef PG8_STAGEB
#undef PG8_LDA
#undef PG8_LDB
#undef PG8_MMA
#undef PG8_WAIT_V
#undef PG8_WAIT_L
#undef PG8_BAR
#undef PG8_SCHED
}
}
struct PreNone { };
struct Pre8 { float v[8]; };
struct EpiSwiGLU {
    static constexpr bool PERM = true;
    bf16_t* O; int ldo; const float* lrs;
    typedef Pre8 Pre;
    __device__ __forceinline__ Pre pre(const pg8::Unit& u, int wr, int fr) const { Pre p;
#pragma unroll
        for (int i = 0; i < 8; ++i) p.v[i] = lrs ? lrs[(size_t)u.e * T + u.arow + (i >> 2) * 128 + (i & 3) * 16 + wr * 64 + fr] : 1.f;
        return p; }
    __device__ __forceinline__ void operator()(const f32x4 (&acc)[2][2][4][2], const pg8::Unit& u, int wr, int wc, int fr, int fq, LAS unsigned char*, const Pre& pr) const {
        const int r0 = wr * 64 + fr, col0 = u.pn * 128 + wc * 32 + 8 * fq;
#pragma unroll
        for (int ai = 0; ai < 2; ++ai) {
#pragma unroll
            for (int m = 0; m < 4; ++m) {
                const float s = pr.v[ai * 4 + m]; float o[8];
#pragma unroll
                for (int n = 0; n < 2; ++n)
#pragma unroll
                    for (int j = 0; j < 4; ++j) { const float gv = acc[ai][0][m][n][j] * s, uv = acc[ai][1][m][n][j] * s; o[n * 4 + j] = silu_f(gv) * uv; }
                u32x4 w; w.x = cvt_pk_bf16(o[0], o[1]); w.y = cvt_pk_bf16(o[2], o[3]); w.z = cvt_pk_bf16(o[4], o[5]); w.w = cvt_pk_bf16(o[6], o[7]);
                *(u32x4*)(O + (size_t)(u.orow + ai * 128 + m * 16 + r0) * ldo + col0) = w;
            }
        }
    }
};
struct EpiRes {
    static constexpr bool PERM = false;
    float* H; bf16_t* HB; float* ssq;
    typedef PreNone Pre;
    __device__ __forceinline__ Pre pre(const pg8::Unit&, int, int) const { return Pre{}; }
    __device__ __forceinline__ void operator()(const f32x4 (&acc)[2][2][4][2], const pg8::Unit& u, int wr, int wc, int fr, int fq, LAS unsigned char*, const Pre&) const {
        const int r0 = u.orow + wr * 64 + fr, col0 = u.pn * 256 + wc * 32 + 4 * fq;
#pragma unroll
        for (int ai = 0; ai < 2; ++ai)
#pragma unroll
            for (int m = 0; m < 4; ++m) {
                const size_t off = (size_t)(r0 + ai * 128 + m * 16) * D + col0; float sq = 0.f;
#pragma unroll
                for (int bj = 0; bj < 2; ++bj)
#pragma unroll
                    for (int n = 0; n < 2; ++n) {
                        const f32x4 hv = *(const f32x4*)(H + off + bj * 128 + n * 16) + acc[ai][bj][m][n];
                        *(f32x4*)(H + off + bj * 128 + n * 16) = hv;
                        u32x2 w; w.x = cvt_pk_bf16(hv[0], hv[1]); w.y = cvt_pk_bf16(hv[2], hv[3]);
                        *(u32x2*)(HB + off + bj * 128 + n * 16) = w;
                        sq += (hv[0] * hv[0] + hv[1] * hv[1]) + (hv[2] * hv[2] + hv[3] * hv[3]);
                    }
                if (ssq) { sq += __shfl_xor(sq, 16); sq += __shfl_xor(sq, 32);
                    if (fq == 0) ssq[(size_t)(r0 + ai * 128 + m * 16) * 16 + u.pn * 4 + wc] = sq; }
            }
    }
};
template <bool STORE>
struct EpiQKV_T {
    static constexpr bool PERM = true;
    bf16_t* O; const float* ssq;
    typedef Pre8 Pre;
    __device__ __forceinline__ Pre pre(const pg8::Unit& u, int, int) const { Pre p; const int tid = threadIdx.x, row = tid >> 1, part = tid & 1;
        const f32x4* q = (const f32x4*)(ssq + (size_t)(u.orow + row) * 16 + part * 8); const f32x4 a = q[0], b = q[1];
        p.v[0] = a[0]; p.v[1] = a[1]; p.v[2] = a[2]; p.v[3] = a[3]; p.v[4] = b[0]; p.v[5] = b[1]; p.v[6] = b[2]; p.v[7] = b[3]; return p; }
    __device__ __forceinline__ void operator()(const f32x4 (&acc)[2][2][4][2], const pg8::Unit& u, int wr, int wc, int fr, int fq, LAS unsigned char* lds, const Pre& pr) const {
        LAS float* rtab = (LAS float*)(lds + RTAB_OFF);
        { const int tid = threadIdx.x, row = tid >> 1, part = tid & 1;
          float s = ((pr.v[0] + pr.v[1]) + (pr.v[2] + pr.v[3])) + ((pr.v[4] + pr.v[5]) + (pr.v[6] + pr.v[7]));
          s += __shfl_xor(s, 1);
          if (part == 0) rtab[row] = 1.0f / sqrtf(s * (1.f / D) + EPS); }
        asm volatile("s_waitcnt lgkmcnt(0)" ::: "memory"); __builtin_amdgcn_s_barrier(); asm volatile("" ::: "memory");
        const float qs = (u.pn * 256 < 3072) ? 0.125f * 1.4426950408889634f : 1.f;
        const int r0 = wr * 64 + fr, col0 = u.pn * 256 + wc * 32 + 8 * fq;
#pragma unroll
        for (int ai = 0; ai < 2; ++ai)
#pragma unroll
            for (int m = 0; m < 4; ++m) {
                const float s = rtab[ai * 128 + m * 16 + r0] * qs;
#pragma unroll
                for (int bj = 0; bj < 2; ++bj) {
                    const f32x4 v0 = acc[ai][bj][m][0] * s, v1 = acc[ai][bj][m][1] * s;
                    u32x4 w; w.x = cvt_pk_bf16(v0[0], v0[1]); w.y = cvt_pk_bf16(v0[2], v0[3]); w.z = cvt_pk_bf16(v1[0], v1[1]); w.w = cvt_pk_bf16(v1[2], v1[3]);
                    if (STORE) *(u32x4*)(O + (size_t)(u.orow + ai * 128 + m * 16 + r0) * QKV_LD + col0 + bj * 128) = w; else asm volatile("" :: "v"(w));
                }
            }
    }
};
typedef EpiQKV_T<true> EpiQKV;
struct EpiNull {
    static constexpr bool PERM = true;
    typedef PreNone Pre;
    __device__ __forceinline__ Pre pre(const pg8::Unit&, int, int) const { return Pre{}; }
    __device__ __forceinline__ void operator()(const f32x4 (&acc)[2][2][4][2], const pg8::Unit& u, int wr, int wc, int fr, int fq, LAS unsigned char*, const Pre&) const {
#pragma unroll
        for (int ai = 0; ai < 2; ++ai)
#pragma unroll
            for (int bj = 0; bj < 2; ++bj)
#pragma unroll
                for (int m = 0; m < 4; ++m)
#pragma unroll
                    for (int n = 0; n < 2; ++n) asm volatile("" :: "v"(acc[ai][bj][m][n]));
    }
};
struct EpiY {
    static constexpr bool PERM = true;
    bf16_t* Y; bf16_t* Y2; int c0rows;
    typedef PreNone Pre;
    __device__ __forceinline__ Pre pre(const pg8::Unit&, int, int) const { return Pre{}; }
    __device__ __forceinline__ void operator()(const f32x4 (&acc)[2][2][4][2], const pg8::Unit& u, int wr, int wc, int fr, int fq, LAS unsigned char*, const Pre&) const {
        bf16_t* Yb = u.koff ? Y2 : Y;
        const int r0 = (u.koff ? u.orow - c0rows : u.orow) + wr * 64 + fr, col0 = u.pn * 256 + wc * 32 + 8 * fq;
#pragma unroll
        for (int ai = 0; ai < 2; ++ai)
#pragma unroll
            for (int m = 0; m < 4; ++m)
#pragma unroll
                for (int bj = 0; bj < 2; ++bj) {
                    const f32x4 v0 = acc[ai][bj][m][0], v1 = acc[ai][bj][m][1];
                    u32x4 w; w.x = cvt_pk_bf16(v0[0], v0[1]); w.y = cvt_pk_bf16(v0[2], v0[3]); w.z = cvt_pk_bf16(v1[0], v1[1]); w.w = cvt_pk_bf16(v1[2], v1[3]);
                    *(u32x4*)(Yb + (size_t)(r0 + ai * 128 + m * 16) * D + col0 + bj * 128) = w;
                }
    }
};

constexpr int MI_CNT = 0, MI_TB = 8, MI_NT = 17, MI_SPLIT0 = 18;
__device__ __forceinline__ void moe_info_build(LAS unsigned char* lds, const unsigned* ctl) {
    volatile LAS int* mi = (volatile LAS int*)(lds + SCR_OFF);
    if (threadIdx.x == 0) { int tb = 0;
        for (int e = 0; e < NE; ++e) { const int c = (int)__hip_atomic_load(ctl + CW_CNT + e, RLX_AGENT); mi[MI_CNT + e] = c; mi[MI_TB + e] = tb; tb += (c + 255) >> 8; }
        mi[MI_TB + NE] = tb; mi[MI_NT] = tb; mi[MI_SPLIT0] = ((tb - 1) / CH_TILES) * CH_TILES * 256; }
    LDS_WAIT(); __syncthreads();
}
struct DynQ {
    unsigned* ctr; volatile LAS unsigned* slot;
    __device__ __forceinline__ void start() const { if (threadIdx.x == 0) { slot[0] = blockIdx.x; slot[1] = gridDim.x + atomicAdd(ctr, 1u); } LDS_WAIT(); __syncthreads(); }
#ifdef MK_STATICQ
    __device__ __forceinline__ int fetch(int i) const { return i * (int)gridDim.x + (int)blockIdx.x; }
#else
    __device__ __forceinline__ int fetch(int i) const { return __builtin_amdgcn_readfirstlane((int)slot[i & 3]); }
#endif
    __device__ __forceinline__ unsigned refill_issue() const { unsigned v = 0u; if (threadIdx.x == 0) v = gridDim.x + atomicAdd(ctr, 1u); return v; }
    __device__ __forceinline__ void refill_commit(int ui, unsigned v) const { if (threadIdx.x == 0) slot[(ui + 2) & 3] = v; }
};
template <int NN, bool G1>
struct MoeOrder {
    DynQ q; volatile LAS int* mi; int c0, ntc; const int* ltok;
    __device__ __forceinline__ void start() const { q.start(); }
    __device__ __forceinline__ unsigned refill_issue() const { return q.refill_issue(); }
    __device__ __forceinline__ void refill_commit(int ui, unsigned v) const { q.refill_commit(ui, v); }
    __device__ __forceinline__ bool next(int i, pg8::Unit& u) const {
        const int idx = q.fetch(i); if (idx >= ntc * NN) return false;
        const int grp = idx / (8 * NN), r = idx - grp * (8 * NN), gsz = (ntc - grp * 8) < 8 ? (ntc - grp * 8) : 8;
        const int pml = grp * 8 + r % gsz, pn = r / gsz, pmg = c0 + pml;
        int e = 0;
#pragma unroll
        for (int k = 1; k < NE; ++k) e += (pmg >= mi[MI_TB + k]) ? 1 : 0;
        e = __builtin_amdgcn_readfirstlane(e);
        u.pm = pmg; u.pn = pn; u.e = e; u.koff = 0;
        if (!G1 && NN == 8) { u.pn = pn & 3; u.koff = (pn >> 2) * (FF1 / 2); }
        const int pnb = u.pn;
        if (G1) { u.arow = (pmg - __builtin_amdgcn_readfirstlane(mi[MI_TB + e])) * 256; u.brow = e * (2 * FF1) + pn * 256; u.orow = pml * 256; }
        else { u.arow = pml * 256; u.brow = e * D + pnb * 256; u.orow = pmg * 256; }
        return true;
    }
    __device__ __forceinline__ unsigned gather_row(const pg8::Unit& u, int r) const {
        const int lr = u.arow + r; const int c = mi[MI_CNT + u.e];
        return lr < c ? (unsigned)ltok[(size_t)u.e * T + lr] : 0u;
    }
};
struct Args { const float* in[19]; float* out; unsigned char* ws; int ph_lo, ph_hi, li, pad; };
enum { I_X = 0, I_ANORM, I_APROJ, I_ASCALE, I_KVNORM, I_WKV, I_BNORM, I_WQ, I_WO, I_RELB, I_FFNORM, I_DWG, I_DWU, I_DWD, I_ROUTER, I_MWG, I_MWU, I_MWD, I_FNORM };
struct Frame {
    LAS unsigned char* lds; unsigned* ctl; int tid, lane, wave, G, bid;
    float* h; unsigned char* ws;
};
__device__ __forceinline__ void conv_item(const float* W, int ldw, const float* gain, bf16_t* WT, int K, int dst_row0, LAS float* scr, int k0, int n0, int lane) {
    float wv[32];
#pragma unroll
    for (int i = 0; i < 32; ++i) wv[i] = W[(size_t)(k0 + 2 * i + (lane >> 5)) * ldw + n0 + (lane & 31)];
    if (gain) {
#pragma unroll
        for (int i = 0; i < 32; ++i) wv[i] *= gain[k0 + 2 * i + (lane >> 5)];
    }
#pragma unroll
    for (int i = 0; i < 32; ++i) scr[(2 * i + (lane >> 5)) * 33 + (lane & 31)] = wv[i];
    LDS_WAIT(); asm volatile("" ::: "memory");
    const int c = lane & 7;
#pragma unroll
    for (int j = 0; j < 4; ++j) { const int n = (lane >> 3) + 8 * j; const LAS float* s = scr + (8 * c) * 33 + n;
        u32x4 o; o.x = pk2(s[0 * 33], s[1 * 33]); o.y = pk2(s[2 * 33], s[3 * 33]); o.z = pk2(s[4 * 33], s[5 * 33]); o.w = pk2(s[6 * 33], s[7 * 33]);
        *(u32x4*)(WT + (size_t)(dst_row0 + n) * K + k0 + 8 * c) = o; }
    LDS_WAIT(); asm volatile("" ::: "memory");
}
__device__ __forceinline__ void conv_job(const Frame& F, int& it0, const float* W, int K, int N, int ldw, const float* gain, bf16_t* WT, int mode, int row_off, LAS float* scr, int cg = 0) {
    const int nblk = N / 32, items = (K / 64) * nblk, NGW = (cg ? cg : F.G) * NWAVES;
    int it = it0;
    for (; it < items; it += NGW) {
        const int kb = it / nblk, nb = it - kb * nblk, n0 = nb * 32;
        const int dr = (mode == 0) ? (row_off + n0) : (row_off + (n0 >> 7) * 256 + (n0 & 127) + (mode == 2 ? 128 : 0));
        conv_item(W, ldw, gain, WT, K, dr, scr, kb * 64, n0, F.lane);
    }
    it0 = it - items;
}
__device__ __forceinline__ void conv_aproj(const Frame& F, const Args& A) {
    LAS float* scr = (LAS float*)(F.lds + RING_OFF + F.wave * 16384);
    int it = F.bid * NWAVES + F.wave;
    for (int g = 0; g < 4; ++g) conv_job(F, it, A.in[I_APROJ] + (size_t)g * 65536, 256, 256, 256, nullptr, (bf16_t*)(F.ws + WS_APT) + (size_t)g * 65536, 0, 0, scr);
}
__device__ __forceinline__ void conv_small(const Frame& F, const Args& A) {
    LAS float* scr = (LAS float*)(F.lds + RING_OFF + F.wave * 16384);
    int it = F.bid * NWAVES + F.wave;
    unsigned char* ws = F.ws;
    conv_job(F, it, A.in[I_DWG], D, FF0, FF0, nullptr, (bf16_t*)(ws + WS_WGU0), 1, 0, scr);
    conv_job(F, it, A.in[I_DWU], D, FF0, FF0, nullptr, (bf16_t*)(ws + WS_WGU0), 2, 0, scr);
}
__device__ __forceinline__ void conv_later(const Frame& F, const Args& A, int cb, int cg) {
    LAS float* scr = (LAS float*)(F.lds + RING_OFF + F.wave * 16384);
    int it = cb * NWAVES + F.wave;
    unsigned char* ws = F.ws;
    conv_job(F, it, A.in[I_DWD], FF0, D, D, nullptr, (bf16_t*)(ws + WS_WD0), 0, 0, scr, cg);
    conv_job(F, it, A.in[I_WQ], D, 3072, 3072, A.in[I_BNORM], (bf16_t*)(ws + WS_WQKV), 0, 0, scr, cg);
    conv_job(F, it, A.in[I_WKV], D, 6144, 6144, A.in[I_KVNORM], (bf16_t*)(ws + WS_WQKV), 0, 3072, scr, cg);
    conv_job(F, it, A.in[I_WO], D, D, D, nullptr, (bf16_t*)(ws + WS_WO), 0, 0, scr, cg);
}
__device__ __forceinline__ void conv_moe(const Frame& F, const Args& A) {
    LAS float* scr = (LAS float*)(F.lds + RING_OFF + F.wave * 16384);
    int it = F.bid * NWAVES + F.wave;
    unsigned char* ws = F.ws;
    for (int e = 0; e < NE; ++e) {
        conv_job(F, it, A.in[I_MWG] + (size_t)e * D * FF1, D, FF1, FF1, A.in[I_FFNORM] + D, (bf16_t*)(ws + WS_WGU1) + (size_t)e * 2 * FF1 * D, 1, 0, scr);
        conv_job(F, it, A.in[I_MWU] + (size_t)e * D * FF1, D, FF1, FF1, A.in[I_FFNORM] + D, (bf16_t*)(ws + WS_WGU1) + (size_t)e * 2 * FF1 * D, 2, 0, scr);
        conv_job(F, it, A.in[I_MWD] + (size_t)e * FF1 * D, FF1, D, D, nullptr, (bf16_t*)(ws + WS_WD1) + (size_t)e * D * FF1, 0, 0, scr);
    }
}

__device__ __forceinline__ void mixer_phase(const Frame& F, const Args& A) {
    LAS float* rs = (LAS float*)(F.lds + 0);
    LAS float* xn = (LAS float*)(F.lds + 512);
    LAS bf16_t* pl = (LAS bf16_t*)(F.lds + 512 + 80896);
    LAS float* sw = (LAS float*)(F.lds + 512 + 80896 + 33792);
    int tid_ = F.tid; asm volatile("" : "+v"(tid_));
    const int tid = tid_, lane = tid & 63, w = F.wave, fr = lane & 15, fq = lane >> 4;
    const bf16_t* apt = (const bf16_t*)(F.ws + WS_APT);
    bf16_t* hn0 = (bf16_t*)(F.ws + WS_S0);
    for (int tile = F.bid; tile < T / 64; tile += F.G) {
        const int t0 = tile * 64, s0 = t0 % SEQ, halo = s0 ? 15 : 0, nrows = 64 + halo;
#pragma unroll 1
        for (int jb = w; jb < nrows; jb += 5 * NWAVES) {
            f32x4 rv[5][4];
#pragma unroll
            for (int u = 0; u < 5; ++u) { const int jj = jb + u * NWAVES, jc = jj < nrows ? jj : nrows - 1; const f32x4* p = (const f32x4*)(A.in[I_X] + (size_t)(t0 - halo + jc) * D);
#pragma unroll
                for (int q = 0; q < 4; ++q) rv[u][q] = p[lane + 64 * q]; }
#pragma unroll
            for (int u = 0; u < 5; ++u) { float s = 0.f;
#pragma unroll
                for (int q = 0; q < 4; ++q) { const f32x4 v = rv[u][q]; s += (v[0] * v[0] + v[1] * v[1]) + (v[2] * v[2] + v[3] * v[3]); }
                s = wave_sum(s);
                const int jj = jb + u * NWAVES;
                if (lane == 0 && jj < nrows) rs[jj] = 1.0f / sqrtf(s * (1.f / D) + EPS); }
        }
        LDS_WAIT(); __syncthreads();
        float ss[4] = {0.f, 0.f, 0.f, 0.f};
        for (int g = 0; g < 4; ++g) {
            { const f32x4 gn = *(const f32x4*)(A.in[I_ANORM] + g * 256 + 4 * lane);
              f32x4 xv[10];
#pragma unroll
              for (int u = 0; u < 10; ++u) { const int jj = w + u * NWAVES, jc = jj < nrows ? jj : nrows - 1; xv[u] = *(const f32x4*)(A.in[I_X] + (size_t)(t0 - halo + jc) * D + g * 256 + 4 * lane); }
#pragma unroll
              for (int u = 0; u < 10; ++u) { const int jj = w + u * NWAVES; if (jj < nrows) { const float r = rs[jj]; const f32x4 v = xv[u];
                  *(LAS f32x4*)(xn + jj * 256 + 4 * lane) = (f32x4){v[0] * r * gn[0], v[1] * r * gn[1], v[2] * r * gn[2], v[3] * r * gn[3]}; } } }
            LDS_WAIT(); __syncthreads();
            { const int c4 = (tid & 63) * 4, win = 2 << g;
#pragma unroll 1
              for (int i = 0; i < 8; ++i) { const int r = (tid >> 6) + 8 * i, s = s0 + r, cnt = (s + 1 < win) ? (s + 1) : win;
                  f32x4 a = {0.f, 0.f, 0.f, 0.f};
                  for (int jj = 0; jj < cnt; ++jj) a += *(const LAS f32x4*)(xn + (halo + r - jj) * 256 + c4);
                  const f32x4 self = *(const LAS f32x4*)(xn + (halo + r) * 256 + c4); const float inv = 1.f / (float)cnt;
                  u32x2 o; o.x = pk2(a[0] * inv - self[0], a[1] * inv - self[1]); o.y = pk2(a[2] * inv - self[2], a[3] * inv - self[3]);
                  *(LAS u32x2*)(pl + r * 264 + c4) = o; } }
            LDS_WAIT(); __syncthreads();
            f32x4 acc[4][2];
#pragma unroll
            for (int m = 0; m < 4; ++m) { acc[m][0] = (f32x4){0.f, 0.f, 0.f, 0.f}; acc[m][1] = (f32x4){0.f, 0.f, 0.f, 0.f}; }
#pragma unroll
            for (int ks = 0; ks < 8; ++ks) {
                bf16x8 bfr[2], afr[4];
#pragma unroll
                for (int n = 0; n < 2; ++n) bfr[n] = *(const bf16x8*)(apt + (size_t)g * 65536 + (size_t)(32 * w + 16 * n + fr) * 256 + 32 * ks + 8 * fq);
#pragma unroll
                for (int m = 0; m < 4; ++m) afr[m] = *(const LAS bf16x8*)(pl + (16 * m + fr) * 264 + 32 * ks + 8 * fq);
#pragma unroll
                for (int m = 0; m < 4; ++m)
#pragma unroll
                    for (int n = 0; n < 2; ++n) acc[m][n] = __builtin_amdgcn_mfma_f32_16x16x32_bf16(bfr[n], afr[m], acc[m][n], 0, 0, 0);
            }
#pragma unroll
            for (int m = 0; m < 4; ++m)
#pragma unroll
                for (int n = 0; n < 2; ++n) { const int col = g * 256 + 32 * w + 16 * n + 4 * fq; const size_t off = (size_t)(t0 + 16 * m + fr) * D + col;
                    const f32x4 sc = *(const f32x4*)(A.in[I_ASCALE] + col); const f32x4 hv = *(const f32x4*)(A.in[I_X] + off) + acc[m][n] * sc;
                    *(f32x4*)(F.h + off) = hv; ss[m] += (hv[0] * hv[0] + hv[1] * hv[1]) + (hv[2] * hv[2] + hv[3] * hv[3]); }
        }
#pragma unroll
        for (int m = 0; m < 4; ++m) { float s = ss[m]; s += __shfl_xor(s, 16); s += __shfl_xor(s, 32); if (fq == 0) sw[(16 * m + fr) * 8 + w] = s; }
        VM_WAIT(); LDS_WAIT(); __syncthreads();
#pragma unroll 1
        for (int jb = w; jb < 64; jb += 4 * NWAVES) {
            f32x4 hv[4][4];
#pragma unroll
            for (int u = 0; u < 4; ++u) { const f32x4* p = (const f32x4*)(F.h + (size_t)(t0 + jb + u * NWAVES) * D);
#pragma unroll
                for (int q = 0; q < 4; ++q) hv[u][q] = p[lane + 64 * q]; }
#pragma unroll
            for (int u = 0; u < 4; ++u) { const int jr = jb + u * NWAVES; float s = 0.f;
#pragma unroll
                for (int q = 0; q < 8; ++q) s += sw[jr * 8 + q];
                const float r1 = 1.0f / sqrtf(s * (1.f / D) + EPS);
                u32x2* o = (u32x2*)(hn0 + (size_t)(t0 + jr) * D);
#pragma unroll
                for (int q = 0; q < 4; ++q) { const f32x4 v = hv[u][q]; const f32x4 gn = *(const f32x4*)(A.in[I_FFNORM] + 4 * (lane + 64 * q));
                    u32x2 ov; ov.x = pk2(v[0] * r1 * gn[0], v[1] * r1 * gn[1]); ov.y = pk2(v[2] * r1 * gn[2], v[3] * r1 * gn[3]); o[lane + 64 * q] = ov; } }
        }
        LDS_WAIT(); __syncthreads();
    }
}

__device__ __forceinline__ void router_phase(const Frame& F, const Args& A) {
    volatile LAS int* li = (volatile LAS int*)(F.lds + 0);
    volatile LAS float* lf = (volatile LAS float*)(F.lds + 2048);
    int* ltok = (int*)(F.ws + WS_LTOK); float* lrs = (float*)(F.ws + WS_LRS); u32x4* tinfo = (u32x4*)(F.ws + WS_TOKINFO);
    int tid_ = F.tid; asm volatile("" : "+v"(tid_));
    const int tid = tid_, lane = tid & 63, w = F.wave;
    const float* gain = A.in[I_FFNORM] + D;
    f32x4 wa[4][4], wb[4][4];
#pragma unroll
    for (int q = 0; q < 4; ++q) { const int c0 = 4 * (lane + 64 * q); const f32x4 gn = *(const f32x4*)(gain + c0);
#pragma unroll
        for (int j = 0; j < 4; ++j) { wa[q][j] = *(const f32x4*)(A.in[I_ROUTER] + (size_t)(c0 + j) * 8) * gn[j]; wb[q][j] = *(const f32x4*)(A.in[I_ROUTER] + (size_t)(c0 + j) * 8 + 4) * gn[j]; } }
    if (F.bid == 0 && tid < 128) ((u32x4*)(F.ws + WS_ZERO))[tid] = (u32x4){0u, 0u, 0u, 0u};
    for (int tile = F.bid; tile < T / 64; tile += F.G) {
        const int t0 = tile * 64;
        if (tid < 8) li[tid] = 0;
        LDS_WAIT(); __syncthreads();
        f32x4 v[4], vn[4];
        { const f32x4* p = (const f32x4*)(F.h + (size_t)(t0 + 8 * w) * D);
#pragma unroll
          for (int q = 0; q < 4; ++q) vn[q] = p[lane + 64 * q]; }
#pragma unroll 1
        for (int k = 0; k < 8; ++k) {
            const int tl = 8 * w + k;
#pragma unroll
            for (int q = 0; q < 4; ++q) v[q] = vn[q];
            if (k < 7) { const f32x4* p = (const f32x4*)(F.h + (size_t)(t0 + tl + 1) * D);
#pragma unroll
                for (int q = 0; q < 4; ++q) vn[q] = p[lane + 64 * q]; }
            float s = 0.f; f32x4 la = {0.f, 0.f, 0.f, 0.f}, lb = {0.f, 0.f, 0.f, 0.f};
#pragma unroll
            for (int q = 0; q < 4; ++q) { s += (v[q][0] * v[q][0] + v[q][1] * v[q][1]) + (v[q][2] * v[q][2] + v[q][3] * v[q][3]);
#pragma unroll
                for (int j = 0; j < 4; ++j) { la += wa[q][j] * v[q][j]; lb += wb[q][j] * v[q][j]; } }
            float red[9] = {s, la[0], la[1], la[2], la[3], lb[0], lb[1], lb[2], lb[3]};
#pragma unroll
            for (int o = 1; o < 64; o <<= 1) {
#pragma unroll
                for (int e = 0; e < 9; ++e) red[e] += __shfl_xor(red[e], o); }
            if (lane == 0) {
                const float r = 1.0f / sqrtf(red[0] * (1.f / D) + EPS);
                float lg[8];
#pragma unroll
                for (int e = 0; e < 8; ++e) lg[e] = red[1 + e] * r;
                float b1 = lg[0]; int i1 = 0;
#pragma unroll
                for (int e = 1; e < 8; ++e) if (lg[e] > b1) { b1 = lg[e]; i1 = e; }
                float b2 = -3.0e38f; int i2 = 0;
#pragma unroll
                for (int e = 0; e < 8; ++e) if (e != i1 && lg[e] > b2) { b2 = lg[e]; i2 = e; }
                const float e2 = expf(b2 - b1), g1 = 1.f / (1.f + e2), g2 = e2 / (1.f + e2);
                const int r1 = __hip_atomic_fetch_add((LAS int*)&li[i1], 1, __ATOMIC_RELAXED, __HIP_MEMORY_SCOPE_WORKGROUP), r2 = __hip_atomic_fetch_add((LAS int*)&li[i2], 1, __ATOMIC_RELAXED, __HIP_MEMORY_SCOPE_WORKGROUP);
                li[16 + tl * 4 + 0] = i1; li[16 + tl * 4 + 1] = i2; li[16 + tl * 4 + 2] = r1; li[16 + tl * 4 + 3] = r2;
                lf[tl * 4 + 0] = g1; lf[tl * 4 + 1] = g2; lf[tl * 4 + 2] = r;
            }
        }
        LDS_WAIT(); __syncthreads();
        if (tid < 8) li[8 + tid] = (int)atomicAdd(F.ctl + CW_CNT + tid, (unsigned)li[tid]);
        LDS_WAIT(); __syncthreads();
        if (tid < 64) {
            const int i1 = li[16 + tid * 4 + 0], i2 = li[16 + tid * 4 + 1], s1 = li[8 + i1] + li[16 + tid * 4 + 2], s2 = li[8 + i2] + li[16 + tid * 4 + 3];
            const float g1 = lf[tid * 4 + 0], g2 = lf[tid * 4 + 1], r = lf[tid * 4 + 2];
            ltok[(size_t)i1 * T + s1] = t0 + tid; lrs[(size_t)i1 * T + s1] = r;
            ltok[(size_t)i2 * T + s2] = t0 + tid; lrs[(size_t)i2 * T + s2] = r;
            u32x4 ti; ti.x = (unsigned)(s1 << 3 | i1); ti.y = (unsigned)(s2 << 3 | i2); ti.z = __builtin_bit_cast(unsigned, g1); ti.w = __builtin_bit_cast(unsigned, g2);
            tinfo[t0 + tid] = ti;
        }
        LDS_WAIT(); __syncthreads();
    }
}

__device__ __forceinline__ void final_phase(const Frame& F, const Args& A) {
    volatile LAS int* mi = (volatile LAS int*)(F.lds + SCR_OFF);
    const u32x4* tinfo = (const u32x4*)(F.ws + WS_TOKINFO); const bf16_t* Y = (const bf16_t*)(F.ws + WS_Y);
    int lane_ = F.lane; asm volatile("" : "+v"(lane_));
    const int lane = lane_;
    f32x4 gn[4];
#pragma unroll
    for (int q = 0; q < 4; ++q) gn[q] = *(const f32x4*)(A.in[I_FNORM] + 4 * (lane + 64 * q));
    const int stride = F.G * NWAVES; int t = F.bid * NWAVES + F.wave;
    const bf16_t* Y2 = (const bf16_t*)(F.ws + WS_Y2); const bf16_t* ZR = (const bf16_t*)(F.ws + WS_ZERO);
    f32x4 hv[4], hn[4]; u32x2 ya[4], yb[4], yan[4], ybn[4], za[4], zb[4], zan[4], zbn[4]; float g1n = 0.f, g2n = 0.f;
#define FIN_ISSUE(tt, HV, YA, YB, ZA, ZB, G1, G2) do { const u32x4 ti = tinfo[tt]; const unsigned tx = ti.x, ty = ti.y, gz = ti.z, gw = ti.w; \
        const int e1 = tx & 7, s1 = tx >> 3, e2 = ty & 7, s2 = ty >> 3; G1 = __uint_as_float(gz); G2 = __uint_as_float(gw); \
        const size_t r1 = (size_t)mi[MI_TB + e1] * 256 + s1, r2 = (size_t)mi[MI_TB + e2] * 256 + s2; \
        const size_t sp0 = (size_t)mi[MI_SPLIT0]; const u32x2* z1_ = r1 >= sp0 ? (const u32x2*)(Y2 + (r1 - sp0) * D) : (const u32x2*)ZR; const u32x2* z2_ = r2 >= sp0 ? (const u32x2*)(Y2 + (r2 - sp0) * D) : (const u32x2*)ZR; \
        const f32x4* p_ = (const f32x4*)(F.h + (size_t)(tt) * D); const u32x2* y1_ = (const u32x2*)(Y + r1 * D); const u32x2* y2_ = (const u32x2*)(Y + r2 * D); \
        _Pragma("unroll") for (int q = 0; q < 4; ++q) { HV[q] = p_[lane + 64 * q]; YA[q] = y1_[lane + 64 * q]; YB[q] = y2_[lane + 64 * q]; } \
        if (r1 >= sp0) { _Pragma("unroll") for (int q = 0; q < 4; ++q) ZA[q] = z1_[lane + 64 * q]; } else { _Pragma("unroll") for (int q = 0; q < 4; ++q) ZA[q] = (u32x2){0u, 0u}; } \
        if (r2 >= sp0) { _Pragma("unroll") for (int q = 0; q < 4; ++q) ZB[q] = z2_[lane + 64 * q]; } else { _Pragma("unroll") for (int q = 0; q < 4; ++q) ZB[q] = (u32x2){0u, 0u}; } } while (0)
    if (t < T) FIN_ISSUE(t, hn, yan, ybn, zan, zbn, g1n, g2n);
    for (; t < T; t += stride) {
        const float g1 = g1n, g2 = g2n;
#pragma unroll
        for (int q = 0; q < 4; ++q) { hv[q] = hn[q]; ya[q] = yan[q]; yb[q] = ybn[q]; za[q] = zan[q]; zb[q] = zbn[q]; }
        if (t + stride < T) FIN_ISSUE(t + stride, hn, yan, ybn, zan, zbn, g1n, g2n);
        f32x4 v[4]; float s = 0.f;
#pragma unroll
        for (int q = 0; q < 4; ++q) { const u32x2 a = ya[q], b = yb[q], a2 = za[q], b2 = zb[q];
            f32x4 o;
            o[0] = hv[q][0] + g1 * (bf2f((unsigned short)(a.x & 0xffff)) + bf2f((unsigned short)(a2.x & 0xffff))) + g2 * (bf2f((unsigned short)(b.x & 0xffff)) + bf2f((unsigned short)(b2.x & 0xffff)));
            o[1] = hv[q][1] + g1 * (bf2f((unsigned short)(a.x >> 16)) + bf2f((unsigned short)(a2.x >> 16))) + g2 * (bf2f((unsigned short)(b.x >> 16)) + bf2f((unsigned short)(b2.x >> 16)));
            o[2] = hv[q][2] + g1 * (bf2f((unsigned short)(a.y & 0xffff)) + bf2f((unsigned short)(a2.y & 0xffff))) + g2 * (bf2f((unsigned short)(b.y & 0xffff)) + bf2f((unsigned short)(b2.y & 0xffff)));
            o[3] = hv[q][3] + g1 * (bf2f((unsigned short)(a.y >> 16)) + bf2f((unsigned short)(a2.y >> 16))) + g2 * (bf2f((unsigned short)(b.y >> 16)) + bf2f((unsigned short)(b2.y >> 16)));
            v[q] = o; s += (o[0] * o[0] + o[1] * o[1]) + (o[2] * o[2] + o[3] * o[3]); }
        s = wave_sum(s);
        const float r = 1.0f / sqrtf(s * (1.f / D) + EPS);
        f32x4* p = (f32x4*)(F.h + (size_t)t * D);
#pragma unroll
        for (int q = 0; q < 4; ++q) p[lane + 64 * q] = (f32x4){v[q][0] * r * gn[q][0], v[q][1] * r * gn[q][1], v[q][2] * r * gn[q][2], v[q][3] * r * gn[q][3]};
    }
#undef FIN_ISSUE
}

__device__ __forceinline__ int t5_bucket(int n) {
    if (n < 16) return n;
    int large = 16 + (int)(log((double)n / 16.0) / log(128.0) * 16.0);
    return large < 31 ? large : 31;
}
typedef float f32x16 __attribute__((ext_vector_type(16)));
typedef short s16x4 __attribute__((ext_vector_type(4)));
constexpr int AT_TAB = 0;
constexpr int AT_BKT = 7680;
constexpr int AT_CNT = 9472;
constexpr int AT_V = 10240;
constexpr float L2E = 1.4426950408889634f;
constexpr size_t WS_AST_O = WS_POOL + 291 * MiB;
constexpr size_t WS_AST_M = WS_AST_O + 64 * MiB;
static_assert(WS_AST_M + 4 * MiB <= WS_END, "attention scratch");
constexpr unsigned PITCHB = QKV_LD * 2;
__device__ __forceinline__ s16x4 vtr(const LAS unsigned char* p) { return __builtin_bit_cast(s16x4, __builtin_amdgcn_ds_read_tr16_b64_v4i16((LAS s16x4*)p)); }
__device__ __forceinline__ float max3f(float a, float b, float c) { return fmaxf(fmaxf(a, b), c); }

#define AT_LOADS(KF, VR, ub, koff, voff) do { const unsigned ub_ = (ub); \
        _Pragma("unroll") for (int d0 = 0; d0 < 4; ++d0) KF[d0] = __builtin_bit_cast(bf16x8, __builtin_amdgcn_raw_buffer_load_b128(rsrc, (koff) + 32 * d0, ub_, 0)); \
        _Pragma("unroll") for (int i = 0; i < 4; ++i) VR[i] = __builtin_bit_cast(u32x4, __builtin_amdgcn_raw_buffer_load_b128(rsrc, (voff)[i], ub_, 0)); } while (0)
#define AT_SCORE(KF, VR, QF, tla) \
        _Pragma("unroll") for (int i = 0; i < 4; ++i) *(LAS u32x4*)(vwr + i * 512) = VR[i]; \
        { const LAS float* tl_ = (const LAS float*)(tla); _Pragma("unroll") for (int r = 0; r < 16; ++r) s[r] = tl_[(r & 3) + 8 * (r >> 2)]; } \
        _Pragma("unroll") for (int d0 = 0; d0 < 4; ++d0) s = __builtin_amdgcn_mfma_f32_32x32x16_bf16(KF[d0], QF[d0], s, 0, 0, 0);
#define AT_SOFTPV() do { \
        float rm = fmaxf(max3f(max3f(s[0], s[1], s[2]), max3f(s[3], s[4], s[5]), max3f(s[6], s[7], s[8])), max3f(max3f(s[9], s[10], s[11]), max3f(s[12], s[13], s[14]), s[15])); \
        { auto rr = __builtin_amdgcn_permlane32_swap(__float_as_uint(rm), __float_as_uint(rm), false, false); rm = fmaxf(__uint_as_float(rr[0]), __uint_as_float(rr[1])); } \
        if (__any(rm > M)) { const float Mn = fmaxf(M, rm), al = __builtin_amdgcn_exp2f(M - Mn); M = Mn; l *= al; \
            _Pragma("unroll") for (int r = 0; r < 16; ++r) { o0[r] *= al; o1[r] *= al; } } \
        float ps0 = 0.f, ps1 = 0.f; \
        _Pragma("unroll") for (int r = 0; r < 16; r += 2) { s[r] = __builtin_amdgcn_exp2f(s[r] - M); s[r + 1] = __builtin_amdgcn_exp2f(s[r + 1] - M); ps0 += s[r]; ps1 += s[r + 1]; } \
        l += ps0 + ps1; \
        u32x4 pw0, pw1; \
        pw0.x = cvt_pk_bf16(s[0], s[1]); pw0.y = cvt_pk_bf16(s[2], s[3]); pw0.z = cvt_pk_bf16(s[4], s[5]); pw0.w = cvt_pk_bf16(s[6], s[7]); \
        pw1.x = cvt_pk_bf16(s[8], s[9]); pw1.y = cvt_pk_bf16(s[10], s[11]); pw1.z = cvt_pk_bf16(s[12], s[13]); pw1.w = cvt_pk_bf16(s[14], s[15]); \
        const bf16x8 pa0 = __builtin_bit_cast(bf16x8, pw0), pa1 = __builtin_bit_cast(bf16x8, pw1); \
        LDS_WAIT(); \
        { const s16x4 a0 = vtr(vrd), a1 = vtr(vrd + 512), b0 = vtr(vrd + 1024), b1 = vtr(vrd + 1536); \
          const bf16x8 v0 = (bf16x8){a0[0], a0[1], a0[2], a0[3], a1[0], a1[1], a1[2], a1[3]}, v1 = (bf16x8){b0[0], b0[1], b0[2], b0[3], b1[0], b1[1], b1[2], b1[3]}; \
          o0 = __builtin_amdgcn_mfma_f32_32x32x16_bf16(v0, pa0, o0, 0, 0, 0); o0 = __builtin_amdgcn_mfma_f32_32x32x16_bf16(v1, pa1, o0, 0, 0, 0); } \
        { const s16x4 a0 = vtr(vrd + 2048), a1 = vtr(vrd + 2560), b0 = vtr(vrd + 3072), b1 = vtr(vrd + 3584); \
          const bf16x8 v0 = (bf16x8){a0[0], a0[1], a0[2], a0[3], a1[0], a1[1], a1[2], a1[3]}, v1 = (bf16x8){b0[0], b0[1], b0[2], b0[3], b1[0], b1[1], b1[2], b1[3]}; \
          o1 = __builtin_amdgcn_mfma_f32_32x32x16_bf16(v0, pa0, o1, 0, 0, 0); o1 = __builtin_amdgcn_mfma_f32_32x32x16_bf16(v1, pa1, o1, 0, 0, 0); } \
    } while (0)

#ifdef MK_ATT_TS
#define AT_TS(k) do { __builtin_amdgcn_sched_barrier(0); unsigned long long t_; asm volatile("s_memtime %0\n\ts_waitcnt lgkmcnt(0)" : "=s"(t_) :: "memory"); ts_acc[k] += t_ - ts_prev; ts_prev = t_; __builtin_amdgcn_sched_barrier(0); } while (0)
#else
#define AT_TS(k) do { } while (0)
#endif
template <int MODE>
__device__ __forceinline__ void attn_phase(const Frame& F, const Args& A, unsigned long long* ts_out = nullptr) {
#ifdef MK_ATT_TS
    unsigned long long ts_acc[6] = {0, 0, 0, 0, 0, 0}, ts_prev = 0;
    { unsigned long long t_; asm volatile("s_memtime %0\n\ts_waitcnt lgkmcnt(0)" : "=s"(t_) :: "memory"); ts_prev = t_; }
#endif
    LAS float* tab = (LAS float*)(F.lds + AT_TAB);
    const char* qkvb = (const char*)(F.ws + WS_QKV); bf16_t* mo = (bf16_t*)(F.ws + (MODE == 0 ? WS_S0 : WS_S1));
    float* sto = (float*)(F.ws + WS_AST_O); float* stm = (float*)(F.ws + WS_AST_M);
    int lane_ = F.lane; asm volatile("" : "+v"(lane_));
    const int lane = lane_, w = F.wave, j = lane & 31, hi = lane >> 5;
    LAS unsigned char* vbuf = F.lds + AT_V + w * 4096;
    LAS unsigned char* vwr = vbuf + ((lane & 7) >> 2) * 2048 + (lane >> 3) * 64 + (lane & 3) * 16;
    const LAS unsigned char* vrd = vbuf + (4 * hi + ((lane & 15) >> 2)) * 64 + ((lane >> 4) & 1) * 32 + (lane & 3) * 8;
    volatile LAS int* bkt = (volatile LAS int*)(F.lds + AT_BKT);
    volatile LAS int* acnt = (volatile LAS int*)(F.lds + AT_CNT);
    for (int i = F.tid; i < 3 * 129; i += NTHREADS) { const int g = i / 129, m = i - g * 129; bkt[i] = t5_bucket(m * (g == 0 ? 1 : (g == 1 ? 4 : 16))); }
    LDS_WAIT(); __syncthreads();
    const __amdgpu_buffer_rsrc_t rsrc = __builtin_amdgcn_make_buffer_rsrc((void*)(F.ws + WS_QKV), 0, (int)((size_t)T * PITCHB), 0x00020000);
    for (int it = 0; ; ++it) {
        int b, h, cp;
        { const int u = ((F.G & 7) == 0) ? ((F.bid & 7) * (F.G >> 3) + (F.bid >> 3)) + it * F.G : F.bid + it * F.G;
          if (u >= 256) break;
          b = u >> 5; h = (u >> 1) & 15; cp = u & 1; }
        const int tb = b * SEQ;
        __syncthreads();
        if (F.tid < 4) acnt[F.tid] = 0;
        for (int i = F.tid; i < 3 * 640; i += NTHREADS) { const int g = i / 640, m = 383 - (i - g * 640);
            tab[i] = (m >= 0 && m <= 128) ? A.in[I_RELB][bkt[g * 129 + m] * 48 + g * 16 + h] * L2E : -1e30f; }
        LDS_WAIT(); __syncthreads();
        AT_TS(5);
        const int c = 2 * cp + (w & 1);
        f32x16 o0, o1, s; float M, l;
        bf16x8 kfA[4], kfB[4]; u32x4 vrA[4], vrB[4];
#pragma unroll 1
        for (int rd = 0; rd < 4; ++rd) {
            const int r16 = c + 4 * (w >> 1), nt = rd + 1;
            const size_t tq = (size_t)(tb + 16 * (32 * rd + j) + r16);
            bf16x8 qf[4];
            { const char* qp = qkvb + tq * PITCHB + (2 * 1024 + h * 64 + 8 * hi) * 2;
#pragma unroll
              for (int d0 = 0; d0 < 4; ++d0) qf[d0] = *(const bf16x8*)(qp + 32 * d0); }
            const unsigned koff = (unsigned)(16 * j) * PITCHB + (3072 + 2 * 1024 + h * 64 + 8 * hi) * 2;
            unsigned voff[4];
#pragma unroll
            for (int i = 0; i < 4; ++i) voff[i] = (unsigned)(16 * (8 * i + (lane >> 3))) * PITCHB + (6144 + 2 * 1024 + h * 64 + 8 * (lane & 7)) * 2;
            const unsigned ub = (unsigned)(tb + r16) * PITCHB, ustep = (unsigned)(16 * 32) * PITCHB;
            const LAS float* tla = tab + 2 * 640 + 383 - (32 * rd + j) + 4 * hi;
#pragma unroll
            for (int r = 0; r < 16; ++r) { o0[r] = 0.f; o1[r] = 0.f; }
            M = -1e29f; l = 0.f;
#define AT_LOADA(m, KF, VR) do { int m_ = (m); m_ = m_ < nt ? m_ : nt - 1; if (MODE == 1) m_ = 0; AT_LOADS(KF, VR, ub + (unsigned)m_ * ustep, koff, voff); } while (0)
            AT_LOADA(0, kfA, vrA); AT_LOADA(1, kfB, vrB);
            AT_TS(0);
            int n = 0;
#pragma unroll 1
            for (; n + 1 < nt; n += 2) {
                AT_SCORE(kfA, vrA, qf, tla + 32 * n)
                AT_LOADA(n + 2, kfA, vrA);
                AT_SOFTPV();
                AT_SCORE(kfB, vrB, qf, tla + 32 * (n + 1))
                AT_LOADA(n + 3, kfB, vrB);
                AT_SOFTPV();
            }
            if (n < nt) { AT_SCORE(kfA, vrA, qf, tla + 32 * n) AT_SOFTPV(); }
            AT_TS(1);
#undef AT_LOADA
            float* so = sto + ((tq * 16 + h) * 2 + hi) * 32;
#pragma unroll
            for (int r = 0; r < 16; r += 4) { *(f32x4*)(so + r) = (f32x4){o0[r], o0[r + 1], o0[r + 2], o0[r + 3]}; *(f32x4*)(so + 16 + r) = (f32x4){o1[r], o1[r + 1], o1[r + 2], o1[r + 3]}; }
            *(f32x2*)(stm + ((tq * 16 + h) * 2 + hi) * 2) = (f32x2){M, l};
            VM_WAIT();
            if (lane == 0) __hip_atomic_fetch_add((LAS int*)&acnt[rd], 1, __ATOMIC_RELAXED, __HIP_MEMORY_SCOPE_WORKGROUP);
            AT_TS(2);
        }
        AT_TS(3);
#pragma unroll 1
        for (int rd = 0; rd < 4; ++rd) {
            const int i0 = 32 * (4 * rd + (w >> 1));
            const int ktlo0 = (4 - i0 / 8) > 0 ? (4 - i0 / 8) : 0, n0 = 8 - ktlo0;
            const int ktlo1 = (4 - i0 / 32) > 0 ? (4 - i0 / 32) : 0, n1 = 5 - ktlo1, ntl = n0 + n1;
            const size_t tq = (size_t)(tb + 4 * (i0 + j) + c);
            bf16x8 qf0[4], qf1[4];
            { const char* qp = qkvb + tq * PITCHB + (h * 64 + 8 * hi) * 2;
#pragma unroll
              for (int d0 = 0; d0 < 4; ++d0) { qf0[d0] = *(const bf16x8*)(qp + 32 * d0); qf1[d0] = *(const bf16x8*)(qp + 2048 + 32 * d0); } }
            while (__builtin_amdgcn_readfirstlane(acnt[rd]) < NWAVES) __builtin_amdgcn_s_sleep(2);
            asm volatile("" ::: "memory");
            { const float* so = sto + ((tq * 16 + h) * 2 + hi) * 32;
#pragma unroll
              for (int r = 0; r < 16; r += 4) { const f32x4 a = *(const f32x4*)(so + r), bq = *(const f32x4*)(so + 16 + r);
                  o0[r] = a[0]; o0[r + 1] = a[1]; o0[r + 2] = a[2]; o0[r + 3] = a[3]; o1[r] = bq[0]; o1[r + 1] = bq[1]; o1[r + 2] = bq[2]; o1[r + 3] = bq[3]; }
              const f32x2 ml = *(const f32x2*)(stm + ((tq * 16 + h) * 2 + hi) * 2); M = ml[0]; l = ml[1]; }
            const int kb0 = 4 * i0 - 128 + 32 * ktlo0, ik1 = i0 - 128 + 32 * ktlo1;
            const unsigned koff0 = (unsigned)j * PITCHB + (3072 + h * 64 + 8 * hi) * 2, koff1 = (unsigned)(4 * j) * PITCHB + (3072 + 1024 + h * 64 + 8 * hi) * 2;
            unsigned voff0[4], voff1[4];
#pragma unroll
            for (int i = 0; i < 4; ++i) { voff0[i] = (unsigned)(8 * i + (lane >> 3)) * PITCHB + (6144 + h * 64 + 8 * (lane & 7)) * 2;
                                          voff1[i] = (unsigned)(4 * (8 * i + (lane >> 3))) * PITCHB + (6144 + 1024 + h * 64 + 8 * (lane & 7)) * 2; }
            const unsigned ub0 = (unsigned)(tb + kb0) * PITCHB, ub1 = (unsigned)(tb + 4 * ik1 + c) * PITCHB;
            const unsigned us0 = 32u * PITCHB, us1 = 128u * PITCHB;
            const LAS float* tla0 = tab + 383 - (4 * (i0 + j) + c - kb0) + 4 * hi;
            const LAS float* tla1 = tab + 640 + 383 - (i0 + j - ik1) + 4 * hi;
#define AT_LOADN(m, KF, VR) do { int m_ = (m); m_ = m_ < ntl ? m_ : ntl - 1; if (m_ < n0) AT_LOADS(KF, VR, ub0 + (unsigned)(MODE == 1 ? 0 : m_) * us0, koff0, voff0); else AT_LOADS(KF, VR, ub1 + (unsigned)(MODE == 1 ? 0 : m_ - n0) * us1, koff1, voff1); } while (0)
#define AT_STEPN(n, KF, VR, PF) do { const int n_ = (n); if (n_ < n0) { AT_SCORE(KF, VR, qf0, tla0 + 32 * n_) } else { AT_SCORE(KF, VR, qf1, tla1 + 32 * (n_ - n0)) } \
            if (PF) AT_LOADN(n_ + 2, KF, VR); AT_SOFTPV(); } while (0)
            AT_LOADN(0, kfA, vrA); AT_LOADN(1, kfB, vrB);
            AT_TS(0);
            int n = 0;
#pragma unroll 1
            for (; n + 1 < ntl; n += 2) { AT_STEPN(n, kfA, vrA, true); AT_STEPN(n + 1, kfB, vrB, true); }
            if (n < ntl) AT_STEPN(n, kfA, vrA, false);
            AT_TS(4);
#undef AT_STEPN
#undef AT_LOADN
            { auto rr = __builtin_amdgcn_permlane32_swap(__float_as_uint(l), __float_as_uint(l), false, false); l = __uint_as_float(rr[0]) + __uint_as_float(rr[1]); }
            const float il = 1.0f / l;
            bf16_t* op = mo + tq * D + h * 64 + 4 * hi;
#pragma unroll
            for (int gq = 0; gq < 4; ++gq) {
                u32x2 w0, w1;
                w0.x = cvt_pk_bf16(o0[4 * gq] * il, o0[4 * gq + 1] * il); w0.y = cvt_pk_bf16(o0[4 * gq + 2] * il, o0[4 * gq + 3] * il);
                w1.x = cvt_pk_bf16(o1[4 * gq] * il, o1[4 * gq + 1] * il); w1.y = cvt_pk_bf16(o1[4 * gq + 2] * il, o1[4 * gq + 3] * il);
                *(u32x2*)(op + 8 * gq) = w0; *(u32x2*)(op + 32 + 8 * gq) = w1;
            }
            AT_TS(2);
        }
    }
#ifdef MK_ATT_TS
    if (ts_out && F.tid == 0) { for (int k = 0; k < 6; ++k) ts_out[k] = ts_acc[k]; }
#endif
    __syncthreads();
}
#undef AT_LOADS
#undef AT_SCORE
#undef AT_SOFTPV
constexpr int PH_MIX = 0, PH_FF1 = 1, PH_FF2 = 2, PH_QKV = 3, PH_ATT = 4, PH_WO = 5, PH_ROUTE = 6, PH_MOE0 = 7, PH_FINAL = 11, PH_END = 12;

__global__ void __launch_bounds__(NTHREADS, 2) mk_fwd(Args args) {
    extern __shared__ __attribute__((aligned(16))) unsigned char lds_raw[];
    Frame F;
    F.lds = (LAS unsigned char*)lds_raw;
    F.tid = threadIdx.x; F.lane = F.tid & 63; F.wave = __builtin_amdgcn_readfirstlane(F.tid >> 6); F.G = gridDim.x; F.bid = blockIdx.x;
    F.ws = args.ws; F.ctl = (unsigned*)(args.ws + WS_CTL); F.h = args.out;
    volatile LAS unsigned* MISC = (volatile LAS unsigned*)(F.lds + MISC_OFF);
    for (int u = F.tid; u < 64; u += NTHREADS) MISC[u] = 0u;
    __syncthreads();
    XcdBarrier bar = xcd_barrier_post(F.ctl + CW_BAR + args.li * XCD_BAR_WORDS, MISC + 8);
    const int lo = args.ph_lo, hi = args.ph_hi;
#ifndef MK_MASK
#define MK_MASK 0xffffffffu
#endif
#define IN(k) (((MK_MASK >> (k)) & 1u) && lo <= (k) && (k) < hi)
#define SEAM(k) do { if (IN(k) && IN((k) + 1)) xcd_barrier(bar); } while (0)
    unsigned char* ws = args.ws;
    LAS unsigned char* ring = F.lds + RING_OFF;
#ifdef MK_PROBE_LO
    unsigned long long pr_t0 = 0, pr_t1 = 0;
#define PROBE_AT(k) do { if ((k) == MK_PROBE_LO) pr_t0 = __builtin_amdgcn_s_memrealtime(); if ((k) == MK_PROBE_HI) pr_t1 = __builtin_amdgcn_s_memrealtime(); } while (0)
#else
#define PROBE_AT(k) do { } while (0)
#endif

    PROBE_AT(0);
    if (IN(PH_MIX)) { conv_aproj(F, args); conv_small(F, args); VM_WAIT(); __syncthreads(); }
    PROBE_AT(20);
    if (IN(PH_MIX)) { xcd_barrier(bar); PROBE_AT(21); mixer_phase(F, args); }
    PROBE_AT(22);
    SEAM(PH_MIX);

    PROBE_AT(1);
    if (IN(PH_FF1)) {
        pg8::Gemm g{(const bf16_t*)(ws + WS_S0), (const bf16_t*)(ws + WS_WGU0), D, D, D}; pg8::StaticOrder S; S.init(T, 2 * FF0, F.G, F.bid);
        EpiSwiGLU E{(bf16_t*)(ws + WS_ACT0), ACT0_LD, nullptr};
        pg8::gemm_phase<EpiSwiGLU, pg8::StaticOrder, false>(ring, g, S, E);
        { const int units = (T / 256) * (2 * FF0 / 256), rem = units % F.G;
          if (rem == 0) conv_later(F, args, F.bid, F.G); else if (F.bid >= rem) conv_later(F, args, F.bid - rem, F.G - rem); }
    }
    SEAM(PH_FF1);
    PROBE_AT(2);
    if (IN(PH_FF2)) {
        pg8::Gemm g{(const bf16_t*)(ws + WS_ACT0), (const bf16_t*)(ws + WS_WD0), FF0, ACT0_LD, FF0}; pg8::StaticOrder S; S.init(T, D, F.G, F.bid);
        EpiRes E{F.h, (bf16_t*)(ws + WS_S1), (float*)(ws + WS_SSQ)};
        pg8::gemm_phase<EpiRes, pg8::StaticOrder, false>(ring, g, S, E);
    }
    SEAM(PH_FF2);
    PROBE_AT(3);
    if (IN(PH_QKV)) {
        pg8::Gemm g{(const bf16_t*)(ws + WS_S1), (const bf16_t*)(ws + WS_WQKV), D, D, D}; pg8::StaticOrder S; S.init(T, NQKV, F.G, F.bid);
        EpiQKV E{(bf16_t*)(ws + WS_QKV), (const float*)(ws + WS_SSQ)};
        pg8::gemm_phase<EpiQKV, pg8::StaticOrder, false>(ring, g, S, E);
#if defined(MK_QKV_EXTRA) && MK_QKV_EXTRA == 1
        pg8::gemm_phase<EpiQKV, pg8::StaticOrder, false>(ring, g, S, E);
#elif defined(MK_QKV_EXTRA) && MK_QKV_EXTRA == 3
        { EpiQKV_T<false> EN{(bf16_t*)(ws + WS_QKV), (const float*)(ws + WS_SSQ)}; pg8::gemm_phase<EpiQKV_T<false>, pg8::StaticOrder, false>(ring, g, S, EN); }
#elif defined(MK_QKV_EXTRA) && MK_QKV_EXTRA == 2
        { EpiNull EN; pg8::gemm_phase<EpiNull, pg8::StaticOrder, false>(ring, g, S, EN); }
#endif
    }
    SEAM(PH_QKV);
        PROBE_AT(4);
#ifdef MK_ATT_TS
    unsigned long long att_ts[6] = {0, 0, 0, 0, 0, 0};
    if (IN(PH_ATT)) { attn_phase<0>(F, args, att_ts);
#else
    if (IN(PH_ATT)) { attn_phase<0>(F, args);
#endif
#ifdef MK_ATT_EXTRA
        attn_phase<MK_ATT_EXTRA>(F, args);
#endif
    }
    SEAM(PH_ATT);
    PROBE_AT(5);
    if (IN(PH_WO)) {
        pg8::Gemm g{(const bf16_t*)(ws + WS_S0), (const bf16_t*)(ws + WS_WO), D, D, D}; pg8::StaticOrder S; S.init(T, D, F.G, F.bid);
        EpiRes E{F.h, (bf16_t*)(ws + WS_S1), nullptr};
        pg8::gemm_phase<EpiRes, pg8::StaticOrder, false>(ring, g, S, E);
        conv_moe(F, args);
    }
    SEAM(PH_WO);
    PROBE_AT(6);
    if (IN(PH_ROUTE)) { router_phase(F, args); }
    SEAM(PH_ROUTE);
#pragma unroll 1
    for (int j = 0; j < 4; ++j) {
        PROBE_AT(7 + j);
        if (IN(PH_MOE0 + j)) {
            moe_info_build(F.lds, F.ctl);
            volatile LAS int* mi = (volatile LAS int*)(F.lds + SCR_OFF);
            const int ntiles = __builtin_amdgcn_readfirstlane(mi[MI_NT]);
            if (j >= 1) {
                const int c0 = (j - 1) * CH_TILES; int ntc = ntiles - c0; ntc = ntc < 0 ? 0 : (ntc > CH_TILES ? CH_TILES : ntc);
                const bool lastc = (c0 + CH_TILES >= ntiles);
                EpiY E{(bf16_t*)(ws + WS_Y), (bf16_t*)(ws + WS_Y2), c0 * 256};
                if (lastc) {
                    pg8::Gemm g{(const bf16_t*)(ws + WS_ACT1 + (size_t)((j - 1) & 1) * ACT1_CHUNK), (const bf16_t*)(ws + WS_WD1), FF1 / 2, FF1, FF1};
                    MoeOrder<8, false> S{{F.ctl + CW_Q + 64 * (2 * j), MISC + 16}, mi, c0, ntc, nullptr};
                    pg8::gemm_phase<EpiY, MoeOrder<8, false>, false>(ring, g, S, E);
                } else {
                    pg8::Gemm g{(const bf16_t*)(ws + WS_ACT1 + (size_t)((j - 1) & 1) * ACT1_CHUNK), (const bf16_t*)(ws + WS_WD1), FF1, FF1, FF1};
                    MoeOrder<4, false> S{{F.ctl + CW_Q + 64 * (2 * j), MISC + 16}, mi, c0, ntc, nullptr};
                    pg8::gemm_phase<EpiY, MoeOrder<4, false>, false>(ring, g, S, E);
                }
            }
            if (j <= 2) {
                const int c0 = j * CH_TILES; int ntc = ntiles - c0; ntc = ntc < 0 ? 0 : (ntc > CH_TILES ? CH_TILES : ntc);
                pg8::Gemm g{(const bf16_t*)(ws + WS_S1), (const bf16_t*)(ws + WS_WGU1), D, D, D};
                MoeOrder<28, true> S{{F.ctl + CW_Q + 64 * (2 * j + 1), MISC + 16}, mi, c0, ntc, (const int*)(ws + WS_LTOK)};
                EpiSwiGLU E{(bf16_t*)(ws + WS_ACT1 + (size_t)(j & 1) * ACT1_CHUNK), FF1, (const float*)(ws + WS_LRS)};
                pg8::gemm_phase<EpiSwiGLU, MoeOrder<28, true>, true>(ring, g, S, E);
            }
        }
        SEAM(PH_MOE0 + j);
    }
#ifdef MK_EXTRA_BARS
    for (int i = 0; i < MK_EXTRA_BARS; ++i) xcd_barrier(bar);
#endif
    PROBE_AT(11);
    if (IN(PH_FINAL)) { moe_info_build(F.lds, F.ctl); final_phase(F, args); }
    PROBE_AT(12);
#ifdef MK_ATT_TS
    if (F.bid == 0 && F.wave == 0) { const unsigned long long dt = att_ts[MK_ATT_TS] / 5ull, ts = __builtin_amdgcn_s_memrealtime(); while (__builtin_amdgcn_s_memrealtime() - ts < dt) __builtin_amdgcn_s_sleep(8); }
#endif
#ifdef MK_PROBE_LO
    { const unsigned long long dt = (pr_t1 - pr_t0) * MK_PROBE_MULT, ts = __builtin_amdgcn_s_memrealtime(); while (__builtin_amdgcn_s_memrealtime() - ts < dt) __builtin_amdgcn_s_sleep(8); }
#endif
#undef IN
#undef SEAM
}
}
#ifndef MK_STEP
#define MK_STEP 1
#endif
static void naive_dense_ffn(hipStream_t stream, float* h, float* rstd, float* big, const float* ffn_norm, const float* dwg, const float* dwu, const float* dwd) {
    using namespace nv; GemmP p{};
    hipLaunchKernelGGL(k_rstd, dim3(T / 4), dim3(256), 0, stream, h, rstd);
    p = GemmP{}; p.A = h; p.lda = D; p.B1 = dwg; p.B2 = dwu; p.ldb = FF0; p.C = big; p.ldc = FF0; p.M = T; p.N = FF0; p.K = D; p.rowscale = rstd; p.kgain = ffn_norm; gemm<2>(stream, p);
    p = GemmP{}; p.A = big; p.lda = FF0; p.B1 = dwd; p.ldb = D; p.C = h; p.ldc = D; p.M = T; p.N = D; p.K = FF0; p.R = h; p.ldr = D; gemm<3>(stream, p);
}
static void naive_mixer_b(hipStream_t stream, float* h, float* rstd, float* big, float* buf0, float* mbuf, float* lbuf, const float* w_q, const float* w_kv, const float* w_o, const float* b_norm, const float* kv_norm, const float* rel_bias) {
    using namespace nv; GemmP p{};
    hipLaunchKernelGGL(k_rstd, dim3(T / 4), dim3(256), 0, stream, h, rstd);
    float* qg = big; float* kg = big + (size_t)T * D; float* vg = big + (size_t)2 * T * D;
    const int dil[3] = {1, 4, 16};
    for (int g = 0; g < 3; ++g) {
        p = GemmP{}; p.A = h; p.lda = D; p.B1 = w_q + g * 1024; p.ldb = 3072; p.C = qg; p.ldc = D; p.M = T; p.N = D; p.K = D; p.rowscale = rstd; p.kgain = b_norm; gemm<0>(stream, p);
        p.B1 = w_kv + g * 1024; p.ldb = 6144; p.C = kg; p.kgain = kv_norm; gemm<0>(stream, p);
        p.B1 = w_kv + 3072 + g * 1024; p.C = vg; gemm<0>(stream, p);
        hipLaunchKernelGGL(k_attn, dim3(T * 16 / 4), dim3(256), 0, stream, qg, kg, vg, rel_bias, buf0, mbuf, lbuf, g, dil[g]);
    }
    p = GemmP{}; p.A = buf0; p.lda = D; p.B1 = w_o; p.ldb = D; p.C = h; p.ldc = D; p.M = T; p.N = D; p.K = D; p.R = h; p.ldr = D; gemm<3>(stream, p);
}
static void naive_moe_final(hipStream_t stream, float* h, float* rstd, float* big, float* buf0, float* gates, const float* ffn_norm, const float* router, const float* mwg, const float* mwu, const float* mwd, const float* final_norm) {
    using namespace nv; GemmP p{};
    hipLaunchKernelGGL(k_rstd, dim3(T / 4), dim3(256), 0, stream, h, rstd);
    hipLaunchKernelGGL(k_router, dim3(T / 4), dim3(256), 0, stream, h, rstd, ffn_norm + D, router, gates);
    (void)hipMemcpyAsync(buf0, h, (size_t)T * D * 4, hipMemcpyDeviceToDevice, stream);
    for (int e = 0; e < NE; ++e) {
        p = GemmP{}; p.A = buf0; p.lda = D; p.B1 = mwg + (size_t)e * D * FF1; p.B2 = mwu + (size_t)e * D * FF1; p.ldb = FF1; p.C = big; p.ldc = FF1; p.M = T; p.N = FF1; p.K = D;
        p.rowscale = rstd; p.kgain = ffn_norm + D; gemm<2>(stream, p);
        p = GemmP{}; p.A = big; p.lda = FF1; p.B1 = mwd + (size_t)e * FF1 * D; p.ldb = D; p.C = h; p.ldc = D; p.M = T; p.N = D; p.K = FF1; p.rowgate = gates + e; p.rg_stride = 8; gemm<4>(stream, p);
    }
    hipLaunchKernelGGL(k_final, dim3(T / 4), dim3(256), 0, stream, h, final_norm, h);
}

extern "C" void kernel_launch(void* const* d_in, const int* in_sizes, int n_in, void* d_out, int out_size, void* d_ws, size_t ws_size, hipStream_t stream) {
    static int grid = 0;
    if (grid == 0) {
        if (n_in != 19 || out_size != mk::T * mk::D || ws_size < mk::WS_END) { fprintf(stderr, "kernel_launch: unexpected shapes / workspace (%d inputs, out %d, ws %zu)\n", n_in, out_size, ws_size); grid = -1; return; }
        int dev = 0, cus = 0;
        if (hipGetDevice(&dev) != hipSuccess || hipDeviceGetAttribute(&cus, hipDeviceAttributeMultiprocessorCount, dev) != hipSuccess) { grid = -1; return; }
        if (hipFuncSetAttribute((const void*)mk::mk_fwd, hipFuncAttributeMaxDynamicSharedMemorySize, mk::LDS_BYTES) != hipSuccess) { fprintf(stderr, "kernel_launch: hipFuncSetAttribute failed\n"); grid = -1; return; }
        int per_cu = 0;
        if (hipOccupancyMaxActiveBlocksPerMultiprocessor(&per_cu, (const void*)mk::mk_fwd, mk::NTHREADS, mk::LDS_BYTES) != hipSuccess || per_cu < 1) { fprintf(stderr, "kernel_launch: occupancy query says %d blocks per CU\n", per_cu); }
        (void)hipGetLastError();
        grid = cus;
    }
    if (grid < 0) return;
    const float* in[19]; for (int i = 0; i < 19; ++i) in[i] = (const float*)d_in[i];
    (void)hipMemsetAsync((char*)d_ws + mk::WS_CTL, 0, mk::CTL_ZERO_BYTES, stream);
    mk::Args a{};
    for (int i = 0; i < 19; ++i) a.in[i] = in[i];
    a.out = (float*)d_out; a.ws = (unsigned char*)d_ws;
    float* h = (float*)d_out; char* ws = (char*)d_ws; const size_t MiB = 1u << 20;
    float* rstd = (float*)(ws + 1 * MiB); float* mbuf = (float*)(ws + 2 * MiB); float* lbuf = (float*)(ws + 3 * MiB); float* gates = (float*)(ws + 4 * MiB);
    float* buf0 = (float*)(ws + 5 * MiB); float* big = (float*)(ws + 69 * MiB);
#if MK_STEP == 1
    a.ph_lo = 0; a.ph_hi = 3; a.li = 0;
    hipLaunchKernelGGL(mk::mk_fwd, dim3(grid), dim3(mk::NTHREADS), mk::LDS_BYTES, stream, a);
    naive_mixer_b(stream, h, rstd, big, buf0, mbuf, lbuf, in[7], in[5], in[8], in[6], in[4], in[9]);
    naive_moe_final(stream, h, rstd, big, buf0, gates, in[10], in[14], in[15], in[16], in[17], in[18]);
#elif MK_STEP == 2
    a.ph_lo = 0; a.ph_hi = 6; a.li = 0;
    hipLaunchKernelGGL(mk::mk_fwd, dim3(grid), dim3(mk::NTHREADS), mk::LDS_BYTES, stream, a);
    naive_moe_final(stream, h, rstd, big, buf0, gates, in[10], in[14], in[15], in[16], in[17], in[18]);
#else
    a.ph_lo = 0; a.ph_hi = mk::PH_END; a.li = 0;
    hipLaunchKernelGGL(mk::mk_fwd, dim3(grid), dim3(mk::NTHREADS), mk::LDS_BYTES, stream, a);
#endif
}
```

```cpp
#include <hip/hip_runtime.h>
#include <cstdio>
#include <cstdint>
namespace mk {
#define LAS __attribute__((address_space(3)))
#define GAS __attribute__((address_space(1)))
typedef unsigned short bf16_t;
typedef short bf16x8 __attribute__((ext_vector_type(8)));
typedef float f32x4 __attribute__((ext_vector_type(4)));
typedef float f32x2 __attribute__((ext_vector_type(2)));
typedef unsigned u32x4 __attribute__((ext_vector_type(4)));
typedef unsigned u32x2 __attribute__((ext_vector_type(2)));

constexpr int T = 16384, D = 1024, SEQ = 2048, NBATCH = 8;
constexpr int FF0 = 2816, FF1 = 3584, NE = 8, NQKV = 9216;
constexpr int ACT0_LD = FF0 + 64;
constexpr int QKV_LD = NQKV + 64;
constexpr float EPS = 1e-6f;
constexpr int NWAVES = 8, NTHREADS = 512;

constexpr size_t MiB = 1u << 20;
constexpr size_t WS_CTL = 0, CTL_ZERO_BYTES = 1 * MiB;
constexpr size_t WS_SSQ = 1 * MiB;
constexpr size_t WS_LTOK = 2 * MiB;
constexpr size_t WS_LRS = 2 * MiB + 512 * 1024;
constexpr size_t WS_TOKINFO = 3 * MiB;
constexpr size_t WS_ZERO = 3 * MiB + 256 * 1024;
constexpr size_t WS_APT = 3 * MiB + 512 * 1024;
constexpr size_t WS_WGU0 = 4 * MiB;
constexpr size_t WS_WD0 = 15 * MiB;
constexpr size_t WS_WQKV = WS_WD0 + (size_t)D * FF0 * 2;
constexpr size_t WS_WO = WS_WQKV + (size_t)NQKV * D * 2;
constexpr size_t WS_S0 = 41 * MiB;
constexpr size_t WS_S1 = 73 * MiB;
constexpr size_t WS_POOL = 105 * MiB;
constexpr size_t WS_ACT0 = WS_POOL;
constexpr size_t WS_QKV = WS_POOL;
constexpr int CH_TILES = 46;
constexpr size_t ACT1_CHUNK = (size_t)CH_TILES * 256 * FF1 * 2;
constexpr size_t WS_ACT1 = WS_POOL;
constexpr size_t WS_Y = 4 * MiB;
constexpr size_t WS_Y2 = WS_S1;
constexpr size_t WS_WGU1 = 306 * MiB;
constexpr size_t WS_WD1 = 418 * MiB;
constexpr size_t WS_END = 474 * MiB;
static_assert(WS_WO + (size_t)D * D * 2 <= WS_S0, "small weights");
static_assert(WS_ACT1 + 2 * ACT1_CHUNK <= WS_WGU1 && WS_Y + (size_t)34816 * D * 2 <= WS_S1 && (size_t)CH_TILES * 256 * D * 2 <= 32 * MiB && 3 * CH_TILES >= 136, "moe map");
static_assert(WS_WGU1 + (size_t)NE * 7168 * D * 2 <= WS_WD1 && WS_WD1 + (size_t)NE * D * FF1 * 2 <= WS_END, "moe weights");
static_assert(WS_QKV + (size_t)T * QKV_LD * 2 <= WS_END, "qkv");

constexpr int CW_TMO = 0;
constexpr int CW_CNT = 64;
constexpr int CW_Q = 128;
constexpr int CW_BAR = 4096;

constexpr int RING_OFF = 0, RING_BYTES = 131072;
constexpr int MISC_OFF = RING_BYTES;
constexpr int RTAB_OFF = MISC_OFF + 1024;
constexpr int SCR_OFF = MISC_OFF + 2048;
constexpr int LDS_BYTES = 147456;

#define RLX_AGENT __ATOMIC_RELAXED, __HIP_MEMORY_SCOPE_AGENT
#define LDS_WAIT() asm volatile("s_waitcnt lgkmcnt(0)" ::: "memory")
#define VM_WAIT() asm volatile("s_waitcnt vmcnt(0)" ::: "memory")
__device__ __forceinline__ unsigned f2bf(float f) { unsigned u = __builtin_bit_cast(unsigned, f); return (u + 0x7fffu + ((u >> 16) & 1u)) >> 16; }
__device__ __forceinline__ unsigned pk2(float lo, float hi) { return f2bf(lo) | (f2bf(hi) << 16); }
__device__ __forceinline__ unsigned cvt_pk_bf16(float lo, float hi) { unsigned r; asm volatile("v_cvt_pk_bf16_f32 %0, %1, %2" : "=v"(r) : "v"(lo), "v"(hi)); return r; }
__device__ __forceinline__ float bf2f(unsigned short b) { return __builtin_bit_cast(float, ((unsigned)b) << 16); }
__device__ __forceinline__ float wave_sum(float v) {
#pragma unroll
    for (int o = 1; o < 64; o <<= 1) v += __shfl_xor(v, o);
    return v;
}
__device__ __forceinline__ float silu_f(float x) { return x * __builtin_amdgcn_rcpf(1.f + __builtin_amdgcn_exp2f(-1.4426950408889634f * x)); }
#define XB_TMO      128
#define XB_XCNT(j)  (256  + 64 * (j))
#define XB_XSUB(j)  (1280 + 64 * (j))
#define XB_XGEN(j)  (2304 + 64 * (j))
#define XB_TOP      3328
#define XB_TOPGEN   3392
#define XCD_BAR_WORDS 3456
#define XB_SPIN_CAP (1u << 18)
__device__ __forceinline__ unsigned xb_ld(unsigned* p)              { return __hip_atomic_load(p, __ATOMIC_RELAXED, __HIP_MEMORY_SCOPE_AGENT); }
__device__ __forceinline__ unsigned xb_add(unsigned* p, unsigned v) { return __hip_atomic_fetch_add(p, v, __ATOMIC_RELAXED, __HIP_MEMORY_SCOPE_AGENT); }
__device__ __forceinline__ unsigned xb_xcc_id() { return (unsigned)__builtin_amdgcn_s_getreg((3 << 11) | 20) & 0xFu; }
#define XB_SPIN(cond, bar) do { unsigned _sp = 0; while (cond) { __builtin_amdgcn_s_sleep(1); \
    if ((++_sp & 255u) == 0u) { if (xb_ld(&(bar)[XB_TMO])) break; if (_sp > XB_SPIN_CAP) { atomicAdd(&(bar)[XB_TMO], 1u); break; } } } } while (0)
struct XcdBarrier { unsigned* bar; unsigned x; volatile LAS unsigned* st; };
__device__ __forceinline__ XcdBarrier xcd_barrier_post(unsigned* bar, volatile LAS unsigned* st) {
    XcdBarrier b; b.bar = bar; b.x = xb_xcc_id(); b.st = st;
    if (threadIdx.x == 0) (void)xb_add(&bar[XB_XCNT(b.x)], 1u);
    return b;
}
__device__ __forceinline__ void xcd_barrier_complete(unsigned* bar, unsigned x, unsigned& nloc, unsigned& nx) {
    const unsigned G = gridDim.x * gridDim.y * gridDim.z;
    unsigned sum, cnt, mine, sp = 0u;
    for (;;) {
        sum = 0u; cnt = 0u; mine = 0u;
#pragma unroll
        for (unsigned j = 0; j < 16; ++j) { const unsigned c = xb_ld(&bar[XB_XCNT(j)]); sum += c; cnt += (c > 0u) ? 1u : 0u; mine = (j == x) ? c : mine; }
        if (sum == G) break;
        __builtin_amdgcn_s_sleep(1);
        if ((++sp & 255u) == 0u) { if (xb_ld(&bar[XB_TMO])) break; if (sp > XB_SPIN_CAP) { atomicAdd(&bar[XB_TMO], 1u); break; } }
    }
    nloc = mine > 0u ? mine : 1u; nx = cnt > 0u ? cnt : 1u;
}
__device__ __forceinline__ void xcd_barrier(const XcdBarrier& b) {
    asm volatile("s_waitcnt vmcnt(0)" ::: "memory");
    __syncthreads();
    if (threadIdx.x == 0) {
        unsigned* bar = b.bar;
        __builtin_amdgcn_s_waitcnt(0);
        unsigned nloc = b.st[0], nx = b.st[1];
        if (nloc == 0u) { xcd_barrier_complete(bar, b.x, nloc, nx); b.st[0] = nloc; b.st[1] = nx; }
        const unsigned old = xb_add(&bar[XB_XSUB(b.x)], 1u);
        const unsigned gen = old / nloc;
        if (old + 1u == (gen + 1u) * nloc) {
            __builtin_amdgcn_fence(__ATOMIC_RELEASE, "agent");
            asm volatile("s_waitcnt vmcnt(0)" ::: "memory");
            const unsigned og = xb_add(&bar[XB_TOP], 1u);
            const unsigned tg = og / nx;
            if (og + 1u == (tg + 1u) * nx) xb_add(&bar[XB_TOPGEN], 1u);
            else XB_SPIN(xb_ld(&bar[XB_TOPGEN]) == tg, bar);
            __builtin_amdgcn_fence(__ATOMIC_ACQUIRE, "agent");
            xb_add(&bar[XB_XGEN(b.x)], 1u);
            asm volatile("s_waitcnt vmcnt(0)" ::: "memory");
        } else {
            XB_SPIN(xb_ld(&bar[XB_XGEN(b.x)]) == gen, bar);
            __builtin_amdgcn_fence(__ATOMIC_ACQUIRE, "agent");
            asm volatile("s_waitcnt vmcnt(0)" ::: "memory");
        }
    }
    __syncthreads();
}
namespace pg8 {
constexpr int BM = 256, BK = 64, HALF = 128, HTB = HALF * BK * 2, STAGE_BYTES = 8 * HTB, NXCD = 8, WGM = 4;
__host__ __device__ __forceinline__ int lds_byte(int r, int c) { const int st = (r >> 4) * 2 + (c >> 5), rr = r & 15, cc = c & 31, ob = rr * 64 + cc * 2; return st * 1024 + (ob ^ (((ob >> 9) & 1) << 5)); }
__host__ __device__ __forceinline__ void stage_rc(int b, int& R, int& C) { const int st = b / 1024, sb = b % 1024, swz = sb ^ (((sb >> 9) & 1) << 5); R = (st >> 1) * 16 + swz / 64; C = (st & 1) * 32 + (swz % 64) / 2; }
__host__ __device__ __forceinline__ int perm32(int rho) { const int n = rho >> 4, i = rho & 15; return 8 * (i >> 2) + 4 * n + (i & 3); }

struct Unit { int pm, pn, arow, brow, e, orow, koff; };
struct Gemm { const bf16_t* A; const bf16_t* Bt; int K; int lda; int ldb; };

struct StaticOrder {
    int nM, nN, nwg, G, c;
    __device__ void init(int M, int N, int G_, int c_) { nM = M / BM; nN = N / BM; nwg = nM * nN; G = G_; c = c_; }
    __device__ __forceinline__ void start() const {}
    __device__ __forceinline__ bool next(int i, Unit& u) const {
        const long L = (long)i * G + c; if (L >= nwg) return false;
        int wgid = (int)L; { const int q = nwg / NXCD, r = nwg % NXCD, xcd = wgid % NXCD, off = wgid / NXCD; wgid = (xcd < r ? xcd * (q + 1) : r * (q + 1) + (xcd - r) * q) + off; }
        const int nig = WGM * nN, gid = wgid / nig, fm = gid * WGM, gsz = (nM - fm) < WGM ? (nM - fm) : WGM;
        u.pm = fm + ((wgid % nig) % gsz); u.pn = (wgid % nig) / gsz; u.arow = u.pm * BM; u.brow = u.pn * BM; u.e = 0; u.orow = u.arow; u.koff = 0; return true;
    }
    __device__ __forceinline__ unsigned refill_issue() const { return 0u; }
    __device__ __forceinline__ void refill_commit(int, unsigned) const {}
    __device__ __forceinline__ unsigned gather_row(const Unit&, int) const { return 0u; }
};

template <class Epi, class Sched, bool GATHER>
__device__ __forceinline__ void gemm_phase(LAS unsigned char* lds, const Gemm g, Sched& S, const Epi& E) {
    int tid_ = threadIdx.x; asm volatile("" : "+v"(tid_));
    const int tid = tid_, wid = __builtin_amdgcn_readfirstlane(tid >> 6), lane = tid & 63, wr = wid >> 2, wc = wid & 3, fr = lane & 15, fq = lane >> 4;
    const int K = g.K, nt = K / BK, LDA = g.lda, LDB = g.ldb;
    unsigned voffB[2]; unsigned va[2][2];
    const size_t kstep = (size_t)(BK * 2);
    const size_t hstep = (size_t)HALF * LDB * 2, hstepA = (size_t)HALF * LDA * 2;
#pragma unroll
    for (int i = 0; i < 2; ++i) { int R, C; stage_rc(tid * 16 + i * 8192, R, C); const int Rb = Epi::PERM ? ((R & ~31) + perm32(R & 31)) : R;
        voffB[i] = (unsigned)(Rb * LDB + C) * 2u;
        va[0][i] = (unsigned)(R * LDA + C) * 2u; va[1][i] = va[0][i] + (unsigned)hstepA; }
    const unsigned ldsw = (unsigned)wid * 1024u;
    const int aoff = lds_byte(wr * 64 + fr, fq * 8), boff = lds_byte(wc * 32 + fr, fq * 8);
#define PG8_SA(b, h) (((b) * 2 + (h)) * HTB)
#define PG8_SB(b, h) ((4 + (b) * 2 + (h)) * HTB)
#define PG8_STAGEB(bufoff, gbase) do { _Pragma("unroll") for (int _i = 0; _i < 2; ++_i) \
        __builtin_amdgcn_global_load_lds((const unsigned*)((const char*)(gbase) + voffB[_i]), (LAS unsigned*)(lds + (bufoff) + ldsw + _i * 8192), 16, 0, 0); } while (0)
#define PG8_STAGEA(bufoff, gbase, vo, h) do { _Pragma("unroll") for (int _i = 0; _i < 2; ++_i) \
        __builtin_amdgcn_global_load_lds((const unsigned*)((const char*)(gbase) + (vo)[h][_i]), (LAS unsigned*)(lds + (bufoff) + ldsw + _i * 8192), 16, 0, 0); } while (0)
#define PG8_LDA(dst, b, h) do { _Pragma("unroll") for (int m = 0; m < 4; ++m) _Pragma("unroll") for (int k = 0; k < 2; ++k) dst[m][k] = *(const LAS bf16x8*)(lds + PG8_SA(b, h) + aoff + m * 2048 + k * 1024); } while (0)
#define PG8_LDB(dst, b, h) do { _Pragma("unroll") for (int n = 0; n < 2; ++n) _Pragma("unroll") for (int k = 0; k < 2; ++k) dst[n][k] = *(const LAS bf16x8*)(lds + PG8_SB(b, h) + boff + n * 2048 + k * 1024); } while (0)
#define PG8_MMA(ai, bj, At, Bt) do { __builtin_amdgcn_s_setprio(1); _Pragma("unroll") for (int m = 0; m < 4; ++m) _Pragma("unroll") for (int n = 0; n < 2; ++n) _Pragma("unroll") for (int k = 0; k < 2; ++k) \
        acc[ai][bj][m][n] = __builtin_amdgcn_mfma_f32_16x16x32_bf16(Bt[n][k], At[m][k], acc[ai][bj][m][n], 0, 0, 0); __builtin_amdgcn_s_setprio(0); } while (0)
#define PG8_WAIT_V(n) asm volatile("s_waitcnt vmcnt(" #n ")" ::: "memory")
#define PG8_WAIT_L(n) asm volatile("s_waitcnt lgkmcnt(" #n ")" ::: "memory")
#define PG8_BAR __builtin_amdgcn_s_barrier()
#define PG8_SCHED __builtin_amdgcn_sched_barrier(0)
    Unit cur, nxt; int ui = 0;
    typename Epi::Pre pre{};
#ifdef MK_STAGGER
    { const unsigned long long dt = (unsigned long long)((blockIdx.x >> 3) & 7) * MK_STAGGER, ts = __builtin_amdgcn_s_memrealtime(); while (__builtin_amdgcn_s_memrealtime() - ts < dt) __builtin_amdgcn_s_sleep(4); }
#endif
    S.start();
    if (!S.next(0, cur)) return;
    f32x4 acc[2][2][4][2];
#pragma unroll
    for (int a = 0; a < 2; ++a)
#pragma unroll
        for (int b = 0; b < 2; ++b)
#pragma unroll
            for (int m = 0; m < 4; ++m)
#pragma unroll
                for (int n = 0; n < 2; ++n) acc[a][b][m][n] = (f32x4){0.f, 0.f, 0.f, 0.f};
    bf16x8 At[4][2], B0[2][2], B1[2][2];
    const char* cA; const char* cB = (const char*)g.Bt + ((size_t)cur.brow * LDB + cur.koff) * 2;
    if constexpr (GATHER) { cA = (const char*)g.A;
#pragma unroll
        for (int h = 0; h < 2; ++h)
#pragma unroll
            for (int i = 0; i < 2; ++i) { int R, C; stage_rc(tid * 16 + i * 8192, R, C); va[h][i] = (S.gather_row(cur, h * HALF + R) * (unsigned)LDA + (unsigned)C) * 2u; }
    } else cA = (const char*)g.A + ((size_t)cur.arow * LDA + cur.koff) * 2;
    PG8_STAGEB(PG8_SB(0, 0), cB); PG8_STAGEB(PG8_SB(0, 1), cB + hstep); PG8_STAGEA(PG8_SA(0, 0), cA, va, 0); PG8_STAGEA(PG8_SA(0, 1), cA, va, 1);
    if (wr == 1) PG8_BAR;
    PG8_WAIT_V(2); PG8_BAR;
    PG8_STAGEB(PG8_SB(1, 0), cB + kstep); PG8_STAGEA(PG8_SA(1, 0), cA + kstep, va, 0); PG8_STAGEB(PG8_SB(1, 1), cB + hstep + kstep);
    PG8_WAIT_V(6); PG8_BAR;
    for (;;) {
        bool has_next = false; const char* nA = cA; const char* nB = cB;
        unsigned vnx[2][2] = {{0u, 0u}, {0u, 0u}};
        for (int t = 0; t < nt; t += 2) {
            const bool last = (t == nt - 2);
            unsigned v2[2][2];
#pragma unroll
            for (int h = 0; h < 2; ++h)
#pragma unroll
                for (int i = 0; i < 2; ++i) v2[h][i] = va[h][i];
            if (last) {
                pre = E.pre(cur, wr, fr);
                has_next = S.next(ui + 1, nxt);
                if (has_next) { nB = (const char*)g.Bt + ((size_t)nxt.brow * LDB + nxt.koff) * 2;
                    if constexpr (GATHER) {
#pragma unroll
                        for (int h = 0; h < 2; ++h)
#pragma unroll
                            for (int i = 0; i < 2; ++i) { int R, C; stage_rc(tid * 16 + i * 8192, R, C); v2[h][i] = (S.gather_row(nxt, h * HALF + R) * (unsigned)LDA + (unsigned)C) * 2u; }
                    } else nA = (const char*)g.A + ((size_t)nxt.arow * LDA + nxt.koff) * 2;
                }
            }
            if constexpr (GATHER) { if (last) {
#pragma unroll
                for (int h = 0; h < 2; ++h)
#pragma unroll
                    for (int i = 0; i < 2; ++i) vnx[h][i] = v2[h][i]; } }
            const char* a1 = cA + (size_t)(t + 1) * kstep;
            const char* a2 = last ? nA : cA + (size_t)(t + 2) * kstep; const char* b2 = last ? nB : cB + (size_t)(t + 2) * kstep;
            const char* a3 = a2 + kstep; const char* b3 = b2 + kstep;
            PG8_LDB(B0, 0, 0); PG8_LDB(B1, 0, 1); PG8_SCHED; PG8_LDA(At, 0, 0); PG8_STAGEA(PG8_SA(1, 1), a1, va, 1);
            PG8_WAIT_V(8); PG8_WAIT_L(0); PG8_BAR; PG8_MMA(0, 0, At, B0); PG8_MMA(0, 1, At, B1); PG8_BAR; PG8_SCHED;
            PG8_LDA(At, 0, 1); PG8_STAGEB(PG8_SB(0, 0), b2); PG8_STAGEB(PG8_SB(0, 1), b2 + hstep); PG8_STAGEA(PG8_SA(0, 0), a2, v2, 0);
            PG8_WAIT_V(8); PG8_WAIT_L(0); PG8_BAR; PG8_MMA(1, 0, At, B0); PG8_MMA(1, 1, At, B1); PG8_BAR; PG8_SCHED;
            PG8_LDB(B0, 1, 0); PG8_LDB(B1, 1, 1); PG8_SCHED; PG8_LDA(At, 1, 0); PG8_STAGEA(PG8_SA(0, 1), a2, v2, 1);
            PG8_WAIT_V(8); PG8_WAIT_L(0); PG8_BAR; PG8_MMA(0, 0, At, B0); PG8_MMA(0, 1, At, B1); PG8_BAR; PG8_SCHED;
            PG8_LDA(At, 1, 1); PG8_STAGEB(PG8_SB(1, 0), b3); PG8_STAGEB(PG8_SB(1, 1), b3 + hstep); PG8_STAGEA(PG8_SA(1, 0), a3, v2, 0);
            PG8_WAIT_V(8); PG8_WAIT_L(0); PG8_BAR; PG8_MMA(1, 0, At, B0); PG8_MMA(1, 1, At, B1); PG8_BAR; PG8_SCHED;
        }
        if (wr == 0) PG8_BAR;
        const unsigned rf = S.refill_issue();
        E(acc, cur, wr, wc, fr, fq, lds, pre);
        S.refill_commit(ui, rf);
        if (!has_next) break;
#pragma unroll
        for (int a = 0; a < 2; ++a)
#pragma unroll
            for (int b = 0; b < 2; ++b)
#pragma unroll
                for (int m = 0; m < 4; ++m)
#pragma unroll
                    for (int n = 0; n < 2; ++n) acc[a][b][m][n] = (f32x4){0.f, 0.f, 0.f, 0.f};
        cur = nxt; cA = nA; cB = nB; ++ui;
        if constexpr (GATHER) {
#pragma unroll
            for (int h = 0; h < 2; ++h)
#pragma unroll
                for (int i = 0; i < 2; ++i) va[h][i] = vnx[h][i];
        }
        if (wr == 1) PG8_BAR;
    }
    PG8_WAIT_V(0);
    PG8_BAR;
#undef PG8_SA
#undef PG8_SB
#undef PG8_STAGEA
#undef PG8_STAGEB
#undef PG8_LDA
#undef PG8_LDB
#undef PG8_MMA
#undef PG8_WAIT_V
#undef PG8_WAIT_L
#undef PG8_BAR
#undef PG8_SCHED
}
}
struct PreNone { };
struct Pre8 { float v[8]; };
struct EpiSwiGLU {
    static constexpr bool PERM = true;
    bf16_t* O; int ldo; const float* lrs;
    typedef Pre8 Pre;
    __device__ __forceinline__ Pre pre(const pg8::Unit& u, int wr, int fr) const { Pre p;
#pragma unroll
        for (int i = 0; i < 8; ++i) p.v[i] = lrs ? lrs[(size_t)u.e * T + u.arow + (i >> 2) * 128 + (i & 3) * 16 + wr * 64 + fr] : 1.f;
        return p; }
    __device__ __forceinline__ void operator()(const f32x4 (&acc)[2][2][4][2], const pg8::Unit& u, int wr, int wc, int fr, int fq, LAS unsigned char*, const Pre& pr) const {
        const int r0 = wr * 64 + fr, col0 = u.pn * 128 + wc * 32 + 8 * fq;
#pragma unroll
        for (int ai = 0; ai < 2; ++ai) {
#pragma unroll
            for (int m = 0; m < 4; ++m) {
                const float s = pr.v[ai * 4 + m]; float o[8];
#pragma unroll
                for (int n = 0; n < 2; ++n)
#pragma unroll
                    for (int j = 0; j < 4; ++j) { const float gv = acc[ai][0][m][n][j] * s, uv = acc[ai][1][m][n][j] * s; o[n * 4 + j] = silu_f(gv) * uv; }
                u32x4 w; w.x = cvt_pk_bf16(o[0], o[1]); w.y = cvt_pk_bf16(o[2], o[3]); w.z = cvt_pk_bf16(o[4], o[5]); w.w = cvt_pk_bf16(o[6], o[7]);
                *(u32x4*)(O + (size_t)(u.orow + ai * 128 + m * 16 + r0) * ldo + col0) = w;
            }
        }
    }
};
struct EpiRes {
    static constexpr bool PERM = false;
    float* H; bf16_t* HB; float* ssq;
    typedef PreNone Pre;
    __device__ __forceinline__ Pre pre(const pg8::Unit&, int, int) const { return Pre{}; }
    __device__ __forceinline__ void operator()(const f32x4 (&acc)[2][2][4][2], const pg8::Unit& u, int wr, int wc, int fr, int fq, LAS unsigned char*, const Pre&) const {
        const int r0 = u.orow + wr * 64 + fr, col0 = u.pn * 256 + wc * 32 + 4 * fq;
#pragma unroll
        for (int ai = 0; ai < 2; ++ai)
#pragma unroll
            for (int m = 0; m < 4; ++m) {
                const size_t off = (size_t)(r0 + ai * 128 + m * 16) * D + col0; float sq = 0.f;
#pragma unroll
                for (int bj = 0; bj < 2; ++bj)
#pragma unroll
                    for (int n = 0; n < 2; ++n) {
                        const f32x4 hv = *(const f32x4*)(H + off + bj * 128 + n * 16) + acc[ai][bj][m][n];
                        *(f32x4*)(H + off + bj * 128 + n * 16) = hv;
                        u32x2 w; w.x = cvt_pk_bf16(hv[0], hv[1]); w.y = cvt_pk_bf16(hv[2], hv[3]);
                        *(u32x2*)(HB + off + bj * 128 + n * 16) = w;
                        sq += (hv[0] * hv[0] + hv[1] * hv[1]) + (hv[2] * hv[2] + hv[3] * hv[3]);
                    }
                if (ssq) { sq += __shfl_xor(sq, 16); sq += __shfl_xor(sq, 32);
                    if (fq == 0) ssq[(size_t)(r0 + ai * 128 + m * 16) * 16 + u.pn * 4 + wc] = sq; }
            }
    }
};
template <bool STORE>
struct EpiQKV_T {
    static constexpr bool PERM = true;
    bf16_t* O; const float* ssq;
    typedef Pre8 Pre;
    __device__ __forceinline__ Pre pre(const pg8::Unit& u, int, int) const { Pre p; const int tid = threadIdx.x, row = tid >> 1, part = tid & 1;
        const f32x4* q = (const f32x4*)(ssq + (size_t)(u.orow + row) * 16 + part * 8); const f32x4 a = q[0], b = q[1];
        p.v[0] = a[0]; p.v[1] = a[1]; p.v[2] = a[2]; p.v[3] = a[3]; p.v[4] = b[0]; p.v[5] = b[1]; p.v[6] = b[2]; p.v[7] = b[3]; return p; }
    __device__ __forceinline__ void operator()(const f32x4 (&acc)[2][2][4][2], const pg8::Unit& u, int wr, int wc, int fr, int fq, LAS unsigned char* lds, const Pre& pr) const {
        LAS float* rtab = (LAS float*)(lds + RTAB_OFF);
        { const int tid = threadIdx.x, row = tid >> 1, part = tid & 1;
          float s = ((pr.v[0] + pr.v[1]) + (pr.v[2] + pr.v[3])) + ((pr.v[4] + pr.v[5]) + (pr.v[6] + pr.v[7]));
          s += __shfl_xor(s, 1);
          if (part == 0) rtab[row] = 1.0f / sqrtf(s * (1.f / D) + EPS); }
        asm volatile("s_waitcnt lgkmcnt(0)" ::: "memory"); __builtin_amdgcn_s_barrier(); asm volatile("" ::: "memory");
        const float qs = (u.pn * 256 < 3072) ? 0.125f * 1.4426950408889634f : 1.f;
        const int r0 = wr * 64 + fr, col0 = u.pn * 256 + wc * 32 + 8 * fq;
#pragma unroll
        for (int ai = 0; ai < 2; ++ai)
#pragma unroll
            for (int m = 0; m < 4; ++m) {
                const float s = rtab[ai * 128 + m * 16 + r0] * qs;
#pragma unroll
                for (int bj = 0; bj < 2; ++bj) {
                    const f32x4 v0 = acc[ai][bj][m][0] * s, v1 = acc[ai][bj][m][1] * s;
                    u32x4 w; w.x = cvt_pk_bf16(v0[0], v0[1]); w.y = cvt_pk_bf16(v0[2], v0[3]); w.z = cvt_pk_bf16(v1[0], v1[1]); w.w = cvt_pk_bf16(v1[2], v1[3]);
                    if (STORE) *(u32x4*)(O + (size_t)(u.orow + ai * 128 + m * 16 + r0) * QKV_LD + col0 + bj * 128) = w; else asm volatile("" :: "v"(w));
                }
            }
    }
};
typedef EpiQKV_T<true> EpiQKV;
struct EpiNull {
    static constexpr bool PERM = true;
    typedef PreNone Pre;
    __device__ __forceinline__ Pre pre(const pg8::Unit&, int, int) const { return Pre{}; }
    __device__ __forceinline__ void operator()(const f32x4 (&acc)[2][2][4][2], const pg8::Unit& u, int wr, int wc, int fr, int fq, LAS unsigned char*, const Pre&) const {
#pragma unroll
        for (int ai = 0; ai < 2; ++ai)
#pragma unroll
            for (int bj = 0; bj < 2; ++bj)
#pragma unroll
                for (int m = 0; m < 4; ++m)
#pragma unroll
                    for (int n = 0; n < 2; ++n) asm volatile("" :: "v"(acc[ai][bj][m][n]));
    }
};
struct EpiY {
    static constexpr bool PERM = true;
    bf16_t* Y; bf16_t* Y2; int c0rows;
    typedef PreNone Pre;
    __device__ __forceinline__ Pre pre(const pg8::Unit&, int, int) const { return Pre{}; }
    __device__ __forceinline__ void operator()(const f32x4 (&acc)[2][2][4][2], const pg8::Unit& u, int wr, int wc, int fr, int fq, LAS unsigned char*, const Pre&) const {
        bf16_t* Yb = u.koff ? Y2 : Y;
        const int r0 = (u.koff ? u.orow - c0rows : u.orow) + wr * 64 + fr, col0 = u.pn * 256 + wc * 32 + 8 * fq;
#pragma unroll
        for (int ai = 0; ai < 2; ++ai)
#pragma unroll
            for (int m = 0; m < 4; ++m)
#pragma unroll
                for (int bj = 0; bj < 2; ++bj) {
                    const f32x4 v0 = acc[ai][bj][m][0], v1 = acc[ai][bj][m][1];
                    u32x4 w; w.x = cvt_pk_bf16(v0[0], v0[1]); w.y = cvt_pk_bf16(v0[2], v0[3]); w.z = cvt_pk_bf16(v1[0], v1[1]); w.w = cvt_pk_bf16(v1[2], v1[3]);
                    *(u32x4*)(Yb + (size_t)(r0 + ai * 128 + m * 16) * D + col0 + bj * 128) = w;
                }
    }
};

constexpr int MI_CNT = 0, MI_TB = 8, MI_NT = 17, MI_SPLIT0 = 18;
__device__ __forceinline__ void moe_info_build(LAS unsigned char* lds, const unsigned* ctl) {
    volatile LAS int* mi = (volatile LAS int*)(lds + SCR_OFF);
    if (threadIdx.x == 0) { int tb = 0;
        for (int e = 0; e < NE; ++e) { const int c = (int)__hip_atomic_load(ctl + CW_CNT + e, RLX_AGENT); mi[MI_CNT + e] = c; mi[MI_TB + e] = tb; tb += (c + 255) >> 8; }
        mi[MI_TB + NE] = tb; mi[MI_NT] = tb; mi[MI_SPLIT0] = ((tb - 1) / CH_TILES) * CH_TILES * 256; }
    LDS_WAIT(); __syncthreads();
}
struct DynQ {
    unsigned* ctr; volatile LAS unsigned* slot;
    __device__ __forceinline__ void start() const { if (threadIdx.x == 0) { slot[0] = blockIdx.x; slot[1] = gridDim.x + atomicAdd(ctr, 1u); } LDS_WAIT(); __syncthreads(); }
#ifdef MK_STATICQ
    __device__ __forceinline__ int fetch(int i) const { return i * (int)gridDim.x + (int)blockIdx.x; }
#else
    __device__ __forceinline__ int fetch(int i) const { return __builtin_amdgcn_readfirstlane((int)slot[i & 3]); }
#endif
    __device__ __forceinline__ unsigned refill_issue() const { unsigned v = 0u; if (threadIdx.x == 0) v = gridDim.x + atomicAdd(ctr, 1u); return v; }
    __device__ __forceinline__ void refill_commit(int ui, unsigned v) const { if (threadIdx.x == 0) slot[(ui + 2) & 3] = v; }
};
template <int NN, bool G1>
struct MoeOrder {
    DynQ q; volatile LAS int* mi; int c0, ntc; const int* ltok;
    __device__ __forceinline__ void start() const { q.start(); }
    __device__ __forceinline__ unsigned refill_issue() const { return q.refill_issue(); }
    __device__ __forceinline__ void refill_commit(int ui, unsigned v) const { q.refill_commit(ui, v); }
    __device__ __forceinline__ bool next(int i, pg8::Unit& u) const {
        const int idx = q.fetch(i); if (idx >= ntc * NN) return false;
        const int grp = idx / (8 * NN), r = idx - grp * (8 * NN), gsz = (ntc - grp * 8) < 8 ? (ntc - grp * 8) : 8;
        const int pml = grp * 8 + r % gsz, pn = r / gsz, pmg = c0 + pml;
        int e = 0;
#pragma unroll
        for (int k = 1; k < NE; ++k) e += (pmg >= mi[MI_TB + k]) ? 1 : 0;
        e = __builtin_amdgcn_readfirstlane(e);
        u.pm = pmg; u.pn = pn; u.e = e; u.koff = 0;
        if (!G1 && NN == 8) { u.pn = pn & 3; u.koff = (pn >> 2) * (FF1 / 2); }
        const int pnb = u.pn;
        if (G1) { u.arow = (pmg - __builtin_amdgcn_readfirstlane(mi[MI_TB + e])) * 256; u.brow = e * (2 * FF1) + pn * 256; u.orow = pml * 256; }
        else { u.arow = pml * 256; u.brow = e * D + pnb * 256; u.orow = pmg * 256; }
        return true;
    }
    __device__ __forceinline__ unsigned gather_row(const pg8::Unit& u, int r) const {
        const int lr = u.arow + r; const int c = mi[MI_CNT + u.e];
        return lr < c ? (unsigned)ltok[(size_t)u.e * T + lr] : 0u;
    }
};
struct Args { const float* in[19]; float* out; unsigned char* ws; int ph_lo, ph_hi, li, pad; };
enum { I_X = 0, I_ANORM, I_APROJ, I_ASCALE, I_KVNORM, I_WKV, I_BNORM, I_WQ, I_WO, I_RELB, I_FFNORM, I_DWG, I_DWU, I_DWD, I_ROUTER, I_MWG, I_MWU, I_MWD, I_FNORM };
struct Frame {
    LAS unsigned char* lds; unsigned* ctl; int tid, lane, wave, G, bid;
    float* h; unsigned char* ws;
};
__device__ __forceinline__ void conv_item(const float* W, int ldw, const float* gain, bf16_t* WT, int K, int dst_row0, LAS float* scr, int k0, int n0, int lane) {
    float wv[32];
#pragma unroll
    for (int i = 0; i < 32; ++i) wv[i] = W[(size_t)(k0 + 2 * i + (lane >> 5)) * ldw + n0 + (lane & 31)];
    if (gain) {
#pragma unroll
        for (int i = 0; i < 32; ++i) wv[i] *= gain[k0 + 2 * i + (lane >> 5)];
    }
#pragma unroll
    for (int i = 0; i < 32; ++i) scr[(2 * i + (lane >> 5)) * 33 + (lane & 31)] = wv[i];
    LDS_WAIT(); asm volatile("" ::: "memory");
    const int c = lane & 7;
#pragma unroll
    for (int j = 0; j < 4; ++j) { const int n = (lane >> 3) + 8 * j; const LAS float* s = scr + (8 * c) * 33 + n;
        u32x4 o; o.x = pk2(s[0 * 33], s[1 * 33]); o.y = pk2(s[2 * 33], s[3 * 33]); o.z = pk2(s[4 * 33], s[5 * 33]); o.w = pk2(s[6 * 33], s[7 * 33]);
        *(u32x4*)(WT + (size_t)(dst_row0 + n) * K + k0 + 8 * c) = o; }
    LDS_WAIT(); asm volatile("" ::: "memory");
}
__device__ __forceinline__ void conv_job(const Frame& F, int& it0, const float* W, int K, int N, int ldw, const float* gain, bf16_t* WT, int mode, int row_off, LAS float* scr, int cg = 0) {
    const int nblk = N / 32, items = (K / 64) * nblk, NGW = (cg ? cg : F.G) * NWAVES;
    int it = it0;
    for (; it < items; it += NGW) {
        const int kb = it / nblk, nb = it - kb * nblk, n0 = nb * 32;
        const int dr = (mode == 0) ? (row_off + n0) : (row_off + (n0 >> 7) * 256 + (n0 & 127) + (mode == 2 ? 128 : 0));
        conv_item(W, ldw, gain, WT, K, dr, scr, kb * 64, n0, F.lane);
    }
    it0 = it - items;
}
__device__ __forceinline__ void conv_aproj(const Frame& F, const Args& A) {
    LAS float* scr = (LAS float*)(F.lds + RING_OFF + F.wave * 16384);
    int it = F.bid * NWAVES + F.wave;
    for (int g = 0; g < 4; ++g) conv_job(F, it, A.in[I_APROJ] + (size_t)g * 65536, 256, 256, 256, nullptr, (bf16_t*)(F.ws + WS_APT) + (size_t)g * 65536, 0, 0, scr);
}
__device__ __forceinline__ void conv_small(const Frame& F, const Args& A) {
    LAS float* scr = (LAS float*)(F.lds + RING_OFF + F.wave * 16384);
    int it = F.bid * NWAVES + F.wave;
    unsigned char* ws = F.ws;
    conv_job(F, it, A.in[I_DWG], D, FF0, FF0, nullptr, (bf16_t*)(ws + WS_WGU0), 1, 0, scr);
    conv_job(F, it, A.in[I_DWU], D, FF0, FF0, nullptr, (bf16_t*)(ws + WS_WGU0), 2, 0, scr);
}
__device__ __forceinline__ void conv_later(const Frame& F, const Args& A, int cb, int cg) {
    LAS float* scr = (LAS float*)(F.lds + RING_OFF + F.wave * 16384);
    int it = cb * NWAVES + F.wave;
    unsigned char* ws = F.ws;
    conv_job(F, it, A.in[I_DWD], FF0, D, D, nullptr, (bf16_t*)(ws + WS_WD0), 0, 0, scr, cg);
    conv_job(F, it, A.in[I_WQ], D, 3072, 3072, A.in[I_BNORM], (bf16_t*)(ws + WS_WQKV), 0, 0, scr, cg);
    conv_job(F, it, A.in[I_WKV], D, 6144, 6144, A.in[I_KVNORM], (bf16_t*)(ws + WS_WQKV), 0, 3072, scr, cg);
    conv_job(F, it, A.in[I_WO], D, D, D, nullptr, (bf16_t*)(ws + WS_WO), 0, 0, scr, cg);
}
__device__ __forceinline__ void conv_moe(const Frame& F, const Args& A) {
    LAS float* scr = (LAS float*)(F.lds + RING_OFF + F.wave * 16384);
    int it = F.bid * NWAVES + F.wave;
    unsigned char* ws = F.ws;
    for (int e = 0; e < NE; ++e) {
        conv_job(F, it, A.in[I_MWG] + (size_t)e * D * FF1, D, FF1, FF1, A.in[I_FFNORM] + D, (bf16_t*)(ws + WS_WGU1) + (size_t)e * 2 * FF1 * D, 1, 0, scr);
        conv_job(F, it, A.in[I_MWU] + (size_t)e * D * FF1, D, FF1, FF1, A.in[I_FFNORM] + D, (bf16_t*)(ws + WS_WGU1) + (size_t)e * 2 * FF1 * D, 2, 0, scr);
        conv_job(F, it, A.in[I_MWD] + (size_t)e * FF1 * D, FF1, D, D, nullptr, (bf16_t*)(ws + WS_WD1) + (size_t)e * D * FF1, 0, 0, scr);
    }
}

__device__ __forceinline__ void mixer_phase(const Frame& F, const Args& A) {
    LAS float* rs = (LAS float*)(F.lds + 0);
    LAS float* xn = (LAS float*)(F.lds + 512);
    LAS bf16_t* pl = (LAS bf16_t*)(F.lds + 512 + 80896);
    LAS float* sw = (LAS float*)(F.lds + 512 + 80896 + 33792);
    int tid_ = F.tid; asm volatile("" : "+v"(tid_));
    const int tid = tid_, lane = tid & 63, w = F.wave, fr = lane & 15, fq = lane >> 4;
    const bf16_t* apt = (const bf16_t*)(F.ws + WS_APT);
    bf16_t* hn0 = (bf16_t*)(F.ws + WS_S0);
    for (int tile = F.bid; tile < T / 64; tile += F.G) {
        const int t0 = tile * 64, s0 = t0 % SEQ, halo = s0 ? 15 : 0, nrows = 64 + halo;
#pragma unroll 1
        for (int jb = w; jb < nrows; jb += 5 * NWAVES) {
            f32x4 rv[5][4];
#pragma unroll
            for (int u = 0; u < 5; ++u) { const int jj = jb + u * NWAVES, jc = jj < nrows ? jj : nrows - 1; const f32x4* p = (const f32x4*)(A.in[I_X] + (size_t)(t0 - halo + jc) * D);
#pragma unroll
                for (int q = 0; q < 4; ++q) rv[u][q] = p[lane + 64 * q]; }
#pragma unroll
            for (int u = 0; u < 5; ++u) { float s = 0.f;
#pragma unroll
                for (int q = 0; q < 4; ++q) { const f32x4 v = rv[u][q]; s += (v[0] * v[0] + v[1] * v[1]) + (v[2] * v[2] + v[3] * v[3]); }
                s = wave_sum(s);
                const int jj = jb + u * NWAVES;
                if (lane == 0 && jj < nrows) rs[jj] = 1.0f / sqrtf(s * (1.f / D) + EPS); }
        }
        LDS_WAIT(); __syncthreads();
        float ss[4] = {0.f, 0.f, 0.f, 0.f};
        for (int g = 0; g < 4; ++g) {
            { const f32x4 gn = *(const f32x4*)(A.in[I_ANORM] + g * 256 + 4 * lane);
              f32x4 xv[10];
#pragma unroll
              for (int u = 0; u < 10; ++u) { const int jj = w + u * NWAVES, jc = jj < nrows ? jj : nrows - 1; xv[u] = *(const f32x4*)(A.in[I_X] + (size_t)(t0 - halo + jc) * D + g * 256 + 4 * lane); }
#pragma unroll
              for (int u = 0; u < 10; ++u) { const int jj = w + u * NWAVES; if (jj < nrows) { const float r = rs[jj]; const f32x4 v = xv[u];
                  *(LAS f32x4*)(xn + jj * 256 + 4 * lane) = (f32x4){v[0] * r * gn[0], v[1] * r * gn[1], v[2] * r * gn[2], v[3] * r * gn[3]}; } } }
            LDS_WAIT(); __syncthreads();
            { const int c4 = (tid & 63) * 4, win = 2 << g;
#pragma unroll 1
              for (int i = 0; i < 8; ++i) { const int r = (tid >> 6) + 8 * i, s = s0 + r, cnt = (s + 1 < win) ? (s + 1) : win;
                  f32x4 a = {0.f, 0.f, 0.f, 0.f};
                  for (int jj = 0; jj < cnt; ++jj) a += *(const LAS f32x4*)(xn + (halo + r - jj) * 256 + c4);
                  const f32x4 self = *(const LAS f32x4*)(xn + (halo + r) * 256 + c4); const float inv = 1.f / (float)cnt;
                  u32x2 o; o.x = pk2(a[0] * inv - self[0], a[1] * inv - self[1]); o.y = pk2(a[2] * inv - self[2], a[3] * inv - self[3]);
                  *(LAS u32x2*)(pl + r * 264 + c4) = o; } }
            LDS_WAIT(); __syncthreads();
            f32x4 acc[4][2];
#pragma unroll
            for (int m = 0; m < 4; ++m) { acc[m][0] = (f32x4){0.f, 0.f, 0.f, 0.f}; acc[m][1] = (f32x4){0.f, 0.f, 0.f, 0.f}; }
#pragma unroll
            for (int ks = 0; ks < 8; ++ks) {
                bf16x8 bfr[2], afr[4];
#pragma unroll
                for (int n = 0; n < 2; ++n) bfr[n] = *(const bf16x8*)(apt + (size_t)g * 65536 + (size_t)(32 * w + 16 * n + fr) * 256 + 32 * ks + 8 * fq);
#pragma unroll
                for (int m = 0; m < 4; ++m) afr[m] = *(const LAS bf16x8*)(pl + (16 * m + fr) * 264 + 32 * ks + 8 * fq);
#pragma unroll
                for (int m = 0; m < 4; ++m)
#pragma unroll
                    for (int n = 0; n < 2; ++n) acc[m][n] = __builtin_amdgcn_mfma_f32_16x16x32_bf16(bfr[n], afr[m], acc[m][n], 0, 0, 0);
            }
#pragma unroll
            for (int m = 0; m < 4; ++m)
#pragma unroll
                for (int n = 0; n < 2; ++n) { const int col = g * 256 + 32 * w + 16 * n + 4 * fq; const size_t off = (size_t)(t0 + 16 * m + fr) * D + col;
                    const f32x4 sc = *(const f32x4*)(A.in[I_ASCALE] + col); const f32x4 hv = *(const f32x4*)(A.in[I_X] + off) + acc[m][n] * sc;
                    *(f32x4*)(F.h + off) = hv; ss[m] += (hv[0] * hv[0] + hv[1] * hv[1]) + (hv[2] * hv[2] + hv[3] * hv[3]); }
        }
#pragma unroll
        for (int m = 0; m < 4; ++m) { float s = ss[m]; s += __shfl_xor(s, 16); s += __shfl_xor(s, 32); if (fq == 0) sw[(16 * m + fr) * 8 + w] = s; }
        VM_WAIT(); LDS_WAIT(); __syncthreads();
#pragma unroll 1
        for (int jb = w; jb < 64; jb += 4 * NWAVES) {
            f32x4 hv[4][4];
#pragma unroll
            for (int u = 0; u < 4; ++u) { const f32x4* p = (const f32x4*)(F.h + (size_t)(t0 + jb + u * NWAVES) * D);
#pragma unroll
                for (int q = 0; q < 4; ++q) hv[u][q] = p[lane + 64 * q]; }
#pragma unroll
            for (int u = 0; u < 4; ++u) { const int jr = jb + u * NWAVES; float s = 0.f;
#pragma unroll
                for (int q = 0; q < 8; ++q) s += sw[jr * 8 + q];
                const float r1 = 1.0f / sqrtf(s * (1.f / D) + EPS);
                u32x2* o = (u32x2*)(hn0 + (size_t)(t0 + jr) * D);
#pragma unroll
                for (int q = 0; q < 4; ++q) { const f32x4 v = hv[u][q]; const f32x4 gn = *(const f32x4*)(A.in[I_FFNORM] + 4 * (lane + 64 * q));
                    u32x2 ov; ov.x = pk2(v[0] * r1 * gn[0], v[1] * r1 * gn[1]); ov.y = pk2(v[2] * r1 * gn[2], v[3] * r1 * gn[3]); o[lane + 64 * q] = ov; } }
        }
        LDS_WAIT(); __syncthreads();
    }
}

__device__ __forceinline__ void router_phase(const Frame& F, const Args& A) {
    volatile LAS int* li = (volatile LAS int*)(F.lds + 0);
    volatile LAS float* lf = (volatile LAS float*)(F.lds + 2048);
    int* ltok = (int*)(F.ws + WS_LTOK); float* lrs = (float*)(F.ws + WS_LRS); u32x4* tinfo = (u32x4*)(F.ws + WS_TOKINFO);
    int tid_ = F.tid; asm volatile("" : "+v"(tid_));
    const int tid = tid_, lane = tid & 63, w = F.wave;
    const float* gain = A.in[I_FFNORM] + D;
    f32x4 wa[4][4], wb[4][4];
#pragma unroll
    for (int q = 0; q < 4; ++q) { const int c0 = 4 * (lane + 64 * q); const f32x4 gn = *(const f32x4*)(gain + c0);
#pragma unroll
        for (int j = 0; j < 4; ++j) { wa[q][j] = *(const f32x4*)(A.in[I_ROUTER] + (size_t)(c0 + j) * 8) * gn[j]; wb[q][j] = *(const f32x4*)(A.in[I_ROUTER] + (size_t)(c0 + j) * 8 + 4) * gn[j]; } }
    if (F.bid == 0 && tid < 128) ((u32x4*)(F.ws + WS_ZERO))[tid] = (u32x4){0u, 0u, 0u, 0u};
    for (int tile = F.bid; tile < T / 64; tile += F.G) {
        const int t0 = tile * 64;
        if (tid < 8) li[tid] = 0;
        LDS_WAIT(); __syncthreads();
        f32x4 v[4], vn[4];
        { const f32x4* p = (const f32x4*)(F.h + (size_t)(t0 + 8 * w) * D);
#pragma unroll
          for (int q = 0; q < 4; ++q) vn[q] = p[lane + 64 * q]; }
#pragma unroll 1
        for (int k = 0; k < 8; ++k) {
            const int tl = 8 * w + k;
#pragma unroll
            for (int q = 0; q < 4; ++q) v[q] = vn[q];
            if (k < 7) { const f32x4* p = (const f32x4*)(F.h + (size_t)(t0 + tl + 1) * D);
#pragma unroll
                for (int q = 0; q < 4; ++q) vn[q] = p[lane + 64 * q]; }
            float s = 0.f; f32x4 la = {0.f, 0.f, 0.f, 0.f}, lb = {0.f, 0.f, 0.f, 0.f};
#pragma unroll
            for (int q = 0; q < 4; ++q) { s += (v[q][0] * v[q][0] + v[q][1] * v[q][1]) + (v[q][2] * v[q][2] + v[q][3] * v[q][3]);
#pragma unroll
                for (int j = 0; j < 4; ++j) { la += wa[q][j] * v[q][j]; lb += wb[q][j] * v[q][j]; } }
            float red[9] = {s, la[0], la[1], la[2], la[3], lb[0], lb[1], lb[2], lb[3]};
#pragma unroll
            for (int o = 1; o < 64; o <<= 1) {
#pragma unroll
                for (int e = 0; e < 9; ++e) red[e] += __shfl_xor(red[e], o); }
            if (lane == 0) {
                const float r = 1.0f / sqrtf(red[0] * (1.f / D) + EPS);
                float lg[8];
#pragma unroll
                for (int e = 0; e < 8; ++e) lg[e] = red[1 + e] * r;
                float b1 = lg[0]; int i1 = 0;
#pragma unroll
                for (int e = 1; e < 8; ++e) if (lg[e] > b1) { b1 = lg[e]; i1 = e; }
                float b2 = -3.0e38f; int i2 = 0;
#pragma unroll
                for (int e = 0; e < 8; ++e) if (e != i1 && lg[e] > b2) { b2 = lg[e]; i2 = e; }
                const float e2 = expf(b2 - b1), g1 = 1.f / (1.f + e2), g2 = e2 / (1.f + e2);
                const int r1 = __hip_atomic_fetch_add((LAS int*)&li[i1], 1, __ATOMIC_RELAXED, __HIP_MEMORY_SCOPE_WORKGROUP), r2 = __hip_atomic_fetch_add((LAS int*)&li[i2], 1, __ATOMIC_RELAXED, __HIP_MEMORY_SCOPE_WORKGROUP);
                li[16 + tl * 4 + 0] = i1; li[16 + tl * 4 + 1] = i2; li[16 + tl * 4 + 2] = r1; li[16 + tl * 4 + 3] = r2;
                lf[tl * 4 + 0] = g1; lf[tl * 4 + 1] = g2; lf[tl * 4 + 2] = r;
            }
        }
        LDS_WAIT(); __syncthreads();
        if (tid < 8) li[8 + tid] = (int)atomicAdd(F.ctl + CW_CNT + tid, (unsigned)li[tid]);
        LDS_WAIT(); __syncthreads();
        if (tid < 64) {
            const int i1 = li[16 + tid * 4 + 0], i2 = li[16 + tid * 4 + 1], s1 = li[8 + i1] + li[16 + tid * 4 + 2], s2 = li[8 + i2] + li[16 + tid * 4 + 3];
            const float g1 = lf[tid * 4 + 0], g2 = lf[tid * 4 + 1], r = lf[tid * 4 + 2];
            ltok[(size_t)i1 * T + s1] = t0 + tid; lrs[(size_t)i1 * T + s1] = r;
            ltok[(size_t)i2 * T + s2] = t0 + tid; lrs[(size_t)i2 * T + s2] = r;
            u32x4 ti; ti.x = (unsigned)(s1 << 3 | i1); ti.y = (unsigned)(s2 << 3 | i2); ti.z = __builtin_bit_cast(unsigned, g1); ti.w = __builtin_bit_cast(unsigned, g2);
            tinfo[t0 + tid] = ti;
        }
        LDS_WAIT(); __syncthreads();
    }
}

__device__ __forceinline__ void final_phase(const Frame& F, const Args& A) {
    volatile LAS int* mi = (volatile LAS int*)(F.lds + SCR_OFF);
    const u32x4* tinfo = (const u32x4*)(F.ws + WS_TOKINFO); const bf16_t* Y = (const bf16_t*)(F.ws + WS_Y);
    int lane_ = F.lane; asm volatile("" : "+v"(lane_));
    const int lane = lane_;
    f32x4 gn[4];
#pragma unroll
    for (int q = 0; q < 4; ++q) gn[q] = *(const f32x4*)(A.in[I_FNORM] + 4 * (lane + 64 * q));
    const int stride = F.G * NWAVES; int t = F.bid * NWAVES + F.wave;
    const bf16_t* Y2 = (const bf16_t*)(F.ws + WS_Y2); const bf16_t* ZR = (const bf16_t*)(F.ws + WS_ZERO);
    f32x4 hv[4], hn[4]; u32x2 ya[4], yb[4], yan[4], ybn[4], za[4], zb[4], zan[4], zbn[4]; float g1n = 0.f, g2n = 0.f;
#define FIN_ISSUE(tt, HV, YA, YB, ZA, ZB, G1, G2) do { const u32x4 ti = tinfo[tt]; const unsigned tx = ti.x, ty = ti.y, gz = ti.z, gw = ti.w; \
        const int e1 = tx & 7, s1 = tx >> 3, e2 = ty & 7, s2 = ty >> 3; G1 = __uint_as_float(gz); G2 = __uint_as_float(gw); \
        const size_t r1 = (size_t)mi[MI_TB + e1] * 256 + s1, r2 = (size_t)mi[MI_TB + e2] * 256 + s2; \
        const size_t sp0 = (size_t)mi[MI_SPLIT0]; const u32x2* z1_ = r1 >= sp0 ? (const u32x2*)(Y2 + (r1 - sp0) * D) : (const u32x2*)ZR; const u32x2* z2_ = r2 >= sp0 ? (const u32x2*)(Y2 + (r2 - sp0) * D) : (const u32x2*)ZR; \
        const f32x4* p_ = (const f32x4*)(F.h + (size_t)(tt) * D); const u32x2* y1_ = (const u32x2*)(Y + r1 * D); const u32x2* y2_ = (const u32x2*)(Y + r2 * D); \
        _Pragma("unroll") for (int q = 0; q < 4; ++q) { HV[q] = p_[lane + 64 * q]; YA[q] = y1_[lane + 64 * q]; YB[q] = y2_[lane + 64 * q]; } \
        if (r1 >= sp0) { _Pragma("unroll") for (int q = 0; q < 4; ++q) ZA[q] = z1_[lane + 64 * q]; } else { _Pragma("unroll") for (int q = 0; q < 4; ++q) ZA[q] = (u32x2){0u, 0u}; } \
        if (r2 >= sp0) { _Pragma("unroll") for (int q = 0; q < 4; ++q) ZB[q] = z2_[lane + 64 * q]; } else { _Pragma("unroll") for (int q = 0; q < 4; ++q) ZB[q] = (u32x2){0u, 0u}; } } while (0)
    if (t < T) FIN_ISSUE(t, hn, yan, ybn, zan, zbn, g1n, g2n);
    for (; t < T; t += stride) {
        const float g1 = g1n, g2 = g2n;
#pragma unroll
        for (int q = 0; q < 4; ++q) { hv[q] = hn[q]; ya[q] = yan[q]; yb[q] = ybn[q]; za[q] = zan[q]; zb[q] = zbn[q]; }
        if (t + stride < T) FIN_ISSUE(t + stride, hn, yan, ybn, zan, zbn, g1n, g2n);
        f32x4 v[4]; float s = 0.f;
#pragma unroll
        for (int q = 0; q < 4; ++q) { const u32x2 a = ya[q], b = yb[q], a2 = za[q], b2 = zb[q];
            f32x4 o;
            o[0] = hv[q][0] + g1 * (bf2f((unsigned short)(a.x & 0xffff)) + bf2f((unsigned short)(a2.x & 0xffff))) + g2 * (bf2f((unsigned short)(b.x & 0xffff)) + bf2f((unsigned short)(b2.x & 0xffff)));
            o[1] = hv[q][1] + g1 * (bf2f((unsigned short)(a.x >> 16)) + bf2f((unsigned short)(a2.x >> 16))) + g2 * (bf2f((unsigned short)(b.x >> 16)) + bf2f((unsigned short)(b2.x >> 16)));
            o[2] = hv[q][2] + g1 * (bf2f((unsigned short)(a.y & 0xffff)) + bf2f((unsigned short)(a2.y & 0xffff))) + g2 * (bf2f((unsigned short)(b.y & 0xffff)) + bf2f((unsigned short)(b2.y & 0xffff)));
            o[3] = hv[q][3] + g1 * (bf2f((unsigned short)(a.y >> 16)) + bf2f((unsigned short)(a2.y >> 16))) + g2 * (bf2f((unsigned short)(b.y >> 16)) + bf2f((unsigned short)(b2.y >> 16)));
            v[q] = o; s += (o[0] * o[0] + o[1] * o[1]) + (o[2] * o[2] + o[3] * o[3]); }
        s = wave_sum(s);
        const float r = 1.0f / sqrtf(s * (1.f / D) + EPS);
        f32x4* p = (f32x4*)(F.h + (size_t)t * D);
#pragma unroll
        for (int q = 0; q < 4; ++q) p[lane + 64 * q] = (f32x4){v[q][0] * r * gn[q][0], v[q][1] * r * gn[q][1], v[q][2] * r * gn[q][2], v[q][3] * r * gn[q][3]};
    }
#undef FIN_ISSUE
}

__device__ __forceinline__ int t5_bucket(int n) {
    if (n < 16) return n;
    int large = 16 + (int)(log((double)n / 16.0) / log(128.0) * 16.0);
    return large < 31 ? large : 31;
}
typedef float f32x16 __attribute__((ext_vector_type(16)));
typedef short s16x4 __attribute__((ext_vector_type(4)));
constexpr int AT_TAB = 0;
constexpr int AT_BKT = 7680;
constexpr int AT_CNT = 9472;
constexpr int AT_V = 10240;
constexpr float L2E = 1.4426950408889634f;
constexpr size_t WS_AST_O = WS_POOL + 291 * MiB;
constexpr size_t WS_AST_M = WS_AST_O + 64 * MiB;
static_assert(WS_AST_M + 4 * MiB <= WS_END, "attention scratch");
constexpr unsigned PITCHB = QKV_LD * 2;
__device__ __forceinline__ s16x4 vtr(const LAS unsigned char* p) { return __builtin_bit_cast(s16x4, __builtin_amdgcn_ds_read_tr16_b64_v4i16((LAS s16x4*)p)); }
__device__ __forceinline__ float max3f(float a, float b, float c) { return fmaxf(fmaxf(a, b), c); }

#define AT_LOADS(KF, VR, ub, koff, voff) do { const unsigned ub_ = (ub); \
        _Pragma("unroll") for (int d0 = 0; d0 < 4; ++d0) KF[d0] = __builtin_bit_cast(bf16x8, __builtin_amdgcn_raw_buffer_load_b128(rsrc, (koff) + 32 * d0, ub_, 0)); \
        _Pragma("unroll") for (int i = 0; i < 4; ++i) VR[i] = __builtin_bit_cast(u32x4, __builtin_amdgcn_raw_buffer_load_b128(rsrc, (voff)[i], ub_, 0)); } while (0)
#define AT_SCORE(KF, VR, QF, tla) \
        _Pragma("unroll") for (int i = 0; i < 4; ++i) *(LAS u32x4*)(vwr + i * 512) = VR[i]; \
        { const LAS float* tl_ = (const LAS float*)(tla); _Pragma("unroll") for (int r = 0; r < 16; ++r) s[r] = tl_[(r & 3) + 8 * (r >> 2)]; } \
        _Pragma("unroll") for (int d0 = 0; d0 < 4; ++d0) s = __builtin_amdgcn_mfma_f32_32x32x16_bf16(KF[d0], QF[d0], s, 0, 0, 0);
#define AT_SOFTPV() do { \
        float rm = fmaxf(max3f(max3f(s[0], s[1], s[2]), max3f(s[3], s[4], s[5]), max3f(s[6], s[7], s[8])), max3f(max3f(s[9], s[10], s[11]), max3f(s[12], s[13], s[14]), s[15])); \
        { auto rr = __builtin_amdgcn_permlane32_swap(__float_as_uint(rm), __float_as_uint(rm), false, false); rm = fmaxf(__uint_as_float(rr[0]), __uint_as_float(rr[1])); } \
        if (__any(rm > M)) { const float Mn = fmaxf(M, rm), al = __builtin_amdgcn_exp2f(M - Mn); M = Mn; l *= al; \
            _Pragma("unroll") for (int r = 0; r < 16; ++r) { o0[r] *= al; o1[r] *= al; } } \
        float ps0 = 0.f, ps1 = 0.f; \
        _Pragma("unroll") for (int r = 0; r < 16; r += 2) { s[r] = __builtin_amdgcn_exp2f(s[r] - M); s[r + 1] = __builtin_amdgcn_exp2f(s[r + 1] - M); ps0 += s[r]; ps1 += s[r + 1]; } \
        l += ps0 + ps1; \
        u32x4 pw0, pw1; \
        pw0.x = cvt_pk_bf16(s[0], s[1]); pw0.y = cvt_pk_bf16(s[2], s[3]); pw0.z = cvt_pk_bf16(s[4], s[5]); pw0.w = cvt_pk_bf16(s[6], s[7]); \
        pw1.x = cvt_pk_bf16(s[8], s[9]); pw1.y = cvt_pk_bf16(s[10], s[11]); pw1.z = cvt_pk_bf16(s[12], s[13]); pw1.w = cvt_pk_bf16(s[14], s[15]); \
        const bf16x8 pa0 = __builtin_bit_cast(bf16x8, pw0), pa1 = __builtin_bit_cast(bf16x8, pw1); \
        LDS_WAIT(); \
        { const s16x4 a0 = vtr(vrd), a1 = vtr(vrd + 512), b0 = vtr(vrd + 1024), b1 = vtr(vrd + 1536); \
          const bf16x8 v0 = (bf16x8){a0[0], a0[1], a0[2], a0[3], a1[0], a1[1], a1[2], a1[3]}, v1 = (bf16x8){b0[0], b0[1], b0[2], b0[3], b1[0], b1[1], b1[2], b1[3]}; \
          o0 = __builtin_amdgcn_mfma_f32_32x32x16_bf16(v0, pa0, o0, 0, 0, 0); o0 = __builtin_amdgcn_mfma_f32_32x32x16_bf16(v1, pa1, o0, 0, 0, 0); } \
        { const s16x4 a0 = vtr(vrd + 2048), a1 = vtr(vrd + 2560), b0 = vtr(vrd + 3072), b1 = vtr(vrd + 3584); \
          const bf16x8 v0 = (bf16x8){a0[0], a0[1], a0[2], a0[3], a1[0], a1[1], a1[2], a1[3]}, v1 = (bf16x8){b0[0], b0[1], b0[2], b0[3], b1[0], b1[1], b1[2], b1[3]}; \
          o1 = __builtin_amdgcn_mfma_f32_32x32x16_bf16(v0, pa0, o1, 0, 0, 0); o1 = __builtin_amdgcn_mfma_f32_32x32x16_bf16(v1, pa1, o1, 0, 0, 0); } \
    } while (0)

#ifdef MK_ATT_TS
#define AT_TS(k) do { __builtin_amdgcn_sched_barrier(0); unsigned long long t_; asm volatile("s_memtime %0\n\ts_waitcnt lgkmcnt(0)" : "=s"(t_) :: "memory"); ts_acc[k] += t_ - ts_prev; ts_prev = t_; __builtin_amdgcn_sched_barrier(0); } while (0)
#else
#define AT_TS(k) do { } while (0)
#endif
template <int MODE>
__device__ __forceinline__ void attn_phase(const Frame& F, const Args& A, unsigned long long* ts_out = nullptr) {
#ifdef MK_ATT_TS
    unsigned long long ts_acc[6] = {0, 0, 0, 0, 0, 0}, ts_prev = 0;
    { unsigned long long t_; asm volatile("s_memtime %0\n\ts_waitcnt lgkmcnt(0)" : "=s"(t_) :: "memory"); ts_prev = t_; }
#endif
    LAS float* tab = (LAS float*)(F.lds + AT_TAB);
    const char* qkvb = (const char*)(F.ws + WS_QKV); bf16_t* mo = (bf16_t*)(F.ws + (MODE == 0 ? WS_S0 : WS_S1));
    float* sto = (float*)(F.ws + WS_AST_O); float* stm = (float*)(F.ws + WS_AST_M);
    int lane_ = F.lane; asm volatile("" : "+v"(lane_));
    const int lane = lane_, w = F.wave, j = lane & 31, hi = lane >> 5;
    LAS unsigned char* vbuf = F.lds + AT_V + w * 4096;
    LAS unsigned char* vwr = vbuf + ((lane & 7) >> 2) * 2048 + (lane >> 3) * 64 + (lane & 3) * 16;
    const LAS unsigned char* vrd = vbuf + (4 * hi + ((lane & 15) >> 2)) * 64 + ((lane >> 4) & 1) * 32 + (lane & 3) * 8;
    volatile LAS int* bkt = (volatile LAS int*)(F.lds + AT_BKT);
    volatile LAS int* acnt = (volatile LAS int*)(F.lds + AT_CNT);
    for (int i = F.tid; i < 3 * 129; i += NTHREADS) { const int g = i / 129, m = i - g * 129; bkt[i] = t5_bucket(m * (g == 0 ? 1 : (g == 1 ? 4 : 16))); }
    LDS_WAIT(); __syncthreads();
    const __amdgpu_buffer_rsrc_t rsrc = __builtin_amdgcn_make_buffer_rsrc((void*)(F.ws + WS_QKV), 0, (int)((size_t)T * PITCHB), 0x00020000);
    for (int it = 0; ; ++it) {
        int b, h, cp;
        { const int u = ((F.G & 7) == 0) ? ((F.bid & 7) * (F.G >> 3) + (F.bid >> 3)) + it * F.G : F.bid + it * F.G;
          if (u >= 256) break;
          b = u >> 5; h = (u >> 1) & 15; cp = u & 1; }
        const int tb = b * SEQ;
        __syncthreads();
        if (F.tid < 4) acnt[F.tid] = 0;
        for (int i = F.tid; i < 3 * 640; i += NTHREADS) { const int g = i / 640, m = 383 - (i - g * 640);
            tab[i] = (m >= 0 && m <= 128) ? A.in[I_RELB][bkt[g * 129 + m] * 48 + g * 16 + h] * L2E : -1e30f; }
        LDS_WAIT(); __syncthreads();
        AT_TS(5);
        const int c = 2 * cp + (w & 1);
        f32x16 o0, o1, s; float M, l;
        bf16x8 kfA[4], kfB[4]; u32x4 vrA[4], vrB[4];
#pragma unroll 1
        for (int rd = 0; rd < 4; ++rd) {
            const int r16 = c + 4 * (w >> 1), nt = rd + 1;
            const size_t tq = (size_t)(tb + 16 * (32 * rd + j) + r16);
            bf16x8 qf[4];
            { const char* qp = qkvb + tq * PITCHB + (2 * 1024 + h * 64 + 8 * hi) * 2;
#pragma unroll
              for (int d0 = 0; d0 < 4; ++d0) qf[d0] = *(const bf16x8*)(qp + 32 * d0); }
            const unsigned koff = (unsigned)(16 * j) * PITCHB + (3072 + 2 * 1024 + h * 64 + 8 * hi) * 2;
            unsigned voff[4];
#pragma unroll
            for (int i = 0; i < 4; ++i) voff[i] = (unsigned)(16 * (8 * i + (lane >> 3))) * PITCHB + (6144 + 2 * 1024 + h * 64 + 8 * (lane & 7)) * 2;
            const unsigned ub = (unsigned)(tb + r16) * PITCHB, ustep = (unsigned)(16 * 32) * PITCHB;
            const LAS float* tla = tab + 2 * 640 + 383 - (32 * rd + j) + 4 * hi;
#pragma unroll
            for (int r = 0; r < 16; ++r) { o0[r] = 0.f; o1[r] = 0.f; }
            M = -1e29f; l = 0.f;
#define AT_LOADA(m, KF, VR) do { int m_ = (m); m_ = m_ < nt ? m_ : nt - 1; if (MODE == 1) m_ = 0; AT_LOADS(KF, VR, ub + (unsigned)m_ * ustep, koff, voff); } while (0)
            AT_LOADA(0, kfA, vrA); AT_LOADA(1, kfB, vrB);
            AT_TS(0);
            int n = 0;
#pragma unroll 1
            for (; n + 1 < nt; n += 2) {
                AT_SCORE(kfA, vrA, qf, tla + 32 * n)
                AT_LOADA(n + 2, kfA, vrA);
                AT_SOFTPV();
                AT_SCORE(kfB, vrB, qf, tla + 32 * (n + 1))
                AT_LOADA(n + 3, kfB, vrB);
                AT_SOFTPV();
            }
            if (n < nt) { AT_SCORE(kfA, vrA, qf, tla + 32 * n) AT_SOFTPV(); }
            AT_TS(1);
#undef AT_LOADA
            float* so = sto + ((tq * 16 + h) * 2 + hi) * 32;
#pragma unroll
            for (int r = 0; r < 16; r += 4) { *(f32x4*)(so + r) = (f32x4){o0[r], o0[r + 1], o0[r + 2], o0[r + 3]}; *(f32x4*)(so + 16 + r) = (f32x4){o1[r], o1[r + 1], o1[r + 2], o1[r + 3]}; }
            *(f32x2*)(stm + ((tq * 16 + h) * 2 + hi) * 2) = (f32x2){M, l};
            VM_WAIT();
            if (lane == 0) __hip_atomic_fetch_add((LAS int*)&acnt[rd], 1, __ATOMIC_RELAXED, __HIP_MEMORY_SCOPE_WORKGROUP);
            AT_TS(2);
        }
        AT_TS(3);
#pragma unroll 1
        for (int rd = 0; rd < 4; ++rd) {
            const int i0 = 32 * (4 * rd + (w >> 1));
            const int ktlo0 = (4 - i0 / 8) > 0 ? (4 - i0 / 8) : 0, n0 = 8 - ktlo0;
            const int ktlo1 = (4 - i0 / 32) > 0 ? (4 - i0 / 32) : 0, n1 = 5 - ktlo1, ntl = n0 + n1;
            const size_t tq = (size_t)(tb + 4 * (i0 + j) + c);
            bf16x8 qf0[4], qf1[4];
            { const char* qp = qkvb + tq * PITCHB + (h * 64 + 8 * hi) * 2;
#pragma unroll
              for (int d0 = 0; d0 < 4; ++d0) { qf0[d0] = *(const bf16x8*)(qp + 32 * d0); qf1[d0] = *(const bf16x8*)(qp + 2048 + 32 * d0); } }
            while (__builtin_amdgcn_readfirstlane(acnt[rd]) < NWAVES) __builtin_amdgcn_s_sleep(2);
            asm volatile("" ::: "memory");
            { const float* so = sto + ((tq * 16 + h) * 2 + hi) * 32;
#pragma unroll
              for (int r = 0; r < 16; r += 4) { const f32x4 a = *(const f32x4*)(so + r), bq = *(const f32x4*)(so + 16 + r);
                  o0[r] = a[0]; o0[r + 1] = a[1]; o0[r + 2] = a[2]; o0[r + 3] = a[3]; o1[r] = bq[0]; o1[r + 1] = bq[1]; o1[r + 2] = bq[2]; o1[r + 3] = bq[3]; }
              const f32x2 ml = *(const f32x2*)(stm + ((tq * 16 + h) * 2 + hi) * 2); M = ml[0]; l = ml[1]; }
            const int kb0 = 4 * i0 - 128 + 32 * ktlo0, ik1 = i0 - 128 + 32 * ktlo1;
            const unsigned koff0 = (unsigned)j * PITCHB + (3072 + h * 64 + 8 * hi) * 2, koff1 = (unsigned)(4 * j) * PITCHB + (3072 + 1024 + h * 64 + 8 * hi) * 2;
            unsigned voff0[4], voff1[4];
#pragma unroll
            for (int i = 0; i < 4; ++i) { voff0[i] = (unsigned)(8 * i + (lane >> 3)) * PITCHB + (6144 + h * 64 + 8 * (lane & 7)) * 2;
                                          voff1[i] = (unsigned)(4 * (8 * i + (lane >> 3))) * PITCHB + (6144 + 1024 + h * 64 + 8 * (lane & 7)) * 2; }
            const unsigned ub0 = (unsigned)(tb + kb0) * PITCHB, ub1 = (unsigned)(tb + 4 * ik1 + c) * PITCHB;
            const unsigned us0 = 32u * PITCHB, us1 = 128u * PITCHB;
            const LAS float* tla0 = tab + 383 - (4 * (i0 + j) + c - kb0) + 4 * hi;
            const LAS float* tla1 = tab + 640 + 383 - (i0 + j - ik1) + 4 * hi;
#define AT_LOADN(m, KF, VR) do { int m_ = (m); m_ = m_ < ntl ? m_ : ntl - 1; if (m_ < n0) AT_LOADS(KF, VR, ub0 + (unsigned)(MODE == 1 ? 0 : m_) * us0, koff0, voff0); else AT_LOADS(KF, VR, ub1 + (unsigned)(MODE == 1 ? 0 : m_ - n0) * us1, koff1, voff1); } while (0)
#define AT_STEPN(n, KF, VR, PF) do { const int n_ = (n); if (n_ < n0) { AT_SCORE(KF, VR, qf0, tla0 + 32 * n_) } else { AT_SCORE(KF, VR, qf1, tla1 + 32 * (n_ - n0)) } \
            if (PF) AT_LOADN(n_ + 2, KF, VR); AT_SOFTPV(); } while (0)
            AT_LOADN(0, kfA, vrA); AT_LOADN(1, kfB, vrB);
            AT_TS(0);
            int n = 0;
#pragma unroll 1
            for (; n + 1 < ntl; n += 2) { AT_STEPN(n, kfA, vrA, true); AT_STEPN(n + 1, kfB, vrB, true); }
            if (n < ntl) AT_STEPN(n, kfA, vrA, false);
            AT_TS(4);
#undef AT_STEPN
#undef AT_LOADN
            { auto rr = __builtin_amdgcn_permlane32_swap(__float_as_uint(l), __float_as_uint(l), false, false); l = __uint_as_float(rr[0]) + __uint_as_float(rr[1]); }
            const float il = 1.0f / l;
            bf16_t* op = mo + tq * D + h * 64 + 4 * hi;
#pragma unroll
            for (int gq = 0; gq < 4; ++gq) {
                u32x2 w0, w1;
                w0.x = cvt_pk_bf16(o0[4 * gq] * il, o0[4 * gq + 1] * il); w0.y = cvt_pk_bf16(o0[4 * gq + 2] * il, o0[4 * gq + 3] * il);
                w1.x = cvt_pk_bf16(o1[4 * gq] * il, o1[4 * gq + 1] * il); w1.y = cvt_pk_bf16(o1[4 * gq + 2] * il, o1[4 * gq + 3] * il);
                *(u32x2*)(op + 8 * gq) = w0; *(u32x2*)(op + 32 + 8 * gq) = w1;
            }
            AT_TS(2);
        }
    }
#ifdef MK_ATT_TS
    if (ts_out && F.tid == 0) { for (int k = 0; k < 6; ++k) ts_out[k] = ts_acc[k]; }
#endif
    __syncthreads();
}
#undef AT_LOADS
#undef AT_SCORE
#undef AT_SOFTPV
constexpr int PH_MIX = 0, PH_FF1 = 1, PH_FF2 = 2, PH_QKV = 3, PH_ATT = 4, PH_WO = 5, PH_ROUTE = 6, PH_MOE0 = 7, PH_FINAL = 11, PH_END = 12;

__global__ void __launch_bounds__(NTHREADS, 2) mk_fwd(Args args) {
    extern __shared__ __attribute__((aligned(16))) unsigned char lds_raw[];
    Frame F;
    F.lds = (LAS unsigned char*)lds_raw;
    F.tid = threadIdx.x; F.lane = F.tid & 63; F.wave = __builtin_amdgcn_readfirstlane(F.tid >> 6); F.G = gridDim.x; F.bid = blockIdx.x;
    F.ws = args.ws; F.ctl = (unsigned*)(args.ws + WS_CTL); F.h = args.out;
    volatile LAS unsigned* MISC = (volatile LAS unsigned*)(F.lds + MISC_OFF);
    for (int u = F.tid; u < 64; u += NTHREADS) MISC[u] = 0u;
    __syncthreads();
    XcdBarrier bar = xcd_barrier_post(F.ctl + CW_BAR + args.li * XCD_BAR_WORDS, MISC + 8);
    const int lo = args.ph_lo, hi = args.ph_hi;
#ifndef MK_MASK
#define MK_MASK 0xffffffffu
#endif
#define IN(k) (((MK_MASK >> (k)) & 1u) && lo <= (k) && (k) < hi)
#define SEAM(k) do { if (IN(k) && IN((k) + 1)) xcd_barrier(bar); } while (0)
    unsigned char* ws = args.ws;
    LAS unsigned char* ring = F.lds + RING_OFF;
#ifdef MK_PROBE_LO
    unsigned long long pr_t0 = 0, pr_t1 = 0;
#define PROBE_AT(k) do { if ((k) == MK_PROBE_LO) pr_t0 = __builtin_amdgcn_s_memrealtime(); if ((k) == MK_PROBE_HI) pr_t1 = __builtin_amdgcn_s_memrealtime(); } while (0)
#else
#define PROBE_AT(k) do { } while (0)
#endif

    PROBE_AT(0);
    if (IN(PH_MIX)) { conv_aproj(F, args); conv_small(F, args); VM_WAIT(); __syncthreads(); }
    PROBE_AT(20);
    if (IN(PH_MIX)) { xcd_barrier(bar); PROBE_AT(21); mixer_phase(F, args); }
    PROBE_AT(22);
    SEAM(PH_MIX);

    PROBE_AT(1);
    if (IN(PH_FF1)) {
        pg8::Gemm g{(const bf16_t*)(ws + WS_S0), (const bf16_t*)(ws + WS_WGU0), D, D, D}; pg8::StaticOrder S; S.init(T, 2 * FF0, F.G, F.bid);
        EpiSwiGLU E{(bf16_t*)(ws + WS_ACT0), ACT0_LD, nullptr};
        pg8::gemm_phase<EpiSwiGLU, pg8::StaticOrder, false>(ring, g, S, E);
        { const int units = (T / 256) * (2 * FF0 / 256), rem = units % F.G;
          if (rem == 0) conv_later(F, args, F.bid, F.G); else if (F.bid >= rem) conv_later(F, args, F.bid - rem, F.G - rem); }
    }
    SEAM(PH_FF1);
    PROBE_AT(2);
    if (IN(PH_FF2)) {
        pg8::Gemm g{(const bf16_t*)(ws + WS_ACT0), (const bf16_t*)(ws + WS_WD0), FF0, ACT0_LD, FF0}; pg8::StaticOrder S; S.init(T, D, F.G, F.bid);
        EpiRes E{F.h, (bf16_t*)(ws + WS_S1), (float*)(ws + WS_SSQ)};
        pg8::gemm_phase<EpiRes, pg8::StaticOrder, false>(ring, g, S, E);
    }
    SEAM(PH_FF2);
    PROBE_AT(3);
    if (IN(PH_QKV)) {
        pg8::Gemm g{(const bf16_t*)(ws + WS_S1), (const bf16_t*)(ws + WS_WQKV), D, D, D}; pg8::StaticOrder S; S.init(T, NQKV, F.G, F.bid);
        EpiQKV E{(bf16_t*)(ws + WS_QKV), (const float*)(ws + WS_SSQ)};
        pg8::gemm_phase<EpiQKV, pg8::StaticOrder, false>(ring, g, S, E);
#if defined(MK_QKV_EXTRA) && MK_QKV_EXTRA == 1
        pg8::gemm_phase<EpiQKV, pg8::StaticOrder, false>(ring, g, S, E);
#elif defined(MK_QKV_EXTRA) && MK_QKV_EXTRA == 3
        { EpiQKV_T<false> EN{(bf16_t*)(ws + WS_QKV), (const float*)(ws + WS_SSQ)}; pg8::gemm_phase<EpiQKV_T<false>, pg8::StaticOrder, false>(ring, g, S, EN); }
#elif defined(MK_QKV_EXTRA) && MK_QKV_EXTRA == 2
        { EpiNull EN; pg8::gemm_phase<EpiNull, pg8::StaticOrder, false>(ring, g, S, EN); }
#endif
    }
    SEAM(PH_QKV);
        PROBE_AT(4);
#ifdef MK_ATT_TS
    unsigned long long att_ts[6] = {0, 0, 0, 0, 0, 0};
    if (IN(PH_ATT)) { attn_phase<0>(F, args, att_ts);
#else
    if (IN(PH_ATT)) { attn_phase<0>(F, args);
#endif
#ifdef MK_ATT_EXTRA
        attn_phase<MK_ATT_EXTRA>(F, args);
#endif
    }
    SEAM(PH_ATT);
    PROBE_AT(5);
    if (IN(PH_WO)) {
        pg8::Gemm g{(const bf16_t*)(ws + WS_S0), (const bf16_t*)(ws + WS_WO), D, D, D}; pg8::StaticOrder S; S.init(T, D, F.G, F.bid);
        EpiRes E{F.h, (bf16_t*)(ws + WS_S1), nullptr};
        pg8::gemm_phase<EpiRes, pg8::StaticOrder, false>(ring, g, S, E);
        conv_moe(F, args);
    }
    SEAM(PH_WO);
    PROBE_AT(6);
    if (IN(PH_ROUTE)) { router_phase(F, args); }
    SEAM(PH_ROUTE);
#pragma unroll 1
    for (int j = 0; j < 4; ++j) {
        PROBE_AT(7 + j);
        if (IN(PH_MOE0 + j)) {
            moe_info_build(F.lds, F.ctl);
            volatile LAS int* mi = (volatile LAS int*)(F.lds + SCR_OFF);
            const int ntiles = __builtin_amdgcn_readfirstlane(mi[MI_NT]);
            if (j >= 1) {
                const int c0 = (j - 1) * CH_TILES; int ntc = ntiles - c0; ntc = ntc < 0 ? 0 : (ntc > CH_TILES ? CH_TILES : ntc);
                const bool lastc = (c0 + CH_TILES >= ntiles);
                EpiY E{(bf16_t*)(ws + WS_Y), (bf16_t*)(ws + WS_Y2), c0 * 256};
                if (lastc) {
                    pg8::Gemm g{(const bf16_t*)(ws + WS_ACT1 + (size_t)((j - 1) & 1) * ACT1_CHUNK), (const bf16_t*)(ws + WS_WD1), FF1 / 2, FF1, FF1};
                    MoeOrder<8, false> S{{F.ctl + CW_Q + 64 * (2 * j), MISC + 16}, mi, c0, ntc, nullptr};
                    pg8::gemm_phase<EpiY, MoeOrder<8, false>, false>(ring, g, S, E);
                } else {
                    pg8::Gemm g{(const bf16_t*)(ws + WS_ACT1 + (size_t)((j - 1) & 1) * ACT1_CHUNK), (const bf16_t*)(ws + WS_WD1), FF1, FF1, FF1};
                    MoeOrder<4, false> S{{F.ctl + CW_Q + 64 * (2 * j), MISC + 16}, mi, c0, ntc, nullptr};
                    pg8::gemm_phase<EpiY, MoeOrder<4, false>, false>(ring, g, S, E);
                }
            }
            if (j <= 2) {
                const int c0 = j * CH_TILES; int ntc = ntiles - c0; ntc = ntc < 0 ? 0 : (ntc > CH_TILES ? CH_TILES : ntc);
                pg8::Gemm g{(const bf16_t*)(ws + WS_S1), (const bf16_t*)(ws + WS_WGU1), D, D, D};
                MoeOrder<28, true> S{{F.ctl + CW_Q + 64 * (2 * j + 1), MISC + 16}, mi, c0, ntc, (const int*)(ws + WS_LTOK)};
                EpiSwiGLU E{(bf16_t*)(ws + WS_ACT1 + (size_t)(j & 1) * ACT1_CHUNK), FF1, (const float*)(ws + WS_LRS)};
                pg8::gemm_phase<EpiSwiGLU, MoeOrder<28, true>, true>(ring, g, S, E);
            }
        }
        SEAM(PH_MOE0 + j);
    }
#ifdef MK_EXTRA_BARS
    for (int i = 0; i < MK_EXTRA_BARS; ++i) xcd_barrier(bar);
#endif
    PROBE_AT(11);
    if (IN(PH_FINAL)) { moe_info_build(F.lds, F.ctl); final_phase(F, args); }
    PROBE_AT(12);
#ifdef MK_ATT_TS
    if (F.bid == 0 && F.wave == 0) { const unsigned long long dt = att_ts[MK_ATT_TS] / 5ull, ts = __builtin_amdgcn_s_memrealtime(); while (__builtin_amdgcn_s_memrealtime() - ts < dt) __builtin_amdgcn_s_sleep(8); }
#endif
#ifdef MK_PROBE_LO
    { const unsigned long long dt = (pr_t1 - pr_t0) * MK_PROBE_MULT, ts = __builtin_amdgcn_s_memrealtime(); while (__builtin_amdgcn_s_memrealtime() - ts < dt) __builtin_amdgcn_s_sleep(8); }
#endif
#undef IN
#undef SEAM
}
}
extern "C" void kernel_launch(void* const* d_in, const int* in_sizes, int n_in, void* d_out, int out_size, void* d_ws, size_t ws_size, hipStream_t stream) {
    static int grid = 0;
    if (grid == 0) {
        if (n_in != 19 || out_size != mk::T * mk::D || ws_size < mk::WS_END) { fprintf(stderr, "kernel_launch: unexpected shapes / workspace (%d inputs, out %d, ws %zu)\n", n_in, out_size, ws_size); grid = -1; return; }
        int dev = 0, cus = 0;
        if (hipGetDevice(&dev) != hipSuccess || hipDeviceGetAttribute(&cus, hipDeviceAttributeMultiprocessorCount, dev) != hipSuccess) { grid = -1; return; }
        if (hipFuncSetAttribute((const void*)mk::mk_fwd, hipFuncAttributeMaxDynamicSharedMemorySize, mk::LDS_BYTES) != hipSuccess) { fprintf(stderr, "kernel_launch: hipFuncSetAttribute failed\n"); grid = -1; return; }
        int per_cu = 0;
        if (hipOccupancyMaxActiveBlocksPerMultiprocessor(&per_cu, (const void*)mk::mk_fwd, mk::NTHREADS, mk::LDS_BYTES) != hipSuccess || per_cu < 1) { fprintf(stderr, "kernel_launch: occupancy query says %d blocks per CU\n", per_cu); }
        (void)hipGetLastError();
        grid = cus;
    }
    if (grid < 0) return;
    (void)hipMemsetAsync((char*)d_ws + mk::WS_CTL, 0, mk::CTL_ZERO_BYTES, stream);
    mk::Args a{};
    for (int i = 0; i < 19; ++i) a.in[i] = (const float*)d_in[i];
    a.out = (float*)d_out; a.ws = (unsigned char*)d_ws;
    a.ph_lo = 0; a.ph_hi = mk::PH_END; a.li = 0;
    hipLaunchKernelGGL(mk::mk_fwd, dim3(grid), dim3(mk::NTHREADS), mk::LDS_BYTES, stream, a);
}
```

```cpp
#include <hip/hip_runtime.h>
#include <cstdio>
#include <cstdint>
namespace mk {
#define LAS __attribute__((address_space(3)))
#define GAS __attribute__((address_space(1)))
typedef unsigned short bf16_t;
typedef short bf16x8 __attribute__((ext_vector_type(8)));
typedef float f32x4 __attribute__((ext_vector_type(4)));
typedef float f32x2 __attribute__((ext_vector_type(2)));
typedef unsigned u32x4 __attribute__((ext_vector_type(4)));
typedef unsigned u32x2 __attribute__((ext_vector_type(2)));

constexpr int T = 16384, D = 1024, SEQ = 2048, NBATCH = 8;
constexpr int FF0 = 2816, FF1 = 3584, NE = 8, NQKV = 9216;
constexpr int ACT0_LD = FF0 + 64;
constexpr int QKV_LD = NQKV + 64;
constexpr float EPS = 1e-6f;
constexpr float WGU_PRESC = 32.f, WD_PRESC = 64.f, ACT_PRESC = 4.f;
constexpr int NWAVES = 8, NTHREADS = 512;

constexpr size_t MiB = 1u << 20;
constexpr size_t WS_CTL = 0, CTL_ZERO_BYTES = 1 * MiB;
constexpr size_t WS_SSQ = 1 * MiB;
constexpr size_t WS_LTOK = 2 * MiB;
constexpr size_t WS_LRS = 2 * MiB + 512 * 1024;
constexpr size_t WS_TOKINFO = 3 * MiB;
constexpr size_t WS_ZERO = 3 * MiB + 256 * 1024;
constexpr size_t WS_APT = 3 * MiB + 512 * 1024;
constexpr size_t WS_WGU0 = 4 * MiB;
constexpr size_t WS_WD0 = 15 * MiB;
constexpr size_t WS_WQKV = WS_WD0 + (size_t)D * FF0 * 2;
constexpr size_t WS_WO = WS_WQKV + (size_t)NQKV * D * 2;
constexpr size_t WS_S0 = 41 * MiB;
constexpr size_t WS_S1 = 73 * MiB;
constexpr size_t WS_POOL = 105 * MiB;
constexpr size_t WS_ACT0 = WS_POOL;
constexpr size_t WS_QKV = WS_POOL;
constexpr int CH_TILES = 46;
constexpr size_t ACT1_CHUNK = (size_t)CH_TILES * 256 * FF1 * 2;
constexpr size_t WS_ACT1 = WS_POOL;
constexpr size_t WS_Y = 4 * MiB;
constexpr size_t WS_Y2 = WS_S1;
constexpr size_t WS_WGU1 = 306 * MiB;
constexpr size_t WS_WD1 = 418 * MiB;
constexpr size_t WS_END = 474 * MiB;
static_assert(WS_WO + (size_t)D * D * 2 <= WS_S0, "small weights");
static_assert(WS_ACT1 + 2 * ACT1_CHUNK <= WS_WGU1 && WS_Y + (size_t)34816 * D * 2 <= WS_S1 && (size_t)CH_TILES * 256 * D * 2 <= 32 * MiB && 3 * CH_TILES >= 136, "moe map");
static_assert(WS_WGU1 + (size_t)NE * 7168 * D * 2 <= WS_WD1 && WS_WD1 + (size_t)NE * D * FF1 * 2 <= WS_END, "moe weights");
static_assert(WS_QKV + (size_t)T * QKV_LD * 2 <= WS_END, "qkv");

constexpr int CW_TMO = 0;
constexpr int CW_CNT = 64;
constexpr int CW_Q = 128;
constexpr int CW_BAR = 4096;

constexpr int RING_OFF = 0, RING_BYTES = 131072;
constexpr int MISC_OFF = RING_BYTES;
constexpr int RTAB_OFF = MISC_OFF + 1024;
constexpr int SCR_OFF = MISC_OFF + 2048;
constexpr int LDS_BYTES = 147456;

#define RLX_AGENT __ATOMIC_RELAXED, __HIP_MEMORY_SCOPE_AGENT
#define LDS_WAIT() asm volatile("s_waitcnt lgkmcnt(0)" ::: "memory")
#define VM_WAIT() asm volatile("s_waitcnt vmcnt(0)" ::: "memory")
__device__ __forceinline__ unsigned f2bf(float f) { unsigned u = __builtin_bit_cast(unsigned, f); return (u + 0x7fffu + ((u >> 16) & 1u)) >> 16; }
__device__ __forceinline__ unsigned pk2(float lo, float hi) { return f2bf(lo) | (f2bf(hi) << 16); }
__device__ __forceinline__ unsigned cvt_pk_bf16(float lo, float hi) { unsigned r; asm volatile("v_cvt_pk_bf16_f32 %0, %1, %2" : "=v"(r) : "v"(lo), "v"(hi)); return r; }
__device__ __forceinline__ float bf2f(unsigned short b) { return __builtin_bit_cast(float, ((unsigned)b) << 16); }
__device__ __forceinline__ float wave_sum(float v) {
#pragma unroll
    for (int o = 1; o < 64; o <<= 1) v += __shfl_xor(v, o);
    return v;
}
__device__ __forceinline__ float silu_f(float x) { return x * __builtin_amdgcn_rcpf(1.f + __builtin_amdgcn_exp2f(-1.4426950408889634f * x)); }
#define XB_TMO      128
#define XB_XCNT(j)  (256  + 64 * (j))
#define XB_XSUB(j)  (1280 + 64 * (j))
#define XB_XGEN(j)  (2304 + 64 * (j))
#define XB_TOP      3328
#define XB_TOPGEN   3392
#define XCD_BAR_WORDS 3456
#define XB_SPIN_CAP (1u << 18)
__device__ __forceinline__ unsigned xb_ld(unsigned* p)              { return __hip_atomic_load(p, __ATOMIC_RELAXED, __HIP_MEMORY_SCOPE_AGENT); }
__device__ __forceinline__ unsigned xb_add(unsigned* p, unsigned v) { return __hip_atomic_fetch_add(p, v, __ATOMIC_RELAXED, __HIP_MEMORY_SCOPE_AGENT); }
__device__ __forceinline__ unsigned xb_xcc_id() { return (unsigned)__builtin_amdgcn_s_getreg((3 << 11) | 20) & 0xFu; }
#define XB_SPIN(cond, bar) do { unsigned _sp = 0; while (cond) { __builtin_amdgcn_s_sleep(1); \
    if ((++_sp & 255u) == 0u) { if (xb_ld(&(bar)[XB_TMO])) break; if (_sp > XB_SPIN_CAP) { atomicAdd(&(bar)[XB_TMO], 1u); break; } } } } while (0)
struct XcdBarrier { unsigned* bar; unsigned x; volatile LAS unsigned* st; };
__device__ __forceinline__ XcdBarrier xcd_barrier_post(unsigned* bar, volatile LAS unsigned* st) {
    XcdBarrier b; b.bar = bar; b.x = xb_xcc_id(); b.st = st;
    if (threadIdx.x == 0) (void)xb_add(&bar[XB_XCNT(b.x)], 1u);
    return b;
}
__device__ __forceinline__ void xcd_barrier_complete(unsigned* bar, unsigned x, unsigned& nloc, unsigned& nx) {
    const unsigned G = gridDim.x * gridDim.y * gridDim.z;
    unsigned sum, cnt, mine, sp = 0u;
    for (;;) {
        sum = 0u; cnt = 0u; mine = 0u;
#pragma unroll
        for (unsigned j = 0; j < 16; ++j) { const unsigned c = xb_ld(&bar[XB_XCNT(j)]); sum += c; cnt += (c > 0u) ? 1u : 0u; mine = (j == x) ? c : mine; }
        if (sum == G) break;
        __builtin_amdgcn_s_sleep(1);
        if ((++sp & 255u) == 0u) { if (xb_ld(&bar[XB_TMO])) break; if (sp > XB_SPIN_CAP) { atomicAdd(&bar[XB_TMO], 1u); break; } }
    }
    nloc = mine > 0u ? mine : 1u; nx = cnt > 0u ? cnt : 1u;
}
__device__ __forceinline__ void xcd_barrier(const XcdBarrier& b) {
    asm volatile("s_waitcnt vmcnt(0)" ::: "memory");
    __syncthreads();
    if (threadIdx.x == 0) {
        unsigned* bar = b.bar;
        __builtin_amdgcn_s_waitcnt(0);
        unsigned nloc = b.st[0], nx = b.st[1];
        if (nloc == 0u) { xcd_barrier_complete(bar, b.x, nloc, nx); b.st[0] = nloc; b.st[1] = nx; }
        const unsigned old = xb_add(&bar[XB_XSUB(b.x)], 1u);
        const unsigned gen = old / nloc;
        if (old + 1u == (gen + 1u) * nloc) {
            __builtin_amdgcn_fence(__ATOMIC_RELEASE, "agent");
            asm volatile("s_waitcnt vmcnt(0)" ::: "memory");
            const unsigned og = xb_add(&bar[XB_TOP], 1u);
            const unsigned tg = og / nx;
            if (og + 1u == (tg + 1u) * nx) xb_add(&bar[XB_TOPGEN], 1u);
            else XB_SPIN(xb_ld(&bar[XB_TOPGEN]) == tg, bar);
            __builtin_amdgcn_fence(__ATOMIC_ACQUIRE, "agent");
            xb_add(&bar[XB_XGEN(b.x)], 1u);
            asm volatile("s_waitcnt vmcnt(0)" ::: "memory");
        } else {
            XB_SPIN(xb_ld(&bar[XB_XGEN(b.x)]) == gen, bar);
            __builtin_amdgcn_fence(__ATOMIC_ACQUIRE, "agent");
            asm volatile("s_waitcnt vmcnt(0)" ::: "memory");
        }
    }
    __syncthreads();
}
namespace pg8 {
typedef int v4i __attribute__((ext_vector_type(4)));
typedef int v8i __attribute__((ext_vector_type(8)));
constexpr int BM = 256, BK = 64, HALF = 128, HTB = HALF * BK * 2, STAGE_BYTES = 8 * HTB, NXCD = 8, WGM = 4;
__host__ __device__ __forceinline__ int lds_byte(int r, int c) { const int st = (r >> 4) * 2 + (c >> 5), rr = r & 15, cc = c & 31, ob = rr * 64 + cc * 2; return st * 1024 + (ob ^ (((ob >> 9) & 1) << 5)); }
__host__ __device__ __forceinline__ void stage_rc(int b, int& R, int& C) { const int st = b / 1024, sb = b % 1024, swz = sb ^ (((sb >> 9) & 1) << 5); R = (st >> 1) * 16 + swz / 64; C = (st & 1) * 32 + (swz % 64) / 2; }
__host__ __device__ __forceinline__ int perm32(int rho) { const int n = rho >> 4, i = rho & 15; return 8 * (i >> 2) + 4 * n + (i & 3); }

struct Unit { int pm, pn, arow, brow, e, orow, koff; };
struct Gemm { const bf16_t* A; const bf16_t* Bt; int K; int lda; int ldb; };

struct StaticOrder {
    int nM, nN, nwg, G, c;
    __device__ void init(int M, int N, int G_, int c_) { nM = M / BM; nN = N / BM; nwg = nM * nN; G = G_; c = c_; }
    __device__ __forceinline__ void start() const {}
    __device__ __forceinline__ bool next(int i, Unit& u) const {
        const long L = (long)i * G + c; if (L >= nwg) return false;
        int wgid = (int)L; { const int q = nwg / NXCD, r = nwg % NXCD, xcd = wgid % NXCD, off = wgid / NXCD; wgid = (xcd < r ? xcd * (q + 1) : r * (q + 1) + (xcd - r) * q) + off; }
        const int nig = WGM * nN, gid = wgid / nig, fm = gid * WGM, gsz = (nM - fm) < WGM ? (nM - fm) : WGM;
        u.pm = fm + ((wgid % nig) % gsz); u.pn = (wgid % nig) / gsz; u.arow = u.pm * BM; u.brow = u.pn * BM; u.e = 0; u.orow = u.arow; u.koff = 0; return true;
    }
    __device__ __forceinline__ unsigned refill_issue() const { return 0u; }
    __device__ __forceinline__ void refill_commit(int, unsigned) const {}
    __device__ __forceinline__ unsigned gather_row(const Unit&, int) const { return 0u; }
};

template <class Epi, class Sched, bool GATHER, bool FP8 = false>
__device__ __forceinline__ void gemm_phase(LAS unsigned char* lds, const Gemm g, Sched& S, const Epi& E) {
    int tid_ = threadIdx.x; asm volatile("" : "+v"(tid_));
    const int tid = tid_, wid = __builtin_amdgcn_readfirstlane(tid >> 6), lane = tid & 63, wr = wid >> 2, wc = wid & 3, fr = lane & 15, fq = lane >> 4;
    int K_ = g.K; asm volatile("" : "+s"(K_));
    const int K = K_, nt = K / BK, LDA = g.lda, LDB = g.ldb;
    unsigned voffB[2]; unsigned va[2][2];
    const size_t kstep = (size_t)(BK * 2);
    const size_t hstep = (size_t)HALF * LDB * 2, hstepA = (size_t)HALF * LDA * 2;
#pragma unroll
    for (int i = 0; i < 2; ++i) { int R, C; stage_rc(tid * 16 + i * 8192, R, C); const int Rb = Epi::PERM ? ((R & ~31) + perm32(R & 31)) : R;
        voffB[i] = (unsigned)(Rb * LDB + C) * 2u;
        va[0][i] = (unsigned)(R * LDA + C) * 2u; va[1][i] = va[0][i] + (unsigned)hstepA; }
    const unsigned ldsw = (unsigned)wid * 1024u;
    const int aoff0 = lds_byte(wr * 64 + fr, FP8 ? 16 * fq : 8 * fq), aoff1 = lds_byte(wr * 64 + fr, FP8 ? 16 * fq + 8 : 8 * fq + 32);
    const int boff0 = lds_byte(wc * 32 + fr, FP8 ? 16 * fq : 8 * fq), boff1 = lds_byte(wc * 32 + fr, FP8 ? 16 * fq + 8 : 8 * fq + 32);
#define PG8_SA(b, h) (((b) * 2 + (h)) * HTB)
#define PG8_SB(b, h) ((4 + (b) * 2 + (h)) * HTB)
#define PG8_STAGEB(bufoff, gbase) do { _Pragma("unroll") for (int _i = 0; _i < 2; ++_i) \
        __builtin_amdgcn_global_load_lds((const unsigned*)((const char*)(gbase) + voffB[_i]), (LAS unsigned*)(lds + (bufoff) + ldsw + _i * 8192), 16, 0, 0); } while (0)
#define PG8_STAGEA(bufoff, gbase, vo, h) do { _Pragma("unroll") for (int _i = 0; _i < 2; ++_i) \
        __builtin_amdgcn_global_load_lds((const unsigned*)((const char*)(gbase) + (vo)[h][_i]), (LAS unsigned*)(lds + (bufoff) + ldsw + _i * 8192), 16, 0, 0); } while (0)
#define PG8_CAT8(p0, p1) __builtin_shufflevector(__builtin_bit_cast(v4i, *(const LAS bf16x8*)(p0)), __builtin_bit_cast(v4i, *(const LAS bf16x8*)(p1)), 0, 1, 2, 3, 4, 5, 6, 7)
#define PG8_LDA(dst, b, h) do { _Pragma("unroll") for (int m = 0; m < 4; ++m) { \
        if constexpr (FP8) dst##8[m] = PG8_CAT8(lds + PG8_SA(b, h) + aoff0 + m * 2048, lds + PG8_SA(b, h) + aoff0 + m * 2048 + 16);   \
        else { dst[m][0] = *(const LAS bf16x8*)(lds + PG8_SA(b, h) + aoff0 + m * 2048); dst[m][1] = *(const LAS bf16x8*)(lds + PG8_SA(b, h) + aoff1 + m * 2048); } } } while (0)
#define PG8_LDB(dst, b, h) do { _Pragma("unroll") for (int n = 0; n < 2; ++n) { \
        if constexpr (FP8) dst##8[n] = PG8_CAT8(lds + PG8_SB(b, h) + boff0 + n * 2048, lds + PG8_SB(b, h) + boff0 + n * 2048 + 16); \
        else { dst[n][0] = *(const LAS bf16x8*)(lds + PG8_SB(b, h) + boff0 + n * 2048); dst[n][1] = *(const LAS bf16x8*)(lds + PG8_SB(b, h) + boff1 + n * 2048); } } } while (0)
#define PG8_MMA(ai, bj, At, Bt) do { __builtin_amdgcn_s_setprio(1); _Pragma("unroll") for (int m = 0; m < 4; ++m) _Pragma("unroll") for (int n = 0; n < 2; ++n) { \
        if constexpr (FP8) asm volatile("v_mfma_scale_f32_16x16x128_f8f6f4 %0, %1, %2, %0, %3, %3 op_sel_hi:[0,0,0]" : "+v"(acc[ai][bj][m][n]) : "v"(Bt##8[n]), "v"(At##8[m]), "v"(sc8));   \
        else { _Pragma("unroll") for (int k = 0; k < 2; ++k) acc[ai][bj][m][n] = __builtin_amdgcn_mfma_f32_16x16x32_bf16(Bt[n][k], At[m][k], acc[ai][bj][m][n], 0, 0, 0); } } \
        __builtin_amdgcn_s_setprio(0); } while (0)
#define PG8_WAIT_V(n) asm volatile("s_waitcnt vmcnt(" #n ")" ::: "memory")
#define PG8_WAIT_L(n) asm volatile("s_waitcnt lgkmcnt(" #n ")" ::: "memory")
#define PG8_BAR __builtin_amdgcn_s_barrier()
#define PG8_SCHED __builtin_amdgcn_sched_barrier(0)
    int sc8 = 0x7f7f7f7f; asm volatile("" : "+v"(sc8));
    Unit cur, nxt; int ui = 0;
    typename Epi::Pre pre{};
#ifdef MK_STAGGER
    { const unsigned long long dt = (unsigned long long)((blockIdx.x >> 3) & 7) * MK_STAGGER, ts = __builtin_amdgcn_s_memrealtime(); while (__builtin_amdgcn_s_memrealtime() - ts < dt) __builtin_amdgcn_s_sleep(4); }
#endif
    S.start();
    if (!S.next(0, cur)) return;
    f32x4 acc[2][2][4][2];
#pragma unroll
    for (int a = 0; a < 2; ++a)
#pragma unroll
        for (int b = 0; b < 2; ++b)
#pragma unroll
            for (int m = 0; m < 4; ++m)
#pragma unroll
                for (int n = 0; n < 2; ++n) acc[a][b][m][n] = (f32x4){0.f, 0.f, 0.f, 0.f};
    bf16x8 At[4][2], B0[2][2], B1[2][2]; v8i At8[4], B08[2], B18[2];
    const char* cA; const char* cB = (const char*)g.Bt + ((size_t)cur.brow * LDB + cur.koff) * 2;
    if constexpr (GATHER) { cA = (const char*)g.A;
#pragma unroll
        for (int h = 0; h < 2; ++h)
#pragma unroll
            for (int i = 0; i < 2; ++i) { int R, C; stage_rc(tid * 16 + i * 8192, R, C); va[h][i] = (S.gather_row(cur, h * HALF + R) * (unsigned)LDA + (unsigned)C) * 2u; }
    } else cA = (const char*)g.A + ((size_t)cur.arow * LDA + cur.koff) * 2;
    PG8_STAGEB(PG8_SB(0, 0), cB); PG8_STAGEB(PG8_SB(0, 1), cB + hstep); PG8_STAGEA(PG8_SA(0, 0), cA, va, 0); PG8_STAGEA(PG8_SA(0, 1), cA, va, 1);
    if (wr == 1) PG8_BAR;
    PG8_WAIT_V(2); PG8_BAR;
    PG8_STAGEB(PG8_SB(1, 0), cB + kstep); PG8_STAGEA(PG8_SA(1, 0), cA + kstep, va, 0); PG8_STAGEB(PG8_SB(1, 1), cB + hstep + kstep);
    PG8_WAIT_V(6); PG8_BAR;
    for (;;) {
        bool has_next = false; const char* nA = cA; const char* nB = cB;
        unsigned vnx[2][2] = {{0u, 0u}, {0u, 0u}};
#pragma unroll 1
        for (int t = 0; t < nt; t += 2) {
            const bool last = (t == nt - 2);
            unsigned v2[2][2];
#pragma unroll
            for (int h = 0; h < 2; ++h)
#pragma unroll
                for (int i = 0; i < 2; ++i) v2[h][i] = va[h][i];
            if (last) {
                pre = E.pre(cur, wr, fr);
                has_next = S.next(ui + 1, nxt);
                if (has_next) { nB = (const char*)g.Bt + ((size_t)nxt.brow * LDB + nxt.koff) * 2;
                    if constexpr (GATHER) {
#pragma unroll
                        for (int h = 0; h < 2; ++h)
#pragma unroll
                            for (int i = 0; i < 2; ++i) { int R, C; stage_rc(tid * 16 + i * 8192, R, C); v2[h][i] = (S.gather_row(nxt, h * HALF + R) * (unsigned)LDA + (unsigned)C) * 2u; }
                    } else nA = (const char*)g.A + ((size_t)nxt.arow * LDA + nxt.koff) * 2;
                }
            }
            if constexpr (GATHER) { if (last) {
#pragma unroll
                for (int h = 0; h < 2; ++h)
#pragma unroll
                    for (int i = 0; i < 2; ++i) vnx[h][i] = v2[h][i]; } }
            const char* a1 = cA + (size_t)(t + 1) * kstep;
            const char* a2 = last ? nA : cA + (size_t)(t + 2) * kstep; const char* b2 = last ? nB : cB + (size_t)(t + 2) * kstep;
            const char* a3 = a2 + kstep; const char* b3 = b2 + kstep;
            PG8_LDB(B0, 0, 0); PG8_LDB(B1, 0, 1); PG8_SCHED; PG8_LDA(At, 0, 0); PG8_STAGEA(PG8_SA(1, 1), a1, va, 1);
            PG8_WAIT_V(8); PG8_WAIT_L(0); PG8_BAR; PG8_MMA(0, 0, At, B0); PG8_MMA(0, 1, At, B1); PG8_BAR; PG8_SCHED;
            PG8_LDA(At, 0, 1); PG8_STAGEB(PG8_SB(0, 0), b2); PG8_STAGEB(PG8_SB(0, 1), b2 + hstep); PG8_STAGEA(PG8_SA(0, 0), a2, v2, 0);
            PG8_WAIT_V(8); PG8_WAIT_L(0); PG8_BAR; PG8_MMA(1, 0, At, B0); PG8_MMA(1, 1, At, B1); PG8_BAR; PG8_SCHED;
            PG8_LDB(B0, 1, 0); PG8_LDB(B1, 1, 1); PG8_SCHED; PG8_LDA(At, 1, 0); PG8_STAGEA(PG8_SA(0, 1), a2, v2, 1);
            PG8_WAIT_V(8); PG8_WAIT_L(0); PG8_BAR; PG8_MMA(0, 0, At, B0); PG8_MMA(0, 1, At, B1); PG8_BAR; PG8_SCHED;
            PG8_LDA(At, 1, 1); PG8_STAGEB(PG8_SB(1, 0), b3); PG8_STAGEB(PG8_SB(1, 1), b3 + hstep); PG8_STAGEA(PG8_SA(1, 0), a3, v2, 0);
            PG8_WAIT_V(8); PG8_WAIT_L(0); PG8_BAR; PG8_MMA(1, 0, At, B0); PG8_MMA(1, 1, At, B1); PG8_BAR; PG8_SCHED;
        }
        if constexpr (FP8) asm volatile("s_nop 15\n\ts_nop 15\n\ts_nop 15\n\ts_nop 15" ::: "memory");
        if (wr == 0) PG8_BAR;
        const unsigned rf = S.refill_issue();
        E(acc, cur, wr, wc, fr, fq, lds, pre);
        S.refill_commit(ui, rf);
        if (!has_next) break;
#pragma unroll
        for (int a = 0; a < 2; ++a)
#pragma unroll
            for (int b = 0; b < 2; ++b)
#pragma unroll
                for (int m = 0; m < 4; ++m)
#pragma unroll
                    for (int n = 0; n < 2; ++n) acc[a][b][m][n] = (f32x4){0.f, 0.f, 0.f, 0.f};
        cur = nxt; cA = nA; cB = nB; ++ui;
        if constexpr (GATHER) {
#pragma unroll
            for (int h = 0; h < 2; ++h)
#pragma unroll
                for (int i = 0; i < 2; ++i) va[h][i] = vnx[h][i];
        }
        if (wr == 1) PG8_BAR;
    }
    PG8_WAIT_V(0);
    PG8_BAR;
#undef PG8_SA
#undef PG8_SB
#undef PG8_STAGEA
#undef PG8_STAGEB
#undef PG8_LDA
#undef PG8_LDB
#undef PG8_MMA
#undef PG8_WAIT_V
#undef PG8_WAIT_L
#undef PG8_BAR
#undef PG8_SCHED
}
}
struct PreNone { };
struct Pre8 { float v[8]; };
__device__ __forceinline__ unsigned pk4_fp8(float a, float b, float c, float d) { int w = __builtin_amdgcn_cvt_pk_fp8_f32(a, b, 0, false); w = __builtin_amdgcn_cvt_pk_fp8_f32(c, d, w, true); return (unsigned)w; }
template <bool F8>
struct EpiSwiGLU_T {
    static constexpr bool PERM = true;
    bf16_t* O; int ldo; const float* lrs; float wsc, osc;
    typedef PreNone Pre;
    __device__ __forceinline__ Pre pre(const pg8::Unit&, int, int) const { return Pre{}; }
    __device__ __forceinline__ void operator()(const f32x4 (&acc)[2][2][4][2], const pg8::Unit& u, int wr, int wc, int fr, int fq, LAS unsigned char*, const Pre&) const {
        struct { float v[8]; } pr;
#pragma unroll
        for (int i = 0; i < 8; ++i) pr.v[i] = lrs ? lrs[(size_t)u.e * T + u.arow + (i >> 2) * 128 + (i & 3) * 16 + wr * 64 + fr] : 1.f;
        const int r0 = wr * 64 + fr, col0 = u.pn * 128 + wc * 32 + 8 * fq;
#pragma unroll
        for (int ai = 0; ai < 2; ++ai) {
#pragma unroll
            for (int m = 0; m < 4; ++m) {
                const float s = pr.v[ai * 4 + m] * wsc; float o[8];
#pragma unroll
                for (int n = 0; n < 2; ++n)
#pragma unroll
                    for (int j = 0; j < 4; ++j) { const float gv = acc[ai][0][m][n][j] * s, uv = acc[ai][1][m][n][j] * s; o[n * 4 + j] = silu_f(gv) * uv; }
                if constexpr (F8) { u32x2 w; w.x = pk4_fp8(o[0] * osc, o[1] * osc, o[2] * osc, o[3] * osc); w.y = pk4_fp8(o[4] * osc, o[5] * osc, o[6] * osc, o[7] * osc);
                    *(u32x2*)((unsigned char*)O + (size_t)(u.orow + ai * 128 + m * 16 + r0) * ldo + col0) = w; }
                else { u32x4 w; w.x = cvt_pk_bf16(o[0], o[1]); w.y = cvt_pk_bf16(o[2], o[3]); w.z = cvt_pk_bf16(o[4], o[5]); w.w = cvt_pk_bf16(o[6], o[7]);
                    *(u32x4*)(O + (size_t)(u.orow + ai * 128 + m * 16 + r0) * ldo + col0) = w; }
            }
        }
    }
};
typedef EpiSwiGLU_T<false> EpiSwiGLU;
struct EpiRes {
    static constexpr bool PERM = false;
    float* H; bf16_t* HB; float* ssq; unsigned char* HB8;
    typedef PreNone Pre;
    __device__ __forceinline__ Pre pre(const pg8::Unit&, int, int) const { return Pre{}; }
    __device__ __forceinline__ void operator()(const f32x4 (&acc)[2][2][4][2], const pg8::Unit& u, int wr, int wc, int fr, int fq, LAS unsigned char*, const Pre&) const {
        const int r0 = u.orow + wr * 64 + fr, col0 = u.pn * 256 + wc * 32 + 4 * fq;
#pragma unroll
        for (int ai = 0; ai < 2; ++ai)
#pragma unroll
            for (int m = 0; m < 4; ++m) {
                const size_t off = (size_t)(r0 + ai * 128 + m * 16) * D + col0; float sq = 0.f;
#pragma unroll
                for (int bj = 0; bj < 2; ++bj)
#pragma unroll
                    for (int n = 0; n < 2; ++n) {
                        const f32x4 hv = *(const f32x4*)(H + off + bj * 128 + n * 16) + acc[ai][bj][m][n];
                        *(f32x4*)(H + off + bj * 128 + n * 16) = hv;
                        if (HB8) *(unsigned*)(HB8 + off + bj * 128 + n * 16) = pk4_fp8(hv[0], hv[1], hv[2], hv[3]);
                        else { u32x2 w; w.x = cvt_pk_bf16(hv[0], hv[1]); w.y = cvt_pk_bf16(hv[2], hv[3]); *(u32x2*)(HB + off + bj * 128 + n * 16) = w; }
                        sq += (hv[0] * hv[0] + hv[1] * hv[1]) + (hv[2] * hv[2] + hv[3] * hv[3]);
                    }
                if (ssq) { sq += __shfl_xor(sq, 16); sq += __shfl_xor(sq, 32);
                    if (fq == 0) ssq[(size_t)(r0 + ai * 128 + m * 16) * 16 + u.pn * 4 + wc] = sq; }
            }
    }
};
template <bool STORE>
struct EpiQKV_T {
    static constexpr bool PERM = true;
    bf16_t* O; const float* ssq;
    typedef Pre8 Pre;
    __device__ __forceinline__ Pre pre(const pg8::Unit& u, int, int) const { Pre p; const int tid = threadIdx.x, row = tid >> 1, part = tid & 1;
        const f32x4* q = (const f32x4*)(ssq + (size_t)(u.orow + row) * 16 + part * 8); const f32x4 a = q[0], b = q[1];
        p.v[0] = a[0]; p.v[1] = a[1]; p.v[2] = a[2]; p.v[3] = a[3]; p.v[4] = b[0]; p.v[5] = b[1]; p.v[6] = b[2]; p.v[7] = b[3]; return p; }
    __device__ __forceinline__ void operator()(const f32x4 (&acc)[2][2][4][2], const pg8::Unit& u, int wr, int wc, int fr, int fq, LAS unsigned char* lds, const Pre& pr) const {
        LAS float* rtab = (LAS float*)(lds + RTAB_OFF);
        { const int tid = threadIdx.x, row = tid >> 1, part = tid & 1;
          float s = ((pr.v[0] + pr.v[1]) + (pr.v[2] + pr.v[3])) + ((pr.v[4] + pr.v[5]) + (pr.v[6] + pr.v[7]));
          s += __shfl_xor(s, 1);
          if (part == 0) rtab[row] = 1.0f / sqrtf(s * (1.f / D) + EPS); }
        asm volatile("s_waitcnt lgkmcnt(0)" ::: "memory"); __builtin_amdgcn_s_barrier(); asm volatile("" ::: "memory");
        const float qs = (u.pn * 256 < 3072) ? 0.125f * 1.4426950408889634f : 1.f;
        const int r0 = wr * 64 + fr, col0 = u.pn * 256 + wc * 32 + 8 * fq;
#pragma unroll
        for (int ai = 0; ai < 2; ++ai)
#pragma unroll
            for (int m = 0; m < 4; ++m) {
                const float s = rtab[ai * 128 + m * 16 + r0] * qs;
#pragma unroll
                for (int bj = 0; bj < 2; ++bj) {
                    const f32x4 v0 = acc[ai][bj][m][0] * s, v1 = acc[ai][bj][m][1] * s;
                    u32x4 w; w.x = cvt_pk_bf16(v0[0], v0[1]); w.y = cvt_pk_bf16(v0[2], v0[3]); w.z = cvt_pk_bf16(v1[0], v1[1]); w.w = cvt_pk_bf16(v1[2], v1[3]);
                    if (STORE) *(u32x4*)(O + (size_t)(u.orow + ai * 128 + m * 16 + r0) * QKV_LD + col0 + bj * 128) = w; else asm volatile("" :: "v"(w));
                }
            }
    }
};
typedef EpiQKV_T<true> EpiQKV;
struct EpiNull {
    static constexpr bool PERM = true;
    typedef PreNone Pre;
    __device__ __forceinline__ Pre pre(const pg8::Unit&, int, int) const { return Pre{}; }
    __device__ __forceinline__ void operator()(const f32x4 (&acc)[2][2][4][2], const pg8::Unit& u, int wr, int wc, int fr, int fq, LAS unsigned char*, const Pre&) const {
#pragma unroll
        for (int ai = 0; ai < 2; ++ai)
#pragma unroll
            for (int bj = 0; bj < 2; ++bj)
#pragma unroll
                for (int m = 0; m < 4; ++m)
#pragma unroll
                    for (int n = 0; n < 2; ++n) asm volatile("" :: "v"(acc[ai][bj][m][n]));
    }
};
struct EpiY {
    static constexpr bool PERM = true;
    bf16_t* Y; bf16_t* Y2; int c0rows; float ysc;
    typedef PreNone Pre;
    __device__ __forceinline__ Pre pre(const pg8::Unit&, int, int) const { return Pre{}; }
    __device__ __forceinline__ void operator()(const f32x4 (&acc)[2][2][4][2], const pg8::Unit& u, int wr, int wc, int fr, int fq, LAS unsigned char*, const Pre&) const {
        bf16_t* Yb = u.koff ? Y2 : Y;
        const int r0 = (u.koff ? u.orow - c0rows : u.orow) + wr * 64 + fr, col0 = u.pn * 256 + wc * 32 + 8 * fq;
#pragma unroll
        for (int ai = 0; ai < 2; ++ai)
#pragma unroll
            for (int m = 0; m < 4; ++m)
#pragma unroll
                for (int bj = 0; bj < 2; ++bj) {
                    const f32x4 v0 = acc[ai][bj][m][0] * ysc, v1 = acc[ai][bj][m][1] * ysc;
                    u32x4 w; w.x = cvt_pk_bf16(v0[0], v0[1]); w.y = cvt_pk_bf16(v0[2], v0[3]); w.z = cvt_pk_bf16(v1[0], v1[1]); w.w = cvt_pk_bf16(v1[2], v1[3]);
                    *(u32x4*)(Yb + (size_t)(r0 + ai * 128 + m * 16) * D + col0 + bj * 128) = w;
                }
    }
};

constexpr int MI_CNT = 0, MI_TB = 8, MI_NT = 17, MI_SPLIT0 = 18;
__device__ __forceinline__ void moe_info_build(LAS unsigned char* lds, const unsigned* ctl) {
    volatile LAS int* mi = (volatile LAS int*)(lds + SCR_OFF);
    if (threadIdx.x == 0) { int tb = 0;
        for (int e = 0; e < NE; ++e) { const int c = (int)__hip_atomic_load(ctl + CW_CNT + e, RLX_AGENT); mi[MI_CNT + e] = c; mi[MI_TB + e] = tb; tb += (c + 255) >> 8; }
        mi[MI_TB + NE] = tb; mi[MI_NT] = tb; mi[MI_SPLIT0] = ((tb - 1) / CH_TILES) * CH_TILES * 256; }
    LDS_WAIT(); __syncthreads();
}
struct DynQ {
    unsigned* ctr; volatile LAS unsigned* slot;
    __device__ __forceinline__ void start() const { if (threadIdx.x == 0) { slot[0] = blockIdx.x; slot[1] = gridDim.x + atomicAdd(ctr, 1u); } LDS_WAIT(); __syncthreads(); }
#ifdef MK_STATICQ
    __device__ __forceinline__ int fetch(int i) const { return i * (int)gridDim.x + (int)blockIdx.x; }
#else
    __device__ __forceinline__ int fetch(int i) const { return __builtin_amdgcn_readfirstlane((int)slot[i & 3]); }
#endif
    __device__ __forceinline__ unsigned refill_issue() const { unsigned v = 0u; if (threadIdx.x == 0) v = gridDim.x + atomicAdd(ctr, 1u); return v; }
    __device__ __forceinline__ void refill_commit(int ui, unsigned v) const { if (threadIdx.x == 0) slot[(ui + 2) & 3] = v; }
};
template <int NN, bool G1>
struct MoeOrder {
    DynQ q; volatile LAS int* mi; int c0, ntc; const int* ltok;
    __device__ __forceinline__ void start() const { q.start(); }
    __device__ __forceinline__ unsigned refill_issue() const { return q.refill_issue(); }
    __device__ __forceinline__ void refill_commit(int ui, unsigned v) const { q.refill_commit(ui, v); }
    __device__ __forceinline__ bool next(int i, pg8::Unit& u) const {
        const int idx = q.fetch(i); if (idx >= ntc * NN) return false;
        const int grp = idx / (8 * NN), r = idx - grp * (8 * NN), gsz = (ntc - grp * 8) < 8 ? (ntc - grp * 8) : 8;
        const int pml = grp * 8 + r % gsz, pn = r / gsz, pmg = c0 + pml;
        int e = 0;
#pragma unroll
        for (int k = 1; k < NE; ++k) e += (pmg >= mi[MI_TB + k]) ? 1 : 0;
        e = __builtin_amdgcn_readfirstlane(e);
        u.pm = pmg; u.pn = pn; u.e = e; u.koff = 0;
        if (!G1 && NN == 8) { u.pn = pn & 3; u.koff = (pn >> 2) * (FF1 / 4); }
        const int pnb = u.pn;
        if (G1) { u.arow = (pmg - __builtin_amdgcn_readfirstlane(mi[MI_TB + e])) * 256; u.brow = e * (2 * FF1) + pn * 256; u.orow = pml * 256; }
        else { u.arow = pml * 256; u.brow = e * D + pnb * 256; u.orow = pmg * 256; }
        return true;
    }
    __device__ __forceinline__ unsigned gather_row(const pg8::Unit& u, int r) const {
        const int lr = u.arow + r; const int c = mi[MI_CNT + u.e];
        return lr < c ? (unsigned)ltok[(size_t)u.e * T + lr] : 0u;
    }
};
struct Args { const float* in[19]; float* out; unsigned char* ws; int ph_lo, ph_hi, li, pad; };
enum { I_X = 0, I_ANORM, I_APROJ, I_ASCALE, I_KVNORM, I_WKV, I_BNORM, I_WQ, I_WO, I_RELB, I_FFNORM, I_DWG, I_DWU, I_DWD, I_ROUTER, I_MWG, I_MWU, I_MWD, I_FNORM };
struct Frame {
    LAS unsigned char* lds; unsigned* ctl; int tid, lane, wave, G, bid;
    float* h; unsigned char* ws;
};
__device__ __forceinline__ void conv_item(const float* W, int ldw, const float* gain, bf16_t* WT, int K, int dst_row0, LAS float* scr, int k0, int n0, int lane) {
    float wv[32];
#pragma unroll
    for (int i = 0; i < 32; ++i) wv[i] = W[(size_t)(k0 + 2 * i + (lane >> 5)) * ldw + n0 + (lane & 31)];
    if (gain) {
#pragma unroll
        for (int i = 0; i < 32; ++i) wv[i] *= gain[k0 + 2 * i + (lane >> 5)];
    }
#pragma unroll
    for (int i = 0; i < 32; ++i) scr[(2 * i + (lane >> 5)) * 33 + (lane & 31)] = wv[i];
    LDS_WAIT(); asm volatile("" ::: "memory");
    const int c = lane & 7;
#pragma unroll
    for (int j = 0; j < 4; ++j) { const int n = (lane >> 3) + 8 * j; const LAS float* s = scr + (8 * c) * 33 + n;
        u32x4 o; o.x = pk2(s[0 * 33], s[1 * 33]); o.y = pk2(s[2 * 33], s[3 * 33]); o.z = pk2(s[4 * 33], s[5 * 33]); o.w = pk2(s[6 * 33], s[7 * 33]);
        *(u32x4*)(WT + (size_t)(dst_row0 + n) * K + k0 + 8 * c) = o; }
    LDS_WAIT(); asm volatile("" ::: "memory");
}
__device__ __forceinline__ void conv_job(const Frame& F, int& it0, const float* W, int K, int N, int ldw, const float* gain, bf16_t* WT, int mode, int row_off, LAS float* scr, int cg = 0) {
    const int nblk = N / 32, items = (K / 64) * nblk, NGW = (cg ? cg : F.G) * NWAVES;
    int it = it0;
    for (; it < items; it += NGW) {
        const int kb = it / nblk, nb = it - kb * nblk, n0 = nb * 32;
        const int dr = (mode == 0) ? (row_off + n0) : (row_off + (n0 >> 7) * 256 + (n0 & 127) + (mode == 2 ? 128 : 0));
        conv_item(W, ldw, gain, WT, K, dr, scr, kb * 64, n0, F.lane);
    }
    it0 = it - items;
}
__device__ __forceinline__ void conv_item8(const float* W, int ldw, const float* gain, float presc, unsigned char* WT8, int K, int dst_row0, LAS float* scr, int k0, int n0, int lane) {
    float wv[32];
#pragma unroll
    for (int i = 0; i < 32; ++i) wv[i] = W[(size_t)(k0 + 2 * i + (lane >> 5)) * ldw + n0 + (lane & 31)];
#pragma unroll
    for (int i = 0; i < 32; ++i) wv[i] *= gain ? gain[k0 + 2 * i + (lane >> 5)] * presc : presc;
#pragma unroll
    for (int i = 0; i < 32; ++i) scr[(2 * i + (lane >> 5)) * 33 + (lane & 31)] = wv[i];
    LDS_WAIT(); asm volatile("" ::: "memory");
    const int c = lane & 7;
#pragma unroll
    for (int j = 0; j < 4; ++j) { const int n = (lane >> 3) + 8 * j; const LAS float* s = scr + (8 * c) * 33 + n;
        u32x2 o; o.x = pk4_fp8(s[0 * 33], s[1 * 33], s[2 * 33], s[3 * 33]); o.y = pk4_fp8(s[4 * 33], s[5 * 33], s[6 * 33], s[7 * 33]);
        *(u32x2*)(WT8 + (size_t)(dst_row0 + n) * K + k0 + 8 * c) = o; }
    LDS_WAIT(); asm volatile("" ::: "memory");
}
__device__ __forceinline__ void conv_job8(const Frame& F, int& it0, const float* W, int K, int N, int ldw, const float* gain, float presc, unsigned char* WT8, int mode, int row_off, LAS float* scr) {
    const int nblk = N / 32, items = (K / 64) * nblk, NGW = F.G * NWAVES;
    int it = it0;
    for (; it < items; it += NGW) {
        const int kb = it / nblk, nb = it - kb * nblk, n0 = nb * 32;
        const int dr = (mode == 0) ? (row_off + n0) : (row_off + (n0 >> 7) * 256 + (n0 & 127) + (mode == 2 ? 128 : 0));
        conv_item8(W, ldw, gain, presc, WT8, K, dr, scr, kb * 64, n0, F.lane);
    }
    it0 = it - items;
}
__device__ __forceinline__ void conv_aproj(const Frame& F, const Args& A) {
    LAS float* scr = (LAS float*)(F.lds + RING_OFF + F.wave * 16384);
    int it = F.bid * NWAVES + F.wave;
    for (int g = 0; g < 4; ++g) conv_job(F, it, A.in[I_APROJ] + (size_t)g * 65536, 256, 256, 256, nullptr, (bf16_t*)(F.ws + WS_APT) + (size_t)g * 65536, 0, 0, scr);
}
__device__ __forceinline__ void conv_small(const Frame& F, const Args& A) {
    LAS float* scr = (LAS float*)(F.lds + RING_OFF + F.wave * 16384);
    int it = F.bid * NWAVES + F.wave;
    unsigned char* ws = F.ws;
    conv_job(F, it, A.in[I_DWG], D, FF0, FF0, nullptr, (bf16_t*)(ws + WS_WGU0), 1, 0, scr);
    conv_job(F, it, A.in[I_DWU], D, FF0, FF0, nullptr, (bf16_t*)(ws + WS_WGU0), 2, 0, scr);
}
__device__ __forceinline__ void conv_later(const Frame& F, const Args& A, int cb, int cg) {
    LAS float* scr = (LAS float*)(F.lds + RING_OFF + F.wave * 16384);
    int it = cb * NWAVES + F.wave;
    unsigned char* ws = F.ws;
    conv_job(F, it, A.in[I_DWD], FF0, D, D, nullptr, (bf16_t*)(ws + WS_WD0), 0, 0, scr, cg);
    conv_job(F, it, A.in[I_WQ], D, 3072, 3072, A.in[I_BNORM], (bf16_t*)(ws + WS_WQKV), 0, 0, scr, cg);
    conv_job(F, it, A.in[I_WKV], D, 6144, 6144, A.in[I_KVNORM], (bf16_t*)(ws + WS_WQKV), 0, 3072, scr, cg);
    conv_job(F, it, A.in[I_WO], D, D, D, nullptr, (bf16_t*)(ws + WS_WO), 0, 0, scr, cg);
}
__device__ __forceinline__ void conv_moe(const Frame& F, const Args& A) {
    LAS float* scr = (LAS float*)(F.lds + RING_OFF + F.wave * 16384);
    int it = F.bid * NWAVES + F.wave;
    unsigned char* ws = F.ws;
    for (int e = 0; e < NE; ++e) {
        conv_job8(F, it, A.in[I_MWG] + (size_t)e * D * FF1, D, FF1, FF1, A.in[I_FFNORM] + D, WGU_PRESC, ws + WS_WGU1 + (size_t)e * 2 * FF1 * D, 1, 0, scr);
        conv_job8(F, it, A.in[I_MWU] + (size_t)e * D * FF1, D, FF1, FF1, A.in[I_FFNORM] + D, WGU_PRESC, ws + WS_WGU1 + (size_t)e * 2 * FF1 * D, 2, 0, scr);
        conv_job8(F, it, A.in[I_MWD] + (size_t)e * FF1 * D, FF1, D, D, nullptr, WD_PRESC, ws + WS_WD1 + (size_t)e * D * FF1, 0, 0, scr);
    }
}

__device__ __forceinline__ void mixer_phase(const Frame& F, const Args& A) {
    LAS float* rs = (LAS float*)(F.lds + 0);
    LAS float* xn = (LAS float*)(F.lds + 512);
    LAS bf16_t* pl = (LAS bf16_t*)(F.lds + 512 + 80896);
    LAS float* sw = (LAS float*)(F.lds + 512 + 80896 + 33792);
    int tid_ = F.tid; asm volatile("" : "+v"(tid_));
    const int tid = tid_, lane = tid & 63, w = F.wave, fr = lane & 15, fq = lane >> 4;
    const bf16_t* apt = (const bf16_t*)(F.ws + WS_APT);
    bf16_t* hn0 = (bf16_t*)(F.ws + WS_S0);
    for (int tile = F.bid; tile < T / 64; tile += F.G) {
        const int t0 = tile * 64, s0 = t0 % SEQ, halo = s0 ? 15 : 0, nrows = 64 + halo;
#pragma unroll 1
        for (int jb = w; jb < nrows; jb += 5 * NWAVES) {
            f32x4 rv[5][4];
#pragma unroll
            for (int u = 0; u < 5; ++u) { const int jj = jb + u * NWAVES, jc = jj < nrows ? jj : nrows - 1; const f32x4* p = (const f32x4*)(A.in[I_X] + (size_t)(t0 - halo + jc) * D);
#pragma unroll
                for (int q = 0; q < 4; ++q) rv[u][q] = p[lane + 64 * q]; }
#pragma unroll
            for (int u = 0; u < 5; ++u) { float s = 0.f;
#pragma unroll
                for (int q = 0; q < 4; ++q) { const f32x4 v = rv[u][q]; s += (v[0] * v[0] + v[1] * v[1]) + (v[2] * v[2] + v[3] * v[3]); }
                s = wave_sum(s);
                const int jj = jb + u * NWAVES;
                if (lane == 0 && jj < nrows) rs[jj] = 1.0f / sqrtf(s * (1.f / D) + EPS); }
        }
        LDS_WAIT(); __syncthreads();
        float ss[4] = {0.f, 0.f, 0.f, 0.f};
        for (int g = 0; g < 4; ++g) {
            { const f32x4 gn = *(const f32x4*)(A.in[I_ANORM] + g * 256 + 4 * lane);
              f32x4 xv[10];
#pragma unroll
              for (int u = 0; u < 10; ++u) { const int jj = w + u * NWAVES, jc = jj < nrows ? jj : nrows - 1; xv[u] = *(const f32x4*)(A.in[I_X] + (size_t)(t0 - halo + jc) * D + g * 256 + 4 * lane); }
#pragma unroll
              for (int u = 0; u < 10; ++u) { const int jj = w + u * NWAVES; if (jj < nrows) { const float r = rs[jj]; const f32x4 v = xv[u];
                  *(LAS f32x4*)(xn + jj * 256 + 4 * lane) = (f32x4){v[0] * r * gn[0], v[1] * r * gn[1], v[2] * r * gn[2], v[3] * r * gn[3]}; } } }
            LDS_WAIT(); __syncthreads();
            { const int c4 = (tid & 63) * 4, win = 2 << g;
#pragma unroll 1
              for (int i = 0; i < 8; ++i) { const int r = (tid >> 6) + 8 * i, s = s0 + r, cnt = (s + 1 < win) ? (s + 1) : win;
                  f32x4 a = {0.f, 0.f, 0.f, 0.f};
                  for (int jj = 0; jj < cnt; ++jj) a += *(const LAS f32x4*)(xn + (halo + r - jj) * 256 + c4);
                  const f32x4 self = *(const LAS f32x4*)(xn + (halo + r) * 256 + c4); const float inv = 1.f / (float)cnt;
                  u32x2 o; o.x = pk2(a[0] * inv - self[0], a[1] * inv - self[1]); o.y = pk2(a[2] * inv - self[2], a[3] * inv - self[3]);
                  *(LAS u32x2*)(pl + r * 264 + c4) = o; } }
            LDS_WAIT(); __syncthreads();
            f32x4 acc[4][2];
#pragma unroll
            for (int m = 0; m < 4; ++m) { acc[m][0] = (f32x4){0.f, 0.f, 0.f, 0.f}; acc[m][1] = (f32x4){0.f, 0.f, 0.f, 0.f}; }
#pragma unroll
            for (int ks = 0; ks < 8; ++ks) {
                bf16x8 bfr[2], afr[4];
#pragma unroll
                for (int n = 0; n < 2; ++n) bfr[n] = *(const bf16x8*)(apt + (size_t)g * 65536 + (size_t)(32 * w + 16 * n + fr) * 256 + 32 * ks + 8 * fq);
#pragma unroll
                for (int m = 0; m < 4; ++m) afr[m] = *(const LAS bf16x8*)(pl + (16 * m + fr) * 264 + 32 * ks + 8 * fq);
#pragma unroll
                for (int m = 0; m < 4; ++m)
#pragma unroll
                    for (int n = 0; n < 2; ++n) acc[m][n] = __builtin_amdgcn_mfma_f32_16x16x32_bf16(bfr[n], afr[m], acc[m][n], 0, 0, 0);
            }
#pragma unroll
            for (int m = 0; m < 4; ++m)
#pragma unroll
                for (int n = 0; n < 2; ++n) { const int col = g * 256 + 32 * w + 16 * n + 4 * fq; const size_t off = (size_t)(t0 + 16 * m + fr) * D + col;
                    const f32x4 sc = *(const f32x4*)(A.in[I_ASCALE] + col); const f32x4 hv = *(const f32x4*)(A.in[I_X] + off) + acc[m][n] * sc;
                    *(f32x4*)(F.h + off) = hv; ss[m] += (hv[0] * hv[0] + hv[1] * hv[1]) + (hv[2] * hv[2] + hv[3] * hv[3]); }
        }
#pragma unroll
        for (int m = 0; m < 4; ++m) { float s = ss[m]; s += __shfl_xor(s, 16); s += __shfl_xor(s, 32); if (fq == 0) sw[(16 * m + fr) * 8 + w] = s; }
        VM_WAIT(); LDS_WAIT(); __syncthreads();
#pragma unroll 1
        for (int jb = w; jb < 64; jb += 4 * NWAVES) {
            f32x4 hv[4][4];
#pragma unroll
            for (int u = 0; u < 4; ++u) { const f32x4* p = (const f32x4*)(F.h + (size_t)(t0 + jb + u * NWAVES) * D);
#pragma unroll
                for (int q = 0; q < 4; ++q) hv[u][q] = p[lane + 64 * q]; }
#pragma unroll
            for (int u = 0; u < 4; ++u) { const int jr = jb + u * NWAVES; float s = 0.f;
#pragma unroll
                for (int q = 0; q < 8; ++q) s += sw[jr * 8 + q];
                const float r1 = 1.0f / sqrtf(s * (1.f / D) + EPS);
                u32x2* o = (u32x2*)(hn0 + (size_t)(t0 + jr) * D);
#pragma unroll
                for (int q = 0; q < 4; ++q) { const f32x4 v = hv[u][q]; const f32x4 gn = *(const f32x4*)(A.in[I_FFNORM] + 4 * (lane + 64 * q));
                    u32x2 ov; ov.x = pk2(v[0] * r1 * gn[0], v[1] * r1 * gn[1]); ov.y = pk2(v[2] * r1 * gn[2], v[3] * r1 * gn[3]); o[lane + 64 * q] = ov; } }
        }
        LDS_WAIT(); __syncthreads();
    }
}

__device__ __forceinline__ void router_phase(const Frame& F, const Args& A) {
    volatile LAS int* li = (volatile LAS int*)(F.lds + 0);
    volatile LAS float* lf = (volatile LAS float*)(F.lds + 2048);
    int* ltok = (int*)(F.ws + WS_LTOK); float* lrs = (float*)(F.ws + WS_LRS); u32x4* tinfo = (u32x4*)(F.ws + WS_TOKINFO);
    int tid_ = F.tid; asm volatile("" : "+v"(tid_));
    const int tid = tid_, lane = tid & 63, w = F.wave;
    const float* gain = A.in[I_FFNORM] + D;
    f32x4 wa[4][4], wb[4][4];
#pragma unroll
    for (int q = 0; q < 4; ++q) { const int c0 = 4 * (lane + 64 * q); const f32x4 gn = *(const f32x4*)(gain + c0);
#pragma unroll
        for (int j = 0; j < 4; ++j) { wa[q][j] = *(const f32x4*)(A.in[I_ROUTER] + (size_t)(c0 + j) * 8) * gn[j]; wb[q][j] = *(const f32x4*)(A.in[I_ROUTER] + (size_t)(c0 + j) * 8 + 4) * gn[j]; } }
    if (F.bid == 0 && tid < 128) ((u32x4*)(F.ws + WS_ZERO))[tid] = (u32x4){0u, 0u, 0u, 0u};
    for (int tile = F.bid; tile < T / 64; tile += F.G) {
        const int t0 = tile * 64;
        if (tid < 8) li[tid] = 0;
        LDS_WAIT(); __syncthreads();
        f32x4 v[4], vn[4];
        { const f32x4* p = (const f32x4*)(F.h + (size_t)(t0 + 8 * w) * D);
#pragma unroll
          for (int q = 0; q < 4; ++q) vn[q] = p[lane + 64 * q]; }
#pragma unroll 1
        for (int k = 0; k < 8; ++k) {
            const int tl = 8 * w + k;
#pragma unroll
            for (int q = 0; q < 4; ++q) v[q] = vn[q];
            if (k < 7) { const f32x4* p = (const f32x4*)(F.h + (size_t)(t0 + tl + 1) * D);
#pragma unroll
                for (int q = 0; q < 4; ++q) vn[q] = p[lane + 64 * q]; }
            float s = 0.f; f32x4 la = {0.f, 0.f, 0.f, 0.f}, lb = {0.f, 0.f, 0.f, 0.f};
#pragma unroll
            for (int q = 0; q < 4; ++q) { s += (v[q][0] * v[q][0] + v[q][1] * v[q][1]) + (v[q][2] * v[q][2] + v[q][3] * v[q][3]);
#pragma unroll
                for (int j = 0; j < 4; ++j) { la += wa[q][j] * v[q][j]; lb += wb[q][j] * v[q][j]; } }
            float red[9] = {s, la[0], la[1], la[2], la[3], lb[0], lb[1], lb[2], lb[3]};
#pragma unroll
            for (int o = 1; o < 64; o <<= 1) {
#pragma unroll
                for (int e = 0; e < 9; ++e) red[e] += __shfl_xor(red[e], o); }
            if (lane == 0) {
                const float r = 1.0f / sqrtf(red[0] * (1.f / D) + EPS);
                float lg[8];
#pragma unroll
                for (int e = 0; e < 8; ++e) lg[e] = red[1 + e] * r;
                float b1 = lg[0]; int i1 = 0;
#pragma unroll
                for (int e = 1; e < 8; ++e) if (lg[e] > b1) { b1 = lg[e]; i1 = e; }
                float b2 = -3.0e38f; int i2 = 0;
#pragma unroll
                for (int e = 0; e < 8; ++e) if (e != i1 && lg[e] > b2) { b2 = lg[e]; i2 = e; }
                const float e2 = expf(b2 - b1), g1 = 1.f / (1.f + e2), g2 = e2 / (1.f + e2);
                const int r1 = __hip_atomic_fetch_add((LAS int*)&li[i1], 1, __ATOMIC_RELAXED, __HIP_MEMORY_SCOPE_WORKGROUP), r2 = __hip_atomic_fetch_add((LAS int*)&li[i2], 1, __ATOMIC_RELAXED, __HIP_MEMORY_SCOPE_WORKGROUP);
                li[16 + tl * 4 + 0] = i1; li[16 + tl * 4 + 1] = i2; li[16 + tl * 4 + 2] = r1; li[16 + tl * 4 + 3] = r2;
                lf[tl * 4 + 0] = g1; lf[tl * 4 + 1] = g2; lf[tl * 4 + 2] = r;
            }
        }
        LDS_WAIT(); __syncthreads();
        if (tid < 8) li[8 + tid] = (int)atomicAdd(F.ctl + CW_CNT + tid, (unsigned)li[tid]);
        LDS_WAIT(); __syncthreads();
        if (tid < 64) {
            const int i1 = li[16 + tid * 4 + 0], i2 = li[16 + tid * 4 + 1], s1 = li[8 + i1] + li[16 + tid * 4 + 2], s2 = li[8 + i2] + li[16 + tid * 4 + 3];
            const float g1 = lf[tid * 4 + 0], g2 = lf[tid * 4 + 1], r = lf[tid * 4 + 2];
            ltok[(size_t)i1 * T + s1] = t0 + tid; lrs[(size_t)i1 * T + s1] = r;
            ltok[(size_t)i2 * T + s2] = t0 + tid; lrs[(size_t)i2 * T + s2] = r;
            u32x4 ti; ti.x = (unsigned)(s1 << 3 | i1); ti.y = (unsigned)(s2 << 3 | i2); ti.z = __builtin_bit_cast(unsigned, g1); ti.w = __builtin_bit_cast(unsigned, g2);
            tinfo[t0 + tid] = ti;
        }
        LDS_WAIT(); __syncthreads();
    }
}

__device__ __forceinline__ void final_phase(const Frame& F, const Args& A) {
    volatile LAS int* mi = (volatile LAS int*)(F.lds + SCR_OFF);
    const u32x4* tinfo = (const u32x4*)(F.ws + WS_TOKINFO); const bf16_t* Y = (const bf16_t*)(F.ws + WS_Y);
    int lane_ = F.lane; asm volatile("" : "+v"(lane_));
    const int lane = lane_;
    f32x4 gn[4];
#pragma unroll
    for (int q = 0; q < 4; ++q) gn[q] = *(const f32x4*)(A.in[I_FNORM] + 4 * (lane + 64 * q));
    const int stride = F.G * NWAVES; int t = F.bid * NWAVES + F.wave;
    const bf16_t* Y2 = (const bf16_t*)(F.ws + WS_Y2); const bf16_t* ZR = (const bf16_t*)(F.ws + WS_ZERO);
    f32x4 hv[4], hn[4]; u32x2 ya[4], yb[4], yan[4], ybn[4], za[4], zb[4], zan[4], zbn[4]; float g1n = 0.f, g2n = 0.f;
#define FIN_ISSUE(tt, HV, YA, YB, ZA, ZB, G1, G2) do { const u32x4 ti = tinfo[tt]; const unsigned tx = ti.x, ty = ti.y, gz = ti.z, gw = ti.w; \
        const int e1 = tx & 7, s1 = tx >> 3, e2 = ty & 7, s2 = ty >> 3; G1 = __uint_as_float(gz); G2 = __uint_as_float(gw); \
        const size_t r1 = (size_t)mi[MI_TB + e1] * 256 + s1, r2 = (size_t)mi[MI_TB + e2] * 256 + s2; \
        const size_t sp0 = (size_t)mi[MI_SPLIT0]; const u32x2* z1_ = r1 >= sp0 ? (const u32x2*)(Y2 + (r1 - sp0) * D) : (const u32x2*)ZR; const u32x2* z2_ = r2 >= sp0 ? (const u32x2*)(Y2 + (r2 - sp0) * D) : (const u32x2*)ZR; \
        const f32x4* p_ = (const f32x4*)(F.h + (size_t)(tt) * D); const u32x2* y1_ = (const u32x2*)(Y + r1 * D); const u32x2* y2_ = (const u32x2*)(Y + r2 * D); \
        _Pragma("unroll") for (int q = 0; q < 4; ++q) { HV[q] = p_[lane + 64 * q]; YA[q] = y1_[lane + 64 * q]; YB[q] = y2_[lane + 64 * q]; } \
        if (r1 >= sp0) { _Pragma("unroll") for (int q = 0; q < 4; ++q) ZA[q] = z1_[lane + 64 * q]; } else { _Pragma("unroll") for (int q = 0; q < 4; ++q) ZA[q] = (u32x2){0u, 0u}; } \
        if (r2 >= sp0) { _Pragma("unroll") for (int q = 0; q < 4; ++q) ZB[q] = z2_[lane + 64 * q]; } else { _Pragma("unroll") for (int q = 0; q < 4; ++q) ZB[q] = (u32x2){0u, 0u}; } } while (0)
    if (t < T) FIN_ISSUE(t, hn, yan, ybn, zan, zbn, g1n, g2n);
    for (; t < T; t += stride) {
        const float g1 = g1n, g2 = g2n;
#pragma unroll
        for (int q = 0; q < 4; ++q) { hv[q] = hn[q]; ya[q] = yan[q]; yb[q] = ybn[q]; za[q] = zan[q]; zb[q] = zbn[q]; }
        if (t + stride < T) FIN_ISSUE(t + stride, hn, yan, ybn, zan, zbn, g1n, g2n);
        f32x4 v[4]; float s = 0.f;
#pragma unroll
        for (int q = 0; q < 4; ++q) { const u32x2 a = ya[q], b = yb[q], a2 = za[q], b2 = zb[q];
            f32x4 o;
            o[0] = hv[q][0] + g1 * (bf2f((unsigned short)(a.x & 0xffff)) + bf2f((unsigned short)(a2.x & 0xffff))) + g2 * (bf2f((unsigned short)(b.x & 0xffff)) + bf2f((unsigned short)(b2.x & 0xffff)));
            o[1] = hv[q][1] + g1 * (bf2f((unsigned short)(a.x >> 16)) + bf2f((unsigned short)(a2.x >> 16))) + g2 * (bf2f((unsigned short)(b.x >> 16)) + bf2f((unsigned short)(b2.x >> 16)));
            o[2] = hv[q][2] + g1 * (bf2f((unsigned short)(a.y & 0xffff)) + bf2f((unsigned short)(a2.y & 0xffff))) + g2 * (bf2f((unsigned short)(b.y & 0xffff)) + bf2f((unsigned short)(b2.y & 0xffff)));
            o[3] = hv[q][3] + g1 * (bf2f((unsigned short)(a.y >> 16)) + bf2f((unsigned short)(a2.y >> 16))) + g2 * (bf2f((unsigned short)(b.y >> 16)) + bf2f((unsigned short)(b2.y >> 16)));
            v[q] = o; s += (o[0] * o[0] + o[1] * o[1]) + (o[2] * o[2] + o[3] * o[3]); }
        s = wave_sum(s);
        const float r = 1.0f / sqrtf(s * (1.f / D) + EPS);
        f32x4* p = (f32x4*)(F.h + (size_t)t * D);
#pragma unroll
        for (int q = 0; q < 4; ++q) p[lane + 64 * q] = (f32x4){v[q][0] * r * gn[q][0], v[q][1] * r * gn[q][1], v[q][2] * r * gn[q][2], v[q][3] * r * gn[q][3]};
    }
#undef FIN_ISSUE
}

__device__ __forceinline__ int t5_bucket(int n) {
    if (n < 16) return n;
    int large = 16 + (int)(log((double)n / 16.0) / log(128.0) * 16.0);
    return large < 31 ? large : 31;
}
typedef float f32x16 __attribute__((ext_vector_type(16)));
typedef short s16x4 __attribute__((ext_vector_type(4)));
constexpr int AT_TAB = 0;
constexpr int AT_BKT = 7680;
constexpr int AT_CNT = 9472;
constexpr int AT_V = 10240;
constexpr float L2E = 1.4426950408889634f;
constexpr size_t WS_AST_O = WS_POOL + 291 * MiB;
constexpr size_t WS_AST_M = WS_AST_O + 64 * MiB;
static_assert(WS_AST_M + 4 * MiB <= WS_END, "attention scratch");
constexpr unsigned PITCHB = QKV_LD * 2;
__device__ __forceinline__ s16x4 vtr(const LAS unsigned char* p) { return __builtin_bit_cast(s16x4, __builtin_amdgcn_ds_read_tr16_b64_v4i16((LAS s16x4*)p)); }
__device__ __forceinline__ float max3f(float a, float b, float c) { return fmaxf(fmaxf(a, b), c); }

#define AT_LOADS(KF, VR, ub, koff, voff) do { const unsigned ub_ = (ub); \
        _Pragma("unroll") for (int d0 = 0; d0 < 4; ++d0) KF[d0] = __builtin_bit_cast(bf16x8, __builtin_amdgcn_raw_buffer_load_b128(rsrc, (koff) + 32 * d0, ub_, 0)); \
        _Pragma("unroll") for (int i = 0; i < 4; ++i) VR[i] = __builtin_bit_cast(u32x4, __builtin_amdgcn_raw_buffer_load_b128(rsrc, (voff)[i], ub_, 0)); } while (0)
#define AT_SCORE(KF, VR, QF, tla) \
        _Pragma("unroll") for (int i = 0; i < 4; ++i) *(LAS u32x4*)(vwr + i * 512) = VR[i]; \
        { const LAS float* tl_ = (const LAS float*)(tla); _Pragma("unroll") for (int r = 0; r < 16; ++r) s[r] = tl_[(r & 3) + 8 * (r >> 2)]; } \
        _Pragma("unroll") for (int d0 = 0; d0 < 4; ++d0) s = __builtin_amdgcn_mfma_f32_32x32x16_bf16(KF[d0], QF[d0], s, 0, 0, 0);
#define AT_SOFTPV() do { \
        float rm = fmaxf(max3f(max3f(s[0], s[1], s[2]), max3f(s[3], s[4], s[5]), max3f(s[6], s[7], s[8])), max3f(max3f(s[9], s[10], s[11]), max3f(s[12], s[13], s[14]), s[15])); \
        { auto rr = __builtin_amdgcn_permlane32_swap(__float_as_uint(rm), __float_as_uint(rm), false, false); rm = fmaxf(__uint_as_float(rr[0]), __uint_as_float(rr[1])); } \
        if (__any(rm > M)) { const float Mn = fmaxf(M, rm), al = __builtin_amdgcn_exp2f(M - Mn); M = Mn; l *= al; \
            _Pragma("unroll") for (int r = 0; r < 16; ++r) { o0[r] *= al; o1[r] *= al; } } \
        float ps0 = 0.f, ps1 = 0.f; \
        _Pragma("unroll") for (int r = 0; r < 16; r += 2) { s[r] = __builtin_amdgcn_exp2f(s[r] - M); s[r + 1] = __builtin_amdgcn_exp2f(s[r + 1] - M); ps0 += s[r]; ps1 += s[r + 1]; } \
        l += ps0 + ps1; \
        u32x4 pw0, pw1; \
        pw0.x = cvt_pk_bf16(s[0], s[1]); pw0.y = cvt_pk_bf16(s[2], s[3]); pw0.z = cvt_pk_bf16(s[4], s[5]); pw0.w = cvt_pk_bf16(s[6], s[7]); \
        pw1.x = cvt_pk_bf16(s[8], s[9]); pw1.y = cvt_pk_bf16(s[10], s[11]); pw1.z = cvt_pk_bf16(s[12], s[13]); pw1.w = cvt_pk_bf16(s[14], s[15]); \
        const bf16x8 pa0 = __builtin_bit_cast(bf16x8, pw0), pa1 = __builtin_bit_cast(bf16x8, pw1); \
        LDS_WAIT(); \
        { const s16x4 a0 = vtr(vrd), a1 = vtr(vrd + 512), b0 = vtr(vrd + 1024), b1 = vtr(vrd + 1536); \
          const bf16x8 v0 = (bf16x8){a0[0], a0[1], a0[2], a0[3], a1[0], a1[1], a1[2], a1[3]}, v1 = (bf16x8){b0[0], b0[1], b0[2], b0[3], b1[0], b1[1], b1[2], b1[3]}; \
          o0 = __builtin_amdgcn_mfma_f32_32x32x16_bf16(v0, pa0, o0, 0, 0, 0); o0 = __builtin_amdgcn_mfma_f32_32x32x16_bf16(v1, pa1, o0, 0, 0, 0); } \
        { const s16x4 a0 = vtr(vrd + 2048), a1 = vtr(vrd + 2560), b0 = vtr(vrd + 3072), b1 = vtr(vrd + 3584); \
          const bf16x8 v0 = (bf16x8){a0[0], a0[1], a0[2], a0[3], a1[0], a1[1], a1[2], a1[3]}, v1 = (bf16x8){b0[0], b0[1], b0[2], b0[3], b1[0], b1[1], b1[2], b1[3]}; \
          o1 = __builtin_amdgcn_mfma_f32_32x32x16_bf16(v0, pa0, o1, 0, 0, 0); o1 = __builtin_amdgcn_mfma_f32_32x32x16_bf16(v1, pa1, o1, 0, 0, 0); } \
    } while (0)

#ifdef MK_ATT_TS
#define AT_TS(k) do { __builtin_amdgcn_sched_barrier(0); unsigned long long t_; asm volatile("s_memtime %0\n\ts_waitcnt lgkmcnt(0)" : "=s"(t_) :: "memory"); ts_acc[k] += t_ - ts_prev; ts_prev = t_; __builtin_amdgcn_sched_barrier(0); } while (0)
#else
#define AT_TS(k) do { } while (0)
#endif
template <int MODE>
__device__ __forceinline__ void attn_phase(const Frame& F, const Args& A, unsigned long long* ts_out = nullptr) {
#ifdef MK_ATT_TS
    unsigned long long ts_acc[6] = {0, 0, 0, 0, 0, 0}, ts_prev = 0;
    { unsigned long long t_; asm volatile("s_memtime %0\n\ts_waitcnt lgkmcnt(0)" : "=s"(t_) :: "memory"); ts_prev = t_; }
#endif
    LAS float* tab = (LAS float*)(F.lds + AT_TAB);
    const char* qkvb = (const char*)(F.ws + WS_QKV); bf16_t* mo = (bf16_t*)(F.ws + (MODE == 0 ? WS_S0 : WS_S1));
    float* sto = (float*)(F.ws + WS_AST_O); float* stm = (float*)(F.ws + WS_AST_M);
    int lane_ = F.lane; asm volatile("" : "+v"(lane_));
    const int lane = lane_, w = F.wave, j = lane & 31, hi = lane >> 5;
    LAS unsigned char* vbuf = F.lds + AT_V + w * 4096;
    LAS unsigned char* vwr = vbuf + ((lane & 7) >> 2) * 2048 + (lane >> 3) * 64 + (lane & 3) * 16;
    const LAS unsigned char* vrd = vbuf + (4 * hi + ((lane & 15) >> 2)) * 64 + ((lane >> 4) & 1) * 32 + (lane & 3) * 8;
    volatile LAS int* bkt = (volatile LAS int*)(F.lds + AT_BKT);
    volatile LAS int* acnt = (volatile LAS int*)(F.lds + AT_CNT);
    for (int i = F.tid; i < 3 * 129; i += NTHREADS) { const int g = i / 129, m = i - g * 129; bkt[i] = t5_bucket(m * (g == 0 ? 1 : (g == 1 ? 4 : 16))); }
    LDS_WAIT(); __syncthreads();
    const __amdgpu_buffer_rsrc_t rsrc = __builtin_amdgcn_make_buffer_rsrc((void*)(F.ws + WS_QKV), 0, (int)((size_t)T * PITCHB), 0x00020000);
    for (int it = 0; ; ++it) {
        int b, h, cp;
        { const int u = ((F.G & 7) == 0) ? ((F.bid & 7) * (F.G >> 3) + (F.bid >> 3)) + it * F.G : F.bid + it * F.G;
          if (u >= 256) break;
          b = u >> 5; h = (u >> 1) & 15; cp = u & 1; }
        const int tb = b * SEQ;
        __syncthreads();
        if (F.tid < 4) acnt[F.tid] = 0;
        for (int i = F.tid; i < 3 * 640; i += NTHREADS) { const int g = i / 640, m = 383 - (i - g * 640);
            tab[i] = (m >= 0 && m <= 128) ? A.in[I_RELB][bkt[g * 129 + m] * 48 + g * 16 + h] * L2E : -1e30f; }
        LDS_WAIT(); __syncthreads();
        AT_TS(5);
        const int c = 2 * cp + (w & 1);
        f32x16 o0, o1, s; float M, l;
        bf16x8 kfA[4], kfB[4]; u32x4 vrA[4], vrB[4];
#pragma unroll 1
        for (int rd = 0; rd < 4; ++rd) {
            const int r16 = c + 4 * (w >> 1), nt = rd + 1;
            const size_t tq = (size_t)(tb + 16 * (32 * rd + j) + r16);
            bf16x8 qf[4];
            { const char* qp = qkvb + tq * PITCHB + (2 * 1024 + h * 64 + 8 * hi) * 2;
#pragma unroll
              for (int d0 = 0; d0 < 4; ++d0) qf[d0] = *(const bf16x8*)(qp + 32 * d0); }
            const unsigned koff = (unsigned)(16 * j) * PITCHB + (3072 + 2 * 1024 + h * 64 + 8 * hi) * 2;
            unsigned voff[4];
#pragma unroll
            for (int i = 0; i < 4; ++i) voff[i] = (unsigned)(16 * (8 * i + (lane >> 3))) * PITCHB + (6144 + 2 * 1024 + h * 64 + 8 * (lane & 7)) * 2;
            const unsigned ub = (unsigned)(tb + r16) * PITCHB, ustep = (unsigned)(16 * 32) * PITCHB;
            const LAS float* tla = tab + 2 * 640 + 383 - (32 * rd + j) + 4 * hi;
#pragma unroll
            for (int r = 0; r < 16; ++r) { o0[r] = 0.f; o1[r] = 0.f; }
            M = -1e29f; l = 0.f;
#define AT_LOADA(m, KF, VR) do { int m_ = (m); m_ = m_ < nt ? m_ : nt - 1; if (MODE == 1) m_ = 0; AT_LOADS(KF, VR, ub + (unsigned)m_ * ustep, koff, voff); } while (0)
            AT_LOADA(0, kfA, vrA); AT_LOADA(1, kfB, vrB);
            AT_TS(0);
            int n = 0;
#pragma unroll 1
            for (; n + 1 < nt; n += 2) {
                AT_SCORE(kfA, vrA, qf, tla + 32 * n)
                AT_LOADA(n + 2, kfA, vrA);
                AT_SOFTPV();
                AT_SCORE(kfB, vrB, qf, tla + 32 * (n + 1))
                AT_LOADA(n + 3, kfB, vrB);
                AT_SOFTPV();
            }
            if (n < nt) { AT_SCORE(kfA, vrA, qf, tla + 32 * n) AT_SOFTPV(); }
            AT_TS(1);
#undef AT_LOADA
            float* so = sto + ((tq * 16 + h) * 2 + hi) * 32;
#pragma unroll
            for (int r = 0; r < 16; r += 4) { *(f32x4*)(so + r) = (f32x4){o0[r], o0[r + 1], o0[r + 2], o0[r + 3]}; *(f32x4*)(so + 16 + r) = (f32x4){o1[r], o1[r + 1], o1[r + 2], o1[r + 3]}; }
            *(f32x2*)(stm + ((tq * 16 + h) * 2 + hi) * 2) = (f32x2){M, l};
            VM_WAIT();
            if (lane == 0) __hip_atomic_fetch_add((LAS int*)&acnt[rd], 1, __ATOMIC_RELAXED, __HIP_MEMORY_SCOPE_WORKGROUP);
            AT_TS(2);
        }
        AT_TS(3);
#pragma unroll 1
        for (int rd = 0; rd < 4; ++rd) {
            const int i0 = 32 * (4 * rd + (w >> 1));
            const int ktlo0 = (4 - i0 / 8) > 0 ? (4 - i0 / 8) : 0, n0 = 8 - ktlo0;
            const int ktlo1 = (4 - i0 / 32) > 0 ? (4 - i0 / 32) : 0, n1 = 5 - ktlo1, ntl = n0 + n1;
            const size_t tq = (size_t)(tb + 4 * (i0 + j) + c);
            bf16x8 qf0[4], qf1[4];
            { const char* qp = qkvb + tq * PITCHB + (h * 64 + 8 * hi) * 2;
#pragma unroll
              for (int d0 = 0; d0 < 4; ++d0) { qf0[d0] = *(const bf16x8*)(qp + 32 * d0); qf1[d0] = *(const bf16x8*)(qp + 2048 + 32 * d0); } }
            while (__builtin_amdgcn_readfirstlane(acnt[rd]) < NWAVES) __builtin_amdgcn_s_sleep(2);
            asm volatile("" ::: "memory");
            { const float* so = sto + ((tq * 16 + h) * 2 + hi) * 32;
#pragma unroll
              for (int r = 0; r < 16; r += 4) { const f32x4 a = *(const f32x4*)(so + r), bq = *(const f32x4*)(so + 16 + r);
                  o0[r] = a[0]; o0[r + 1] = a[1]; o0[r + 2] = a[2]; o0[r + 3] = a[3]; o1[r] = bq[0]; o1[r + 1] = bq[1]; o1[r + 2] = bq[2]; o1[r + 3] = bq[3]; }
              const f32x2 ml = *(const f32x2*)(stm + ((tq * 16 + h) * 2 + hi) * 2); M = ml[0]; l = ml[1]; }
            const int kb0 = 4 * i0 - 128 + 32 * ktlo0, ik1 = i0 - 128 + 32 * ktlo1;
            const unsigned koff0 = (unsigned)j * PITCHB + (3072 + h * 64 + 8 * hi) * 2, koff1 = (unsigned)(4 * j) * PITCHB + (3072 + 1024 + h * 64 + 8 * hi) * 2;
            unsigned voff0[4], voff1[4];
#pragma unroll
            for (int i = 0; i < 4; ++i) { voff0[i] = (unsigned)(8 * i + (lane >> 3)) * PITCHB + (6144 + h * 64 + 8 * (lane & 7)) * 2;
                                          voff1[i] = (unsigned)(4 * (8 * i + (lane >> 3))) * PITCHB + (6144 + 1024 + h * 64 + 8 * (lane & 7)) * 2; }
            const unsigned ub0 = (unsigned)(tb + kb0) * PITCHB, ub1 = (unsigned)(tb + 4 * ik1 + c) * PITCHB;
            const unsigned us0 = 32u * PITCHB, us1 = 128u * PITCHB;
            const LAS float* tla0 = tab + 383 - (4 * (i0 + j) + c - kb0) + 4 * hi;
            const LAS float* tla1 = tab + 640 + 383 - (i0 + j - ik1) + 4 * hi;
#define AT_LOADN(m, KF, VR) do { int m_ = (m); m_ = m_ < ntl ? m_ : ntl - 1; if (m_ < n0) AT_LOADS(KF, VR, ub0 + (unsigned)(MODE == 1 ? 0 : m_) * us0, koff0, voff0); else AT_LOADS(KF, VR, ub1 + (unsigned)(MODE == 1 ? 0 : m_ - n0) * us1, koff1, voff1); } while (0)
#define AT_STEPN(n, KF, VR, PF) do { const int n_ = (n); if (n_ < n0) { AT_SCORE(KF, VR, qf0, tla0 + 32 * n_) } else { AT_SCORE(KF, VR, qf1, tla1 + 32 * (n_ - n0)) } \
            if (PF) AT_LOADN(n_ + 2, KF, VR); AT_SOFTPV(); } while (0)
            AT_LOADN(0, kfA, vrA); AT_LOADN(1, kfB, vrB);
            AT_TS(0);
            int n = 0;
#pragma unroll 1
            for (; n + 1 < ntl; n += 2) { AT_STEPN(n, kfA, vrA, true); AT_STEPN(n + 1, kfB, vrB, true); }
            if (n < ntl) AT_STEPN(n, kfA, vrA, false);
            AT_TS(4);
#undef AT_STEPN
#undef AT_LOADN
            { auto rr = __builtin_amdgcn_permlane32_swap(__float_as_uint(l), __float_as_uint(l), false, false); l = __uint_as_float(rr[0]) + __uint_as_float(rr[1]); }
            const float il = 1.0f / l;
            bf16_t* op = mo + tq * D + h * 64 + 4 * hi;
#pragma unroll
            for (int gq = 0; gq < 4; ++gq) {
                u32x2 w0, w1;
                w0.x = cvt_pk_bf16(o0[4 * gq] * il, o0[4 * gq + 1] * il); w0.y = cvt_pk_bf16(o0[4 * gq + 2] * il, o0[4 * gq + 3] * il);
                w1.x = cvt_pk_bf16(o1[4 * gq] * il, o1[4 * gq + 1] * il); w1.y = cvt_pk_bf16(o1[4 * gq + 2] * il, o1[4 * gq + 3] * il);
                *(u32x2*)(op + 8 * gq) = w0; *(u32x2*)(op + 32 + 8 * gq) = w1;
            }
            AT_TS(2);
        }
    }
#ifdef MK_ATT_TS
    if (ts_out && F.tid == 0) { for (int k = 0; k < 6; ++k) ts_out[k] = ts_acc[k]; }
#endif
    __syncthreads();
}
#undef AT_LOADS
#undef AT_SCORE
#undef AT_SOFTPV
constexpr int PH_MIX = 0, PH_FF1 = 1, PH_FF2 = 2, PH_QKV = 3, PH_ATT = 4, PH_WO = 5, PH_ROUTE = 6, PH_MOE0 = 7, PH_FINAL = 11, PH_END = 12;

__global__ void __launch_bounds__(NTHREADS, 2) mk_fwd(Args args) {
    extern __shared__ __attribute__((aligned(16))) unsigned char lds_raw[];
    Frame F;
    F.lds = (LAS unsigned char*)lds_raw;
    F.tid = threadIdx.x; F.lane = F.tid & 63; F.wave = __builtin_amdgcn_readfirstlane(F.tid >> 6); F.G = gridDim.x; F.bid = blockIdx.x;
    F.ws = args.ws; F.ctl = (unsigned*)(args.ws + WS_CTL); F.h = args.out;
    volatile LAS unsigned* MISC = (volatile LAS unsigned*)(F.lds + MISC_OFF);
    for (int u = F.tid; u < 64; u += NTHREADS) MISC[u] = 0u;
    __syncthreads();
    XcdBarrier bar = xcd_barrier_post(F.ctl + CW_BAR + args.li * XCD_BAR_WORDS, MISC + 8);
    const int lo = args.ph_lo, hi = args.ph_hi;
#ifndef MK_MASK
#define MK_MASK 0xffffffffu
#endif
#define IN(k) (((MK_MASK >> (k)) & 1u) && lo <= (k) && (k) < hi)
#define SEAM(k) do { if (IN(k) && IN((k) + 1)) xcd_barrier(bar); } while (0)
    unsigned char* ws = args.ws;
    LAS unsigned char* ring = F.lds + RING_OFF;
#ifdef MK_PROBE_LO
    unsigned long long pr_t0 = 0, pr_t1 = 0;
#define PROBE_AT(k) do { if ((k) == MK_PROBE_LO) pr_t0 = __builtin_amdgcn_s_memrealtime(); if ((k) == MK_PROBE_HI) pr_t1 = __builtin_amdgcn_s_memrealtime(); } while (0)
#else
#define PROBE_AT(k) do { } while (0)
#endif

    PROBE_AT(0);
    if (IN(PH_MIX)) { conv_aproj(F, args); conv_small(F, args); VM_WAIT(); __syncthreads(); }
    PROBE_AT(20);
    if (IN(PH_MIX)) { xcd_barrier(bar); PROBE_AT(21); mixer_phase(F, args); }
    PROBE_AT(22);
    SEAM(PH_MIX);

    PROBE_AT(1);
    if (IN(PH_FF1)) {
        pg8::Gemm g{(const bf16_t*)(ws + WS_S0), (const bf16_t*)(ws + WS_WGU0), D, D, D}; pg8::StaticOrder S; S.init(T, 2 * FF0, F.G, F.bid);
        EpiSwiGLU E{(bf16_t*)(ws + WS_ACT0), ACT0_LD, nullptr, 1.f, 1.f};
        pg8::gemm_phase<EpiSwiGLU, pg8::StaticOrder, false>(ring, g, S, E);
        { const int units = (T / 256) * (2 * FF0 / 256), rem = units % F.G;
          if (rem == 0) conv_later(F, args, F.bid, F.G); else if (F.bid >= rem) conv_later(F, args, F.bid - rem, F.G - rem); }
    }
    SEAM(PH_FF1);
    PROBE_AT(2);
    if (IN(PH_FF2)) {
        pg8::Gemm g{(const bf16_t*)(ws + WS_ACT0), (const bf16_t*)(ws + WS_WD0), FF0, ACT0_LD, FF0}; pg8::StaticOrder S; S.init(T, D, F.G, F.bid);
        EpiRes E{F.h, (bf16_t*)(ws + WS_S1), (float*)(ws + WS_SSQ), nullptr};
        pg8::gemm_phase<EpiRes, pg8::StaticOrder, false>(ring, g, S, E);
    }
    SEAM(PH_FF2);
    PROBE_AT(3);
    if (IN(PH_QKV)) {
        pg8::Gemm g{(const bf16_t*)(ws + WS_S1), (const bf16_t*)(ws + WS_WQKV), D, D, D}; pg8::StaticOrder S; S.init(T, NQKV, F.G, F.bid);
        EpiQKV E{(bf16_t*)(ws + WS_QKV), (const float*)(ws + WS_SSQ)};
        pg8::gemm_phase<EpiQKV, pg8::StaticOrder, false>(ring, g, S, E);
#if defined(MK_QKV_EXTRA) && MK_QKV_EXTRA == 1
        pg8::gemm_phase<EpiQKV, pg8::StaticOrder, false>(ring, g, S, E);
#elif defined(MK_QKV_EXTRA) && MK_QKV_EXTRA == 3
        { EpiQKV_T<false> EN{(bf16_t*)(ws + WS_QKV), (const float*)(ws + WS_SSQ)}; pg8::gemm_phase<EpiQKV_T<false>, pg8::StaticOrder, false>(ring, g, S, EN); }
#elif defined(MK_QKV_EXTRA) && MK_QKV_EXTRA == 2
        { EpiNull EN; pg8::gemm_phase<EpiNull, pg8::StaticOrder, false>(ring, g, S, EN); }
#endif
    }
    SEAM(PH_QKV);
        PROBE_AT(4);
#ifdef MK_ATT_TS
    unsigned long long att_ts[6] = {0, 0, 0, 0, 0, 0};
    if (IN(PH_ATT)) { attn_phase<0>(F, args, att_ts);
#else
    if (IN(PH_ATT)) { attn_phase<0>(F, args);
#endif
#ifdef MK_ATT_EXTRA
        attn_phase<MK_ATT_EXTRA>(F, args);
#endif
    }
    SEAM(PH_ATT);
    PROBE_AT(5);
    if (IN(PH_WO)) {
        pg8::Gemm g{(const bf16_t*)(ws + WS_S0), (const bf16_t*)(ws + WS_WO), D, D, D}; pg8::StaticOrder S; S.init(T, D, F.G, F.bid);
        EpiRes E{F.h, (bf16_t*)(ws + WS_S1), nullptr, ws + WS_S1};
        pg8::gemm_phase<EpiRes, pg8::StaticOrder, false>(ring, g, S, E);
        conv_moe(F, args);
    }
    SEAM(PH_WO);
    PROBE_AT(6);
    if (IN(PH_ROUTE)) { router_phase(F, args); }
    SEAM(PH_ROUTE);
#pragma unroll 1
    for (int j = 0; j < 4; ++j) {
        PROBE_AT(7 + j);
        if (IN(PH_MOE0 + j)) {
            moe_info_build(F.lds, F.ctl);
            volatile LAS int* mi = (volatile LAS int*)(F.lds + SCR_OFF);
            const int ntiles = __builtin_amdgcn_readfirstlane(mi[MI_NT]);
            if (j >= 1) {
                const int c0 = (j - 1) * CH_TILES; int ntc = ntiles - c0; ntc = ntc < 0 ? 0 : (ntc > CH_TILES ? CH_TILES : ntc);
                const bool lastc = (c0 + CH_TILES >= ntiles);
                EpiY E{(bf16_t*)(ws + WS_Y), (bf16_t*)(ws + WS_Y2), c0 * 256, 1.f / (WD_PRESC * ACT_PRESC)};
                if (lastc) {
                    pg8::Gemm g{(const bf16_t*)(ws + WS_ACT1 + (size_t)((j - 1) & 1) * ACT1_CHUNK), (const bf16_t*)(ws + WS_WD1), FF1 / 4, FF1 / 2, FF1 / 2};
                    MoeOrder<8, false> S{{F.ctl + CW_Q + 64 * (2 * j), MISC + 16}, mi, c0, ntc, nullptr};
                    pg8::gemm_phase<EpiY, MoeOrder<8, false>, false, true>(ring, g, S, E);
                } else {
                    pg8::Gemm g{(const bf16_t*)(ws + WS_ACT1 + (size_t)((j - 1) & 1) * ACT1_CHUNK), (const bf16_t*)(ws + WS_WD1), FF1 / 2, FF1 / 2, FF1 / 2};
                    MoeOrder<4, false> S{{F.ctl + CW_Q + 64 * (2 * j), MISC + 16}, mi, c0, ntc, nullptr};
                    pg8::gemm_phase<EpiY, MoeOrder<4, false>, false, true>(ring, g, S, E);
                }
            }
            if (j <= 2) {
                const int c0 = j * CH_TILES; int ntc = ntiles - c0; ntc = ntc < 0 ? 0 : (ntc > CH_TILES ? CH_TILES : ntc);
                pg8::Gemm g{(const bf16_t*)(ws + WS_S1), (const bf16_t*)(ws + WS_WGU1), D / 2, D / 2, D / 2};
                MoeOrder<28, true> S{{F.ctl + CW_Q + 64 * (2 * j + 1), MISC + 16}, mi, c0, ntc, (const int*)(ws + WS_LTOK)};
                EpiSwiGLU_T<true> E{(bf16_t*)(ws + WS_ACT1 + (size_t)(j & 1) * ACT1_CHUNK), FF1, (const float*)(ws + WS_LRS), 1.f / WGU_PRESC, ACT_PRESC};
                pg8::gemm_phase<EpiSwiGLU_T<true>, MoeOrder<28, true>, true, true>(ring, g, S, E);
            }
        }
        SEAM(PH_MOE0 + j);
    }
#ifdef MK_EXTRA_BARS
    for (int i = 0; i < MK_EXTRA_BARS; ++i) xcd_barrier(bar);
#endif
    PROBE_AT(11);
    if (IN(PH_FINAL)) { moe_info_build(F.lds, F.ctl); final_phase(F, args); }
    PROBE_AT(12);
#ifdef MK_ATT_TS
    if (F.bid == 0 && F.wave == 0) { const unsigned long long dt = att_ts[MK_ATT_TS] / 5ull, ts = __builtin_amdgcn_s_memrealtime(); while (__builtin_amdgcn_s_memrealtime() - ts < dt) __builtin_amdgcn_s_sleep(8); }
#endif
#ifdef MK_PROBE_LO
    { const unsigned long long dt = (pr_t1 - pr_t0) * MK_PROBE_MULT, ts = __builtin_amdgcn_s_memrealtime(); while (__builtin_amdgcn_s_memrealtime() - ts < dt) __builtin_amdgcn_s_sleep(8); }
#endif
#undef IN
#undef SEAM
}
}
extern "C" void kernel_launch(void* const* d_in, const int* in_sizes, int n_in, void* d_out, int out_size, void* d_ws, size_t ws_size, hipStream_t stream) {
    static int grid = 0;
    if (grid == 0) {
        if (n_in != 19 || out_size != mk::T * mk::D || ws_size < mk::WS_END) { fprintf(stderr, "kernel_launch: unexpected shapes / workspace (%d inputs, out %d, ws %zu)\n", n_in, out_size, ws_size); grid = -1; return; }
        int dev = 0, cus = 0;
        if (hipGetDevice(&dev) != hipSuccess || hipDeviceGetAttribute(&cus, hipDeviceAttributeMultiprocessorCount, dev) != hipSuccess) { grid = -1; return; }
        if (hipFuncSetAttribute((const void*)mk::mk_fwd, hipFuncAttributeMaxDynamicSharedMemorySize, mk::LDS_BYTES) != hipSuccess) { fprintf(stderr, "kernel_launch: hipFuncSetAttribute failed\n"); grid = -1; return; }
        int per_cu = 0;
        if (hipOccupancyMaxActiveBlocksPerMultiprocessor(&per_cu, (const void*)mk::mk_fwd, mk::NTHREADS, mk::LDS_BYTES) != hipSuccess || per_cu < 1) { fprintf(stderr, "kernel_launch: occupancy query says %d blocks per CU\n", per_cu); }
        (void)hipGetLastError();
        grid = cus;
    }
    if (grid < 0) return;
    (void)hipMemsetAsync((char*)d_ws + mk::WS_CTL, 0, mk::CTL_ZERO_BYTES, stream);
    mk::Args a{};
    for (int i = 0; i < 19; ++i) a.in[i] = (const float*)d_in[i];
    a.out = (float*)d_out; a.ws = (unsigned char*)d_ws;
    a.ph_lo = 0; a.ph_hi = mk::PH_END; a.li = 0;
    hipLaunchKernelGGL(mk::mk_fwd, dim3(grid), dim3(mk::NTHREADS), mk::LDS_BYTES, stream, a);
}
```

```cpp
#include <hip/hip_runtime.h>
#include <cstdio>
#include <cstdint>
namespace mk {
#define LAS __attribute__((address_space(3)))
#define GAS __attribute__((address_space(1)))
typedef unsigned short bf16_t;
typedef short bf16x8 __attribute__((ext_vector_type(8)));
typedef float f32x4 __attribute__((ext_vector_type(4)));
typedef float f32x2 __attribute__((ext_vector_type(2)));
typedef unsigned u32x4 __attribute__((ext_vector_type(4)));
typedef unsigned u32x2 __attribute__((ext_vector_type(2)));

constexpr int T = 16384, D = 1024, SEQ = 2048, NBATCH = 8;
constexpr int FF0 = 2816, FF1 = 3584, NE = 8, NQKV = 9216;
constexpr int ACT0_LD = FF0 + 64;
constexpr int QKV_LD = NQKV + 64;
constexpr float EPS = 1e-6f;
constexpr float WGU_PRESC = 32.f, WD_PRESC = 64.f, ACT_PRESC = 4.f;
constexpr int NWAVES = 8, NTHREADS = 512;

constexpr size_t MiB = 1u << 20;
constexpr size_t WS_CTL = 0, CTL_ZERO_BYTES = 1 * MiB;
constexpr size_t WS_SSQ = 1 * MiB;
constexpr size_t WS_LTOK = 2 * MiB;
constexpr size_t WS_LRS = 2 * MiB + 512 * 1024;
constexpr size_t WS_TOKINFO = 3 * MiB;
constexpr size_t WS_ZERO = 3 * MiB + 256 * 1024;
constexpr size_t WS_APT = 3 * MiB + 512 * 1024;
constexpr size_t WS_WGU0 = 4 * MiB;
constexpr size_t WS_WD0 = 15 * MiB;
constexpr size_t WS_WQKV = WS_WD0 + (size_t)D * FF0 * 2;
constexpr size_t WS_WO = WS_WQKV + (size_t)NQKV * D * 2;
constexpr size_t WS_S0 = 41 * MiB;
constexpr size_t WS_S1 = 73 * MiB;
constexpr size_t WS_POOL = 105 * MiB;
constexpr size_t WS_ACT0 = WS_POOL;
constexpr size_t WS_QKV = WS_POOL;
constexpr int LAST_TILES = 32;
constexpr int CH0_CAP = 136 - LAST_TILES;
constexpr size_t ACT1_B1 = (size_t)CH0_CAP * 256 * FF1;
constexpr size_t WS_ACT1 = WS_POOL;
constexpr size_t WS_Y = 4 * MiB;
constexpr size_t WS_Y2 = WS_ACT1 + ACT1_B1 + (size_t)LAST_TILES * 256 * FF1;
constexpr size_t WS_WGU1 = 306 * MiB;
constexpr size_t WS_WD1 = 418 * MiB;
constexpr size_t WS_END = 474 * MiB;
static_assert(WS_WO + (size_t)D * D * 2 <= WS_S0, "small weights");
static_assert(WS_Y2 + (size_t)LAST_TILES * 256 * D * 2 <= WS_WGU1 && WS_Y + (size_t)34816 * D * 2 <= WS_S1, "moe map");
static_assert(WS_WGU1 + (size_t)NE * 7168 * D * 2 <= WS_WD1 && WS_WD1 + (size_t)NE * D * FF1 * 2 <= WS_END, "moe weights");
static_assert(WS_QKV + (size_t)T * QKV_LD * 2 <= WS_END, "qkv");

constexpr int CW_TMO = 0;
constexpr int CW_CNT = 64;
constexpr int CW_Q = 128;
constexpr int CW_BAR = 4096;

constexpr int RING_OFF = 0, RING_BYTES = 131072;
constexpr int MISC_OFF = RING_BYTES;
constexpr int RTAB_OFF = MISC_OFF + 1024;
constexpr int SCR_OFF = MISC_OFF + 2048;
constexpr int LDS_BYTES = 147456;

#define RLX_AGENT __ATOMIC_RELAXED, __HIP_MEMORY_SCOPE_AGENT
#define LDS_WAIT() asm volatile("s_waitcnt lgkmcnt(0)" ::: "memory")
#define VM_WAIT() asm volatile("s_waitcnt vmcnt(0)" ::: "memory")
__device__ __forceinline__ unsigned f2bf(float f) { unsigned u = __builtin_bit_cast(unsigned, f); return (u + 0x7fffu + ((u >> 16) & 1u)) >> 16; }
__device__ __forceinline__ unsigned pk2(float lo, float hi) { return f2bf(lo) | (f2bf(hi) << 16); }
__device__ __forceinline__ unsigned cvt_pk_bf16(float lo, float hi) { unsigned r; asm volatile("v_cvt_pk_bf16_f32 %0, %1, %2" : "=v"(r) : "v"(lo), "v"(hi)); return r; }
__device__ __forceinline__ float bf2f(unsigned short b) { return __builtin_bit_cast(float, ((unsigned)b) << 16); }
__device__ __forceinline__ float wave_sum(float v) {
#pragma unroll
    for (int o = 1; o < 64; o <<= 1) v += __shfl_xor(v, o);
    return v;
}
__device__ __forceinline__ float silu_f(float x) { return x * __builtin_amdgcn_rcpf(1.f + __builtin_amdgcn_exp2f(-1.4426950408889634f * x)); }
#define XB_TMO      128
#define XB_XCNT(j)  (256  + 64 * (j))
#define XB_XSUB(j)  (1280 + 64 * (j))
#define XB_XGEN(j)  (2304 + 64 * (j))
#define XB_TOP      3328
#define XB_TOPGEN   3392
#define XCD_BAR_WORDS 3456
#define XB_SPIN_CAP (1u << 18)
__device__ __forceinline__ unsigned xb_ld(unsigned* p)              { return __hip_atomic_load(p, __ATOMIC_RELAXED, __HIP_MEMORY_SCOPE_AGENT); }
__device__ __forceinline__ unsigned xb_add(unsigned* p, unsigned v) { return __hip_atomic_fetch_add(p, v, __ATOMIC_RELAXED, __HIP_MEMORY_SCOPE_AGENT); }
__device__ __forceinline__ unsigned xb_xcc_id() { return (unsigned)__builtin_amdgcn_s_getreg((3 << 11) | 20) & 0xFu; }
#define XB_SPIN(cond, bar) do { unsigned _sp = 0; while (cond) { __builtin_amdgcn_s_sleep(1); \
    if ((++_sp & 255u) == 0u) { if (xb_ld(&(bar)[XB_TMO])) break; if (_sp > XB_SPIN_CAP) { atomicAdd(&(bar)[XB_TMO], 1u); break; } } } } while (0)
struct XcdBarrier { unsigned* bar; unsigned x; volatile LAS unsigned* st; };
__device__ __forceinline__ XcdBarrier xcd_barrier_post(unsigned* bar, volatile LAS unsigned* st) {
    XcdBarrier b; b.bar = bar; b.x = xb_xcc_id(); b.st = st;
    if (threadIdx.x == 0) (void)xb_add(&bar[XB_XCNT(b.x)], 1u);
    return b;
}
__device__ __forceinline__ void xcd_barrier_complete(unsigned* bar, unsigned x, unsigned& nloc, unsigned& nx) {
    const unsigned G = gridDim.x * gridDim.y * gridDim.z;
    unsigned sum, cnt, mine, sp = 0u;
    for (;;) {
        sum = 0u; cnt = 0u; mine = 0u;
#pragma unroll
        for (unsigned j = 0; j < 16; ++j) { const unsigned c = xb_ld(&bar[XB_XCNT(j)]); sum += c; cnt += (c > 0u) ? 1u : 0u; mine = (j == x) ? c : mine; }
        if (sum == G) break;
        __builtin_amdgcn_s_sleep(1);
        if ((++sp & 255u) == 0u) { if (xb_ld(&bar[XB_TMO])) break; if (sp > XB_SPIN_CAP) { atomicAdd(&bar[XB_TMO], 1u); break; } }
    }
    nloc = mine > 0u ? mine : 1u; nx = cnt > 0u ? cnt : 1u;
}
__device__ __forceinline__ void xcd_barrier(const XcdBarrier& b) {
    asm volatile("s_waitcnt vmcnt(0)" ::: "memory");
    __syncthreads();
    if (threadIdx.x == 0) {
        unsigned* bar = b.bar;
        __builtin_amdgcn_s_waitcnt(0);
        unsigned nloc = b.st[0], nx = b.st[1];
        if (nloc == 0u) { xcd_barrier_complete(bar, b.x, nloc, nx); b.st[0] = nloc; b.st[1] = nx; }
        const unsigned old = xb_add(&bar[XB_XSUB(b.x)], 1u);
        const unsigned gen = old / nloc;
        if (old + 1u == (gen + 1u) * nloc) {
            __builtin_amdgcn_fence(__ATOMIC_RELEASE, "agent");
            asm volatile("s_waitcnt vmcnt(0)" ::: "memory");
            const unsigned og = xb_add(&bar[XB_TOP], 1u);
            const unsigned tg = og / nx;
            if (og + 1u == (tg + 1u) * nx) xb_add(&bar[XB_TOPGEN], 1u);
            else XB_SPIN(xb_ld(&bar[XB_TOPGEN]) == tg, bar);
            __builtin_amdgcn_fence(__ATOMIC_ACQUIRE, "agent");
            xb_add(&bar[XB_XGEN(b.x)], 1u);
            asm volatile("s_waitcnt vmcnt(0)" ::: "memory");
        } else {
            XB_SPIN(xb_ld(&bar[XB_XGEN(b.x)]) == gen, bar);
            __builtin_amdgcn_fence(__ATOMIC_ACQUIRE, "agent");
            asm volatile("s_waitcnt vmcnt(0)" ::: "memory");
        }
    }
    __syncthreads();
}
namespace pg8 {
typedef int v4i __attribute__((ext_vector_type(4)));
typedef int v8i __attribute__((ext_vector_type(8)));
constexpr int BM = 256, BK = 64, HALF = 128, HTB = HALF * BK * 2, STAGE_BYTES = 8 * HTB, NXCD = 8, WGM = 4;
__host__ __device__ __forceinline__ int lds_byte(int r, int c) { const int st = (r >> 4) * 2 + (c >> 5), rr = r & 15, cc = c & 31, ob = rr * 64 + cc * 2; return st * 1024 + (ob ^ (((ob >> 9) & 1) << 5)); }
__host__ __device__ __forceinline__ void stage_rc(int b, int& R, int& C) { const int st = b / 1024, sb = b % 1024, swz = sb ^ (((sb >> 9) & 1) << 5); R = (st >> 1) * 16 + swz / 64; C = (st & 1) * 32 + (swz % 64) / 2; }
__host__ __device__ __forceinline__ int perm32(int rho) { const int n = rho >> 4, i = rho & 15; return 8 * (i >> 2) + 4 * n + (i & 3); }

struct Unit { int pm, pn, arow, brow, e, orow, koff; };
struct Gemm { const bf16_t* A; const bf16_t* Bt; int K; int lda; int ldb; };

struct StaticOrder {
    int nM, nN, nwg, G, c;
    __device__ void init(int M, int N, int G_, int c_) { nM = M / BM; nN = N / BM; nwg = nM * nN; G = G_; c = c_; }
    __device__ __forceinline__ void start() const {}
    __device__ __forceinline__ bool next(int i, Unit& u) const {
        const long L = (long)i * G + c; if (L >= nwg) return false;
        int wgid = (int)L; { const int q = nwg / NXCD, r = nwg % NXCD, xcd = wgid % NXCD, off = wgid / NXCD; wgid = (xcd < r ? xcd * (q + 1) : r * (q + 1) + (xcd - r) * q) + off; }
        const int nig = WGM * nN, gid = wgid / nig, fm = gid * WGM, gsz = (nM - fm) < WGM ? (nM - fm) : WGM;
        u.pm = fm + ((wgid % nig) % gsz); u.pn = (wgid % nig) / gsz; u.arow = u.pm * BM; u.brow = u.pn * BM; u.e = 0; u.orow = u.arow; u.koff = 0; return true;
    }
    __device__ __forceinline__ unsigned refill_issue() const { return 0u; }
    __device__ __forceinline__ void refill_commit(int, unsigned) const {}
    __device__ __forceinline__ unsigned gather_row(const Unit&, int) const { return 0u; }
};

template <class Epi, class Sched, bool GATHER, bool FP8 = false>
__device__ __forceinline__ void gemm_phase(LAS unsigned char* lds, const Gemm g, Sched& S, const Epi& E) {
    int tid_ = threadIdx.x; asm volatile("" : "+v"(tid_));
    const int tid = tid_, wid = __builtin_amdgcn_readfirstlane(tid >> 6), lane = tid & 63, wr = wid >> 2, wc = wid & 3, fr = lane & 15, fq = lane >> 4;
    int K_ = g.K; asm volatile("" : "+s"(K_));
    const int K = K_, nt = K / BK, LDA = g.lda, LDB = g.ldb;
    unsigned voffB[2]; unsigned va[2][2];
    const size_t kstep = (size_t)(BK * 2);
    const size_t hstep = (size_t)HALF * LDB * 2, hstepA = (size_t)HALF * LDA * 2;
#pragma unroll
    for (int i = 0; i < 2; ++i) { int R, C; stage_rc(tid * 16 + i * 8192, R, C); const int Rb = Epi::PERM ? ((R & ~31) + perm32(R & 31)) : R;
        voffB[i] = (unsigned)(Rb * LDB + C) * 2u;
        va[0][i] = (unsigned)(R * LDA + C) * 2u; va[1][i] = va[0][i] + (unsigned)hstepA; }
    const unsigned ldsw = (unsigned)wid * 1024u;
    const int aoff0 = lds_byte(wr * 64 + fr, FP8 ? 16 * fq : 8 * fq), aoff1 = lds_byte(wr * 64 + fr, FP8 ? 16 * fq + 8 : 8 * fq + 32);
    const int boff0 = lds_byte(wc * 32 + fr, FP8 ? 16 * fq : 8 * fq), boff1 = lds_byte(wc * 32 + fr, FP8 ? 16 * fq + 8 : 8 * fq + 32);
#define PG8_SA(b, h) (((b) * 2 + (h)) * HTB)
#define PG8_SB(b, h) ((4 + (b) * 2 + (h)) * HTB)
#define PG8_STAGEB(bufoff, gbase) do { _Pragma("unroll") for (int _i = 0; _i < 2; ++_i) \
        __builtin_amdgcn_global_load_lds((const unsigned*)((const char*)(gbase) + voffB[_i]), (LAS unsigned*)(lds + (bufoff) + ldsw + _i * 8192), 16, 0, 0); } while (0)
#define PG8_STAGEA(bufoff, gbase, vo, h) do { _Pragma("unroll") for (int _i = 0; _i < 2; ++_i) \
        __builtin_amdgcn_global_load_lds((const unsigned*)((const char*)(gbase) + (vo)[h][_i]), (LAS unsigned*)(lds + (bufoff) + ldsw + _i * 8192), 16, 0, 0); } while (0)
#define PG8_CAT8(p0, p1) __builtin_shufflevector(__builtin_bit_cast(v4i, *(const LAS bf16x8*)(p0)), __builtin_bit_cast(v4i, *(const LAS bf16x8*)(p1)), 0, 1, 2, 3, 4, 5, 6, 7)
#define PG8_LDA(dst, b, h) do { _Pragma("unroll") for (int m = 0; m < 4; ++m) { \
        if constexpr (FP8) dst##8[m] = PG8_CAT8(lds + PG8_SA(b, h) + aoff0 + m * 2048, lds + PG8_SA(b, h) + aoff0 + m * 2048 + 16);   \
        else { dst[m][0] = *(const LAS bf16x8*)(lds + PG8_SA(b, h) + aoff0 + m * 2048); dst[m][1] = *(const LAS bf16x8*)(lds + PG8_SA(b, h) + aoff1 + m * 2048); } } } while (0)
#define PG8_LDB(dst, b, h) do { _Pragma("unroll") for (int n = 0; n < 2; ++n) { \
        if constexpr (FP8) dst##8[n] = PG8_CAT8(lds + PG8_SB(b, h) + boff0 + n * 2048, lds + PG8_SB(b, h) + boff0 + n * 2048 + 16); \
        else { dst[n][0] = *(const LAS bf16x8*)(lds + PG8_SB(b, h) + boff0 + n * 2048); dst[n][1] = *(const LAS bf16x8*)(lds + PG8_SB(b, h) + boff1 + n * 2048); } } } while (0)
#define PG8_MMA(ai, bj, At, Bt) do { __builtin_amdgcn_s_setprio(1); _Pragma("unroll") for (int m = 0; m < 4; ++m) _Pragma("unroll") for (int n = 0; n < 2; ++n) { \
        if constexpr (FP8) asm volatile("v_mfma_scale_f32_16x16x128_f8f6f4 %0, %1, %2, %0, %3, %3 op_sel_hi:[0,0,0]" : "+v"(acc[ai][bj][m][n]) : "v"(Bt##8[n]), "v"(At##8[m]), "v"(sc8));   \
        else { _Pragma("unroll") for (int k = 0; k < 2; ++k) acc[ai][bj][m][n] = __builtin_amdgcn_mfma_f32_16x16x32_bf16(Bt[n][k], At[m][k], acc[ai][bj][m][n], 0, 0, 0); } } \
        __builtin_amdgcn_s_setprio(0); } while (0)
#define PG8_WAIT_V(n) asm volatile("s_waitcnt vmcnt(" #n ")" ::: "memory")
#define PG8_WAIT_L(n) asm volatile("s_waitcnt lgkmcnt(" #n ")" ::: "memory")
#define PG8_BAR __builtin_amdgcn_s_barrier()
#define PG8_SCHED __builtin_amdgcn_sched_barrier(0)
    int sc8 = 0x7f7f7f7f; asm volatile("" : "+v"(sc8));
    Unit cur, nxt; int ui = 0;
    typename Epi::Pre pre{};
#ifdef MK_STAGGER
    { const unsigned long long dt = (unsigned long long)((blockIdx.x >> 3) & 7) * MK_STAGGER, ts = __builtin_amdgcn_s_memrealtime(); while (__builtin_amdgcn_s_memrealtime() - ts < dt) __builtin_amdgcn_s_sleep(4); }
#endif
    S.start();
    if (!S.next(0, cur)) return;
    f32x4 acc[2][2][4][2];
#pragma unroll
    for (int a = 0; a < 2; ++a)
#pragma unroll
        for (int b = 0; b < 2; ++b)
#pragma unroll
            for (int m = 0; m < 4; ++m)
#pragma unroll
                for (int n = 0; n < 2; ++n) acc[a][b][m][n] = (f32x4){0.f, 0.f, 0.f, 0.f};
    bf16x8 At[4][2], B0[2][2], B1[2][2]; v8i At8[4], B08[2], B18[2];
    const char* cA; const char* cB = (const char*)g.Bt + ((size_t)cur.brow * LDB + cur.koff) * 2;
    if constexpr (GATHER) { cA = (const char*)g.A;
#pragma unroll
        for (int h = 0; h < 2; ++h)
#pragma unroll
            for (int i = 0; i < 2; ++i) { int R, C; stage_rc(tid * 16 + i * 8192, R, C); va[h][i] = (S.gather_row(cur, h * HALF + R) * (unsigned)LDA + (unsigned)C) * 2u; }
    } else cA = (const char*)g.A + ((size_t)cur.arow * LDA + cur.koff) * 2;
    PG8_STAGEB(PG8_SB(0, 0), cB); PG8_STAGEB(PG8_SB(0, 1), cB + hstep); PG8_STAGEA(PG8_SA(0, 0), cA, va, 0); PG8_STAGEA(PG8_SA(0, 1), cA, va, 1);
    if (wr == 1) PG8_BAR;
    PG8_WAIT_V(2); PG8_BAR;
    PG8_STAGEB(PG8_SB(1, 0), cB + kstep); PG8_STAGEA(PG8_SA(1, 0), cA + kstep, va, 0); PG8_STAGEB(PG8_SB(1, 1), cB + hstep + kstep);
    PG8_WAIT_V(6); PG8_BAR;
    for (;;) {
        bool has_next = false; const char* nA = cA; const char* nB = cB;
        unsigned vnx[2][2] = {{0u, 0u}, {0u, 0u}};
#pragma unroll 1
        for (int t = 0; t < nt; t += 2) {
            const bool last = (t == nt - 2);
            unsigned v2[2][2];
#pragma unroll
            for (int h = 0; h < 2; ++h)
#pragma unroll
                for (int i = 0; i < 2; ++i) v2[h][i] = va[h][i];
            if (last) {
                pre = E.pre(cur, wr, fr);
                has_next = S.next(ui + 1, nxt);
                if (has_next) { nB = (const char*)g.Bt + ((size_t)nxt.brow * LDB + nxt.koff) * 2;
                    if constexpr (GATHER) {
#pragma unroll
                        for (int h = 0; h < 2; ++h)
#pragma unroll
                            for (int i = 0; i < 2; ++i) { int R, C; stage_rc(tid * 16 + i * 8192, R, C); v2[h][i] = (S.gather_row(nxt, h * HALF + R) * (unsigned)LDA + (unsigned)C) * 2u; }
                    } else nA = (const char*)g.A + ((size_t)nxt.arow * LDA + nxt.koff) * 2;
                }
            }
            if constexpr (GATHER) { if (last) {
#pragma unroll
                for (int h = 0; h < 2; ++h)
#pragma unroll
                    for (int i = 0; i < 2; ++i) vnx[h][i] = v2[h][i]; } }
            const char* a1 = cA + (size_t)(t + 1) * kstep;
            const char* a2 = last ? nA : cA + (size_t)(t + 2) * kstep; const char* b2 = last ? nB : cB + (size_t)(t + 2) * kstep;
            const char* a3 = a2 + kstep; const char* b3 = b2 + kstep;
            PG8_LDB(B0, 0, 0); PG8_LDB(B1, 0, 1); PG8_SCHED; PG8_LDA(At, 0, 0); PG8_STAGEA(PG8_SA(1, 1), a1, va, 1);
            PG8_WAIT_V(8); PG8_WAIT_L(0); PG8_BAR; PG8_MMA(0, 0, At, B0); PG8_MMA(0, 1, At, B1); PG8_BAR; PG8_SCHED;
            PG8_LDA(At, 0, 1); PG8_STAGEB(PG8_SB(0, 0), b2); PG8_STAGEB(PG8_SB(0, 1), b2 + hstep); PG8_STAGEA(PG8_SA(0, 0), a2, v2, 0);
            PG8_WAIT_V(8); PG8_WAIT_L(0); PG8_BAR; PG8_MMA(1, 0, At, B0); PG8_MMA(1, 1, At, B1); PG8_BAR; PG8_SCHED;
            PG8_LDB(B0, 1, 0); PG8_LDB(B1, 1, 1); PG8_SCHED; PG8_LDA(At, 1, 0); PG8_STAGEA(PG8_SA(0, 1), a2, v2, 1);
            PG8_WAIT_V(8); PG8_WAIT_L(0); PG8_BAR; PG8_MMA(0, 0, At, B0); PG8_MMA(0, 1, At, B1); PG8_BAR; PG8_SCHED;
            PG8_LDA(At, 1, 1); PG8_STAGEB(PG8_SB(1, 0), b3); PG8_STAGEB(PG8_SB(1, 1), b3 + hstep); PG8_STAGEA(PG8_SA(1, 0), a3, v2, 0);
            PG8_WAIT_V(8); PG8_WAIT_L(0); PG8_BAR; PG8_MMA(1, 0, At, B0); PG8_MMA(1, 1, At, B1); PG8_BAR; PG8_SCHED;
        }
        if constexpr (FP8) asm volatile("s_nop 15\n\ts_nop 15\n\ts_nop 15\n\ts_nop 15" ::: "memory");
        if (wr == 0) PG8_BAR;
        const unsigned rf = S.refill_issue();
        E(acc, cur, wr, wc, fr, fq, lds, pre);
        S.refill_commit(ui, rf);
        if (!has_next) break;
#pragma unroll
        for (int a = 0; a < 2; ++a)
#pragma unroll
            for (int b = 0; b < 2; ++b)
#pragma unroll
                for (int m = 0; m < 4; ++m)
#pragma unroll
                    for (int n = 0; n < 2; ++n) acc[a][b][m][n] = (f32x4){0.f, 0.f, 0.f, 0.f};
        cur = nxt; cA = nA; cB = nB; ++ui;
        if constexpr (GATHER) {
#pragma unroll
            for (int h = 0; h < 2; ++h)
#pragma unroll
                for (int i = 0; i < 2; ++i) va[h][i] = vnx[h][i];
        }
        if (wr == 1) PG8_BAR;
    }
    PG8_WAIT_V(0);
    PG8_BAR;
#undef PG8_SA
#undef PG8_SB
#undef PG8_STAGEA
#undef PG8_STAGEB
#undef PG8_LDA
#undef PG8_LDB
#undef PG8_MMA
#undef PG8_WAIT_V
#undef PG8_WAIT_L
#undef PG8_BAR
#undef PG8_SCHED
}

template <class Epi, class Sched>
__device__ __forceinline__ void gemm_phase_ref(LAS unsigned char* lds, const Gemm g, const Sched& S, const Epi& E) {
    const int tid = threadIdx.x, wid = __builtin_amdgcn_readfirstlane(tid >> 6), lane = tid & 63, wr = wid >> 2, wc = wid & 3, fr = lane & 15, fq = lane >> 4;
    const int K = g.K, nt = K / BK;
    unsigned voffA[2], voffB[2];
#pragma unroll
    for (int i = 0; i < 2; ++i) { int R, C; stage_rc(tid * 16 + i * 8192, R, C); const int Rb = Epi::PERM ? ((R & ~31) + perm32(R & 31)) : R;
        voffA[i] = (unsigned)(R * K + C) * 2u; voffB[i] = (unsigned)(Rb * K + C) * 2u; }
    const size_t kstep = (size_t)(BK * 2), hstep = (size_t)HALF * K * 2, tstep = 2 * hstep;
    const unsigned ldsw = (unsigned)wid * 1024u;
    const int aoff = lds_byte(wr * 64 + fr, fq * 8), boff = lds_byte(wc * 32 + fr, fq * 8);
#define RSA(b, h) (((b) * 2 + (h)) * HTB)
#define RSB(b, h) ((4 + (b) * 2 + (h)) * HTB)
#define RSTAGE(bufoff, gbase, voff) do { _Pragma("unroll") for (int _i = 0; _i < 2; ++_i) \
        __builtin_amdgcn_global_load_lds((const unsigned*)((const char*)(gbase) + (voff)[_i]), (LAS unsigned*)(lds + (bufoff) + ldsw + _i * 8192), 16, 0, 0); } while (0)
#define RLDA(dst, b, h) do { _Pragma("unroll") for (int m = 0; m < 4; ++m) _Pragma("unroll") for (int k = 0; k < 2; ++k) dst[m][k] = *(const LAS bf16x8*)(lds + RSA(b, h) + aoff + m * 2048 + k * 1024); } while (0)
#define RLDB(dst, b, h) do { _Pragma("unroll") for (int n = 0; n < 2; ++n) _Pragma("unroll") for (int k = 0; k < 2; ++k) dst[n][k] = *(const LAS bf16x8*)(lds + RSB(b, h) + boff + n * 2048 + k * 1024); } while (0)
#define RMMA(ai, bj, At, Bt) do { __builtin_amdgcn_s_setprio(1); _Pragma("unroll") for (int m = 0; m < 4; ++m) _Pragma("unroll") for (int n = 0; n < 2; ++n) _Pragma("unroll") for (int k = 0; k < 2; ++k) \
        acc[ai][bj][m][n] = __builtin_amdgcn_mfma_f32_16x16x32_bf16(Bt[n][k], At[m][k], acc[ai][bj][m][n], 0, 0, 0); __builtin_amdgcn_s_setprio(0); } while (0)
#define RWV(n) asm volatile("s_waitcnt vmcnt(" #n ")" ::: "memory")
#define RWL(n) asm volatile("s_waitcnt lgkmcnt(" #n ")" ::: "memory")
#define RBAR __builtin_amdgcn_s_barrier()
#define RSCHED __builtin_amdgcn_sched_barrier(0)
    Unit cur, nxt; int ui = 0;
    if (!S.next(0, cur)) return;
    f32x4 acc[2][2][4][2];
#pragma unroll
    for (int a = 0; a < 2; ++a)
#pragma unroll
        for (int b = 0; b < 2; ++b)
#pragma unroll
            for (int m = 0; m < 4; ++m)
#pragma unroll
                for (int n = 0; n < 2; ++n) acc[a][b][m][n] = (f32x4){0.f, 0.f, 0.f, 0.f};
    bf16x8 At[4][2], B0[2][2], B1[2][2];
    const char* cA = (const char*)g.A + (size_t)cur.pm * tstep; const char* cB = (const char*)g.Bt + (size_t)cur.pn * tstep;
    RSTAGE(RSB(0, 0), cB, voffB); RSTAGE(RSB(0, 1), cB + hstep, voffB); RSTAGE(RSA(0, 0), cA, voffA); RSTAGE(RSA(0, 1), cA + hstep, voffA);
    if (wr == 1) RBAR;
    RWV(2); RBAR;
    RSTAGE(RSB(1, 0), cB + kstep, voffB); RSTAGE(RSA(1, 0), cA + kstep, voffA); RSTAGE(RSB(1, 1), cB + hstep + kstep, voffB);
    RWV(6); RBAR;
    for (;;) {
        const bool has_next = S.next(ui + 1, nxt);
        const char* nA = has_next ? (const char*)g.A + (size_t)nxt.pm * tstep : cA; const char* nB = has_next ? (const char*)g.Bt + (size_t)nxt.pn * tstep : cB;
        for (int t = 0; t < nt; t += 2) {
            const bool last = (t == nt - 2);
            const char* a1 = cA + (size_t)(t + 1) * kstep;
            const char* a2 = last ? nA : cA + (size_t)(t + 2) * kstep; const char* b2 = last ? nB : cB + (size_t)(t + 2) * kstep;
            const char* a3 = a2 + kstep; const char* b3 = b2 + kstep;
            RLDB(B0, 0, 0); RLDB(B1, 0, 1); RSCHED; RLDA(At, 0, 0); RSTAGE(RSA(1, 1), a1 + hstep, voffA);
            RWV(8); RWL(0); RBAR; RMMA(0, 0, At, B0); RMMA(0, 1, At, B1); RBAR; RSCHED;
            RLDA(At, 0, 1); RSTAGE(RSB(0, 0), b2, voffB); RSTAGE(RSB(0, 1), b2 + hstep, voffB); RSTAGE(RSA(0, 0), a2, voffA);
            RWV(8); RWL(0); RBAR; RMMA(1, 0, At, B0); RMMA(1, 1, At, B1); RBAR; RSCHED;
            RLDB(B0, 1, 0); RLDB(B1, 1, 1); RSCHED; RLDA(At, 1, 0); RSTAGE(RSA(0, 1), a2 + hstep, voffA);
            RWV(8); RWL(0); RBAR; RMMA(0, 0, At, B0); RMMA(0, 1, At, B1); RBAR; RSCHED;
            RLDA(At, 1, 1); RSTAGE(RSB(1, 0), b3, voffB); RSTAGE(RSB(1, 1), b3 + hstep, voffB); RSTAGE(RSA(1, 0), a3, voffA);
            RWV(8); RWL(0); RBAR; RMMA(1, 0, At, B0); RMMA(1, 1, At, B1); RBAR; RSCHED;
        }
        if (wr == 0) RBAR;
#pragma unroll
        for (int a = 0; a < 2; ++a)
#pragma unroll
            for (int b = 0; b < 2; ++b)
#pragma unroll
                for (int m = 0; m < 4; ++m)
#pragma unroll
                    for (int n = 0; n < 2; ++n) asm volatile("" :: "v"(acc[a][b][m][n]));
        if (!has_next) break;
#pragma unroll
        for (int a = 0; a < 2; ++a)
#pragma unroll
            for (int b = 0; b < 2; ++b)
#pragma unroll
                for (int m = 0; m < 4; ++m)
#pragma unroll
                    for (int n = 0; n < 2; ++n) acc[a][b][m][n] = (f32x4){0.f, 0.f, 0.f, 0.f};
        cur = nxt; cA = nA; cB = nB; ++ui;
        if (wr == 1) RBAR;
    }
    RWV(0);
    RBAR;
#undef RSA
#undef RSB
#undef RSTAGE
#undef RLDA
#undef RLDB
#undef RMMA
#undef RWV
#undef RWL
#undef RBAR
#undef RSCHED
}
}
struct PreNone { };
struct Pre8 { float v[8]; };
__device__ __forceinline__ unsigned pk4_fp8(float a, float b, float c, float d) { int w = __builtin_amdgcn_cvt_pk_fp8_f32(a, b, 0, false); w = __builtin_amdgcn_cvt_pk_fp8_f32(c, d, w, true); return (unsigned)w; }
template <bool F8>
struct EpiSwiGLU_T {
    static constexpr bool PERM = true;
    bf16_t* O; int ldo; const float* lrs; float wsc, osc;
    typedef PreNone Pre;
    __device__ __forceinline__ Pre pre(const pg8::Unit&, int, int) const { return Pre{}; }
    __device__ __forceinline__ void operator()(const f32x4 (&acc)[2][2][4][2], const pg8::Unit& u, int wr, int wc, int fr, int fq, LAS unsigned char*, const Pre&) const {
        struct { float v[8]; } pr;
#pragma unroll
        for (int i = 0; i < 8; ++i) pr.v[i] = lrs ? lrs[(size_t)u.e * T + u.arow + (i >> 2) * 128 + (i & 3) * 16 + wr * 64 + fr] : 1.f;
        const int r0 = wr * 64 + fr, col0 = u.pn * 128 + wc * 32 + 8 * fq;
#pragma unroll
        for (int ai = 0; ai < 2; ++ai) {
#pragma unroll
            for (int m = 0; m < 4; ++m) {
                const float s = pr.v[ai * 4 + m] * wsc; float o[8];
#pragma unroll
                for (int n = 0; n < 2; ++n)
#pragma unroll
                    for (int j = 0; j < 4; ++j) { const float gv = acc[ai][0][m][n][j] * s, uv = acc[ai][1][m][n][j] * s; o[n * 4 + j] = silu_f(gv) * uv; }
                if constexpr (F8) { u32x2 w; w.x = pk4_fp8(o[0] * osc, o[1] * osc, o[2] * osc, o[3] * osc); w.y = pk4_fp8(o[4] * osc, o[5] * osc, o[6] * osc, o[7] * osc);
                    *(u32x2*)((unsigned char*)O + (size_t)(u.orow + ai * 128 + m * 16 + r0) * ldo + col0) = w; }
                else { u32x4 w; w.x = cvt_pk_bf16(o[0], o[1]); w.y = cvt_pk_bf16(o[2], o[3]); w.z = cvt_pk_bf16(o[4], o[5]); w.w = cvt_pk_bf16(o[6], o[7]);
                    *(u32x4*)(O + (size_t)(u.orow + ai * 128 + m * 16 + r0) * ldo + col0) = w; }
            }
        }
    }
};
typedef EpiSwiGLU_T<false> EpiSwiGLU;
struct EpiRes {
    static constexpr bool PERM = false;
    float* H; bf16_t* HB; float* ssq; unsigned char* HB8;
    typedef PreNone Pre;
    __device__ __forceinline__ Pre pre(const pg8::Unit&, int, int) const { return Pre{}; }
    __device__ __forceinline__ void operator()(const f32x4 (&acc)[2][2][4][2], const pg8::Unit& u, int wr, int wc, int fr, int fq, LAS unsigned char*, const Pre&) const {
        const int r0 = u.orow + wr * 64 + fr, col0 = u.pn * 256 + wc * 32 + 4 * fq;
#pragma unroll
        for (int ai = 0; ai < 2; ++ai)
#pragma unroll
            for (int m = 0; m < 4; ++m) {
                const size_t off = (size_t)(r0 + ai * 128 + m * 16) * D + col0; float sq = 0.f;
#pragma unroll
                for (int bj = 0; bj < 2; ++bj)
#pragma unroll
                    for (int n = 0; n < 2; ++n) {
                        const f32x4 hv = *(const f32x4*)(H + off + bj * 128 + n * 16) + acc[ai][bj][m][n];
                        *(f32x4*)(H + off + bj * 128 + n * 16) = hv;
                        if (HB8) *(unsigned*)(HB8 + off + bj * 128 + n * 16) = pk4_fp8(hv[0], hv[1], hv[2], hv[3]);
                        else { u32x2 w; w.x = cvt_pk_bf16(hv[0], hv[1]); w.y = cvt_pk_bf16(hv[2], hv[3]); *(u32x2*)(HB + off + bj * 128 + n * 16) = w; }
                        sq += (hv[0] * hv[0] + hv[1] * hv[1]) + (hv[2] * hv[2] + hv[3] * hv[3]);
                    }
                if (ssq) { sq += __shfl_xor(sq, 16); sq += __shfl_xor(sq, 32);
                    if (fq == 0) ssq[(size_t)(r0 + ai * 128 + m * 16) * 16 + u.pn * 4 + wc] = sq; }
            }
    }
};
template <bool STORE>
struct EpiQKV_T {
    static constexpr bool PERM = true;
    bf16_t* O; const float* ssq;
    typedef Pre8 Pre;
    __device__ __forceinline__ Pre pre(const pg8::Unit& u, int, int) const { Pre p; const int tid = threadIdx.x, row = tid >> 1, part = tid & 1;
        const f32x4* q = (const f32x4*)(ssq + (size_t)(u.orow + row) * 16 + part * 8); const f32x4 a = q[0], b = q[1];
        p.v[0] = a[0]; p.v[1] = a[1]; p.v[2] = a[2]; p.v[3] = a[3]; p.v[4] = b[0]; p.v[5] = b[1]; p.v[6] = b[2]; p.v[7] = b[3]; return p; }
    __device__ __forceinline__ void operator()(const f32x4 (&acc)[2][2][4][2], const pg8::Unit& u, int wr, int wc, int fr, int fq, LAS unsigned char* lds, const Pre& pr) const {
        LAS float* rtab = (LAS float*)(lds + RTAB_OFF);
        { const int tid = threadIdx.x, row = tid >> 1, part = tid & 1;
          float s = ((pr.v[0] + pr.v[1]) + (pr.v[2] + pr.v[3])) + ((pr.v[4] + pr.v[5]) + (pr.v[6] + pr.v[7]));
          s += __shfl_xor(s, 1);
          if (part == 0) rtab[row] = 1.0f / sqrtf(s * (1.f / D) + EPS); }
        asm volatile("s_waitcnt lgkmcnt(0)" ::: "memory"); __builtin_amdgcn_s_barrier(); asm volatile("" ::: "memory");
        const float qs = (u.pn * 256 < 3072) ? 0.125f * 1.4426950408889634f : 1.f;
        const int r0 = wr * 64 + fr, col0 = u.pn * 256 + wc * 32 + 8 * fq;
#pragma unroll
        for (int ai = 0; ai < 2; ++ai)
#pragma unroll
            for (int m = 0; m < 4; ++m) {
                const float s = rtab[ai * 128 + m * 16 + r0] * qs;
#pragma unroll
                for (int bj = 0; bj < 2; ++bj) {
                    const f32x4 v0 = acc[ai][bj][m][0] * s, v1 = acc[ai][bj][m][1] * s;
                    u32x4 w; w.x = cvt_pk_bf16(v0[0], v0[1]); w.y = cvt_pk_bf16(v0[2], v0[3]); w.z = cvt_pk_bf16(v1[0], v1[1]); w.w = cvt_pk_bf16(v1[2], v1[3]);
                    if (STORE) *(u32x4*)(O + (size_t)(u.orow + ai * 128 + m * 16 + r0) * QKV_LD + col0 + bj * 128) = w; else asm volatile("" :: "v"(w));
                }
            }
    }
};
typedef EpiQKV_T<true> EpiQKV;
struct EpiNull {
    static constexpr bool PERM = true;
    typedef PreNone Pre;
    __device__ __forceinline__ Pre pre(const pg8::Unit&, int, int) const { return Pre{}; }
    __device__ __forceinline__ void operator()(const f32x4 (&acc)[2][2][4][2], const pg8::Unit& u, int wr, int wc, int fr, int fq, LAS unsigned char*, const Pre&) const {
#pragma unroll
        for (int ai = 0; ai < 2; ++ai)
#pragma unroll
            for (int bj = 0; bj < 2; ++bj)
#pragma unroll
                for (int m = 0; m < 4; ++m)
#pragma unroll
                    for (int n = 0; n < 2; ++n) asm volatile("" :: "v"(acc[ai][bj][m][n]));
    }
};
struct EpiY {
    static constexpr bool PERM = true;
    bf16_t* Y; bf16_t* Y2; int c0rows; float ysc;
    typedef PreNone Pre;
    __device__ __forceinline__ Pre pre(const pg8::Unit&, int, int) const { return Pre{}; }
    __device__ __forceinline__ void operator()(const f32x4 (&acc)[2][2][4][2], const pg8::Unit& u, int wr, int wc, int fr, int fq, LAS unsigned char*, const Pre&) const {
        bf16_t* Yb = u.koff ? Y2 : Y;
        const int r0 = (u.koff ? u.orow - c0rows : u.orow) + wr * 64 + fr, col0 = u.pn * 256 + wc * 32 + 8 * fq;
#pragma unroll
        for (int ai = 0; ai < 2; ++ai)
#pragma unroll
            for (int m = 0; m < 4; ++m)
#pragma unroll
                for (int bj = 0; bj < 2; ++bj) {
                    const f32x4 v0 = acc[ai][bj][m][0] * ysc, v1 = acc[ai][bj][m][1] * ysc;
                    u32x4 w; w.x = cvt_pk_bf16(v0[0], v0[1]); w.y = cvt_pk_bf16(v0[2], v0[3]); w.z = cvt_pk_bf16(v1[0], v1[1]); w.w = cvt_pk_bf16(v1[2], v1[3]);
                    *(u32x4*)(Yb + (size_t)(r0 + ai * 128 + m * 16) * D + col0 + bj * 128) = w;
                }
    }
};

constexpr int MI_CNT = 0, MI_TB = 8, MI_NT = 17, MI_SPLIT0 = 18, MI_C1 = 19;
__device__ __forceinline__ void moe_info_build(LAS unsigned char* lds, const unsigned* ctl) {
    volatile LAS int* mi = (volatile LAS int*)(lds + SCR_OFF);
    if (threadIdx.x == 0) { int tb = 0;
        for (int e = 0; e < NE; ++e) { const int c = (int)__hip_atomic_load(ctl + CW_CNT + e, RLX_AGENT); mi[MI_CNT + e] = c; mi[MI_TB + e] = tb; tb += (c + 255) >> 8; }
        mi[MI_TB + NE] = tb; mi[MI_NT] = tb; const int c1 = tb > LAST_TILES ? tb - LAST_TILES : 0; mi[MI_C1] = c1; mi[MI_SPLIT0] = c1 * 256; }
    LDS_WAIT(); __syncthreads();
}
struct DynQ {
    unsigned* ctr; volatile LAS unsigned* slot;
    __device__ __forceinline__ void start() const { if (threadIdx.x == 0) { slot[0] = blockIdx.x; slot[1] = gridDim.x + atomicAdd(ctr, 1u); } LDS_WAIT(); __syncthreads(); }
#ifdef MK_STATICQ
    __device__ __forceinline__ int fetch(int i) const { return i * (int)gridDim.x + (int)blockIdx.x; }
#else
    __device__ __forceinline__ int fetch(int i) const { return __builtin_amdgcn_readfirstlane((int)slot[i & 3]); }
#endif
    __device__ __forceinline__ unsigned refill_issue() const { unsigned v = 0u; if (threadIdx.x == 0) v = gridDim.x + atomicAdd(ctr, 1u); return v; }
    __device__ __forceinline__ void refill_commit(int ui, unsigned v) const { if (threadIdx.x == 0) slot[(ui + 2) & 3] = v; }
};
template <int NN, bool G1>
struct MoeOrder {
    DynQ q; volatile LAS int* mi; int c0, ntc; const int* ltok;
    __device__ __forceinline__ void start() const { q.start(); }
    __device__ __forceinline__ unsigned refill_issue() const { return q.refill_issue(); }
    __device__ __forceinline__ void refill_commit(int ui, unsigned v) const { q.refill_commit(ui, v); }
    __device__ __forceinline__ bool next(int i, pg8::Unit& u) const {
        const int idx = q.fetch(i); if (idx >= ntc * NN) return false;
        const int grp = idx / (8 * NN), r = idx - grp * (8 * NN), gsz = (ntc - grp * 8) < 8 ? (ntc - grp * 8) : 8;
        const int pml = grp * 8 + r % gsz, pn = r / gsz, pmg = c0 + pml;
        int e = 0;
#pragma unroll
        for (int k = 1; k < NE; ++k) e += (pmg >= mi[MI_TB + k]) ? 1 : 0;
        e = __builtin_amdgcn_readfirstlane(e);
        u.pm = pmg; u.pn = pn; u.e = e; u.koff = 0;
        if (!G1 && NN == 8) { u.pn = pn & 3; u.koff = (pn >> 2) * (FF1 / 4); }
        const int pnb = u.pn;
        if (G1) { u.arow = (pmg - __builtin_amdgcn_readfirstlane(mi[MI_TB + e])) * 256; u.brow = e * (2 * FF1) + pn * 256; u.orow = pml * 256; }
        else { u.arow = pml * 256; u.brow = e * D + pnb * 256; u.orow = pmg * 256; }
        return true;
    }
    __device__ __forceinline__ unsigned gather_row(const pg8::Unit& u, int r) const {
        const int lr = u.arow + r; const int c = mi[MI_CNT + u.e];
        return lr < c ? (unsigned)ltok[(size_t)u.e * T + lr] : 0u;
    }
};
struct Args { const float* in[19]; float* out; unsigned char* ws; int ph_lo, ph_hi, li, pad; };
enum { I_X = 0, I_ANORM, I_APROJ, I_ASCALE, I_KVNORM, I_WKV, I_BNORM, I_WQ, I_WO, I_RELB, I_FFNORM, I_DWG, I_DWU, I_DWD, I_ROUTER, I_MWG, I_MWU, I_MWD, I_FNORM };
struct Frame {
    LAS unsigned char* lds; unsigned* ctl; int tid, lane, wave, G, bid;
    float* h; unsigned char* ws;
};
__device__ __forceinline__ void conv_item(const float* W, int ldw, const float* gain, bf16_t* WT, int K, int dst_row0, LAS float* scr, int k0, int n0, int lane) {
    float wv[32];
#pragma unroll
    for (int i = 0; i < 32; ++i) wv[i] = W[(size_t)(k0 + 2 * i + (lane >> 5)) * ldw + n0 + (lane & 31)];
    if (gain) {
#pragma unroll
        for (int i = 0; i < 32; ++i) wv[i] *= gain[k0 + 2 * i + (lane >> 5)];
    }
#pragma unroll
    for (int i = 0; i < 32; ++i) scr[(2 * i + (lane >> 5)) * 33 + (lane & 31)] = wv[i];
    LDS_WAIT(); asm volatile("" ::: "memory");
    const int c = lane & 7;
#pragma unroll
    for (int j = 0; j < 4; ++j) { const int n = (lane >> 3) + 8 * j; const LAS float* s = scr + (8 * c) * 33 + n;
        u32x4 o; o.x = pk2(s[0 * 33], s[1 * 33]); o.y = pk2(s[2 * 33], s[3 * 33]); o.z = pk2(s[4 * 33], s[5 * 33]); o.w = pk2(s[6 * 33], s[7 * 33]);
        *(u32x4*)(WT + (size_t)(dst_row0 + n) * K + k0 + 8 * c) = o; }
    LDS_WAIT(); asm volatile("" ::: "memory");
}
__device__ __forceinline__ void conv_job(const Frame& F, int& it0, const float* W, int K, int N, int ldw, const float* gain, bf16_t* WT, int mode, int row_off, LAS float* scr, int cg = 0) {
    const int nblk = N / 32, items = (K / 64) * nblk, NGW = (cg ? cg : F.G) * NWAVES;
    int it = it0;
    for (; it < items; it += NGW) {
        const int kb = it / nblk, nb = it - kb * nblk, n0 = nb * 32;
        const int dr = (mode == 0) ? (row_off + n0) : (row_off + (n0 >> 7) * 256 + (n0 & 127) + (mode == 2 ? 128 : 0));
        conv_item(W, ldw, gain, WT, K, dr, scr, kb * 64, n0, F.lane);
    }
    it0 = it - items;
}
__device__ __forceinline__ void conv_item8(const float* W, int ldw, const float* gain, float presc, unsigned char* WT8, int K, int dst_row0, LAS float* scr, int k0, int n0, int lane) {
    float wv[32];
#pragma unroll
    for (int i = 0; i < 32; ++i) wv[i] = W[(size_t)(k0 + 2 * i + (lane >> 5)) * ldw + n0 + (lane & 31)];
#pragma unroll
    for (int i = 0; i < 32; ++i) wv[i] *= gain ? gain[k0 + 2 * i + (lane >> 5)] * presc : presc;
#pragma unroll
    for (int i = 0; i < 32; ++i) scr[(2 * i + (lane >> 5)) * 33 + (lane & 31)] = wv[i];
    LDS_WAIT(); asm volatile("" ::: "memory");
    const int c = lane & 7;
#pragma unroll
    for (int j = 0; j < 4; ++j) { const int n = (lane >> 3) + 8 * j; const LAS float* s = scr + (8 * c) * 33 + n;
        u32x2 o; o.x = pk4_fp8(s[0 * 33], s[1 * 33], s[2 * 33], s[3 * 33]); o.y = pk4_fp8(s[4 * 33], s[5 * 33], s[6 * 33], s[7 * 33]);
        *(u32x2*)(WT8 + (size_t)(dst_row0 + n) * K + k0 + 8 * c) = o; }
    LDS_WAIT(); asm volatile("" ::: "memory");
}
__device__ __forceinline__ void conv_job8(const Frame& F, int& it0, const float* W, int K, int N, int ldw, const float* gain, float presc, unsigned char* WT8, int mode, int row_off, LAS float* scr) {
    const int nblk = N / 32, items = (K / 64) * nblk, NGW = F.G * NWAVES;
    int it = it0;
    for (; it < items; it += NGW) {
        const int kb = it / nblk, nb = it - kb * nblk, n0 = nb * 32;
        const int dr = (mode == 0) ? (row_off + n0) : (row_off + (n0 >> 7) * 256 + (n0 & 127) + (mode == 2 ? 128 : 0));
        conv_item8(W, ldw, gain, presc, WT8, K, dr, scr, kb * 64, n0, F.lane);
    }
    it0 = it - items;
}
__device__ __forceinline__ void conv_aproj(const Frame& F, const Args& A) {
    LAS float* scr = (LAS float*)(F.lds + RING_OFF + F.wave * 16384);
    int it = F.bid * NWAVES + F.wave;
    for (int g = 0; g < 4; ++g) conv_job(F, it, A.in[I_APROJ] + (size_t)g * 65536, 256, 256, 256, nullptr, (bf16_t*)(F.ws + WS_APT) + (size_t)g * 65536, 0, 0, scr);
}
__device__ __forceinline__ void conv_small(const Frame& F, const Args& A) {
    LAS float* scr = (LAS float*)(F.lds + RING_OFF + F.wave * 16384);
    int it = F.bid * NWAVES + F.wave;
    unsigned char* ws = F.ws;
    conv_job(F, it, A.in[I_DWG], D, FF0, FF0, nullptr, (bf16_t*)(ws + WS_WGU0), 1, 0, scr);
    conv_job(F, it, A.in[I_DWU], D, FF0, FF0, nullptr, (bf16_t*)(ws + WS_WGU0), 2, 0, scr);
}
__device__ __forceinline__ void conv_later(const Frame& F, const Args& A, int cb, int cg) {
    LAS float* scr = (LAS float*)(F.lds + RING_OFF + F.wave * 16384);
    int it = cb * NWAVES + F.wave;
    unsigned char* ws = F.ws;
    conv_job(F, it, A.in[I_DWD], FF0, D, D, nullptr, (bf16_t*)(ws + WS_WD0), 0, 0, scr, cg);
    conv_job(F, it, A.in[I_WQ], D, 3072, 3072, A.in[I_BNORM], (bf16_t*)(ws + WS_WQKV), 0, 0, scr, cg);
    conv_job(F, it, A.in[I_WKV], D, 6144, 6144, A.in[I_KVNORM], (bf16_t*)(ws + WS_WQKV), 0, 3072, scr, cg);
    conv_job(F, it, A.in[I_WO], D, D, D, nullptr, (bf16_t*)(ws + WS_WO), 0, 0, scr, cg);
}
__device__ __forceinline__ void conv_moe(const Frame& F, const Args& A) {
    LAS float* scr = (LAS float*)(F.lds + RING_OFF + F.wave * 16384);
    int it = F.bid * NWAVES + F.wave;
    unsigned char* ws = F.ws;
    for (int e = 0; e < NE; ++e) {
        conv_job8(F, it, A.in[I_MWG] + (size_t)e * D * FF1, D, FF1, FF1, A.in[I_FFNORM] + D, WGU_PRESC, ws + WS_WGU1 + (size_t)e * 2 * FF1 * D, 1, 0, scr);
        conv_job8(F, it, A.in[I_MWU] + (size_t)e * D * FF1, D, FF1, FF1, A.in[I_FFNORM] + D, WGU_PRESC, ws + WS_WGU1 + (size_t)e * 2 * FF1 * D, 2, 0, scr);
        conv_job8(F, it, A.in[I_MWD] + (size_t)e * FF1 * D, FF1, D, D, nullptr, WD_PRESC, ws + WS_WD1 + (size_t)e * D * FF1, 0, 0, scr);
    }
}

__device__ __forceinline__ void mixer_phase(const Frame& F, const Args& A) {
    LAS float* rs = (LAS float*)(F.lds + 0);
    LAS float* xn = (LAS float*)(F.lds + 512);
    LAS bf16_t* pl = (LAS bf16_t*)(F.lds + 512 + 80896);
    LAS float* sw = (LAS float*)(F.lds + 512 + 80896 + 33792);
    int tid_ = F.tid; asm volatile("" : "+v"(tid_));
    const int tid = tid_, lane = tid & 63, w = F.wave, fr = lane & 15, fq = lane >> 4;
    const bf16_t* apt = (const bf16_t*)(F.ws + WS_APT);
    bf16_t* hn0 = (bf16_t*)(F.ws + WS_S0);
    for (int tile = F.bid; tile < T / 64; tile += F.G) {
        const int t0 = tile * 64, s0 = t0 % SEQ, halo = s0 ? 15 : 0, nrows = 64 + halo;
#pragma unroll 1
        for (int jb = w; jb < nrows; jb += 5 * NWAVES) {
            f32x4 rv[5][4];
#pragma unroll
            for (int u = 0; u < 5; ++u) { const int jj = jb + u * NWAVES, jc = jj < nrows ? jj : nrows - 1; const f32x4* p = (const f32x4*)(A.in[I_X] + (size_t)(t0 - halo + jc) * D);
#pragma unroll
                for (int q = 0; q < 4; ++q) rv[u][q] = p[lane + 64 * q]; }
#pragma unroll
            for (int u = 0; u < 5; ++u) { float s = 0.f;
#pragma unroll
                for (int q = 0; q < 4; ++q) { const f32x4 v = rv[u][q]; s += (v[0] * v[0] + v[1] * v[1]) + (v[2] * v[2] + v[3] * v[3]); }
                s = wave_sum(s);
                const int jj = jb + u * NWAVES;
                if (lane == 0 && jj < nrows) rs[jj] = 1.0f / sqrtf(s * (1.f / D) + EPS); }
        }
        LDS_WAIT(); __syncthreads();
        float ss[4] = {0.f, 0.f, 0.f, 0.f};
        for (int g = 0; g < 4; ++g) {
            { const f32x4 gn = *(const f32x4*)(A.in[I_ANORM] + g * 256 + 4 * lane);
              f32x4 xv[10];
#pragma unroll
              for (int u = 0; u < 10; ++u) { const int jj = w + u * NWAVES, jc = jj < nrows ? jj : nrows - 1; xv[u] = *(const f32x4*)(A.in[I_X] + (size_t)(t0 - halo + jc) * D + g * 256 + 4 * lane); }
#pragma unroll
              for (int u = 0; u < 10; ++u) { const int jj = w + u * NWAVES; if (jj < nrows) { const float r = rs[jj]; const f32x4 v = xv[u];
                  *(LAS f32x4*)(xn + jj * 256 + 4 * lane) = (f32x4){v[0] * r * gn[0], v[1] * r * gn[1], v[2] * r * gn[2], v[3] * r * gn[3]}; } } }
            LDS_WAIT(); __syncthreads();
            { const int c4 = (tid & 63) * 4, win = 2 << g;
#pragma unroll 1
              for (int i = 0; i < 8; ++i) { const int r = (tid >> 6) + 8 * i, s = s0 + r, cnt = (s + 1 < win) ? (s + 1) : win;
                  f32x4 a = {0.f, 0.f, 0.f, 0.f};
                  for (int jj = 0; jj < cnt; ++jj) a += *(const LAS f32x4*)(xn + (halo + r - jj) * 256 + c4);
                  const f32x4 self = *(const LAS f32x4*)(xn + (halo + r) * 256 + c4); const float inv = 1.f / (float)cnt;
                  u32x2 o; o.x = pk2(a[0] * inv - self[0], a[1] * inv - self[1]); o.y = pk2(a[2] * inv - self[2], a[3] * inv - self[3]);
                  *(LAS u32x2*)(pl + r * 264 + c4) = o; } }
            LDS_WAIT(); __syncthreads();
            f32x4 acc[4][2];
#pragma unroll
            for (int m = 0; m < 4; ++m) { acc[m][0] = (f32x4){0.f, 0.f, 0.f, 0.f}; acc[m][1] = (f32x4){0.f, 0.f, 0.f, 0.f}; }
#pragma unroll
            for (int ks = 0; ks < 8; ++ks) {
                bf16x8 bfr[2], afr[4];
#pragma unroll
                for (int n = 0; n < 2; ++n) bfr[n] = *(const bf16x8*)(apt + (size_t)g * 65536 + (size_t)(32 * w + 16 * n + fr) * 256 + 32 * ks + 8 * fq);
#pragma unroll
                for (int m = 0; m < 4; ++m) afr[m] = *(const LAS bf16x8*)(pl + (16 * m + fr) * 264 + 32 * ks + 8 * fq);
#pragma unroll
                for (int m = 0; m < 4; ++m)
#pragma unroll
                    for (int n = 0; n < 2; ++n) acc[m][n] = __builtin_amdgcn_mfma_f32_16x16x32_bf16(bfr[n], afr[m], acc[m][n], 0, 0, 0);
            }
#pragma unroll
            for (int m = 0; m < 4; ++m)
#pragma unroll
                for (int n = 0; n < 2; ++n) { const int col = g * 256 + 32 * w + 16 * n + 4 * fq; const size_t off = (size_t)(t0 + 16 * m + fr) * D + col;
                    const f32x4 sc = *(const f32x4*)(A.in[I_ASCALE] + col); const f32x4 hv = *(const f32x4*)(A.in[I_X] + off) + acc[m][n] * sc;
                    *(f32x4*)(F.h + off) = hv; ss[m] += (hv[0] * hv[0] + hv[1] * hv[1]) + (hv[2] * hv[2] + hv[3] * hv[3]); }
        }
#pragma unroll
        for (int m = 0; m < 4; ++m) { float s = ss[m]; s += __shfl_xor(s, 16); s += __shfl_xor(s, 32); if (fq == 0) sw[(16 * m + fr) * 8 + w] = s; }
        VM_WAIT(); LDS_WAIT(); __syncthreads();
#pragma unroll 1
        for (int jb = w; jb < 64; jb += 4 * NWAVES) {
            f32x4 hv[4][4];
#pragma unroll
            for (int u = 0; u < 4; ++u) { const f32x4* p = (const f32x4*)(F.h + (size_t)(t0 + jb + u * NWAVES) * D);
#pragma unroll
                for (int q = 0; q < 4; ++q) hv[u][q] = p[lane + 64 * q]; }
#pragma unroll
            for (int u = 0; u < 4; ++u) { const int jr = jb + u * NWAVES; float s = 0.f;
#pragma unroll
                for (int q = 0; q < 8; ++q) s += sw[jr * 8 + q];
                const float r1 = 1.0f / sqrtf(s * (1.f / D) + EPS);
                u32x2* o = (u32x2*)(hn0 + (size_t)(t0 + jr) * D);
#pragma unroll
                for (int q = 0; q < 4; ++q) { const f32x4 v = hv[u][q]; const f32x4 gn = *(const f32x4*)(A.in[I_FFNORM] + 4 * (lane + 64 * q));
                    u32x2 ov; ov.x = pk2(v[0] * r1 * gn[0], v[1] * r1 * gn[1]); ov.y = pk2(v[2] * r1 * gn[2], v[3] * r1 * gn[3]); o[lane + 64 * q] = ov; } }
        }
        LDS_WAIT(); __syncthreads();
    }
}

__device__ __forceinline__ void router_phase(const Frame& F, const Args& A) {
    volatile LAS int* li = (volatile LAS int*)(F.lds + 0);
    volatile LAS float* lf = (volatile LAS float*)(F.lds + 2048);
    int* ltok = (int*)(F.ws + WS_LTOK); float* lrs = (float*)(F.ws + WS_LRS); u32x4* tinfo = (u32x4*)(F.ws + WS_TOKINFO);
    int tid_ = F.tid; asm volatile("" : "+v"(tid_));
    const int tid = tid_, lane = tid & 63, w = F.wave;
    const float* gain = A.in[I_FFNORM] + D;
    f32x4 wa[4][4], wb[4][4];
#pragma unroll
    for (int q = 0; q < 4; ++q) { const int c0 = 4 * (lane + 64 * q); const f32x4 gn = *(const f32x4*)(gain + c0);
#pragma unroll
        for (int j = 0; j < 4; ++j) { wa[q][j] = *(const f32x4*)(A.in[I_ROUTER] + (size_t)(c0 + j) * 8) * gn[j]; wb[q][j] = *(const f32x4*)(A.in[I_ROUTER] + (size_t)(c0 + j) * 8 + 4) * gn[j]; } }
    if (F.bid == 0 && tid < 128) ((u32x4*)(F.ws + WS_ZERO))[tid] = (u32x4){0u, 0u, 0u, 0u};
    for (int tile = F.bid; tile < T / 64; tile += F.G) {
        const int t0 = tile * 64;
        if (tid < 8) li[tid] = 0;
        LDS_WAIT(); __syncthreads();
        f32x4 v[4], vn[4];
        { const f32x4* p = (const f32x4*)(F.h + (size_t)(t0 + 8 * w) * D);
#pragma unroll
          for (int q = 0; q < 4; ++q) vn[q] = p[lane + 64 * q]; }
#pragma unroll 1
        for (int k = 0; k < 8; ++k) {
            const int tl = 8 * w + k;
#pragma unroll
            for (int q = 0; q < 4; ++q) v[q] = vn[q];
            if (k < 7) { const f32x4* p = (const f32x4*)(F.h + (size_t)(t0 + tl + 1) * D);
#pragma unroll
                for (int q = 0; q < 4; ++q) vn[q] = p[lane + 64 * q]; }
            float s = 0.f; f32x4 la = {0.f, 0.f, 0.f, 0.f}, lb = {0.f, 0.f, 0.f, 0.f};
#pragma unroll
            for (int q = 0; q < 4; ++q) { s += (v[q][0] * v[q][0] + v[q][1] * v[q][1]) + (v[q][2] * v[q][2] + v[q][3] * v[q][3]);
#pragma unroll
                for (int j = 0; j < 4; ++j) { la += wa[q][j] * v[q][j]; lb += wb[q][j] * v[q][j]; } }
            float red[9] = {s, la[0], la[1], la[2], la[3], lb[0], lb[1], lb[2], lb[3]};
#pragma unroll
            for (int o = 1; o < 64; o <<= 1) {
#pragma unroll
                for (int e = 0; e < 9; ++e) red[e] += __shfl_xor(red[e], o); }
            if (lane == 0) {
                const float r = 1.0f / sqrtf(red[0] * (1.f / D) + EPS);
                float lg[8];
#pragma unroll
                for (int e = 0; e < 8; ++e) lg[e] = red[1 + e] * r;
                float b1 = lg[0]; int i1 = 0;
#pragma unroll
                for (int e = 1; e < 8; ++e) if (lg[e] > b1) { b1 = lg[e]; i1 = e; }
                float b2 = -3.0e38f; int i2 = 0;
#pragma unroll
                for (int e = 0; e < 8; ++e) if (e != i1 && lg[e] > b2) { b2 = lg[e]; i2 = e; }
                const float e2 = expf(b2 - b1), g1 = 1.f / (1.f + e2), g2 = e2 / (1.f + e2);
                const int r1 = __hip_atomic_fetch_add((LAS int*)&li[i1], 1, __ATOMIC_RELAXED, __HIP_MEMORY_SCOPE_WORKGROUP), r2 = __hip_atomic_fetch_add((LAS int*)&li[i2], 1, __ATOMIC_RELAXED, __HIP_MEMORY_SCOPE_WORKGROUP);
                li[16 + tl * 4 + 0] = i1; li[16 + tl * 4 + 1] = i2; li[16 + tl * 4 + 2] = r1; li[16 + tl * 4 + 3] = r2;
                lf[tl * 4 + 0] = g1; lf[tl * 4 + 1] = g2; lf[tl * 4 + 2] = r;
            }
        }
        LDS_WAIT(); __syncthreads();
        if (tid < 8) li[8 + tid] = (int)atomicAdd(F.ctl + CW_CNT + tid, (unsigned)li[tid]);
        LDS_WAIT(); __syncthreads();
        if (tid < 64) {
            const int i1 = li[16 + tid * 4 + 0], i2 = li[16 + tid * 4 + 1], s1 = li[8 + i1] + li[16 + tid * 4 + 2], s2 = li[8 + i2] + li[16 + tid * 4 + 3];
            const float g1 = lf[tid * 4 + 0], g2 = lf[tid * 4 + 1], r = lf[tid * 4 + 2];
            ltok[(size_t)i1 * T + s1] = t0 + tid; lrs[(size_t)i1 * T + s1] = r;
            ltok[(size_t)i2 * T + s2] = t0 + tid; lrs[(size_t)i2 * T + s2] = r;
            u32x4 ti; ti.x = (unsigned)(s1 << 3 | i1); ti.y = (unsigned)(s2 << 3 | i2); ti.z = __builtin_bit_cast(unsigned, g1); ti.w = __builtin_bit_cast(unsigned, g2);
            tinfo[t0 + tid] = ti;
        }
        LDS_WAIT(); __syncthreads();
    }
}

__device__ __forceinline__ void final_phase(const Frame& F, const Args& A) {
    volatile LAS int* mi = (volatile LAS int*)(F.lds + SCR_OFF);
    const u32x4* tinfo = (const u32x4*)(F.ws + WS_TOKINFO); const bf16_t* Y = (const bf16_t*)(F.ws + WS_Y);
    int lane_ = F.lane; asm volatile("" : "+v"(lane_));
    const int lane = lane_;
    f32x4 gn[4];
#pragma unroll
    for (int q = 0; q < 4; ++q) gn[q] = *(const f32x4*)(A.in[I_FNORM] + 4 * (lane + 64 * q));
    const int stride = F.G * NWAVES; int t = F.bid * NWAVES + F.wave;
    const bf16_t* Y2 = (const bf16_t*)(F.ws + WS_Y2); const bf16_t* ZR = (const bf16_t*)(F.ws + WS_ZERO);
    f32x4 hv[4], hn[4]; u32x2 ya[4], yb[4], yan[4], ybn[4], za[4], zb[4], zan[4], zbn[4]; float g1n = 0.f, g2n = 0.f;
#define FIN_ISSUE(tt, HV, YA, YB, ZA, ZB, G1, G2) do { const u32x4 ti = tinfo[tt]; const unsigned tx = ti.x, ty = ti.y, gz = ti.z, gw = ti.w; \
        const int e1 = tx & 7, s1 = tx >> 3, e2 = ty & 7, s2 = ty >> 3; G1 = __uint_as_float(gz); G2 = __uint_as_float(gw); \
        const size_t r1 = (size_t)mi[MI_TB + e1] * 256 + s1, r2 = (size_t)mi[MI_TB + e2] * 256 + s2; \
        const size_t sp0 = (size_t)mi[MI_SPLIT0]; const u32x2* z1_ = r1 >= sp0 ? (const u32x2*)(Y2 + (r1 - sp0) * D) : (const u32x2*)ZR; const u32x2* z2_ = r2 >= sp0 ? (const u32x2*)(Y2 + (r2 - sp0) * D) : (const u32x2*)ZR; \
        const f32x4* p_ = (const f32x4*)(F.h + (size_t)(tt) * D); const u32x2* y1_ = (const u32x2*)(Y + r1 * D); const u32x2* y2_ = (const u32x2*)(Y + r2 * D); \
        _Pragma("unroll") for (int q = 0; q < 4; ++q) { HV[q] = p_[lane + 64 * q]; YA[q] = y1_[lane + 64 * q]; YB[q] = y2_[lane + 64 * q]; } \
        if (r1 >= sp0) { _Pragma("unroll") for (int q = 0; q < 4; ++q) ZA[q] = z1_[lane + 64 * q]; } else { _Pragma("unroll") for (int q = 0; q < 4; ++q) ZA[q] = (u32x2){0u, 0u}; } \
        if (r2 >= sp0) { _Pragma("unroll") for (int q = 0; q < 4; ++q) ZB[q] = z2_[lane + 64 * q]; } else { _Pragma("unroll") for (int q = 0; q < 4; ++q) ZB[q] = (u32x2){0u, 0u}; } } while (0)
    if (t < T) FIN_ISSUE(t, hn, yan, ybn, zan, zbn, g1n, g2n);
    for (; t < T; t += stride) {
        const float g1 = g1n, g2 = g2n;
#pragma unroll
        for (int q = 0; q < 4; ++q) { hv[q] = hn[q]; ya[q] = yan[q]; yb[q] = ybn[q]; za[q] = zan[q]; zb[q] = zbn[q]; }
        if (t + stride < T) FIN_ISSUE(t + stride, hn, yan, ybn, zan, zbn, g1n, g2n);
        f32x4 v[4]; float s = 0.f;
#pragma unroll
        for (int q = 0; q < 4; ++q) { const u32x2 a = ya[q], b = yb[q], a2 = za[q], b2 = zb[q];
            f32x4 o;
            o[0] = hv[q][0] + g1 * (bf2f((unsigned short)(a.x & 0xffff)) + bf2f((unsigned short)(a2.x & 0xffff))) + g2 * (bf2f((unsigned short)(b.x & 0xffff)) + bf2f((unsigned short)(b2.x & 0xffff)));
            o[1] = hv[q][1] + g1 * (bf2f((unsigned short)(a.x >> 16)) + bf2f((unsigned short)(a2.x >> 16))) + g2 * (bf2f((unsigned short)(b.x >> 16)) + bf2f((unsigned short)(b2.x >> 16)));
            o[2] = hv[q][2] + g1 * (bf2f((unsigned short)(a.y & 0xffff)) + bf2f((unsigned short)(a2.y & 0xffff))) + g2 * (bf2f((unsigned short)(b.y & 0xffff)) + bf2f((unsigned short)(b2.y & 0xffff)));
            o[3] = hv[q][3] + g1 * (bf2f((unsigned short)(a.y >> 16)) + bf2f((unsigned short)(a2.y >> 16))) + g2 * (bf2f((unsigned short)(b.y >> 16)) + bf2f((unsigned short)(b2.y >> 16)));
            v[q] = o; s += (o[0] * o[0] + o[1] * o[1]) + (o[2] * o[2] + o[3] * o[3]); }
        s = wave_sum(s);
        const float r = 1.0f / sqrtf(s * (1.f / D) + EPS);
        f32x4* p = (f32x4*)(F.h + (size_t)t * D);
#pragma unroll
        for (int q = 0; q < 4; ++q) p[lane + 64 * q] = (f32x4){v[q][0] * r * gn[q][0], v[q][1] * r * gn[q][1], v[q][2] * r * gn[q][2], v[q][3] * r * gn[q][3]};
    }
#undef FIN_ISSUE
}

__device__ __forceinline__ int t5_bucket(int n) {
    if (n < 16) return n;
    int large = 16 + (int)(log((double)n / 16.0) / log(128.0) * 16.0);
    return large < 31 ? large : 31;
}
typedef float f32x16 __attribute__((ext_vector_type(16)));
typedef short s16x4 __attribute__((ext_vector_type(4)));
constexpr int AT_TAB = 0;
constexpr int AT_BKT = 7680;
constexpr int AT_CNT = 9472;
constexpr int AT_V = 10240;
constexpr float L2E = 1.4426950408889634f;
constexpr size_t WS_AST_O = WS_POOL + 291 * MiB;
constexpr size_t WS_AST_M = WS_AST_O + 64 * MiB;
static_assert(WS_AST_M + 4 * MiB <= WS_END, "attention scratch");
constexpr unsigned PITCHB = QKV_LD * 2;
__device__ __forceinline__ s16x4 vtr(const LAS unsigned char* p) { return __builtin_bit_cast(s16x4, __builtin_amdgcn_ds_read_tr16_b64_v4i16((LAS s16x4*)p)); }
__device__ __forceinline__ float max3f(float a, float b, float c) { return fmaxf(fmaxf(a, b), c); }

#define AT_LOADS(KF, VR, ub, koff, voff) do { const unsigned ub_ = (ub); \
        _Pragma("unroll") for (int d0 = 0; d0 < 4; ++d0) KF[d0] = __builtin_bit_cast(bf16x8, __builtin_amdgcn_raw_buffer_load_b128(rsrc, (koff) + 32 * d0, ub_, 0)); \
        _Pragma("unroll") for (int i = 0; i < 4; ++i) VR[i] = __builtin_bit_cast(u32x4, __builtin_amdgcn_raw_buffer_load_b128(rsrc, (voff)[i], ub_, 0)); } while (0)
#define AT_SCORE(KF, VR, QF, tla) \
        _Pragma("unroll") for (int i = 0; i < 4; ++i) *(LAS u32x4*)(vwr + i * 512) = VR[i]; \
        { const LAS float* tl_ = (const LAS float*)(tla); _Pragma("unroll") for (int r = 0; r < 16; ++r) s[r] = tl_[(r & 3) + 8 * (r >> 2)]; } \
        _Pragma("unroll") for (int d0 = 0; d0 < 4; ++d0) s = __builtin_amdgcn_mfma_f32_32x32x16_bf16(KF[d0], QF[d0], s, 0, 0, 0);
#define AT_SOFTPV() do { \
        float rm = fmaxf(max3f(max3f(s[0], s[1], s[2]), max3f(s[3], s[4], s[5]), max3f(s[6], s[7], s[8])), max3f(max3f(s[9], s[10], s[11]), max3f(s[12], s[13], s[14]), s[15])); \
        { auto rr = __builtin_amdgcn_permlane32_swap(__float_as_uint(rm), __float_as_uint(rm), false, false); rm = fmaxf(__uint_as_float(rr[0]), __uint_as_float(rr[1])); } \
        if (__any(rm > M)) { const float Mn = fmaxf(M, rm), al = __builtin_amdgcn_exp2f(M - Mn); M = Mn; l *= al; \
            _Pragma("unroll") for (int r = 0; r < 16; ++r) { o0[r] *= al; o1[r] *= al; } } \
        float ps0 = 0.f, ps1 = 0.f; \
        _Pragma("unroll") for (int r = 0; r < 16; r += 2) { s[r] = __builtin_amdgcn_exp2f(s[r] - M); s[r + 1] = __builtin_amdgcn_exp2f(s[r + 1] - M); ps0 += s[r]; ps1 += s[r + 1]; } \
        l += ps0 + ps1; \
        u32x4 pw0, pw1; \
        pw0.x = cvt_pk_bf16(s[0], s[1]); pw0.y = cvt_pk_bf16(s[2], s[3]); pw0.z = cvt_pk_bf16(s[4], s[5]); pw0.w = cvt_pk_bf16(s[6], s[7]); \
        pw1.x = cvt_pk_bf16(s[8], s[9]); pw1.y = cvt_pk_bf16(s[10], s[11]); pw1.z = cvt_pk_bf16(s[12], s[13]); pw1.w = cvt_pk_bf16(s[14], s[15]); \
        const bf16x8 pa0 = __builtin_bit_cast(bf16x8, pw0), pa1 = __builtin_bit_cast(bf16x8, pw1); \
        LDS_WAIT(); \
        { const s16x4 a0 = vtr(vrd), a1 = vtr(vrd + 512), b0 = vtr(vrd + 1024), b1 = vtr(vrd + 1536); \
          const bf16x8 v0 = (bf16x8){a0[0], a0[1], a0[2], a0[3], a1[0], a1[1], a1[2], a1[3]}, v1 = (bf16x8){b0[0], b0[1], b0[2], b0[3], b1[0], b1[1], b1[2], b1[3]}; \
          o0 = __builtin_amdgcn_mfma_f32_32x32x16_bf16(v0, pa0, o0, 0, 0, 0); o0 = __builtin_amdgcn_mfma_f32_32x32x16_bf16(v1, pa1, o0, 0, 0, 0); } \
        { const s16x4 a0 = vtr(vrd + 2048), a1 = vtr(vrd + 2560), b0 = vtr(vrd + 3072), b1 = vtr(vrd + 3584); \
          const bf16x8 v0 = (bf16x8){a0[0], a0[1], a0[2], a0[3], a1[0], a1[1], a1[2], a1[3]}, v1 = (bf16x8){b0[0], b0[1], b0[2], b0[3], b1[0], b1[1], b1[2], b1[3]}; \
          o1 = __builtin_amdgcn_mfma_f32_32x32x16_bf16(v0, pa0, o1, 0, 0, 0); o1 = __builtin_amdgcn_mfma_f32_32x32x16_bf16(v1, pa1, o1, 0, 0, 0); } \
    } while (0)

#ifdef MK_ATT_TS
#define AT_TS(k) do { __builtin_amdgcn_sched_barrier(0); unsigned long long t_; asm volatile("s_memtime %0\n\ts_waitcnt lgkmcnt(0)" : "=s"(t_) :: "memory"); ts_acc[k] += t_ - ts_prev; ts_prev = t_; __builtin_amdgcn_sched_barrier(0); } while (0)
#else
#define AT_TS(k) do { } while (0)
#endif
template <int MODE>
__device__ __forceinline__ void attn_phase(const Frame& F, const Args& A, unsigned long long* ts_out = nullptr) {
#ifdef MK_ATT_TS
    unsigned long long ts_acc[6] = {0, 0, 0, 0, 0, 0}, ts_prev = 0;
    { unsigned long long t_; asm volatile("s_memtime %0\n\ts_waitcnt lgkmcnt(0)" : "=s"(t_) :: "memory"); ts_prev = t_; }
#endif
    LAS float* tab = (LAS float*)(F.lds + AT_TAB);
    const char* qkvb = (const char*)(F.ws + WS_QKV); bf16_t* mo = (bf16_t*)(F.ws + (MODE == 0 ? WS_S0 : WS_S1));
    float* sto = (float*)(F.ws + WS_AST_O); float* stm = (float*)(F.ws + WS_AST_M);
    int lane_ = F.lane; asm volatile("" : "+v"(lane_));
    const int lane = lane_, w = F.wave, j = lane & 31, hi = lane >> 5;
    LAS unsigned char* vbuf = F.lds + AT_V + w * 4096;
    LAS unsigned char* vwr = vbuf + ((lane & 7) >> 2) * 2048 + (lane >> 3) * 64 + (lane & 3) * 16;
    const LAS unsigned char* vrd = vbuf + (4 * hi + ((lane & 15) >> 2)) * 64 + ((lane >> 4) & 1) * 32 + (lane & 3) * 8;
    volatile LAS int* bkt = (volatile LAS int*)(F.lds + AT_BKT);
    volatile LAS int* acnt = (volatile LAS int*)(F.lds + AT_CNT);
    for (int i = F.tid; i < 3 * 129; i += NTHREADS) { const int g = i / 129, m = i - g * 129; bkt[i] = t5_bucket(m * (g == 0 ? 1 : (g == 1 ? 4 : 16))); }
    LDS_WAIT(); __syncthreads();
    const __amdgpu_buffer_rsrc_t rsrc = __builtin_amdgcn_make_buffer_rsrc((void*)(F.ws + WS_QKV), 0, (int)((size_t)T * PITCHB), 0x00020000);
    for (int it = 0; ; ++it) {
        int b, h, cp;
        { const int u = ((F.G & 7) == 0) ? ((F.bid & 7) * (F.G >> 3) + (F.bid >> 3)) + it * F.G : F.bid + it * F.G;
          if (u >= 256) break;
          b = u >> 5; h = (u >> 1) & 15; cp = u & 1; }
        const int tb = b * SEQ;
        __syncthreads();
        if (F.tid < 4) acnt[F.tid] = 0;
        for (int i = F.tid; i < 3 * 640; i += NTHREADS) { const int g = i / 640, m = 383 - (i - g * 640);
            tab[i] = (m >= 0 && m <= 128) ? A.in[I_RELB][bkt[g * 129 + m] * 48 + g * 16 + h] * L2E : -1e30f; }
        LDS_WAIT(); __syncthreads();
        AT_TS(5);
        const int c = 2 * cp + (w & 1);
        f32x16 o0, o1, s; float M, l;
        bf16x8 kfA[4], kfB[4]; u32x4 vrA[4], vrB[4];
#pragma unroll 1
        for (int rd = 0; rd < 4; ++rd) {
            const int r16 = c + 4 * (w >> 1), nt = rd + 1;
            const size_t tq = (size_t)(tb + 16 * (32 * rd + j) + r16);
            bf16x8 qf[4];
            { const char* qp = qkvb + tq * PITCHB + (2 * 1024 + h * 64 + 8 * hi) * 2;
#pragma unroll
              for (int d0 = 0; d0 < 4; ++d0) qf[d0] = *(const bf16x8*)(qp + 32 * d0); }
            const unsigned koff = (unsigned)(16 * j) * PITCHB + (3072 + 2 * 1024 + h * 64 + 8 * hi) * 2;
            unsigned voff[4];
#pragma unroll
            for (int i = 0; i < 4; ++i) voff[i] = (unsigned)(16 * (8 * i + (lane >> 3))) * PITCHB + (6144 + 2 * 1024 + h * 64 + 8 * (lane & 7)) * 2;
            const unsigned ub = (unsigned)(tb + r16) * PITCHB, ustep = (unsigned)(16 * 32) * PITCHB;
            const LAS float* tla = tab + 2 * 640 + 383 - (32 * rd + j) + 4 * hi;
#pragma unroll
            for (int r = 0; r < 16; ++r) { o0[r] = 0.f; o1[r] = 0.f; }
            M = -1e29f; l = 0.f;
#define AT_LOADA(m, KF, VR) do { int m_ = (m); m_ = m_ < nt ? m_ : nt - 1; if (MODE == 1) m_ = 0; AT_LOADS(KF, VR, ub + (unsigned)m_ * ustep, koff, voff); } while (0)
            AT_LOADA(0, kfA, vrA); AT_LOADA(1, kfB, vrB);
            AT_TS(0);
            int n = 0;
#pragma unroll 1
            for (; n + 1 < nt; n += 2) {
                AT_SCORE(kfA, vrA, qf, tla + 32 * n)
                AT_LOADA(n + 2, kfA, vrA);
                AT_SOFTPV();
                AT_SCORE(kfB, vrB, qf, tla + 32 * (n + 1))
                AT_LOADA(n + 3, kfB, vrB);
                AT_SOFTPV();
            }
            if (n < nt) { AT_SCORE(kfA, vrA, qf, tla + 32 * n) AT_SOFTPV(); }
            AT_TS(1);
#undef AT_LOADA
            float* so = sto + ((tq * 16 + h) * 2 + hi) * 32;
#pragma unroll
            for (int r = 0; r < 16; r += 4) { *(f32x4*)(so + r) = (f32x4){o0[r], o0[r + 1], o0[r + 2], o0[r + 3]}; *(f32x4*)(so + 16 + r) = (f32x4){o1[r], o1[r + 1], o1[r + 2], o1[r + 3]}; }
            *(f32x2*)(stm + ((tq * 16 + h) * 2 + hi) * 2) = (f32x2){M, l};
            VM_WAIT();
            if (lane == 0) __hip_atomic_fetch_add((LAS int*)&acnt[rd], 1, __ATOMIC_RELAXED, __HIP_MEMORY_SCOPE_WORKGROUP);
            AT_TS(2);
        }
        AT_TS(3);
#pragma unroll 1
        for (int rd = 0; rd < 4; ++rd) {
            const int i0 = 32 * (4 * rd + (w >> 1));
            const int ktlo0 = (4 - i0 / 8) > 0 ? (4 - i0 / 8) : 0, n0 = 8 - ktlo0;
            const int ktlo1 = (4 - i0 / 32) > 0 ? (4 - i0 / 32) : 0, n1 = 5 - ktlo1, ntl = n0 + n1;
            const size_t tq = (size_t)(tb + 4 * (i0 + j) + c);
            bf16x8 qf0[4], qf1[4];
            { const char* qp = qkvb + tq * PITCHB + (h * 64 + 8 * hi) * 2;
#pragma unroll
              for (int d0 = 0; d0 < 4; ++d0) { qf0[d0] = *(const bf16x8*)(qp + 32 * d0); qf1[d0] = *(const bf16x8*)(qp + 2048 + 32 * d0); } }
            while (__builtin_amdgcn_readfirstlane(acnt[rd]) < NWAVES) __builtin_amdgcn_s_sleep(2);
            asm volatile("" ::: "memory");
            { const float* so = sto + ((tq * 16 + h) * 2 + hi) * 32;
#pragma unroll
              for (int r = 0; r < 16; r += 4) { const f32x4 a = *(const f32x4*)(so + r), bq = *(const f32x4*)(so + 16 + r);
                  o0[r] = a[0]; o0[r + 1] = a[1]; o0[r + 2] = a[2]; o0[r + 3] = a[3]; o1[r] = bq[0]; o1[r + 1] = bq[1]; o1[r + 2] = bq[2]; o1[r + 3] = bq[3]; }
              const f32x2 ml = *(const f32x2*)(stm + ((tq * 16 + h) * 2 + hi) * 2); M = ml[0]; l = ml[1]; }
            const int kb0 = 4 * i0 - 128 + 32 * ktlo0, ik1 = i0 - 128 + 32 * ktlo1;
            const unsigned koff0 = (unsigned)j * PITCHB + (3072 + h * 64 + 8 * hi) * 2, koff1 = (unsigned)(4 * j) * PITCHB + (3072 + 1024 + h * 64 + 8 * hi) * 2;
            unsigned voff0[4], voff1[4];
#pragma unroll
            for (int i = 0; i < 4; ++i) { voff0[i] = (unsigned)(8 * i + (lane >> 3)) * PITCHB + (6144 + h * 64 + 8 * (lane & 7)) * 2;
                                          voff1[i] = (unsigned)(4 * (8 * i + (lane >> 3))) * PITCHB + (6144 + 1024 + h * 64 + 8 * (lane & 7)) * 2; }
            const unsigned ub0 = (unsigned)(tb + kb0) * PITCHB, ub1 = (unsigned)(tb + 4 * ik1 + c) * PITCHB;
            const unsigned us0 = 32u * PITCHB, us1 = 128u * PITCHB;
            const LAS float* tla0 = tab + 383 - (4 * (i0 + j) + c - kb0) + 4 * hi;
            const LAS float* tla1 = tab + 640 + 383 - (i0 + j - ik1) + 4 * hi;
#define AT_LOADN(m, KF, VR) do { int m_ = (m); m_ = m_ < ntl ? m_ : ntl - 1; if (m_ < n0) AT_LOADS(KF, VR, ub0 + (unsigned)(MODE == 1 ? 0 : m_) * us0, koff0, voff0); else AT_LOADS(KF, VR, ub1 + (unsigned)(MODE == 1 ? 0 : m_ - n0) * us1, koff1, voff1); } while (0)
#define AT_STEPN(n, KF, VR, PF) do { const int n_ = (n); if (n_ < n0) { AT_SCORE(KF, VR, qf0, tla0 + 32 * n_) } else { AT_SCORE(KF, VR, qf1, tla1 + 32 * (n_ - n0)) } \
            if (PF) AT_LOADN(n_ + 2, KF, VR); AT_SOFTPV(); } while (0)
            AT_LOADN(0, kfA, vrA); AT_LOADN(1, kfB, vrB);
            AT_TS(0);
            int n = 0;
#pragma unroll 1
            for (; n + 1 < ntl; n += 2) { AT_STEPN(n, kfA, vrA, true); AT_STEPN(n + 1, kfB, vrB, true); }
            if (n < ntl) AT_STEPN(n, kfA, vrA, false);
            AT_TS(4);
#undef AT_STEPN
#undef AT_LOADN
            { auto rr = __builtin_amdgcn_permlane32_swap(__float_as_uint(l), __float_as_uint(l), false, false); l = __uint_as_float(rr[0]) + __uint_as_float(rr[1]); }
            const float il = 1.0f / l;
            bf16_t* op = mo + tq * D + h * 64 + 4 * hi;
#pragma unroll
            for (int gq = 0; gq < 4; ++gq) {
                u32x2 w0, w1;
                w0.x = cvt_pk_bf16(o0[4 * gq] * il, o0[4 * gq + 1] * il); w0.y = cvt_pk_bf16(o0[4 * gq + 2] * il, o0[4 * gq + 3] * il);
                w1.x = cvt_pk_bf16(o1[4 * gq] * il, o1[4 * gq + 1] * il); w1.y = cvt_pk_bf16(o1[4 * gq + 2] * il, o1[4 * gq + 3] * il);
                *(u32x2*)(op + 8 * gq) = w0; *(u32x2*)(op + 32 + 8 * gq) = w1;
            }
            AT_TS(2);
        }
    }
#ifdef MK_ATT_TS
    if (ts_out && F.tid == 0) { for (int k = 0; k < 6; ++k) ts_out[k] = ts_acc[k]; }
#endif
    __syncthreads();
}
#undef AT_LOADS
#undef AT_SCORE
#undef AT_SOFTPV
constexpr int PH_MIX = 0, PH_FF1 = 1, PH_FF2 = 2, PH_QKV = 3, PH_ATT = 4, PH_WO = 5, PH_ROUTE = 6, PH_MOE0 = 7, PH_FINAL = 10, PH_END = 11;

__global__ void __launch_bounds__(NTHREADS, 2) mk_fwd(Args args) {
    extern __shared__ __attribute__((aligned(16))) unsigned char lds_raw[];
    Frame F;
    F.lds = (LAS unsigned char*)lds_raw;
    F.tid = threadIdx.x; F.lane = F.tid & 63; F.wave = __builtin_amdgcn_readfirstlane(F.tid >> 6); F.G = gridDim.x; F.bid = blockIdx.x;
    F.ws = args.ws; F.ctl = (unsigned*)(args.ws + WS_CTL); F.h = args.out;
    volatile LAS unsigned* MISC = (volatile LAS unsigned*)(F.lds + MISC_OFF);
    for (int u = F.tid; u < 64; u += NTHREADS) MISC[u] = 0u;
    __syncthreads();
    XcdBarrier bar = xcd_barrier_post(F.ctl + CW_BAR + args.li * XCD_BAR_WORDS, MISC + 8);
    const int lo = args.ph_lo, hi = args.ph_hi;
#ifndef MK_MASK
#define MK_MASK 0xffffffffu
#endif
#define IN(k) (((MK_MASK >> (k)) & 1u) && lo <= (k) && (k) < hi)
#define SEAM(k) do { if (IN(k) && IN((k) + 1)) xcd_barrier(bar); } while (0)
    unsigned char* ws = args.ws;
    LAS unsigned char* ring = F.lds + RING_OFF;
#ifdef MK_PROBE_LO
    unsigned long long pr_t0 = 0, pr_t1 = 0;
#define PROBE_AT(k) do { if ((k) == MK_PROBE_LO) pr_t0 = __builtin_amdgcn_s_memrealtime(); if ((k) == MK_PROBE_HI) pr_t1 = __builtin_amdgcn_s_memrealtime(); } while (0)
#else
#define PROBE_AT(k) do { } while (0)
#endif

    PROBE_AT(0);
    if (IN(PH_MIX)) { conv_aproj(F, args); conv_small(F, args); VM_WAIT(); __syncthreads(); }
    PROBE_AT(20);
    if (IN(PH_MIX)) { xcd_barrier(bar); PROBE_AT(21); mixer_phase(F, args); }
    PROBE_AT(22);
    SEAM(PH_MIX);

    PROBE_AT(1);
    if (IN(PH_FF1)) {
        pg8::Gemm g{(const bf16_t*)(ws + WS_S0), (const bf16_t*)(ws + WS_WGU0), D, D, D}; pg8::StaticOrder S; S.init(T, 2 * FF0, F.G, F.bid);
        EpiSwiGLU E{(bf16_t*)(ws + WS_ACT0), ACT0_LD, nullptr, 1.f, 1.f};
        pg8::gemm_phase<EpiSwiGLU, pg8::StaticOrder, false>(ring, g, S, E);
        { const int units = (T / 256) * (2 * FF0 / 256), rem = units % F.G;
          if (rem == 0) conv_later(F, args, F.bid, F.G); else if (F.bid >= rem) conv_later(F, args, F.bid - rem, F.G - rem); }
    }
    SEAM(PH_FF1);
    PROBE_AT(2);
    if (IN(PH_FF2)) {
        pg8::Gemm g{(const bf16_t*)(ws + WS_ACT0), (const bf16_t*)(ws + WS_WD0), FF0, ACT0_LD, FF0}; pg8::StaticOrder S; S.init(T, D, F.G, F.bid);
        EpiRes E{F.h, (bf16_t*)(ws + WS_S1), (float*)(ws + WS_SSQ), nullptr};
        pg8::gemm_phase<EpiRes, pg8::StaticOrder, false>(ring, g, S, E);
    }
    SEAM(PH_FF2);
    PROBE_AT(3);
    if (IN(PH_QKV)) {
        pg8::Gemm g{(const bf16_t*)(ws + WS_S1), (const bf16_t*)(ws + WS_WQKV), D, D, D}; pg8::StaticOrder S; S.init(T, NQKV, F.G, F.bid);
        EpiQKV E{(bf16_t*)(ws + WS_QKV), (const float*)(ws + WS_SSQ)};
        pg8::gemm_phase<EpiQKV, pg8::StaticOrder, false>(ring, g, S, E);
#if defined(MK_QKV_EXTRA) && MK_QKV_EXTRA == 1
        pg8::gemm_phase<EpiQKV, pg8::StaticOrder, false>(ring, g, S, E);
#elif defined(MK_QKV_EXTRA) && MK_QKV_EXTRA == 4
        { EpiNull EN; pg8::gemm_phase_ref<EpiNull, pg8::StaticOrder>(ring, g, S, EN); }
#elif defined(MK_QKV_EXTRA) && MK_QKV_EXTRA == 3
        { EpiQKV_T<false> EN{(bf16_t*)(ws + WS_QKV), (const float*)(ws + WS_SSQ)}; pg8::gemm_phase<EpiQKV_T<false>, pg8::StaticOrder, false>(ring, g, S, EN); }
#elif defined(MK_QKV_EXTRA) && MK_QKV_EXTRA == 2
        { EpiNull EN; pg8::gemm_phase<EpiNull, pg8::StaticOrder, false>(ring, g, S, EN); }
#endif
    }
    SEAM(PH_QKV);
        PROBE_AT(4);
#ifdef MK_ATT_TS
    unsigned long long att_ts[6] = {0, 0, 0, 0, 0, 0};
    if (IN(PH_ATT)) { attn_phase<0>(F, args, att_ts);
#else
    if (IN(PH_ATT)) { attn_phase<0>(F, args);
#endif
#ifdef MK_ATT_EXTRA
        attn_phase<MK_ATT_EXTRA>(F, args);
#endif
    }
    SEAM(PH_ATT);
    PROBE_AT(5);
    if (IN(PH_WO)) {
        pg8::Gemm g{(const bf16_t*)(ws + WS_S0), (const bf16_t*)(ws + WS_WO), D, D, D}; pg8::StaticOrder S; S.init(T, D, F.G, F.bid);
        EpiRes E{F.h, (bf16_t*)(ws + WS_S1), nullptr, ws + WS_S1};
        pg8::gemm_phase<EpiRes, pg8::StaticOrder, false>(ring, g, S, E);
        conv_moe(F, args);
    }
    SEAM(PH_WO);
    PROBE_AT(6);
    if (IN(PH_ROUTE)) { router_phase(F, args); }
    SEAM(PH_ROUTE);
#pragma unroll 1
    for (int j = 0; j < 3; ++j) {
        PROBE_AT(7 + j);
        if (IN(PH_MOE0 + j)) {
            moe_info_build(F.lds, F.ctl);
            volatile LAS int* mi = (volatile LAS int*)(F.lds + SCR_OFF);
            const int ntiles = __builtin_amdgcn_readfirstlane(mi[MI_NT]);
            const int c1s = __builtin_amdgcn_readfirstlane(mi[MI_C1]);
            if (j >= 1) {
                const int c0 = j == 1 ? 0 : c1s; const int ntc = j == 1 ? c1s : ntiles - c1s;
                EpiY E{(bf16_t*)(ws + WS_Y), (bf16_t*)(ws + WS_Y2), c0 * 256, 1.f / (WD_PRESC * ACT_PRESC)};
                if (j == 2) {
                    pg8::Gemm g{(const bf16_t*)(ws + WS_ACT1 + ACT1_B1), (const bf16_t*)(ws + WS_WD1), FF1 / 4, FF1 / 2, FF1 / 2};
                    MoeOrder<8, false> S{{F.ctl + CW_Q + 64 * (2 * j), MISC + 16}, mi, c0, ntc, nullptr};
                    pg8::gemm_phase<EpiY, MoeOrder<8, false>, false, true>(ring, g, S, E);
                } else {
                    pg8::Gemm g{(const bf16_t*)(ws + WS_ACT1), (const bf16_t*)(ws + WS_WD1), FF1 / 2, FF1 / 2, FF1 / 2};
                    MoeOrder<4, false> S{{F.ctl + CW_Q + 64 * (2 * j), MISC + 16}, mi, c0, ntc, nullptr};
                    pg8::gemm_phase<EpiY, MoeOrder<4, false>, false, true>(ring, g, S, E);
                }
            }
            if (j <= 1) {
                const int c0 = j == 0 ? 0 : c1s; const int ntc = j == 0 ? c1s : ntiles - c1s;
                pg8::Gemm g{(const bf16_t*)(ws + WS_S1), (const bf16_t*)(ws + WS_WGU1), D / 2, D / 2, D / 2};
                MoeOrder<28, true> S{{F.ctl + CW_Q + 64 * (2 * j + 1), MISC + 16}, mi, c0, ntc, (const int*)(ws + WS_LTOK)};
                EpiSwiGLU_T<true> E{(bf16_t*)(ws + WS_ACT1 + (j ? ACT1_B1 : (size_t)0)), FF1, (const float*)(ws + WS_LRS), 1.f / WGU_PRESC, ACT_PRESC};
                pg8::gemm_phase<EpiSwiGLU_T<true>, MoeOrder<28, true>, true, true>(ring, g, S, E);
            }
        }
        SEAM(PH_MOE0 + j);
    }
#ifdef MK_EXTRA_BARS
    for (int i = 0; i < MK_EXTRA_BARS; ++i) xcd_barrier(bar);
#endif
    PROBE_AT(10);
    if (IN(PH_FINAL)) { moe_info_build(F.lds, F.ctl); final_phase(F, args); }
    PROBE_AT(11);
#ifdef MK_ATT_TS
    if (F.bid == 0 && F.wave == 0) { const unsigned long long dt = att_ts[MK_ATT_TS] / 5ull, ts = __builtin_amdgcn_s_memrealtime(); while (__builtin_amdgcn_s_memrealtime() - ts < dt) __builtin_amdgcn_s_sleep(8); }
#endif
#ifdef MK_PROBE_LO
    { const unsigned long long dt = (pr_t1 - pr_t0) * MK_PROBE_MULT, ts = __builtin_amdgcn_s_memrealtime(); while (__builtin_amdgcn_s_memrealtime() - ts < dt) __builtin_amdgcn_s_sleep(8); }
#endif
#undef IN
#undef SEAM
}
}
extern "C" void kernel_launch(void* const* d_in, const int* in_sizes, int n_in, void* d_out, int out_size, void* d_ws, size_t ws_size, hipStream_t stream) {
    static int grid = 0;
    if (grid == 0) {
        if (n_in != 19 || out_size != mk::T * mk::D || ws_size < mk::WS_END) { fprintf(stderr, "kernel_launch: unexpected shapes / workspace (%d inputs, out %d, ws %zu)\n", n_in, out_size, ws_size); grid = -1; return; }
        int dev = 0, cus = 0;
        if (hipGetDevice(&dev) != hipSuccess || hipDeviceGetAttribute(&cus, hipDeviceAttributeMultiprocessorCount, dev) != hipSuccess) { grid = -1; return; }
        if (hipFuncSetAttribute((const void*)mk::mk_fwd, hipFuncAttributeMaxDynamicSharedMemorySize, mk::LDS_BYTES) != hipSuccess) { fprintf(stderr, "kernel_launch: hipFuncSetAttribute failed\n"); grid = -1; return; }
        int per_cu = 0;
        if (hipOccupancyMaxActiveBlocksPerMultiprocessor(&per_cu, (const void*)mk::mk_fwd, mk::NTHREADS, mk::LDS_BYTES) != hipSuccess || per_cu < 1) { fprintf(stderr, "kernel_launch: occupancy query says %d blocks per CU\n", per_cu); }
        (void)hipGetLastError();
        grid = cus;
    }
    if (grid < 0) return;
    (void)hipMemsetAsync((char*)d_ws + mk::WS_CTL, 0, mk::CTL_ZERO_BYTES, stream);
    mk::Args a{};
    for (int i = 0; i < 19; ++i) a.in[i] = (const float*)d_in[i];
    a.out = (float*)d_out; a.ws = (unsigned char*)d_ws;
    a.ph_lo = 0; a.ph_hi = mk::PH_END; a.li = 0;
    hipLaunchKernelGGL(mk::mk_fwd, dim3(grid), dim3(mk::NTHREADS), mk::LDS_BYTES, stream, a);
}
```

```cpp
#include <hip/hip_runtime.h>
#include <cstdio>
#include <cstdint>
namespace mk {
#define LAS __attribute__((address_space(3)))
#define GAS __attribute__((address_space(1)))
typedef unsigned short bf16_t;
typedef short bf16x8 __attribute__((ext_vector_type(8)));
typedef float f32x4 __attribute__((ext_vector_type(4)));
typedef float f32x2 __attribute__((ext_vector_type(2)));
typedef unsigned u32x4 __attribute__((ext_vector_type(4)));
typedef unsigned u32x2 __attribute__((ext_vector_type(2)));

constexpr int T = 16384, D = 1024, SEQ = 2048, NBATCH = 8;
constexpr int FF0 = 2816, FF1 = 3584, NE = 8, NQKV = 9216;
constexpr int ACT0_LD = FF0 + 64;
constexpr int QKV_LD = NQKV + 64;
constexpr float EPS = 1e-6f;
constexpr float WGU_PRESC = 32.f, WD_PRESC = 64.f, ACT_PRESC = 4.f;
constexpr int NWAVES = 8, NTHREADS = 512;

constexpr size_t MiB = 1u << 20;
constexpr size_t WS_CTL = 0, CTL_ZERO_BYTES = 1 * MiB;
constexpr size_t WS_SSQ = 1 * MiB;
constexpr size_t WS_LTOK = 2 * MiB;
constexpr size_t WS_LRS = 2 * MiB + 512 * 1024;
constexpr size_t WS_TOKINFO = 3 * MiB;
constexpr size_t WS_ZERO = 3 * MiB + 256 * 1024;
constexpr size_t WS_APT = 3 * MiB + 512 * 1024;
constexpr size_t WS_WGU0 = 4 * MiB;
constexpr size_t WS_WD0 = 15 * MiB;
constexpr size_t WS_WQKV = WS_WD0 + (size_t)D * FF0 * 2;
constexpr size_t WS_WO = WS_WQKV + (size_t)NQKV * D * 2;
constexpr size_t WS_S0 = 41 * MiB;
constexpr size_t WS_S1 = 73 * MiB;
constexpr size_t WS_POOL = 105 * MiB;
constexpr size_t WS_ACT0 = WS_POOL;
constexpr size_t WS_QKV = WS_POOL;
constexpr int LAST_TILES = 32;
constexpr int CH0_CAP = 136 - LAST_TILES;
constexpr size_t ACT1_B1 = (size_t)CH0_CAP * 256 * FF1;
constexpr size_t WS_ACT1 = WS_POOL;
constexpr size_t WS_Y = 4 * MiB;
constexpr size_t WS_Y2 = WS_ACT1 + ACT1_B1 + (size_t)LAST_TILES * 256 * FF1;
constexpr size_t WS_WGU1 = 306 * MiB;
constexpr size_t WS_WD1 = 418 * MiB;
constexpr size_t WS_END = 474 * MiB;
static_assert(WS_WO + (size_t)D * D * 2 <= WS_S0, "small weights");
static_assert(WS_Y2 + (size_t)LAST_TILES * 256 * D * 2 <= WS_WGU1 && WS_Y + (size_t)34816 * D * 2 <= WS_S1, "moe map");
static_assert(WS_WGU1 + (size_t)NE * 7168 * D * 2 <= WS_WD1 && WS_WD1 + (size_t)NE * D * FF1 * 2 <= WS_END, "moe weights");
static_assert(WS_QKV + (size_t)T * QKV_LD * 2 <= WS_END, "qkv");

constexpr int CW_TMO = 0;
constexpr int CW_CNT = 64;
constexpr int CW_Q = 128;
constexpr int CW_BAR = 4096;

constexpr int RING_OFF = 0, RING_BYTES = 131072;
constexpr int MISC_OFF = RING_BYTES;
constexpr int RTAB_OFF = MISC_OFF + 1024;
constexpr int SCR_OFF = MISC_OFF + 2048;
constexpr int TOKT_OFF = SCR_OFF + 1024;
constexpr int LRST_OFF = SCR_OFF + 2048;
constexpr int LDS_BYTES = 147456;

#define RLX_AGENT __ATOMIC_RELAXED, __HIP_MEMORY_SCOPE_AGENT
#define LDS_WAIT() asm volatile("s_waitcnt lgkmcnt(0)" ::: "memory")
#define VM_WAIT() asm volatile("s_waitcnt vmcnt(0)" ::: "memory")
__device__ __forceinline__ unsigned f2bf(float f) { unsigned u = __builtin_bit_cast(unsigned, f); return (u + 0x7fffu + ((u >> 16) & 1u)) >> 16; }
__device__ __forceinline__ unsigned pk2(float lo, float hi) { return f2bf(lo) | (f2bf(hi) << 16); }
__device__ __forceinline__ unsigned cvt_pk_bf16(float lo, float hi) { unsigned r; asm volatile("v_cvt_pk_bf16_f32 %0, %1, %2" : "=v"(r) : "v"(lo), "v"(hi)); return r; }
__device__ __forceinline__ float bf2f(unsigned short b) { return __builtin_bit_cast(float, ((unsigned)b) << 16); }
__device__ __forceinline__ float wave_sum(float v) {
#pragma unroll
    for (int o = 1; o < 64; o <<= 1) v += __shfl_xor(v, o);
    return v;
}
__device__ __forceinline__ float silu_f(float x) { return x * __builtin_amdgcn_rcpf(1.f + __builtin_amdgcn_exp2f(-1.4426950408889634f * x)); }
#define XB_TMO      128
#define XB_XCNT(j)  (256  + 64 * (j))
#define XB_XSUB(j)  (1280 + 64 * (j))
#define XB_XGEN(j)  (2304 + 64 * (j))
#define XB_TOP      3328
#define XB_TOPGEN   3392
#define XCD_BAR_WORDS 3456
#define XB_SPIN_CAP (1u << 18)
__device__ __forceinline__ unsigned xb_ld(unsigned* p)              { return __hip_atomic_load(p, __ATOMIC_RELAXED, __HIP_MEMORY_SCOPE_AGENT); }
__device__ __forceinline__ unsigned xb_add(unsigned* p, unsigned v) { return __hip_atomic_fetch_add(p, v, __ATOMIC_RELAXED, __HIP_MEMORY_SCOPE_AGENT); }
__device__ __forceinline__ unsigned xb_xcc_id() { return (unsigned)__builtin_amdgcn_s_getreg((3 << 11) | 20) & 0xFu; }
#define XB_SPIN(cond, bar) do { unsigned _sp = 0; while (cond) { __builtin_amdgcn_s_sleep(1); \
    if ((++_sp & 255u) == 0u) { if (xb_ld(&(bar)[XB_TMO])) break; if (_sp > XB_SPIN_CAP) { atomicAdd(&(bar)[XB_TMO], 1u); break; } } } } while (0)
struct XcdBarrier { unsigned* bar; unsigned x; volatile LAS unsigned* st; };
__device__ __forceinline__ XcdBarrier xcd_barrier_post(unsigned* bar, volatile LAS unsigned* st) {
    XcdBarrier b; b.bar = bar; b.x = xb_xcc_id(); b.st = st;
    if (threadIdx.x == 0) (void)xb_add(&bar[XB_XCNT(b.x)], 1u);
    return b;
}
__device__ __forceinline__ void xcd_barrier_complete(unsigned* bar, unsigned x, unsigned& nloc, unsigned& nx) {
    const unsigned G = gridDim.x * gridDim.y * gridDim.z;
    unsigned sum, cnt, mine, sp = 0u;
    for (;;) {
        sum = 0u; cnt = 0u; mine = 0u;
#pragma unroll
        for (unsigned j = 0; j < 16; ++j) { const unsigned c = xb_ld(&bar[XB_XCNT(j)]); sum += c; cnt += (c > 0u) ? 1u : 0u; mine = (j == x) ? c : mine; }
        if (sum == G) break;
        __builtin_amdgcn_s_sleep(1);
        if ((++sp & 255u) == 0u) { if (xb_ld(&bar[XB_TMO])) break; if (sp > XB_SPIN_CAP) { atomicAdd(&bar[XB_TMO], 1u); break; } }
    }
    nloc = mine > 0u ? mine : 1u; nx = cnt > 0u ? cnt : 1u;
}
__device__ __forceinline__ void xcd_barrier(const XcdBarrier& b) {
    asm volatile("s_waitcnt vmcnt(0)" ::: "memory");
    __syncthreads();
    if (threadIdx.x == 0) {
        unsigned* bar = b.bar;
        __builtin_amdgcn_s_waitcnt(0);
        unsigned nloc = b.st[0], nx = b.st[1];
        if (nloc == 0u) { xcd_barrier_complete(bar, b.x, nloc, nx); b.st[0] = nloc; b.st[1] = nx; }
        const unsigned old = xb_add(&bar[XB_XSUB(b.x)], 1u);
        const unsigned gen = old / nloc;
        if (old + 1u == (gen + 1u) * nloc) {
            __builtin_amdgcn_fence(__ATOMIC_RELEASE, "agent");
            asm volatile("s_waitcnt vmcnt(0)" ::: "memory");
            const unsigned og = xb_add(&bar[XB_TOP], 1u);
            const unsigned tg = og / nx;
            if (og + 1u == (tg + 1u) * nx) xb_add(&bar[XB_TOPGEN], 1u);
            else XB_SPIN(xb_ld(&bar[XB_TOPGEN]) == tg, bar);
            __builtin_amdgcn_fence(__ATOMIC_ACQUIRE, "agent");
            xb_add(&bar[XB_XGEN(b.x)], 1u);
            asm volatile("s_waitcnt vmcnt(0)" ::: "memory");
        } else {
            XB_SPIN(xb_ld(&bar[XB_XGEN(b.x)]) == gen, bar);
            __builtin_amdgcn_fence(__ATOMIC_ACQUIRE, "agent");
            asm volatile("s_waitcnt vmcnt(0)" ::: "memory");
        }
    }
    __syncthreads();
}
namespace pg8 {
typedef int v4i __attribute__((ext_vector_type(4)));
typedef int v8i __attribute__((ext_vector_type(8)));
constexpr int BM = 256, BK = 64, HALF = 128, HTB = HALF * BK * 2, STAGE_BYTES = 8 * HTB, NXCD = 8, WGM = 4;
__host__ __device__ __forceinline__ int lds_byte(int r, int c) { const int st = (r >> 4) * 2 + (c >> 5), rr = r & 15, cc = c & 31, ob = rr * 64 + cc * 2; return st * 1024 + (ob ^ (((ob >> 9) & 1) << 5)); }
__host__ __device__ __forceinline__ void stage_rc(int b, int& R, int& C) { const int st = b / 1024, sb = b % 1024, swz = sb ^ (((sb >> 9) & 1) << 5); R = (st >> 1) * 16 + swz / 64; C = (st & 1) * 32 + (swz % 64) / 2; }
__host__ __device__ __forceinline__ int perm32(int rho) { const int n = rho >> 4, i = rho & 15; return 8 * (i >> 2) + 4 * n + (i & 3); }

struct Unit { int pm, pn, arow, brow, e, orow, koff; };
struct Gemm { const bf16_t* A; const bf16_t* Bt; int K; int lda; int ldb; };

struct StaticOrder {
    int nM, nN, nwg, G, c;
    __device__ void init(int M, int N, int G_, int c_) { nM = M / BM; nN = N / BM; nwg = nM * nN; G = G_; c = c_; }
    __device__ __forceinline__ void start() const {}
    __device__ __forceinline__ bool next(int i, Unit& u) const {
        const long L = (long)i * G + c; if (L >= nwg) return false;
        int wgid = (int)L; { const int q = nwg / NXCD, r = nwg % NXCD, xcd = wgid % NXCD, off = wgid / NXCD; wgid = (xcd < r ? xcd * (q + 1) : r * (q + 1) + (xcd - r) * q) + off; }
        const int nig = WGM * nN, gid = wgid / nig, fm = gid * WGM, gsz = (nM - fm) < WGM ? (nM - fm) : WGM;
        u.pm = fm + ((wgid % nig) % gsz); u.pn = (wgid % nig) / gsz; u.arow = u.pm * BM; u.brow = u.pn * BM; u.e = 0; u.orow = u.arow; u.koff = 0; return true;
    }
    __device__ __forceinline__ unsigned refill_issue() const { return 0u; }
    __device__ __forceinline__ void refill_commit(int, unsigned) const {}
    __device__ __forceinline__ unsigned gather_row(const Unit&, int) const { return 0u; }
};

template <class Epi, class Sched, bool GATHER, bool FP8 = false>
__device__ __forceinline__ void gemm_phase(LAS unsigned char* lds, const Gemm g, Sched& S, const Epi& E) {
    int tid_ = threadIdx.x; asm volatile("" : "+v"(tid_));
    const int tid = tid_, wid = __builtin_amdgcn_readfirstlane(tid >> 6), lane = tid & 63, wr = wid >> 2, wc = wid & 3, fr = lane & 15, fq = lane >> 4;
    int K_ = g.K; asm volatile("" : "+s"(K_));
    const int K = K_, nt = K / BK, LDA = g.lda, LDB = g.ldb;
    unsigned voffB[2]; unsigned va[2][2];
    const size_t kstep = (size_t)(BK * 2);
    const size_t hstep = (size_t)HALF * LDB * 2, hstepA = (size_t)HALF * LDA * 2;
#pragma unroll
    for (int i = 0; i < 2; ++i) { int R, C; stage_rc(tid * 16 + i * 8192, R, C); const int Rb = Epi::PERM ? ((R & ~31) + perm32(R & 31)) : R;
        voffB[i] = (unsigned)(Rb * LDB + C) * 2u;
        va[0][i] = (unsigned)(R * LDA + C) * 2u; va[1][i] = va[0][i] + (unsigned)hstepA; }
    const unsigned ldsw = (unsigned)wid * 1024u;
    const int aoff0 = lds_byte(wr * 64 + fr, FP8 ? 16 * fq : 8 * fq), aoff1 = lds_byte(wr * 64 + fr, FP8 ? 16 * fq + 8 : 8 * fq + 32);
    const int boff0 = lds_byte(wc * 32 + fr, FP8 ? 16 * fq : 8 * fq), boff1 = lds_byte(wc * 32 + fr, FP8 ? 16 * fq + 8 : 8 * fq + 32);
#define PG8_SA(b, h) (((b) * 2 + (h)) * HTB)
#define PG8_SB(b, h) ((4 + (b) * 2 + (h)) * HTB)
#define PG8_STAGEB(bufoff, gbase) do { _Pragma("unroll") for (int _i = 0; _i < 2; ++_i) \
        __builtin_amdgcn_global_load_lds((const unsigned*)((const char*)(gbase) + voffB[_i]), (LAS unsigned*)(lds + (bufoff) + ldsw + _i * 8192), 16, 0, 0); } while (0)
#define PG8_STAGEA(bufoff, gbase, vo, h) do { _Pragma("unroll") for (int _i = 0; _i < 2; ++_i) \
        __builtin_amdgcn_global_load_lds((const unsigned*)((const char*)(gbase) + (vo)[h][_i]), (LAS unsigned*)(lds + (bufoff) + ldsw + _i * 8192), 16, 0, 0); } while (0)
#define PG8_CAT8(p0, p1) __builtin_shufflevector(__builtin_bit_cast(v4i, *(const LAS bf16x8*)(p0)), __builtin_bit_cast(v4i, *(const LAS bf16x8*)(p1)), 0, 1, 2, 3, 4, 5, 6, 7)
#define PG8_LDA(dst, b, h) do { _Pragma("unroll") for (int m = 0; m < 4; ++m) { \
        if constexpr (FP8) dst##8[m] = PG8_CAT8(lds + PG8_SA(b, h) + aoff0 + m * 2048, lds + PG8_SA(b, h) + aoff0 + m * 2048 + 16);   \
        else { dst[m][0] = *(const LAS bf16x8*)(lds + PG8_SA(b, h) + aoff0 + m * 2048); dst[m][1] = *(const LAS bf16x8*)(lds + PG8_SA(b, h) + aoff1 + m * 2048); } } } while (0)
#define PG8_LDB(dst, b, h) do { _Pragma("unroll") for (int n = 0; n < 2; ++n) { \
        if constexpr (FP8) dst##8[n] = PG8_CAT8(lds + PG8_SB(b, h) + boff0 + n * 2048, lds + PG8_SB(b, h) + boff0 + n * 2048 + 16); \
        else { dst[n][0] = *(const LAS bf16x8*)(lds + PG8_SB(b, h) + boff0 + n * 2048); dst[n][1] = *(const LAS bf16x8*)(lds + PG8_SB(b, h) + boff1 + n * 2048); } } } while (0)
#define PG8_MMA(ai, bj, At, Bt) do { __builtin_amdgcn_s_setprio(1); _Pragma("unroll") for (int m = 0; m < 4; ++m) _Pragma("unroll") for (int n = 0; n < 2; ++n) { \
        if constexpr (FP8) asm volatile("v_mfma_scale_f32_16x16x128_f8f6f4 %0, %1, %2, %0, %3, %3 op_sel_hi:[0,0,0]" : "+v"(acc[ai][bj][m][n]) : "v"(Bt##8[n]), "v"(At##8[m]), "v"(sc8));   \
        else { _Pragma("unroll") for (int k = 0; k < 2; ++k) acc[ai][bj][m][n] = __builtin_amdgcn_mfma_f32_16x16x32_bf16(Bt[n][k], At[m][k], acc[ai][bj][m][n], 0, 0, 0); } } \
        __builtin_amdgcn_s_setprio(0); } while (0)
#define PG8_WAIT_V(n) asm volatile("s_waitcnt vmcnt(" #n ")" ::: "memory")
#define PG8_WAIT_L(n) asm volatile("s_waitcnt lgkmcnt(" #n ")" ::: "memory")
#define PG8_BAR __builtin_amdgcn_s_barrier()
#define PG8_SCHED __builtin_amdgcn_sched_barrier(0)
    int sc8 = 0x7f7f7f7f; asm volatile("" : "+v"(sc8));
    Unit cur, nxt; int ui = 0;
    typename Epi::Pre pre{};
#ifdef MK_STAGGER
    { const unsigned long long dt = (unsigned long long)((blockIdx.x >> 3) & 7) * MK_STAGGER, ts = __builtin_amdgcn_s_memrealtime(); while (__builtin_amdgcn_s_memrealtime() - ts < dt) __builtin_amdgcn_s_sleep(4); }
#endif
    S.start();
    if (!S.next(0, cur)) return;
    f32x4 acc[2][2][4][2];
#pragma unroll
    for (int a = 0; a < 2; ++a)
#pragma unroll
        for (int b = 0; b < 2; ++b)
#pragma unroll
            for (int m = 0; m < 4; ++m)
#pragma unroll
                for (int n = 0; n < 2; ++n) acc[a][b][m][n] = (f32x4){0.f, 0.f, 0.f, 0.f};
    bf16x8 At[4][2], B0[2][2], B1[2][2]; v8i At8[4], B08[2], B18[2];
    const char* cA; const char* cB = (const char*)g.Bt + ((size_t)cur.brow * LDB + cur.koff) * 2;
    if constexpr (GATHER) { cA = (const char*)g.A;
#pragma unroll
        for (int h = 0; h < 2; ++h)
#pragma unroll
            for (int i = 0; i < 2; ++i) { int R, C; stage_rc(tid * 16 + i * 8192, R, C); va[h][i] = (S.gather_row(cur, h * HALF + R) * (unsigned)LDA + (unsigned)C) * 2u; }
    } else cA = (const char*)g.A + ((size_t)cur.arow * LDA + cur.koff) * 2;
    PG8_STAGEB(PG8_SB(0, 0), cB); PG8_STAGEB(PG8_SB(0, 1), cB + hstep); PG8_STAGEA(PG8_SA(0, 0), cA, va, 0); PG8_STAGEA(PG8_SA(0, 1), cA, va, 1);
    if (wr == 1) PG8_BAR;
    PG8_WAIT_V(2); PG8_BAR;
    PG8_STAGEB(PG8_SB(1, 0), cB + kstep); PG8_STAGEA(PG8_SA(1, 0), cA + kstep, va, 0); PG8_STAGEB(PG8_SB(1, 1), cB + hstep + kstep);
    PG8_WAIT_V(6); PG8_BAR;
    for (;;) {
        bool has_next = false; const char* nA = cA; const char* nB = cB;
        unsigned vnx[2][2] = {{0u, 0u}, {0u, 0u}};
#pragma unroll 1
        for (int t = 0; t < nt; t += 2) {
            const bool last = (t == nt - 2);
            unsigned v2[2][2];
#pragma unroll
            for (int h = 0; h < 2; ++h)
#pragma unroll
                for (int i = 0; i < 2; ++i) v2[h][i] = va[h][i];
            if constexpr (GATHER) { if (t == nt - 4) {
                has_next = S.next(ui + 1, nxt);
                if (has_next) __builtin_amdgcn_global_load_lds((const unsigned*)S.gather_src(nxt, tid & 255), (LAS unsigned*)(lds + TOKT_OFF + (wid & 3) * 256), 4, 0, 0);
            } }
            if constexpr (Epi::DMA_PRE) { if (t == nt - 4) E.dma_pre(cur, tid, wid, lds); }
            if (last) {
                pre = E.pre(cur, wr, fr);
                if constexpr (!GATHER) has_next = S.next(ui + 1, nxt);
                if (has_next) { nB = (const char*)g.Bt + ((size_t)nxt.brow * LDB + nxt.koff) * 2;
                    if constexpr (GATHER) {
#pragma unroll
                        for (int h = 0; h < 2; ++h)
#pragma unroll
                            for (int i = 0; i < 2; ++i) { int R, C; stage_rc(tid * 16 + i * 8192, R, C); v2[h][i] = (((volatile LAS unsigned*)(lds + TOKT_OFF))[h * HALF + R] * (unsigned)LDA + (unsigned)C) * 2u; }
                    } else nA = (const char*)g.A + ((size_t)nxt.arow * LDA + nxt.koff) * 2;
                }
            }
            if constexpr (GATHER) { if (last) {
#pragma unroll
                for (int h = 0; h < 2; ++h)
#pragma unroll
                    for (int i = 0; i < 2; ++i) vnx[h][i] = v2[h][i]; } }
            const char* a1 = cA + (size_t)(t + 1) * kstep;
            const char* a2 = last ? nA : cA + (size_t)(t + 2) * kstep; const char* b2 = last ? nB : cB + (size_t)(t + 2) * kstep;
            const char* a3 = a2 + kstep; const char* b3 = b2 + kstep;
            PG8_LDB(B0, 0, 0); PG8_LDB(B1, 0, 1); PG8_SCHED; PG8_LDA(At, 0, 0); PG8_STAGEA(PG8_SA(1, 1), a1, va, 1);
            PG8_WAIT_V(8); PG8_WAIT_L(0); PG8_BAR; PG8_MMA(0, 0, At, B0); PG8_MMA(0, 1, At, B1); PG8_BAR; PG8_SCHED;
            PG8_LDA(At, 0, 1); PG8_STAGEB(PG8_SB(0, 0), b2); PG8_STAGEB(PG8_SB(0, 1), b2 + hstep); PG8_STAGEA(PG8_SA(0, 0), a2, v2, 0);
            PG8_WAIT_V(8); PG8_WAIT_L(0); PG8_BAR; PG8_MMA(1, 0, At, B0); PG8_MMA(1, 1, At, B1); PG8_BAR; PG8_SCHED;
            PG8_LDB(B0, 1, 0); PG8_LDB(B1, 1, 1); PG8_SCHED; PG8_LDA(At, 1, 0); PG8_STAGEA(PG8_SA(0, 1), a2, v2, 1);
            PG8_WAIT_V(8); PG8_WAIT_L(0); PG8_BAR; PG8_MMA(0, 0, At, B0); PG8_MMA(0, 1, At, B1); PG8_BAR; PG8_SCHED;
            PG8_LDA(At, 1, 1); PG8_STAGEB(PG8_SB(1, 0), b3); PG8_STAGEB(PG8_SB(1, 1), b3 + hstep); PG8_STAGEA(PG8_SA(1, 0), a3, v2, 0);
            PG8_WAIT_V(8); PG8_WAIT_L(0); PG8_BAR; PG8_MMA(1, 0, At, B0); PG8_MMA(1, 1, At, B1); PG8_BAR; PG8_SCHED;
        }
        if constexpr (FP8) asm volatile("s_nop 15\n\ts_nop 15\n\ts_nop 15\n\ts_nop 15" ::: "memory");
        if (wr == 0) PG8_BAR;
        const unsigned rf = S.refill_issue();
        E(acc, cur, wr, wc, fr, fq, lds, pre);
        S.refill_commit(ui, rf);
        if (!has_next) break;
#pragma unroll
        for (int a = 0; a < 2; ++a)
#pragma unroll
            for (int b = 0; b < 2; ++b)
#pragma unroll
                for (int m = 0; m < 4; ++m)
#pragma unroll
                    for (int n = 0; n < 2; ++n) acc[a][b][m][n] = (f32x4){0.f, 0.f, 0.f, 0.f};
        cur = nxt; cA = nA; cB = nB; ++ui;
        if constexpr (GATHER) {
#pragma unroll
            for (int h = 0; h < 2; ++h)
#pragma unroll
                for (int i = 0; i < 2; ++i) va[h][i] = vnx[h][i];
        }
        if (wr == 1) PG8_BAR;
    }
    PG8_WAIT_V(0);
    PG8_BAR;
#undef PG8_SA
#undef PG8_SB
#undef PG8_STAGEA
#undef PG8_STAGEB
#undef PG8_LDA
#undef PG8_LDB
#undef PG8_MMA
#undef PG8_WAIT_V
#undef PG8_WAIT_L
#undef PG8_BAR
#undef PG8_SCHED
}

template <class Epi, class Sched>
__device__ __forceinline__ void gemm_phase_ref(LAS unsigned char* lds, const Gemm g, const Sched& S, const Epi& E) {
    const int tid = threadIdx.x, wid = __builtin_amdgcn_readfirstlane(tid >> 6), lane = tid & 63, wr = wid >> 2, wc = wid & 3, fr = lane & 15, fq = lane >> 4;
    const int K = g.K, nt = K / BK;
    unsigned voffA[2], voffB[2];
#pragma unroll
    for (int i = 0; i < 2; ++i) { int R, C; stage_rc(tid * 16 + i * 8192, R, C); const int Rb = Epi::PERM ? ((R & ~31) + perm32(R & 31)) : R;
        voffA[i] = (unsigned)(R * K + C) * 2u; voffB[i] = (unsigned)(Rb * K + C) * 2u; }
    const size_t kstep = (size_t)(BK * 2), hstep = (size_t)HALF * K * 2, tstep = 2 * hstep;
    const unsigned ldsw = (unsigned)wid * 1024u;
    const int aoff = lds_byte(wr * 64 + fr, fq * 8), boff = lds_byte(wc * 32 + fr, fq * 8);
#define RSA(b, h) (((b) * 2 + (h)) * HTB)
#define RSB(b, h) ((4 + (b) * 2 + (h)) * HTB)
#define RSTAGE(bufoff, gbase, voff) do { _Pragma("unroll") for (int _i = 0; _i < 2; ++_i) \
        __builtin_amdgcn_global_load_lds((const unsigned*)((const char*)(gbase) + (voff)[_i]), (LAS unsigned*)(lds + (bufoff) + ldsw + _i * 8192), 16, 0, 0); } while (0)
#define RLDA(dst, b, h) do { _Pragma("unroll") for (int m = 0; m < 4; ++m) _Pragma("unroll") for (int k = 0; k < 2; ++k) dst[m][k] = *(const LAS bf16x8*)(lds + RSA(b, h) + aoff + m * 2048 + k * 1024); } while (0)
#define RLDB(dst, b, h) do { _Pragma("unroll") for (int n = 0; n < 2; ++n) _Pragma("unroll") for (int k = 0; k < 2; ++k) dst[n][k] = *(const LAS bf16x8*)(lds + RSB(b, h) + boff + n * 2048 + k * 1024); } while (0)
#define RMMA(ai, bj, At, Bt) do { __builtin_amdgcn_s_setprio(1); _Pragma("unroll") for (int m = 0; m < 4; ++m) _Pragma("unroll") for (int n = 0; n < 2; ++n) _Pragma("unroll") for (int k = 0; k < 2; ++k) \
        acc[ai][bj][m][n] = __builtin_amdgcn_mfma_f32_16x16x32_bf16(Bt[n][k], At[m][k], acc[ai][bj][m][n], 0, 0, 0); __builtin_amdgcn_s_setprio(0); } while (0)
#define RWV(n) asm volatile("s_waitcnt vmcnt(" #n ")" ::: "memory")
#define RWL(n) asm volatile("s_waitcnt lgkmcnt(" #n ")" ::: "memory")
#define RBAR __builtin_amdgcn_s_barrier()
#define RSCHED __builtin_amdgcn_sched_barrier(0)
    Unit cur, nxt; int ui = 0;
    if (!S.next(0, cur)) return;
    f32x4 acc[2][2][4][2];
#pragma unroll
    for (int a = 0; a < 2; ++a)
#pragma unroll
        for (int b = 0; b < 2; ++b)
#pragma unroll
            for (int m = 0; m < 4; ++m)
#pragma unroll
                for (int n = 0; n < 2; ++n) acc[a][b][m][n] = (f32x4){0.f, 0.f, 0.f, 0.f};
    bf16x8 At[4][2], B0[2][2], B1[2][2];
    const char* cA = (const char*)g.A + (size_t)cur.pm * tstep; const char* cB = (const char*)g.Bt + (size_t)cur.pn * tstep;
    RSTAGE(RSB(0, 0), cB, voffB); RSTAGE(RSB(0, 1), cB + hstep, voffB); RSTAGE(RSA(0, 0), cA, voffA); RSTAGE(RSA(0, 1), cA + hstep, voffA);
    if (wr == 1) RBAR;
    RWV(2); RBAR;
    RSTAGE(RSB(1, 0), cB + kstep, voffB); RSTAGE(RSA(1, 0), cA + kstep, voffA); RSTAGE(RSB(1, 1), cB + hstep + kstep, voffB);
    RWV(6); RBAR;
    for (;;) {
        const bool has_next = S.next(ui + 1, nxt);
        const char* nA = has_next ? (const char*)g.A + (size_t)nxt.pm * tstep : cA; const char* nB = has_next ? (const char*)g.Bt + (size_t)nxt.pn * tstep : cB;
        for (int t = 0; t < nt; t += 2) {
            const bool last = (t == nt - 2);
            const char* a1 = cA + (size_t)(t + 1) * kstep;
            const char* a2 = last ? nA : cA + (size_t)(t + 2) * kstep; const char* b2 = last ? nB : cB + (size_t)(t + 2) * kstep;
            const char* a3 = a2 + kstep; const char* b3 = b2 + kstep;
            RLDB(B0, 0, 0); RLDB(B1, 0, 1); RSCHED; RLDA(At, 0, 0); RSTAGE(RSA(1, 1), a1 + hstep, voffA);
            RWV(8); RWL(0); RBAR; RMMA(0, 0, At, B0); RMMA(0, 1, At, B1); RBAR; RSCHED;
            RLDA(At, 0, 1); RSTAGE(RSB(0, 0), b2, voffB); RSTAGE(RSB(0, 1), b2 + hstep, voffB); RSTAGE(RSA(0, 0), a2, voffA);
            RWV(8); RWL(0); RBAR; RMMA(1, 0, At, B0); RMMA(1, 1, At, B1); RBAR; RSCHED;
            RLDB(B0, 1, 0); RLDB(B1, 1, 1); RSCHED; RLDA(At, 1, 0); RSTAGE(RSA(0, 1), a2 + hstep, voffA);
            RWV(8); RWL(0); RBAR; RMMA(0, 0, At, B0); RMMA(0, 1, At, B1); RBAR; RSCHED;
            RLDA(At, 1, 1); RSTAGE(RSB(1, 0), b3, voffB); RSTAGE(RSB(1, 1), b3 + hstep, voffB); RSTAGE(RSA(1, 0), a3, voffA);
            RWV(8); RWL(0); RBAR; RMMA(1, 0, At, B0); RMMA(1, 1, At, B1); RBAR; RSCHED;
        }
        if (wr == 0) RBAR;
#pragma unroll
        for (int a = 0; a < 2; ++a)
#pragma unroll
            for (int b = 0; b < 2; ++b)
#pragma unroll
                for (int m = 0; m < 4; ++m)
#pragma unroll
                    for (int n = 0; n < 2; ++n) asm volatile("" :: "v"(acc[a][b][m][n]));
        if (!has_next) break;
#pragma unroll
        for (int a = 0; a < 2; ++a)
#pragma unroll
            for (int b = 0; b < 2; ++b)
#pragma unroll
                for (int m = 0; m < 4; ++m)
#pragma unroll
                    for (int n = 0; n < 2; ++n) acc[a][b][m][n] = (f32x4){0.f, 0.f, 0.f, 0.f};
        cur = nxt; cA = nA; cB = nB; ++ui;
        if (wr == 1) RBAR;
    }
    RWV(0);
    RBAR;
#undef RSA
#undef RSB
#undef RSTAGE
#undef RLDA
#undef RLDB
#undef RMMA
#undef RWV
#undef RWL
#undef RBAR
#undef RSCHED
}
}
struct PreNone { };
struct Pre8 { float v[8]; };
__device__ __forceinline__ unsigned pk4_fp8(float a, float b, float c, float d) { int w = __builtin_amdgcn_cvt_pk_fp8_f32(a, b, 0, false); w = __builtin_amdgcn_cvt_pk_fp8_f32(c, d, w, true); return (unsigned)w; }
template <bool F8>
struct EpiSwiGLU_T {
    static constexpr bool PERM = true;
    static constexpr bool DMA_PRE = F8;
    bf16_t* O; int ldo; const float* lrs; float wsc, osc;
    typedef PreNone Pre;
    __device__ __forceinline__ Pre pre(const pg8::Unit&, int, int) const { return Pre{}; }
    __device__ __forceinline__ void dma_pre(const pg8::Unit& u, int tid, int wid, LAS unsigned char* lds) const {
        __builtin_amdgcn_global_load_lds((const unsigned*)(lrs + (size_t)u.e * T + u.arow + (tid & 255)), (LAS unsigned*)(lds + LRST_OFF + (wid & 3) * 256), 4, 0, 0); }
    __device__ __forceinline__ void operator()(const f32x4 (&acc)[2][2][4][2], const pg8::Unit& u, int wr, int wc, int fr, int fq, LAS unsigned char* lds, const Pre&) const {
        struct { float v[8]; } pr;
#pragma unroll
        for (int i = 0; i < 8; ++i) {
            if constexpr (F8) pr.v[i] = ((const LAS float*)(lds + LRST_OFF))[(i >> 2) * 128 + (i & 3) * 16 + wr * 64 + fr];
            else pr.v[i] = lrs ? lrs[(size_t)u.e * T + u.arow + (i >> 2) * 128 + (i & 3) * 16 + wr * 64 + fr] : 1.f; }
        const int r0 = wr * 64 + fr, col0 = u.pn * 128 + wc * 32 + 8 * fq;
#pragma unroll
        for (int ai = 0; ai < 2; ++ai) {
#pragma unroll
            for (int m = 0; m < 4; ++m) {
                const float s = pr.v[ai * 4 + m] * wsc; float o[8];
#pragma unroll
                for (int n = 0; n < 2; ++n)
#pragma unroll
                    for (int j = 0; j < 4; ++j) { const float gv = acc[ai][0][m][n][j] * s, uv = acc[ai][1][m][n][j] * s; o[n * 4 + j] = silu_f(gv) * uv; }
                if constexpr (F8) { u32x2 w; w.x = pk4_fp8(o[0] * osc, o[1] * osc, o[2] * osc, o[3] * osc); w.y = pk4_fp8(o[4] * osc, o[5] * osc, o[6] * osc, o[7] * osc);
                    *(u32x2*)((unsigned char*)O + (size_t)(u.orow + ai * 128 + m * 16 + r0) * ldo + col0) = w; }
                else { u32x4 w; w.x = cvt_pk_bf16(o[0], o[1]); w.y = cvt_pk_bf16(o[2], o[3]); w.z = cvt_pk_bf16(o[4], o[5]); w.w = cvt_pk_bf16(o[6], o[7]);
                    *(u32x4*)(O + (size_t)(u.orow + ai * 128 + m * 16 + r0) * ldo + col0) = w; }
            }
        }
    }
};
typedef EpiSwiGLU_T<false> EpiSwiGLU;
struct EpiRes {
    static constexpr bool PERM = false;
    static constexpr bool DMA_PRE = false;
    float* H; bf16_t* HB; float* ssq; unsigned char* HB8;
    typedef PreNone Pre;
    __device__ __forceinline__ Pre pre(const pg8::Unit&, int, int) const { return Pre{}; }
    __device__ __forceinline__ void operator()(const f32x4 (&acc)[2][2][4][2], const pg8::Unit& u, int wr, int wc, int fr, int fq, LAS unsigned char*, const Pre&) const {
        const int r0 = u.orow + wr * 64 + fr, col0 = u.pn * 256 + wc * 32 + 4 * fq;
#pragma unroll
        for (int ai = 0; ai < 2; ++ai)
#pragma unroll
            for (int m = 0; m < 4; ++m) {
                const size_t off = (size_t)(r0 + ai * 128 + m * 16) * D + col0; float sq = 0.f;
#pragma unroll
                for (int bj = 0; bj < 2; ++bj)
#pragma unroll
                    for (int n = 0; n < 2; ++n) {
                        const f32x4 hv = *(const f32x4*)(H + off + bj * 128 + n * 16) + acc[ai][bj][m][n];
                        *(f32x4*)(H + off + bj * 128 + n * 16) = hv;
                        if (HB8) *(unsigned*)(HB8 + off + bj * 128 + n * 16) = pk4_fp8(hv[0], hv[1], hv[2], hv[3]);
                        else { u32x2 w; w.x = cvt_pk_bf16(hv[0], hv[1]); w.y = cvt_pk_bf16(hv[2], hv[3]); *(u32x2*)(HB + off + bj * 128 + n * 16) = w; }
                        sq += (hv[0] * hv[0] + hv[1] * hv[1]) + (hv[2] * hv[2] + hv[3] * hv[3]);
                    }
                if (ssq) { sq += __shfl_xor(sq, 16); sq += __shfl_xor(sq, 32);
                    if (fq == 0) ssq[(size_t)(r0 + ai * 128 + m * 16) * 16 + u.pn * 4 + wc] = sq; }
            }
    }
};
template <bool STORE>
struct EpiQKV_T {
    static constexpr bool PERM = true;
    static constexpr bool DMA_PRE = false;
    bf16_t* O; const float* ssq;
    typedef Pre8 Pre;
    __device__ __forceinline__ Pre pre(const pg8::Unit& u, int, int) const { Pre p; const int tid = threadIdx.x, row = tid >> 1, part = tid & 1;
        const f32x4* q = (const f32x4*)(ssq + (size_t)(u.orow + row) * 16 + part * 8); const f32x4 a = q[0], b = q[1];
        p.v[0] = a[0]; p.v[1] = a[1]; p.v[2] = a[2]; p.v[3] = a[3]; p.v[4] = b[0]; p.v[5] = b[1]; p.v[6] = b[2]; p.v[7] = b[3]; return p; }
    __device__ __forceinline__ void operator()(const f32x4 (&acc)[2][2][4][2], const pg8::Unit& u, int wr, int wc, int fr, int fq, LAS unsigned char* lds, const Pre& pr) const {
        LAS float* rtab = (LAS float*)(lds + RTAB_OFF);
        { const int tid = threadIdx.x, row = tid >> 1, part = tid & 1;
          float s = ((pr.v[0] + pr.v[1]) + (pr.v[2] + pr.v[3])) + ((pr.v[4] + pr.v[5]) + (pr.v[6] + pr.v[7]));
          s += __shfl_xor(s, 1);
          if (part == 0) rtab[row] = 1.0f / sqrtf(s * (1.f / D) + EPS); }
        asm volatile("s_waitcnt lgkmcnt(0)" ::: "memory"); __builtin_amdgcn_s_barrier(); asm volatile("" ::: "memory");
        const float qs = (u.pn * 256 < 3072) ? 0.125f * 1.4426950408889634f : 1.f;
        const int r0 = wr * 64 + fr, col0 = u.pn * 256 + wc * 32 + 8 * fq;
#pragma unroll
        for (int ai = 0; ai < 2; ++ai)
#pragma unroll
            for (int m = 0; m < 4; ++m) {
                const float s = rtab[ai * 128 + m * 16 + r0] * qs;
#pragma unroll
                for (int bj = 0; bj < 2; ++bj) {
                    const f32x4 v0 = acc[ai][bj][m][0] * s, v1 = acc[ai][bj][m][1] * s;
                    u32x4 w; w.x = cvt_pk_bf16(v0[0], v0[1]); w.y = cvt_pk_bf16(v0[2], v0[3]); w.z = cvt_pk_bf16(v1[0], v1[1]); w.w = cvt_pk_bf16(v1[2], v1[3]);
                    if (STORE) *(u32x4*)(O + (size_t)(u.orow + ai * 128 + m * 16 + r0) * QKV_LD + col0 + bj * 128) = w; else asm volatile("" :: "v"(w));
                }
            }
    }
};
typedef EpiQKV_T<true> EpiQKV;
struct EpiNull {
    static constexpr bool PERM = true;
    static constexpr bool DMA_PRE = false;
    typedef PreNone Pre;
    __device__ __forceinline__ Pre pre(const pg8::Unit&, int, int) const { return Pre{}; }
    __device__ __forceinline__ void operator()(const f32x4 (&acc)[2][2][4][2], const pg8::Unit& u, int wr, int wc, int fr, int fq, LAS unsigned char*, const Pre&) const {
#pragma unroll
        for (int ai = 0; ai < 2; ++ai)
#pragma unroll
            for (int bj = 0; bj < 2; ++bj)
#pragma unroll
                for (int m = 0; m < 4; ++m)
#pragma unroll
                    for (int n = 0; n < 2; ++n) asm volatile("" :: "v"(acc[ai][bj][m][n]));
    }
};
struct EpiY {
    static constexpr bool PERM = true;
    static constexpr bool DMA_PRE = false;
    bf16_t* Y; bf16_t* Y2; int c0rows; float ysc;
    typedef PreNone Pre;
    __device__ __forceinline__ Pre pre(const pg8::Unit&, int, int) const { return Pre{}; }
    __device__ __forceinline__ void operator()(const f32x4 (&acc)[2][2][4][2], const pg8::Unit& u, int wr, int wc, int fr, int fq, LAS unsigned char*, const Pre&) const {
        bf16_t* Yb = u.koff ? Y2 : Y;
        const int r0 = (u.koff ? u.orow - c0rows : u.orow) + wr * 64 + fr, col0 = u.pn * 256 + wc * 32 + 8 * fq;
#pragma unroll
        for (int ai = 0; ai < 2; ++ai)
#pragma unroll
            for (int m = 0; m < 4; ++m)
#pragma unroll
                for (int bj = 0; bj < 2; ++bj) {
                    const f32x4 v0 = acc[ai][bj][m][0] * ysc, v1 = acc[ai][bj][m][1] * ysc;
                    u32x4 w; w.x = cvt_pk_bf16(v0[0], v0[1]); w.y = cvt_pk_bf16(v0[2], v0[3]); w.z = cvt_pk_bf16(v1[0], v1[1]); w.w = cvt_pk_bf16(v1[2], v1[3]);
                    *(u32x4*)(Yb + (size_t)(r0 + ai * 128 + m * 16) * D + col0 + bj * 128) = w;
                }
    }
};

constexpr int MI_CNT = 0, MI_TB = 8, MI_NT = 17, MI_SPLIT0 = 18, MI_C1 = 19;
__device__ __forceinline__ void moe_info_build(LAS unsigned char* lds, const unsigned* ctl) {
    volatile LAS int* mi = (volatile LAS int*)(lds + SCR_OFF);
    if (threadIdx.x == 0) { int tb = 0;
        for (int e = 0; e < NE; ++e) { const int c = (int)__hip_atomic_load(ctl + CW_CNT + e, RLX_AGENT); mi[MI_CNT + e] = c; mi[MI_TB + e] = tb; tb += (c + 255) >> 8; }
        mi[MI_TB + NE] = tb; mi[MI_NT] = tb; const int c1 = tb > LAST_TILES ? tb - LAST_TILES : 0; mi[MI_C1] = c1; mi[MI_SPLIT0] = c1 * 256; }
    LDS_WAIT(); __syncthreads();
}
struct DynQ {
    unsigned* ctr; volatile LAS unsigned* slot;
    __device__ __forceinline__ void start() const { if (threadIdx.x == 0) { slot[0] = blockIdx.x; slot[1] = gridDim.x + atomicAdd(ctr, 1u); } LDS_WAIT(); __syncthreads(); }
#ifdef MK_STATICQ
    __device__ __forceinline__ int fetch(int i) const { return i * (int)gridDim.x + (int)blockIdx.x; }
#else
    __device__ __forceinline__ int fetch(int i) const { return __builtin_amdgcn_readfirstlane((int)slot[i & 3]); }
#endif
    __device__ __forceinline__ unsigned refill_issue() const { unsigned v = 0u; if (threadIdx.x == 0) v = gridDim.x + atomicAdd(ctr, 1u); return v; }
    __device__ __forceinline__ void refill_commit(int ui, unsigned v) const { if (threadIdx.x == 0) slot[(ui + 2) & 3] = v; }
};
template <int NN, bool G1>
struct MoeOrder {
    DynQ q; volatile LAS int* mi; int c0, ntc; const int* ltok;
    __device__ __forceinline__ void start() const { q.start(); }
    __device__ __forceinline__ unsigned refill_issue() const { return q.refill_issue(); }
    __device__ __forceinline__ void refill_commit(int ui, unsigned v) const { q.refill_commit(ui, v); }
    __device__ __forceinline__ bool next(int i, pg8::Unit& u) const {
        const int idx = q.fetch(i); if (idx >= ntc * NN) return false;
        const int grp = idx / (8 * NN), r = idx - grp * (8 * NN), gsz = (ntc - grp * 8) < 8 ? (ntc - grp * 8) : 8;
        const int pml = grp * 8 + r % gsz, pn = r / gsz, pmg = c0 + pml;
        int e = 0;
#pragma unroll
        for (int k = 1; k < NE; ++k) e += (pmg >= mi[MI_TB + k]) ? 1 : 0;
        e = __builtin_amdgcn_readfirstlane(e);
        u.pm = pmg; u.pn = pn; u.e = e; u.koff = 0;
        if (!G1 && NN == 8) { u.pn = pn & 3; u.koff = (pn >> 2) * (FF1 / 4); }
        const int pnb = u.pn;
        if (G1) { u.arow = (pmg - __builtin_amdgcn_readfirstlane(mi[MI_TB + e])) * 256; u.brow = e * (2 * FF1) + pn * 256; u.orow = pml * 256; }
        else { u.arow = pml * 256; u.brow = e * D + pnb * 256; u.orow = pmg * 256; }
        return true;
    }
    __device__ __forceinline__ const int* gather_src(const pg8::Unit& u, int r) const {
        const int lr = u.arow + r; const int c = mi[MI_CNT + u.e];
        return lr < c ? ltok + (size_t)u.e * T + lr : (const int*)((const char*)ltok + (WS_ZERO - WS_LTOK));
    }
    __device__ __forceinline__ unsigned gather_row(const pg8::Unit& u, int r) const {
        const int lr = u.arow + r; const int c = mi[MI_CNT + u.e];
        return lr < c ? (unsigned)ltok[(size_t)u.e * T + lr] : 0u;
    }
};
struct Args { const float* in[19]; float* out; unsigned char* ws; int ph_lo, ph_hi, li, pad; };
enum { I_X = 0, I_ANORM, I_APROJ, I_ASCALE, I_KVNORM, I_WKV, I_BNORM, I_WQ, I_WO, I_RELB, I_FFNORM, I_DWG, I_DWU, I_DWD, I_ROUTER, I_MWG, I_MWU, I_MWD, I_FNORM };
struct Frame {
    LAS unsigned char* lds; unsigned* ctl; int tid, lane, wave, G, bid;
    float* h; unsigned char* ws;
};
__device__ __forceinline__ void conv_item(const float* W, int ldw, const float* gain, bf16_t* WT, int K, int dst_row0, LAS float* scr, int k0, int n0, int lane) {
    float wv[32];
#pragma unroll
    for (int i = 0; i < 32; ++i) wv[i] = W[(size_t)(k0 + 2 * i + (lane >> 5)) * ldw + n0 + (lane & 31)];
    if (gain) {
#pragma unroll
        for (int i = 0; i < 32; ++i) wv[i] *= gain[k0 + 2 * i + (lane >> 5)];
    }
#pragma unroll
    for (int i = 0; i < 32; ++i) scr[(2 * i + (lane >> 5)) * 33 + (lane & 31)] = wv[i];
    LDS_WAIT(); asm volatile("" ::: "memory");
    const int c = lane & 7;
#pragma unroll
    for (int j = 0; j < 4; ++j) { const int n = (lane >> 3) + 8 * j; const LAS float* s = scr + (8 * c) * 33 + n;
        u32x4 o; o.x = pk2(s[0 * 33], s[1 * 33]); o.y = pk2(s[2 * 33], s[3 * 33]); o.z = pk2(s[4 * 33], s[5 * 33]); o.w = pk2(s[6 * 33], s[7 * 33]);
        *(u32x4*)(WT + (size_t)(dst_row0 + n) * K + k0 + 8 * c) = o; }
    LDS_WAIT(); asm volatile("" ::: "memory");
}
__device__ __forceinline__ void conv_job(const Frame& F, int& it0, const float* W, int K, int N, int ldw, const float* gain, bf16_t* WT, int mode, int row_off, LAS float* scr, int cg = 0) {
    const int nblk = N / 32, items = (K / 64) * nblk, NGW = (cg ? cg : F.G) * NWAVES;
    int it = it0;
    for (; it < items; it += NGW) {
        const int kb = it / nblk, nb = it - kb * nblk, n0 = nb * 32;
        const int dr = (mode == 0) ? (row_off + n0) : (row_off + (n0 >> 7) * 256 + (n0 & 127) + (mode == 2 ? 128 : 0));
        conv_item(W, ldw, gain, WT, K, dr, scr, kb * 64, n0, F.lane);
    }
    it0 = it - items;
}
__device__ __forceinline__ void conv_item8(const float* W, int ldw, const float* gain, float presc, unsigned char* WT8, int K, int dst_row0, LAS float* scr, int k0, int n0, int lane) {
    float wv[32];
#pragma unroll
    for (int i = 0; i < 32; ++i) wv[i] = W[(size_t)(k0 + 2 * i + (lane >> 5)) * ldw + n0 + (lane & 31)];
#pragma unroll
    for (int i = 0; i < 32; ++i) wv[i] *= gain ? gain[k0 + 2 * i + (lane >> 5)] * presc : presc;
#pragma unroll
    for (int i = 0; i < 32; ++i) scr[(2 * i + (lane >> 5)) * 33 + (lane & 31)] = wv[i];
    LDS_WAIT(); asm volatile("" ::: "memory");
    const int c = lane & 7;
#pragma unroll
    for (int j = 0; j < 4; ++j) { const int n = (lane >> 3) + 8 * j; const LAS float* s = scr + (8 * c) * 33 + n;
        u32x2 o; o.x = pk4_fp8(s[0 * 33], s[1 * 33], s[2 * 33], s[3 * 33]); o.y = pk4_fp8(s[4 * 33], s[5 * 33], s[6 * 33], s[7 * 33]);
        *(u32x2*)(WT8 + (size_t)(dst_row0 + n) * K + k0 + 8 * c) = o; }
    LDS_WAIT(); asm volatile("" ::: "memory");
}
__device__ __forceinline__ void conv_job8(const Frame& F, int& it0, const float* W, int K, int N, int ldw, const float* gain, float presc, unsigned char* WT8, int mode, int row_off, LAS float* scr) {
    const int nblk = N / 32, items = (K / 64) * nblk, NGW = F.G * NWAVES;
    int it = it0;
    for (; it < items; it += NGW) {
        const int kb = it / nblk, nb = it - kb * nblk, n0 = nb * 32;
        const int dr = (mode == 0) ? (row_off + n0) : (row_off + (n0 >> 7) * 256 + (n0 & 127) + (mode == 2 ? 128 : 0));
        conv_item8(W, ldw, gain, presc, WT8, K, dr, scr, kb * 64, n0, F.lane);
    }
    it0 = it - items;
}
__device__ __forceinline__ void conv_aproj(const Frame& F, const Args& A) {
    LAS float* scr = (LAS float*)(F.lds + RING_OFF + F.wave * 16384);
    int it = F.bid * NWAVES + F.wave;
    for (int g = 0; g < 4; ++g) conv_job(F, it, A.in[I_APROJ] + (size_t)g * 65536, 256, 256, 256, nullptr, (bf16_t*)(F.ws + WS_APT) + (size_t)g * 65536, 0, 0, scr);
}
__device__ __forceinline__ void conv_small(const Frame& F, const Args& A) {
    LAS float* scr = (LAS float*)(F.lds + RING_OFF + F.wave * 16384);
    int it = F.bid * NWAVES + F.wave;
    unsigned char* ws = F.ws;
    conv_job(F, it, A.in[I_DWG], D, FF0, FF0, nullptr, (bf16_t*)(ws + WS_WGU0), 1, 0, scr);
    conv_job(F, it, A.in[I_DWU], D, FF0, FF0, nullptr, (bf16_t*)(ws + WS_WGU0), 2, 0, scr);
}
__device__ __forceinline__ void conv_later(const Frame& F, const Args& A, int cb, int cg) {
    LAS float* scr = (LAS float*)(F.lds + RING_OFF + F.wave * 16384);
    int it = cb * NWAVES + F.wave;
    unsigned char* ws = F.ws;
    conv_job(F, it, A.in[I_DWD], FF0, D, D, nullptr, (bf16_t*)(ws + WS_WD0), 0, 0, scr, cg);
    conv_job(F, it, A.in[I_WQ], D, 3072, 3072, A.in[I_BNORM], (bf16_t*)(ws + WS_WQKV), 0, 0, scr, cg);
    conv_job(F, it, A.in[I_WKV], D, 6144, 6144, A.in[I_KVNORM], (bf16_t*)(ws + WS_WQKV), 0, 3072, scr, cg);
    conv_job(F, it, A.in[I_WO], D, D, D, nullptr, (bf16_t*)(ws + WS_WO), 0, 0, scr, cg);
}
__device__ __forceinline__ void conv_moe(const Frame& F, const Args& A) {
    LAS float* scr = (LAS float*)(F.lds + RING_OFF + F.wave * 16384);
    int it = F.bid * NWAVES + F.wave;
    unsigned char* ws = F.ws;
    for (int e = 0; e < NE; ++e) {
        conv_job8(F, it, A.in[I_MWG] + (size_t)e * D * FF1, D, FF1, FF1, A.in[I_FFNORM] + D, WGU_PRESC, ws + WS_WGU1 + (size_t)e * 2 * FF1 * D, 1, 0, scr);
        conv_job8(F, it, A.in[I_MWU] + (size_t)e * D * FF1, D, FF1, FF1, A.in[I_FFNORM] + D, WGU_PRESC, ws + WS_WGU1 + (size_t)e * 2 * FF1 * D, 2, 0, scr);
        conv_job8(F, it, A.in[I_MWD] + (size_t)e * FF1 * D, FF1, D, D, nullptr, WD_PRESC, ws + WS_WD1 + (size_t)e * D * FF1, 0, 0, scr);
    }
}

__device__ __forceinline__ void mixer_phase(const Frame& F, const Args& A) {
    LAS float* rs = (LAS float*)(F.lds + 0);
    LAS float* xn = (LAS float*)(F.lds + 512);
    LAS bf16_t* pl = (LAS bf16_t*)(F.lds + 512 + 80896);
    LAS float* sw = (LAS float*)(F.lds + 512 + 80896 + 33792);
    int tid_ = F.tid; asm volatile("" : "+v"(tid_));
    const int tid = tid_, lane = tid & 63, w = F.wave, fr = lane & 15, fq = lane >> 4;
    const bf16_t* apt = (const bf16_t*)(F.ws + WS_APT);
    bf16_t* hn0 = (bf16_t*)(F.ws + WS_S0);
    for (int tile = F.bid; tile < T / 64; tile += F.G) {
        const int t0 = tile * 64, s0 = t0 % SEQ, halo = s0 ? 15 : 0, nrows = 64 + halo;
#pragma unroll 1
        for (int jb = w; jb < nrows; jb += 5 * NWAVES) {
            f32x4 rv[5][4];
#pragma unroll
            for (int u = 0; u < 5; ++u) { const int jj = jb + u * NWAVES, jc = jj < nrows ? jj : nrows - 1; const f32x4* p = (const f32x4*)(A.in[I_X] + (size_t)(t0 - halo + jc) * D);
#pragma unroll
                for (int q = 0; q < 4; ++q) rv[u][q] = p[lane + 64 * q]; }
#pragma unroll
            for (int u = 0; u < 5; ++u) { float s = 0.f;
#pragma unroll
                for (int q = 0; q < 4; ++q) { const f32x4 v = rv[u][q]; s += (v[0] * v[0] + v[1] * v[1]) + (v[2] * v[2] + v[3] * v[3]); }
                s = wave_sum(s);
                const int jj = jb + u * NWAVES;
                if (lane == 0 && jj < nrows) rs[jj] = 1.0f / sqrtf(s * (1.f / D) + EPS); }
        }
        LDS_WAIT(); __syncthreads();
        float ss[4] = {0.f, 0.f, 0.f, 0.f};
        for (int g = 0; g < 4; ++g) {
            { const f32x4 gn = *(const f32x4*)(A.in[I_ANORM] + g * 256 + 4 * lane);
              f32x4 xv[10];
#pragma unroll
              for (int u = 0; u < 10; ++u) { const int jj = w + u * NWAVES, jc = jj < nrows ? jj : nrows - 1; xv[u] = *(const f32x4*)(A.in[I_X] + (size_t)(t0 - halo + jc) * D + g * 256 + 4 * lane); }
#pragma unroll
              for (int u = 0; u < 10; ++u) { const int jj = w + u * NWAVES; if (jj < nrows) { const float r = rs[jj]; const f32x4 v = xv[u];
                  *(LAS f32x4*)(xn + jj * 256 + 4 * lane) = (f32x4){v[0] * r * gn[0], v[1] * r * gn[1], v[2] * r * gn[2], v[3] * r * gn[3]}; } } }
            LDS_WAIT(); __syncthreads();
            { const int c4 = (tid & 63) * 4, win = 2 << g;
#pragma unroll 1
              for (int i = 0; i < 8; ++i) { const int r = (tid >> 6) + 8 * i, s = s0 + r, cnt = (s + 1 < win) ? (s + 1) : win;
                  f32x4 a = {0.f, 0.f, 0.f, 0.f};
                  for (int jj = 0; jj < cnt; ++jj) a += *(const LAS f32x4*)(xn + (halo + r - jj) * 256 + c4);
                  const f32x4 self = *(const LAS f32x4*)(xn + (halo + r) * 256 + c4); const float inv = 1.f / (float)cnt;
                  u32x2 o; o.x = pk2(a[0] * inv - self[0], a[1] * inv - self[1]); o.y = pk2(a[2] * inv - self[2], a[3] * inv - self[3]);
                  *(LAS u32x2*)(pl + r * 264 + c4) = o; } }
            LDS_WAIT(); __syncthreads();
            f32x4 acc[4][2];
#pragma unroll
            for (int m = 0; m < 4; ++m) { acc[m][0] = (f32x4){0.f, 0.f, 0.f, 0.f}; acc[m][1] = (f32x4){0.f, 0.f, 0.f, 0.f}; }
#pragma unroll
            for (int ks = 0; ks < 8; ++ks) {
                bf16x8 bfr[2], afr[4];
#pragma unroll
                for (int n = 0; n < 2; ++n) bfr[n] = *(const bf16x8*)(apt + (size_t)g * 65536 + (size_t)(32 * w + 16 * n + fr) * 256 + 32 * ks + 8 * fq);
#pragma unroll
                for (int m = 0; m < 4; ++m) afr[m] = *(const LAS bf16x8*)(pl + (16 * m + fr) * 264 + 32 * ks + 8 * fq);
#pragma unroll
                for (int m = 0; m < 4; ++m)
#pragma unroll
                    for (int n = 0; n < 2; ++n) acc[m][n] = __builtin_amdgcn_mfma_f32_16x16x32_bf16(bfr[n], afr[m], acc[m][n], 0, 0, 0);
            }
#pragma unroll
            for (int m = 0; m < 4; ++m)
#pragma unroll
                for (int n = 0; n < 2; ++n) { const int col = g * 256 + 32 * w + 16 * n + 4 * fq; const size_t off = (size_t)(t0 + 16 * m + fr) * D + col;
                    const f32x4 sc = *(const f32x4*)(A.in[I_ASCALE] + col); const f32x4 hv = *(const f32x4*)(A.in[I_X] + off) + acc[m][n] * sc;
                    *(f32x4*)(F.h + off) = hv; ss[m] += (hv[0] * hv[0] + hv[1] * hv[1]) + (hv[2] * hv[2] + hv[3] * hv[3]); }
        }
#pragma unroll
        for (int m = 0; m < 4; ++m) { float s = ss[m]; s += __shfl_xor(s, 16); s += __shfl_xor(s, 32); if (fq == 0) sw[(16 * m + fr) * 8 + w] = s; }
        VM_WAIT(); LDS_WAIT(); __syncthreads();
#pragma unroll 1
        for (int jb = w; jb < 64; jb += 4 * NWAVES) {
            f32x4 hv[4][4];
#pragma unroll
            for (int u = 0; u < 4; ++u) { const f32x4* p = (const f32x4*)(F.h + (size_t)(t0 + jb + u * NWAVES) * D);
#pragma unroll
                for (int q = 0; q < 4; ++q) hv[u][q] = p[lane + 64 * q]; }
#pragma unroll
            for (int u = 0; u < 4; ++u) { const int jr = jb + u * NWAVES; float s = 0.f;
#pragma unroll
                for (int q = 0; q < 8; ++q) s += sw[jr * 8 + q];
                const float r1 = 1.0f / sqrtf(s * (1.f / D) + EPS);
                u32x2* o = (u32x2*)(hn0 + (size_t)(t0 + jr) * D);
#pragma unroll
                for (int q = 0; q < 4; ++q) { const f32x4 v = hv[u][q]; const f32x4 gn = *(const f32x4*)(A.in[I_FFNORM] + 4 * (lane + 64 * q));
                    u32x2 ov; ov.x = pk2(v[0] * r1 * gn[0], v[1] * r1 * gn[1]); ov.y = pk2(v[2] * r1 * gn[2], v[3] * r1 * gn[3]); o[lane + 64 * q] = ov; } }
        }
        LDS_WAIT(); __syncthreads();
    }
}

__device__ __forceinline__ void router_phase(const Frame& F, const Args& A) {
    volatile LAS int* li = (volatile LAS int*)(F.lds + 0);
    volatile LAS float* lf = (volatile LAS float*)(F.lds + 2048);
    int* ltok = (int*)(F.ws + WS_LTOK); float* lrs = (float*)(F.ws + WS_LRS); u32x4* tinfo = (u32x4*)(F.ws + WS_TOKINFO);
    int tid_ = F.tid; asm volatile("" : "+v"(tid_));
    const int tid = tid_, lane = tid & 63, w = F.wave;
    const float* gain = A.in[I_FFNORM] + D;
    f32x4 wa[4][4], wb[4][4];
#pragma unroll
    for (int q = 0; q < 4; ++q) { const int c0 = 4 * (lane + 64 * q); const f32x4 gn = *(const f32x4*)(gain + c0);
#pragma unroll
        for (int j = 0; j < 4; ++j) { wa[q][j] = *(const f32x4*)(A.in[I_ROUTER] + (size_t)(c0 + j) * 8) * gn[j]; wb[q][j] = *(const f32x4*)(A.in[I_ROUTER] + (size_t)(c0 + j) * 8 + 4) * gn[j]; } }
    if (F.bid == 0 && tid < 128) ((u32x4*)(F.ws + WS_ZERO))[tid] = (u32x4){0u, 0u, 0u, 0u};
    for (int tile = F.bid; tile < T / 64; tile += F.G) {
        const int t0 = tile * 64;
        if (tid < 8) li[tid] = 0;
        LDS_WAIT(); __syncthreads();
        f32x4 v[4], vn[4];
        { const f32x4* p = (const f32x4*)(F.h + (size_t)(t0 + 8 * w) * D);
#pragma unroll
          for (int q = 0; q < 4; ++q) vn[q] = p[lane + 64 * q]; }
#pragma unroll 1
        for (int k = 0; k < 8; ++k) {
            const int tl = 8 * w + k;
#pragma unroll
            for (int q = 0; q < 4; ++q) v[q] = vn[q];
            if (k < 7) { const f32x4* p = (const f32x4*)(F.h + (size_t)(t0 + tl + 1) * D);
#pragma unroll
                for (int q = 0; q < 4; ++q) vn[q] = p[lane + 64 * q]; }
            float s = 0.f; f32x4 la = {0.f, 0.f, 0.f, 0.f}, lb = {0.f, 0.f, 0.f, 0.f};
#pragma unroll
            for (int q = 0; q < 4; ++q) { s += (v[q][0] * v[q][0] + v[q][1] * v[q][1]) + (v[q][2] * v[q][2] + v[q][3] * v[q][3]);
#pragma unroll
                for (int j = 0; j < 4; ++j) { la += wa[q][j] * v[q][j]; lb += wb[q][j] * v[q][j]; } }
            float red[9] = {s, la[0], la[1], la[2], la[3], lb[0], lb[1], lb[2], lb[3]};
#pragma unroll
            for (int o = 1; o < 64; o <<= 1) {
#pragma unroll
                for (int e = 0; e < 9; ++e) red[e] += __shfl_xor(red[e], o); }
            if (lane == 0) {
                const float r = 1.0f / sqrtf(red[0] * (1.f / D) + EPS);
                float lg[8];
#pragma unroll
                for (int e = 0; e < 8; ++e) lg[e] = red[1 + e] * r;
                float b1 = lg[0]; int i1 = 0;
#pragma unroll
                for (int e = 1; e < 8; ++e) if (lg[e] > b1) { b1 = lg[e]; i1 = e; }
                float b2 = -3.0e38f; int i2 = 0;
#pragma unroll
                for (int e = 0; e < 8; ++e) if (e != i1 && lg[e] > b2) { b2 = lg[e]; i2 = e; }
                const float e2 = expf(b2 - b1), g1 = 1.f / (1.f + e2), g2 = e2 / (1.f + e2);
                const int r1 = __hip_atomic_fetch_add((LAS int*)&li[i1], 1, __ATOMIC_RELAXED, __HIP_MEMORY_SCOPE_WORKGROUP), r2 = __hip_atomic_fetch_add((LAS int*)&li[i2], 1, __ATOMIC_RELAXED, __HIP_MEMORY_SCOPE_WORKGROUP);
                li[16 + tl * 4 + 0] = i1; li[16 + tl * 4 + 1] = i2; li[16 + tl * 4 + 2] = r1; li[16 + tl * 4 + 3] = r2;
                lf[tl * 4 + 0] = g1; lf[tl * 4 + 1] = g2; lf[tl * 4 + 2] = r;
            }
        }
        LDS_WAIT(); __syncthreads();
        if (tid < 8) li[8 + tid] = (int)atomicAdd(F.ctl + CW_CNT + tid, (unsigned)li[tid]);
        LDS_WAIT(); __syncthreads();
        if (tid < 64) {
            const int i1 = li[16 + tid * 4 + 0], i2 = li[16 + tid * 4 + 1], s1 = li[8 + i1] + li[16 + tid * 4 + 2], s2 = li[8 + i2] + li[16 + tid * 4 + 3];
            const float g1 = lf[tid * 4 + 0], g2 = lf[tid * 4 + 1], r = lf[tid * 4 + 2];
            ltok[(size_t)i1 * T + s1] = t0 + tid; lrs[(size_t)i1 * T + s1] = r;
            ltok[(size_t)i2 * T + s2] = t0 + tid; lrs[(size_t)i2 * T + s2] = r;
            u32x4 ti; ti.x = (unsigned)(s1 << 3 | i1); ti.y = (unsigned)(s2 << 3 | i2); ti.z = __builtin_bit_cast(unsigned, g1); ti.w = __builtin_bit_cast(unsigned, g2);
            tinfo[t0 + tid] = ti;
        }
        LDS_WAIT(); __syncthreads();
    }
}

__device__ __forceinline__ void final_phase(const Frame& F, const Args& A) {
    volatile LAS int* mi = (volatile LAS int*)(F.lds + SCR_OFF);
    const u32x4* tinfo = (const u32x4*)(F.ws + WS_TOKINFO); const bf16_t* Y = (const bf16_t*)(F.ws + WS_Y);
    int lane_ = F.lane; asm volatile("" : "+v"(lane_));
    const int lane = lane_;
    f32x4 gn[4];
#pragma unroll
    for (int q = 0; q < 4; ++q) gn[q] = *(const f32x4*)(A.in[I_FNORM] + 4 * (lane + 64 * q));
    const int stride = F.G * NWAVES; int t = F.bid * NWAVES + F.wave;
    const bf16_t* Y2 = (const bf16_t*)(F.ws + WS_Y2); const bf16_t* ZR = (const bf16_t*)(F.ws + WS_ZERO);
    f32x4 hv[4], hn[4]; u32x2 ya[4], yb[4], yan[4], ybn[4], za[4], zb[4], zan[4], zbn[4]; float g1n = 0.f, g2n = 0.f;
#define FIN_ISSUE(tt, HV, YA, YB, ZA, ZB, G1, G2) do { const u32x4 ti = tinfo[tt]; const unsigned tx = ti.x, ty = ti.y, gz = ti.z, gw = ti.w; \
        const int e1 = tx & 7, s1 = tx >> 3, e2 = ty & 7, s2 = ty >> 3; G1 = __uint_as_float(gz); G2 = __uint_as_float(gw); \
        const size_t r1 = (size_t)mi[MI_TB + e1] * 256 + s1, r2 = (size_t)mi[MI_TB + e2] * 256 + s2; \
        const size_t sp0 = (size_t)mi[MI_SPLIT0]; const u32x2* z1_ = r1 >= sp0 ? (const u32x2*)(Y2 + (r1 - sp0) * D) : (const u32x2*)ZR; const u32x2* z2_ = r2 >= sp0 ? (const u32x2*)(Y2 + (r2 - sp0) * D) : (const u32x2*)ZR; \
        const f32x4* p_ = (const f32x4*)(F.h + (size_t)(tt) * D); const u32x2* y1_ = (const u32x2*)(Y + r1 * D); const u32x2* y2_ = (const u32x2*)(Y + r2 * D); \
        _Pragma("unroll") for (int q = 0; q < 4; ++q) { HV[q] = p_[lane + 64 * q]; YA[q] = y1_[lane + 64 * q]; YB[q] = y2_[lane + 64 * q]; } \
        if (r1 >= sp0) { _Pragma("unroll") for (int q = 0; q < 4; ++q) ZA[q] = z1_[lane + 64 * q]; } else { _Pragma("unroll") for (int q = 0; q < 4; ++q) ZA[q] = (u32x2){0u, 0u}; } \
        if (r2 >= sp0) { _Pragma("unroll") for (int q = 0; q < 4; ++q) ZB[q] = z2_[lane + 64 * q]; } else { _Pragma("unroll") for (int q = 0; q < 4; ++q) ZB[q] = (u32x2){0u, 0u}; } } while (0)
    if (t < T) FIN_ISSUE(t, hn, yan, ybn, zan, zbn, g1n, g2n);
    for (; t < T; t += stride) {
        const float g1 = g1n, g2 = g2n;
#pragma unroll
        for (int q = 0; q < 4; ++q) { hv[q] = hn[q]; ya[q] = yan[q]; yb[q] = ybn[q]; za[q] = zan[q]; zb[q] = zbn[q]; }
        if (t + stride < T) FIN_ISSUE(t + stride, hn, yan, ybn, zan, zbn, g1n, g2n);
        f32x4 v[4]; float s = 0.f;
#pragma unroll
        for (int q = 0; q < 4; ++q) { const u32x2 a = ya[q], b = yb[q], a2 = za[q], b2 = zb[q];
            f32x4 o;
            o[0] = hv[q][0] + g1 * (bf2f((unsigned short)(a.x & 0xffff)) + bf2f((unsigned short)(a2.x & 0xffff))) + g2 * (bf2f((unsigned short)(b.x & 0xffff)) + bf2f((unsigned short)(b2.x & 0xffff)));
            o[1] = hv[q][1] + g1 * (bf2f((unsigned short)(a.x >> 16)) + bf2f((unsigned short)(a2.x >> 16))) + g2 * (bf2f((unsigned short)(b.x >> 16)) + bf2f((unsigned short)(b2.x >> 16)));
            o[2] = hv[q][2] + g1 * (bf2f((unsigned short)(a.y & 0xffff)) + bf2f((unsigned short)(a2.y & 0xffff))) + g2 * (bf2f((unsigned short)(b.y & 0xffff)) + bf2f((unsigned short)(b2.y & 0xffff)));
            o[3] = hv[q][3] + g1 * (bf2f((unsigned short)(a.y >> 16)) + bf2f((unsigned short)(a2.y >> 16))) + g2 * (bf2f((unsigned short)(b.y >> 16)) + bf2f((unsigned short)(b2.y >> 16)));
            v[q] = o; s += (o[0] * o[0] + o[1] * o[1]) + (o[2] * o[2] + o[3] * o[3]); }
        s = wave_sum(s);
        const float r = 1.0f / sqrtf(s * (1.f / D) + EPS);
        f32x4* p = (f32x4*)(F.h + (size_t)t * D);
#pragma unroll
        for (int q = 0; q < 4; ++q) p[lane + 64 * q] = (f32x4){v[q][0] * r * gn[q][0], v[q][1] * r * gn[q][1], v[q][2] * r * gn[q][2], v[q][3] * r * gn[q][3]};
    }
#undef FIN_ISSUE
}

__device__ __forceinline__ int t5_bucket(int n) {
    if (n < 16) return n;
    int large = 16 + (int)(log((double)n / 16.0) / log(128.0) * 16.0);
    return large < 31 ? large : 31;
}
typedef float f32x16 __attribute__((ext_vector_type(16)));
typedef short s16x4 __attribute__((ext_vector_type(4)));
constexpr int AT_TAB = 0;
constexpr int AT_BKT = 7680;
constexpr int AT_CNT = 9472;
constexpr int AT_V = 10240;
constexpr float L2E = 1.4426950408889634f;
constexpr size_t WS_AST_O = WS_POOL + 291 * MiB;
constexpr size_t WS_AST_M = WS_AST_O + 64 * MiB;
static_assert(WS_AST_M + 4 * MiB <= WS_END, "attention scratch");
constexpr unsigned PITCHB = QKV_LD * 2;
__device__ __forceinline__ s16x4 vtr(const LAS unsigned char* p) { return __builtin_bit_cast(s16x4, __builtin_amdgcn_ds_read_tr16_b64_v4i16((LAS s16x4*)p)); }
__device__ __forceinline__ float max3f(float a, float b, float c) { return fmaxf(fmaxf(a, b), c); }

#define AT_LOADS(KF, VR, ub, koff, voff) do { const unsigned ub_ = (ub); \
        _Pragma("unroll") for (int d0 = 0; d0 < 4; ++d0) KF[d0] = __builtin_bit_cast(bf16x8, __builtin_amdgcn_raw_buffer_load_b128(rsrc, (koff) + 32 * d0, ub_, 0)); \
        _Pragma("unroll") for (int i = 0; i < 4; ++i) VR[i] = __builtin_bit_cast(u32x4, __builtin_amdgcn_raw_buffer_load_b128(rsrc, (voff)[i], ub_, 0)); } while (0)
#define AT_SCORE(KF, VR, QF, tla) \
        _Pragma("unroll") for (int i = 0; i < 4; ++i) *(LAS u32x4*)(vwr + i * 512) = VR[i]; \
        { const LAS float* tl_ = (const LAS float*)(tla); _Pragma("unroll") for (int r = 0; r < 16; ++r) s[r] = tl_[(r & 3) + 8 * (r >> 2)]; } \
        _Pragma("unroll") for (int d0 = 0; d0 < 4; ++d0) s = __builtin_amdgcn_mfma_f32_32x32x16_bf16(KF[d0], QF[d0], s, 0, 0, 0);
#define AT_SOFTPV() do { \
        float rm = fmaxf(max3f(max3f(s[0], s[1], s[2]), max3f(s[3], s[4], s[5]), max3f(s[6], s[7], s[8])), max3f(max3f(s[9], s[10], s[11]), max3f(s[12], s[13], s[14]), s[15])); \
        { auto rr = __builtin_amdgcn_permlane32_swap(__float_as_uint(rm), __float_as_uint(rm), false, false); rm = fmaxf(__uint_as_float(rr[0]), __uint_as_float(rr[1])); } \
        if (__any(rm > M)) { const float Mn = fmaxf(M, rm), al = __builtin_amdgcn_exp2f(M - Mn); M = Mn; l *= al; \
            _Pragma("unroll") for (int r = 0; r < 16; ++r) { o0[r] *= al; o1[r] *= al; } } \
        float ps0 = 0.f, ps1 = 0.f; \
        _Pragma("unroll") for (int r = 0; r < 16; r += 2) { s[r] = __builtin_amdgcn_exp2f(s[r] - M); s[r + 1] = __builtin_amdgcn_exp2f(s[r + 1] - M); ps0 += s[r]; ps1 += s[r + 1]; } \
        l += ps0 + ps1; \
        u32x4 pw0, pw1; \
        pw0.x = cvt_pk_bf16(s[0], s[1]); pw0.y = cvt_pk_bf16(s[2], s[3]); pw0.z = cvt_pk_bf16(s[4], s[5]); pw0.w = cvt_pk_bf16(s[6], s[7]); \
        pw1.x = cvt_pk_bf16(s[8], s[9]); pw1.y = cvt_pk_bf16(s[10], s[11]); pw1.z = cvt_pk_bf16(s[12], s[13]); pw1.w = cvt_pk_bf16(s[14], s[15]); \
        const bf16x8 pa0 = __builtin_bit_cast(bf16x8, pw0), pa1 = __builtin_bit_cast(bf16x8, pw1); \
        LDS_WAIT(); \
        { const s16x4 a0 = vtr(vrd), a1 = vtr(vrd + 512), b0 = vtr(vrd + 1024), b1 = vtr(vrd + 1536); \
          const bf16x8 v0 = (bf16x8){a0[0], a0[1], a0[2], a0[3], a1[0], a1[1], a1[2], a1[3]}, v1 = (bf16x8){b0[0], b0[1], b0[2], b0[3], b1[0], b1[1], b1[2], b1[3]}; \
          o0 = __builtin_amdgcn_mfma_f32_32x32x16_bf16(v0, pa0, o0, 0, 0, 0); o0 = __builtin_amdgcn_mfma_f32_32x32x16_bf16(v1, pa1, o0, 0, 0, 0); } \
        { const s16x4 a0 = vtr(vrd + 2048), a1 = vtr(vrd + 2560), b0 = vtr(vrd + 3072), b1 = vtr(vrd + 3584); \
          const bf16x8 v0 = (bf16x8){a0[0], a0[1], a0[2], a0[3], a1[0], a1[1], a1[2], a1[3]}, v1 = (bf16x8){b0[0], b0[1], b0[2], b0[3], b1[0], b1[1], b1[2], b1[3]}; \
          o1 = __builtin_amdgcn_mfma_f32_32x32x16_bf16(v0, pa0, o1, 0, 0, 0); o1 = __builtin_amdgcn_mfma_f32_32x32x16_bf16(v1, pa1, o1, 0, 0, 0); } \
    } while (0)

#ifdef MK_ATT_TS
#define AT_TS(k) do { __builtin_amdgcn_sched_barrier(0); unsigned long long t_; asm volatile("s_memtime %0\n\ts_waitcnt lgkmcnt(0)" : "=s"(t_) :: "memory"); ts_acc[k] += t_ - ts_prev; ts_prev = t_; __builtin_amdgcn_sched_barrier(0); } while (0)
#else
#define AT_TS(k) do { } while (0)
#endif
template <int MODE>
__device__ __forceinline__ void attn_phase(const Frame& F, const Args& A, unsigned long long* ts_out = nullptr) {
#ifdef MK_ATT_TS
    unsigned long long ts_acc[6] = {0, 0, 0, 0, 0, 0}, ts_prev = 0;
    { unsigned long long t_; asm volatile("s_memtime %0\n\ts_waitcnt lgkmcnt(0)" : "=s"(t_) :: "memory"); ts_prev = t_; }
#endif
    LAS float* tab = (LAS float*)(F.lds + AT_TAB);
    const char* qkvb = (const char*)(F.ws + WS_QKV); bf16_t* mo = (bf16_t*)(F.ws + (MODE == 0 ? WS_S0 : WS_S1));
    float* sto = (float*)(F.ws + WS_AST_O); float* stm = (float*)(F.ws + WS_AST_M);
    int lane_ = F.lane; asm volatile("" : "+v"(lane_));
    const int lane = lane_, w = F.wave, j = lane & 31, hi = lane >> 5;
    LAS unsigned char* vbuf = F.lds + AT_V + w * 4096;
    LAS unsigned char* vwr = vbuf + ((lane & 7) >> 2) * 2048 + (lane >> 3) * 64 + (lane & 3) * 16;
    const LAS unsigned char* vrd = vbuf + (4 * hi + ((lane & 15) >> 2)) * 64 + ((lane >> 4) & 1) * 32 + (lane & 3) * 8;
    volatile LAS int* bkt = (volatile LAS int*)(F.lds + AT_BKT);
    volatile LAS int* acnt = (volatile LAS int*)(F.lds + AT_CNT);
    for (int i = F.tid; i < 3 * 129; i += NTHREADS) { const int g = i / 129, m = i - g * 129; bkt[i] = t5_bucket(m * (g == 0 ? 1 : (g == 1 ? 4 : 16))); }
    LDS_WAIT(); __syncthreads();
    const __amdgpu_buffer_rsrc_t rsrc = __builtin_amdgcn_make_buffer_rsrc((void*)(F.ws + WS_QKV), 0, (int)((size_t)T * PITCHB), 0x00020000);
    for (int it = 0; ; ++it) {
        int b, h, cp;
        { const int u = ((F.G & 7) == 0) ? ((F.bid & 7) * (F.G >> 3) + (F.bid >> 3)) + it * F.G : F.bid + it * F.G;
          if (u >= 256) break;
          b = u >> 5; h = (u >> 1) & 15; cp = u & 1; }
        const int tb = b * SEQ;
        __syncthreads();
        if (F.tid < 4) acnt[F.tid] = 0;
        for (int i = F.tid; i < 3 * 640; i += NTHREADS) { const int g = i / 640, m = 383 - (i - g * 640);
            tab[i] = (m >= 0 && m <= 128) ? A.in[I_RELB][bkt[g * 129 + m] * 48 + g * 16 + h] * L2E : -1e30f; }
        LDS_WAIT(); __syncthreads();
        AT_TS(5);
        const int c = 2 * cp + (w & 1);
        f32x16 o0, o1, s; float M, l;
        bf16x8 kfA[4], kfB[4]; u32x4 vrA[4], vrB[4];
#pragma unroll 1
        for (int rd = 0; rd < 4; ++rd) {
            const int r16 = c + 4 * (w >> 1), nt = rd + 1;
            const size_t tq = (size_t)(tb + 16 * (32 * rd + j) + r16);
            bf16x8 qf[4];
            { const char* qp = qkvb + tq * PITCHB + (2 * 1024 + h * 64 + 8 * hi) * 2;
#pragma unroll
              for (int d0 = 0; d0 < 4; ++d0) qf[d0] = *(const bf16x8*)(qp + 32 * d0); }
            const unsigned koff = (unsigned)(16 * j) * PITCHB + (3072 + 2 * 1024 + h * 64 + 8 * hi) * 2;
            unsigned voff[4];
#pragma unroll
            for (int i = 0; i < 4; ++i) voff[i] = (unsigned)(16 * (8 * i + (lane >> 3))) * PITCHB + (6144 + 2 * 1024 + h * 64 + 8 * (lane & 7)) * 2;
            const unsigned ub = (unsigned)(tb + r16) * PITCHB, ustep = (unsigned)(16 * 32) * PITCHB;
            const LAS float* tla = tab + 2 * 640 + 383 - (32 * rd + j) + 4 * hi;
#pragma unroll
            for (int r = 0; r < 16; ++r) { o0[r] = 0.f; o1[r] = 0.f; }
            M = -1e29f; l = 0.f;
#define AT_LOADA(m, KF, VR) do { int m_ = (m); m_ = m_ < nt ? m_ : nt - 1; if (MODE == 1) m_ = 0; AT_LOADS(KF, VR, ub + (unsigned)m_ * ustep, koff, voff); } while (0)
            AT_LOADA(0, kfA, vrA); AT_LOADA(1, kfB, vrB);
            AT_TS(0);
            int n = 0;
#pragma unroll 1
            for (; n + 1 < nt; n += 2) {
                AT_SCORE(kfA, vrA, qf, tla + 32 * n)
                AT_LOADA(n + 2, kfA, vrA);
                AT_SOFTPV();
                AT_SCORE(kfB, vrB, qf, tla + 32 * (n + 1))
                AT_LOADA(n + 3, kfB, vrB);
                AT_SOFTPV();
            }
            if (n < nt) { AT_SCORE(kfA, vrA, qf, tla + 32 * n) AT_SOFTPV(); }
            AT_TS(1);
#undef AT_LOADA
            float* so = sto + ((tq * 16 + h) * 2 + hi) * 32;
#pragma unroll
            for (int r = 0; r < 16; r += 4) { *(f32x4*)(so + r) = (f32x4){o0[r], o0[r + 1], o0[r + 2], o0[r + 3]}; *(f32x4*)(so + 16 + r) = (f32x4){o1[r], o1[r + 1], o1[r + 2], o1[r + 3]}; }
            *(f32x2*)(stm + ((tq * 16 + h) * 2 + hi) * 2) = (f32x2){M, l};
            VM_WAIT();
            if (lane == 0) __hip_atomic_fetch_add((LAS int*)&acnt[rd], 1, __ATOMIC_RELAXED, __HIP_MEMORY_SCOPE_WORKGROUP);
            AT_TS(2);
        }
        AT_TS(3);
#pragma unroll 1
        for (int rd = 0; rd < 4; ++rd) {
            const int i0 = 32 * (4 * rd + (w >> 1));
            const int ktlo0 = (4 - i0 / 8) > 0 ? (4 - i0 / 8) : 0, n0 = 8 - ktlo0;
            const int ktlo1 = (4 - i0 / 32) > 0 ? (4 - i0 / 32) : 0, n1 = 5 - ktlo1, ntl = n0 + n1;
            const size_t tq = (size_t)(tb + 4 * (i0 + j) + c);
            bf16x8 qf0[4], qf1[4];
            { const char* qp = qkvb + tq * PITCHB + (h * 64 + 8 * hi) * 2;
#pragma unroll
              for (int d0 = 0; d0 < 4; ++d0) { qf0[d0] = *(const bf16x8*)(qp + 32 * d0); qf1[d0] = *(const bf16x8*)(qp + 2048 + 32 * d0); } }
            while (__builtin_amdgcn_readfirstlane(acnt[rd]) < NWAVES) __builtin_amdgcn_s_sleep(2);
            asm volatile("" ::: "memory");
            { const float* so = sto + ((tq * 16 + h) * 2 + hi) * 32;
#pragma unroll
              for (int r = 0; r < 16; r += 4) { const f32x4 a = *(const f32x4*)(so + r), bq = *(const f32x4*)(so + 16 + r);
                  o0[r] = a[0]; o0[r + 1] = a[1]; o0[r + 2] = a[2]; o0[r + 3] = a[3]; o1[r] = bq[0]; o1[r + 1] = bq[1]; o1[r + 2] = bq[2]; o1[r + 3] = bq[3]; }
              const f32x2 ml = *(const f32x2*)(stm + ((tq * 16 + h) * 2 + hi) * 2); M = ml[0]; l = ml[1]; }
            const int kb0 = 4 * i0 - 128 + 32 * ktlo0, ik1 = i0 - 128 + 32 * ktlo1;
            const unsigned koff0 = (unsigned)j * PITCHB + (3072 + h * 64 + 8 * hi) * 2, koff1 = (unsigned)(4 * j) * PITCHB + (3072 + 1024 + h * 64 + 8 * hi) * 2;
            unsigned voff0[4], voff1[4];
#pragma unroll
            for (int i = 0; i < 4; ++i) { voff0[i] = (unsigned)(8 * i + (lane >> 3)) * PITCHB + (6144 + h * 64 + 8 * (lane & 7)) * 2;
                                          voff1[i] = (unsigned)(4 * (8 * i + (lane >> 3))) * PITCHB + (6144 + 1024 + h * 64 + 8 * (lane & 7)) * 2; }
            const unsigned ub0 = (unsigned)(tb + kb0) * PITCHB, ub1 = (unsigned)(tb + 4 * ik1 + c) * PITCHB;
            const unsigned us0 = 32u * PITCHB, us1 = 128u * PITCHB;
            const LAS float* tla0 = tab + 383 - (4 * (i0 + j) + c - kb0) + 4 * hi;
            const LAS float* tla1 = tab + 640 + 383 - (i0 + j - ik1) + 4 * hi;
#define AT_LOADN(m, KF, VR) do { int m_ = (m); m_ = m_ < ntl ? m_ : ntl - 1; if (m_ < n0) AT_LOADS(KF, VR, ub0 + (unsigned)(MODE == 1 ? 0 : m_) * us0, koff0, voff0); else AT_LOADS(KF, VR, ub1 + (unsigned)(MODE == 1 ? 0 : m_ - n0) * us1, koff1, voff1); } while (0)
#define AT_STEPN(n, KF, VR, PF) do { const int n_ = (n); if (n_ < n0) { AT_SCORE(KF, VR, qf0, tla0 + 32 * n_) } else { AT_SCORE(KF, VR, qf1, tla1 + 32 * (n_ - n0)) } \
            if (PF) AT_LOADN(n_ + 2, KF, VR); AT_SOFTPV(); } while (0)
            AT_LOADN(0, kfA, vrA); AT_LOADN(1, kfB, vrB);
            AT_TS(0);
            int n = 0;
#pragma unroll 1
            for (; n + 1 < ntl; n += 2) { AT_STEPN(n, kfA, vrA, true); AT_STEPN(n + 1, kfB, vrB, true); }
            if (n < ntl) AT_STEPN(n, kfA, vrA, false);
            AT_TS(4);
#undef AT_STEPN
#undef AT_LOADN
            { auto rr = __builtin_amdgcn_permlane32_swap(__float_as_uint(l), __float_as_uint(l), false, false); l = __uint_as_float(rr[0]) + __uint_as_float(rr[1]); }
            const float il = 1.0f / l;
            bf16_t* op = mo + tq * D + h * 64 + 4 * hi;
#pragma unroll
            for (int gq = 0; gq < 4; ++gq) {
                u32x2 w0, w1;
                w0.x = cvt_pk_bf16(o0[4 * gq] * il, o0[4 * gq + 1] * il); w0.y = cvt_pk_bf16(o0[4 * gq + 2] * il, o0[4 * gq + 3] * il);
                w1.x = cvt_pk_bf16(o1[4 * gq] * il, o1[4 * gq + 1] * il); w1.y = cvt_pk_bf16(o1[4 * gq + 2] * il, o1[4 * gq + 3] * il);
                *(u32x2*)(op + 8 * gq) = w0; *(u32x2*)(op + 32 + 8 * gq) = w1;
            }
            AT_TS(2);
        }
    }
#ifdef MK_ATT_TS
    if (ts_out && F.tid == 0) { for (int k = 0; k < 6; ++k) ts_out[k] = ts_acc[k]; }
#endif
    __syncthreads();
}
#undef AT_LOADS
#undef AT_SCORE
#undef AT_SOFTPV
constexpr int PH_MIX = 0, PH_FF1 = 1, PH_FF2 = 2, PH_QKV = 3, PH_ATT = 4, PH_WO = 5, PH_ROUTE = 6, PH_MOE0 = 7, PH_FINAL = 10, PH_END = 11;

__global__ void __launch_bounds__(NTHREADS, 2) mk_fwd(Args args) {
    extern __shared__ __attribute__((aligned(16))) unsigned char lds_raw[];
    Frame F;
    F.lds = (LAS unsigned char*)lds_raw;
    F.tid = threadIdx.x; F.lane = F.tid & 63; F.wave = __builtin_amdgcn_readfirstlane(F.tid >> 6); F.G = gridDim.x; F.bid = blockIdx.x;
    F.ws = args.ws; F.ctl = (unsigned*)(args.ws + WS_CTL); F.h = args.out;
    volatile LAS unsigned* MISC = (volatile LAS unsigned*)(F.lds + MISC_OFF);
    for (int u = F.tid; u < 64; u += NTHREADS) MISC[u] = 0u;
    __syncthreads();
    XcdBarrier bar = xcd_barrier_post(F.ctl + CW_BAR + args.li * XCD_BAR_WORDS, MISC + 8);
    const int lo = args.ph_lo, hi = args.ph_hi;
#ifndef MK_MASK
#define MK_MASK 0xffffffffu
#endif
#define IN(k) (((MK_MASK >> (k)) & 1u) && lo <= (k) && (k) < hi)
#define SEAM(k) do { if (IN(k) && IN((k) + 1)) xcd_barrier(bar); } while (0)
    unsigned char* ws = args.ws;
    LAS unsigned char* ring = F.lds + RING_OFF;
#ifdef MK_PROBE_LO
    unsigned long long pr_t0 = 0, pr_t1 = 0;
#define PROBE_AT(k) do { if ((k) == MK_PROBE_LO) pr_t0 = __builtin_amdgcn_s_memrealtime(); if ((k) == MK_PROBE_HI) pr_t1 = __builtin_amdgcn_s_memrealtime(); } while (0)
#else
#define PROBE_AT(k) do { } while (0)
#endif

    PROBE_AT(0);
    if (IN(PH_MIX)) { conv_aproj(F, args); conv_small(F, args); VM_WAIT(); __syncthreads(); }
    PROBE_AT(20);
    if (IN(PH_MIX)) { xcd_barrier(bar); PROBE_AT(21); mixer_phase(F, args); }
    PROBE_AT(22);
    SEAM(PH_MIX);

    PROBE_AT(1);
    if (IN(PH_FF1)) {
        pg8::Gemm g{(const bf16_t*)(ws + WS_S0), (const bf16_t*)(ws + WS_WGU0), D, D, D}; pg8::StaticOrder S; S.init(T, 2 * FF0, F.G, F.bid);
        EpiSwiGLU E{(bf16_t*)(ws + WS_ACT0), ACT0_LD, nullptr, 1.f, 1.f};
        pg8::gemm_phase<EpiSwiGLU, pg8::StaticOrder, false>(ring, g, S, E);
        { const int units = (T / 256) * (2 * FF0 / 256), rem = units % F.G;
          if (rem == 0) conv_later(F, args, F.bid, F.G); else if (F.bid >= rem) conv_later(F, args, F.bid - rem, F.G - rem); }
    }
    SEAM(PH_FF1);
    PROBE_AT(2);
    if (IN(PH_FF2)) {
        pg8::Gemm g{(const bf16_t*)(ws + WS_ACT0), (const bf16_t*)(ws + WS_WD0), FF0, ACT0_LD, FF0}; pg8::StaticOrder S; S.init(T, D, F.G, F.bid);
        EpiRes E{F.h, (bf16_t*)(ws + WS_S1), (float*)(ws + WS_SSQ), nullptr};
        pg8::gemm_phase<EpiRes, pg8::StaticOrder, false>(ring, g, S, E);
    }
    SEAM(PH_FF2);
    PROBE_AT(3);
    if (IN(PH_QKV)) {
        pg8::Gemm g{(const bf16_t*)(ws + WS_S1), (const bf16_t*)(ws + WS_WQKV), D, D, D}; pg8::StaticOrder S; S.init(T, NQKV, F.G, F.bid);
        EpiQKV E{(bf16_t*)(ws + WS_QKV), (const float*)(ws + WS_SSQ)};
        pg8::gemm_phase<EpiQKV, pg8::StaticOrder, false>(ring, g, S, E);
#if defined(MK_QKV_EXTRA) && MK_QKV_EXTRA == 1
        pg8::gemm_phase<EpiQKV, pg8::StaticOrder, false>(ring, g, S, E);
#elif defined(MK_QKV_EXTRA) && MK_QKV_EXTRA == 4
        { EpiNull EN; pg8::gemm_phase_ref<EpiNull, pg8::StaticOrder>(ring, g, S, EN); }
#elif defined(MK_QKV_EXTRA) && MK_QKV_EXTRA == 3
        { EpiQKV_T<false> EN{(bf16_t*)(ws + WS_QKV), (const float*)(ws + WS_SSQ)}; pg8::gemm_phase<EpiQKV_T<false>, pg8::StaticOrder, false>(ring, g, S, EN); }
#elif defined(MK_QKV_EXTRA) && MK_QKV_EXTRA == 2
        { EpiNull EN; pg8::gemm_phase<EpiNull, pg8::StaticOrder, false>(ring, g, S, EN); }
#endif
    }
    SEAM(PH_QKV);
        PROBE_AT(4);
#ifdef MK_ATT_TS
    unsigned long long att_ts[6] = {0, 0, 0, 0, 0, 0};
    if (IN(PH_ATT)) { attn_phase<0>(F, args, att_ts);
#else
    if (IN(PH_ATT)) { attn_phase<0>(F, args);
#endif
#ifdef MK_ATT_EXTRA
        attn_phase<MK_ATT_EXTRA>(F, args);
#endif
    }
    SEAM(PH_ATT);
    PROBE_AT(5);
    if (IN(PH_WO)) {
        pg8::Gemm g{(const bf16_t*)(ws + WS_S0), (const bf16_t*)(ws + WS_WO), D, D, D}; pg8::StaticOrder S; S.init(T, D, F.G, F.bid);
        EpiRes E{F.h, (bf16_t*)(ws + WS_S1), nullptr, ws + WS_S1};
        pg8::gemm_phase<EpiRes, pg8::StaticOrder, false>(ring, g, S, E);
        conv_moe(F, args);
    }
    SEAM(PH_WO);
    PROBE_AT(6);
    if (IN(PH_ROUTE)) { router_phase(F, args); }
    SEAM(PH_ROUTE);
#pragma unroll 1
    for (int j = 0; j < 3; ++j) {
        PROBE_AT(7 + j);
        if (IN(PH_MOE0 + j)) {
            moe_info_build(F.lds, F.ctl);
            volatile LAS int* mi = (volatile LAS int*)(F.lds + SCR_OFF);
            const int ntiles = __builtin_amdgcn_readfirstlane(mi[MI_NT]);
            const int c1s = __builtin_amdgcn_readfirstlane(mi[MI_C1]);
            if (j >= 1) {
                const int c0 = j == 1 ? 0 : c1s; const int ntc = j == 1 ? c1s : ntiles - c1s;
                EpiY E{(bf16_t*)(ws + WS_Y), (bf16_t*)(ws + WS_Y2), c0 * 256, 1.f / (WD_PRESC * ACT_PRESC)};
                if (j == 2) {
                    pg8::Gemm g{(const bf16_t*)(ws + WS_ACT1 + ACT1_B1), (const bf16_t*)(ws + WS_WD1), FF1 / 4, FF1 / 2, FF1 / 2};
                    MoeOrder<8, false> S{{F.ctl + CW_Q + 64 * (2 * j), MISC + 16}, mi, c0, ntc, nullptr};
                    pg8::gemm_phase<EpiY, MoeOrder<8, false>, false, true>(ring, g, S, E);
                } else {
                    pg8::Gemm g{(const bf16_t*)(ws + WS_ACT1), (const bf16_t*)(ws + WS_WD1), FF1 / 2, FF1 / 2, FF1 / 2};
                    MoeOrder<4, false> S{{F.ctl + CW_Q + 64 * (2 * j), MISC + 16}, mi, c0, ntc, nullptr};
                    pg8::gemm_phase<EpiY, MoeOrder<4, false>, false, true>(ring, g, S, E);
                }
            }
            if (j <= 1) {
                const int c0 = j == 0 ? 0 : c1s; const int ntc = j == 0 ? c1s : ntiles - c1s;
                pg8::Gemm g{(const bf16_t*)(ws + WS_S1), (const bf16_t*)(ws + WS_WGU1), D / 2, D / 2, D / 2};
                MoeOrder<28, true> S{{F.ctl + CW_Q + 64 * (2 * j + 1), MISC + 16}, mi, c0, ntc, (const int*)(ws + WS_LTOK)};
                EpiSwiGLU_T<true> E{(bf16_t*)(ws + WS_ACT1 + (j ? ACT1_B1 : (size_t)0)), FF1, (const float*)(ws + WS_LRS), 1.f / WGU_PRESC, ACT_PRESC};
                pg8::gemm_phase<EpiSwiGLU_T<true>, MoeOrder<28, true>, true, true>(ring, g, S, E);
            }
        }
        SEAM(PH_MOE0 + j);
    }
#ifdef MK_EXTRA_BARS
    for (int i = 0; i < MK_EXTRA_BARS; ++i) xcd_barrier(bar);
#endif
    PROBE_AT(10);
    if (IN(PH_FINAL)) { moe_info_build(F.lds, F.ctl); final_phase(F, args); }
    PROBE_AT(11);
#ifdef MK_ATT_TS
    if (F.bid == 0 && F.wave == 0) { const unsigned long long dt = att_ts[MK_ATT_TS] / 5ull, ts = __builtin_amdgcn_s_memrealtime(); while (__builtin_amdgcn_s_memrealtime() - ts < dt) __builtin_amdgcn_s_sleep(8); }
#endif
#ifdef MK_PROBE_LO
    { const unsigned long long dt = (pr_t1 - pr_t0) * MK_PROBE_MULT, ts = __builtin_amdgcn_s_memrealtime(); while (__builtin_amdgcn_s_memrealtime() - ts < dt) __builtin_amdgcn_s_sleep(8); }
#endif
#undef IN
#undef SEAM
}
}
extern "C" void kernel_launch(void* const* d_in, const int* in_sizes, int n_in, void* d_out, int out_size, void* d_ws, size_t ws_size, hipStream_t stream) {
    static int grid = 0;
    if (grid == 0) {
        if (n_in != 19 || out_size != mk::T * mk::D || ws_size < mk::WS_END) { fprintf(stderr, "kernel_launch: unexpected shapes / workspace (%d inputs, out %d, ws %zu)\n", n_in, out_size, ws_size); grid = -1; return; }
        int dev = 0, cus = 0;
        if (hipGetDevice(&dev) != hipSuccess || hipDeviceGetAttribute(&cus, hipDeviceAttributeMultiprocessorCount, dev) != hipSuccess) { grid = -1; return; }
        if (hipFuncSetAttribute((const void*)mk::mk_fwd, hipFuncAttributeMaxDynamicSharedMemorySize, mk::LDS_BYTES) != hipSuccess) { fprintf(stderr, "kernel_launch: hipFuncSetAttribute failed\n"); grid = -1; return; }
        int per_cu = 0;
        if (hipOccupancyMaxActiveBlocksPerMultiprocessor(&per_cu, (const void*)mk::mk_fwd, mk::NTHREADS, mk::LDS_BYTES) != hipSuccess || per_cu < 1) { fprintf(stderr, "kernel_launch: occupancy query says %d blocks per CU\n", per_cu); }
        (void)hipGetLastError();
        grid = cus;
    }
    if (grid < 0) return;
    (void)hipMemsetAsync((char*)d_ws + mk::WS_CTL, 0, mk::CTL_ZERO_BYTES, stream);
    mk::Args a{};
    for (int i = 0; i < 19; ++i) a.in[i] = (const float*)d_in[i];
    a.out = (float*)d_out; a.ws = (unsigned char*)d_ws;
    a.ph_lo = 0; a.ph_hi = mk::PH_END; a.li = 0;
    hipLaunchKernelGGL(mk::mk_fwd, dim3(grid), dim3(mk::NTHREADS), mk::LDS_BYTES, stream, a);
}
```

```cpp
#include <hip/hip_runtime.h>
#include <cstdio>
#include <cstdint>
namespace mk {
#define LAS __attribute__((address_space(3)))
#define GAS __attribute__((address_space(1)))
typedef unsigned short bf16_t;
typedef short bf16x8 __attribute__((ext_vector_type(8)));
typedef float f32x4 __attribute__((ext_vector_type(4)));
typedef float f32x2 __attribute__((ext_vector_type(2)));
typedef unsigned u32x4 __attribute__((ext_vector_type(4)));
typedef unsigned u32x2 __attribute__((ext_vector_type(2)));

constexpr int T = 16384, D = 1024, SEQ = 2048, NBATCH = 8;
constexpr int FF0 = 2816, FF1 = 3584, NE = 8, NQKV = 9216;
constexpr int ACT0_LD = FF0 + 64;
constexpr int QKV_LD = NQKV + 64;
constexpr float EPS = 1e-6f;
constexpr float WGU_PRESC = 32.f, WD_PRESC = 64.f, ACT_PRESC = 4.f;
constexpr int NWAVES = 8, NTHREADS = 512;

constexpr size_t MiB = 1u << 20;
constexpr size_t WS_CTL = 0, CTL_ZERO_BYTES = 1 * MiB;
constexpr size_t WS_SSQ = 1 * MiB;
constexpr size_t WS_LTOK = 2 * MiB;
constexpr size_t WS_LRS = 2 * MiB + 512 * 1024;
constexpr size_t WS_TOKINFO = 3 * MiB;
constexpr size_t WS_ZERO = 3 * MiB + 256 * 1024;
constexpr size_t WS_APT = 3 * MiB + 512 * 1024;
constexpr size_t WS_WGU0 = 4 * MiB;
constexpr size_t WS_WD0 = 15 * MiB;
constexpr size_t WS_WQKV = WS_WD0 + (size_t)D * FF0 * 2;
constexpr size_t WS_WO = WS_WQKV + (size_t)NQKV * D * 2;
constexpr size_t WS_S0 = 41 * MiB;
constexpr size_t WS_S1 = 73 * MiB;
constexpr size_t WS_POOL = 105 * MiB;
constexpr size_t WS_ACT0 = WS_POOL;
constexpr size_t WS_QKV = WS_POOL;
constexpr int LAST_TILES = 32;
constexpr int CH0_CAP = 136 - LAST_TILES;
constexpr size_t ACT1_B1 = (size_t)CH0_CAP * 256 * FF1;
constexpr size_t WS_ACT1 = WS_POOL;
constexpr size_t WS_Y = 4 * MiB;
constexpr size_t WS_Y2 = WS_ACT1 + ACT1_B1 + (size_t)LAST_TILES * 256 * FF1;
constexpr size_t WS_WGU1 = 306 * MiB;
constexpr size_t WS_WD1 = 418 * MiB;
constexpr size_t WS_END = 474 * MiB;
static_assert(WS_WO + (size_t)D * D * 2 <= WS_S0, "small weights");
static_assert(WS_Y2 + (size_t)LAST_TILES * 256 * D * 2 <= WS_WGU1 && WS_Y + (size_t)34816 * D * 2 <= WS_S1, "moe map");
static_assert(WS_WGU1 + (size_t)NE * 7168 * D * 2 <= WS_WD1 && WS_WD1 + (size_t)NE * D * FF1 * 2 <= WS_END, "moe weights");
static_assert(WS_QKV + (size_t)T * QKV_LD * 2 <= WS_END, "qkv");

constexpr int CW_TMO = 0;
constexpr int CW_CNT = 64;
constexpr int CW_Q = 128;
constexpr int CW_BAR = 4096;

constexpr int RING_OFF = 0, RING_BYTES = 131072;
constexpr int MISC_OFF = RING_BYTES;
constexpr int RTAB_OFF = MISC_OFF + 1024;
constexpr int SCR_OFF = MISC_OFF + 2048;
constexpr int TOKT_OFF = SCR_OFF + 1024;
constexpr int LRST_OFF = SCR_OFF + 2048;
constexpr int LDS_BYTES = 147456;

#define RLX_AGENT __ATOMIC_RELAXED, __HIP_MEMORY_SCOPE_AGENT
#define LDS_WAIT() asm volatile("s_waitcnt lgkmcnt(0)" ::: "memory")
#define VM_WAIT() asm volatile("s_waitcnt vmcnt(0)" ::: "memory")
__device__ __forceinline__ unsigned f2bf(float f) { unsigned u = __builtin_bit_cast(unsigned, f); return (u + 0x7fffu + ((u >> 16) & 1u)) >> 16; }
__device__ __forceinline__ unsigned pk2(float lo, float hi) { return f2bf(lo) | (f2bf(hi) << 16); }
__device__ __forceinline__ unsigned cvt_pk_bf16(float lo, float hi) { unsigned r; asm volatile("v_cvt_pk_bf16_f32 %0, %1, %2" : "=v"(r) : "v"(lo), "v"(hi)); return r; }
__device__ __forceinline__ float bf2f(unsigned short b) { return __builtin_bit_cast(float, ((unsigned)b) << 16); }
__device__ __forceinline__ float wave_sum(float v) {
#pragma unroll
    for (int o = 1; o < 64; o <<= 1) v += __shfl_xor(v, o);
    return v;
}
__device__ __forceinline__ float silu_f(float x) { return x * __builtin_amdgcn_rcpf(1.f + __builtin_amdgcn_exp2f(-1.4426950408889634f * x)); }
#define XB_TMO      128
#define XB_XCNT(j)  (256  + 64 * (j))
#define XB_XSUB(j)  (1280 + 64 * (j))
#define XB_XGEN(j)  (2304 + 64 * (j))
#define XB_TOP      3328
#define XB_TOPGEN   3392
#define XCD_BAR_WORDS 3456
#define XB_SPIN_CAP (1u << 18)
__device__ __forceinline__ unsigned xb_ld(unsigned* p)              { return __hip_atomic_load(p, __ATOMIC_RELAXED, __HIP_MEMORY_SCOPE_AGENT); }
__device__ __forceinline__ unsigned xb_add(unsigned* p, unsigned v) { return __hip_atomic_fetch_add(p, v, __ATOMIC_RELAXED, __HIP_MEMORY_SCOPE_AGENT); }
__device__ __forceinline__ unsigned xb_xcc_id() { return (unsigned)__builtin_amdgcn_s_getreg((3 << 11) | 20) & 0xFu; }
#define XB_SPIN(cond, bar) do { unsigned _sp = 0; while (cond) { __builtin_amdgcn_s_sleep(1); \
    if ((++_sp & 255u) == 0u) { if (xb_ld(&(bar)[XB_TMO])) break; if (_sp > XB_SPIN_CAP) { atomicAdd(&(bar)[XB_TMO], 1u); break; } } } } while (0)
struct XcdBarrier { unsigned* bar; unsigned x; volatile LAS unsigned* st; };
__device__ __forceinline__ XcdBarrier xcd_barrier_post(unsigned* bar, volatile LAS unsigned* st) {
    XcdBarrier b; b.bar = bar; b.x = xb_xcc_id(); b.st = st;
    if (threadIdx.x == 0) (void)xb_add(&bar[XB_XCNT(b.x)], 1u);
    return b;
}
__device__ __forceinline__ void xcd_barrier_complete(unsigned* bar, unsigned x, unsigned& nloc, unsigned& nx) {
    const unsigned G = gridDim.x * gridDim.y * gridDim.z;
    unsigned sum, cnt, mine, sp = 0u;
    for (;;) {
        sum = 0u; cnt = 0u; mine = 0u;
#pragma unroll
        for (unsigned j = 0; j < 16; ++j) { const unsigned c = xb_ld(&bar[XB_XCNT(j)]); sum += c; cnt += (c > 0u) ? 1u : 0u; mine = (j == x) ? c : mine; }
        if (sum == G) break;
        __builtin_amdgcn_s_sleep(1);
        if ((++sp & 255u) == 0u) { if (xb_ld(&bar[XB_TMO])) break; if (sp > XB_SPIN_CAP) { atomicAdd(&bar[XB_TMO], 1u); break; } }
    }
    nloc = mine > 0u ? mine : 1u; nx = cnt > 0u ? cnt : 1u;
}
__device__ __forceinline__ void xcd_barrier(const XcdBarrier& b) {
    asm volatile("s_waitcnt vmcnt(0)" ::: "memory");
    __syncthreads();
    if (threadIdx.x == 0) {
        unsigned* bar = b.bar;
        __builtin_amdgcn_s_waitcnt(0);
        unsigned nloc = b.st[0], nx = b.st[1];
        if (nloc == 0u) { xcd_barrier_complete(bar, b.x, nloc, nx); b.st[0] = nloc; b.st[1] = nx; }
        const unsigned old = xb_add(&bar[XB_XSUB(b.x)], 1u);
        const unsigned gen = old / nloc;
        if (old + 1u == (gen + 1u) * nloc) {
            __builtin_amdgcn_fence(__ATOMIC_RELEASE, "agent");
            asm volatile("s_waitcnt vmcnt(0)" ::: "memory");
            const unsigned og = xb_add(&bar[XB_TOP], 1u);
            const unsigned tg = og / nx;
            if (og + 1u == (tg + 1u) * nx) xb_add(&bar[XB_TOPGEN], 1u);
            else XB_SPIN(xb_ld(&bar[XB_TOPGEN]) == tg, bar);
            __builtin_amdgcn_fence(__ATOMIC_ACQUIRE, "agent");
            xb_add(&bar[XB_XGEN(b.x)], 1u);
            asm volatile("s_waitcnt vmcnt(0)" ::: "memory");
        } else {
            XB_SPIN(xb_ld(&bar[XB_XGEN(b.x)]) == gen, bar);
            __builtin_amdgcn_fence(__ATOMIC_ACQUIRE, "agent");
            asm volatile("s_waitcnt vmcnt(0)" ::: "memory");
        }
    }
    __syncthreads();
}
namespace pg8 {
typedef int v4i __attribute__((ext_vector_type(4)));
typedef int v8i __attribute__((ext_vector_type(8)));
constexpr int BM = 256, BK = 64, HALF = 128, HTB = HALF * BK * 2, STAGE_BYTES = 8 * HTB, NXCD = 8, WGM = 4;
__host__ __device__ __forceinline__ int lds_byte(int r, int c) { const int st = (r >> 4) * 2 + (c >> 5), rr = r & 15, cc = c & 31, ob = rr * 64 + cc * 2; return st * 1024 + (ob ^ (((ob >> 9) & 1) << 5)); }
__host__ __device__ __forceinline__ void stage_rc(int b, int& R, int& C) { const int st = b / 1024, sb = b % 1024, swz = sb ^ (((sb >> 9) & 1) << 5); R = (st >> 1) * 16 + swz / 64; C = (st & 1) * 32 + (swz % 64) / 2; }
__host__ __device__ __forceinline__ int perm32(int rho) { const int n = rho >> 4, i = rho & 15; return 8 * (i >> 2) + 4 * n + (i & 3); }

struct Unit { int pm, pn, arow, brow, e, orow, koff; };
struct Gemm { const bf16_t* A; const bf16_t* Bt; int K; int lda; int ldb; };

struct StaticOrder {
    int nM, nN, nwg, G, c;
    __device__ void init(int M, int N, int G_, int c_) { nM = M / BM; nN = N / BM; nwg = nM * nN; G = G_; c = c_; }
    __device__ __forceinline__ void start() const {}
    __device__ __forceinline__ bool next(int i, Unit& u) const {
        const long L = (long)i * G + c; if (L >= nwg) return false;
        int wgid = (int)L; { const int q = nwg / NXCD, r = nwg % NXCD, xcd = wgid % NXCD, off = wgid / NXCD; wgid = (xcd < r ? xcd * (q + 1) : r * (q + 1) + (xcd - r) * q) + off; }
        const int nig = WGM * nN, gid = wgid / nig, fm = gid * WGM, gsz = (nM - fm) < WGM ? (nM - fm) : WGM;
        u.pm = fm + ((wgid % nig) % gsz); u.pn = (wgid % nig) / gsz; u.arow = u.pm * BM; u.brow = u.pn * BM; u.e = 0; u.orow = u.arow; u.koff = 0; return true;
    }
    __device__ __forceinline__ unsigned refill_issue() const { return 0u; }
    __device__ __forceinline__ void refill_commit(int, unsigned) const {}
    __device__ __forceinline__ unsigned gather_row(const Unit&, int) const { return 0u; }
};

template <class Epi, class Sched, bool GATHER, bool FP8 = false>
__device__ __forceinline__ void gemm_phase(LAS unsigned char* lds, const Gemm g, Sched& S, const Epi& E) {
    int tid_ = threadIdx.x; asm volatile("" : "+v"(tid_));
    const int tid = tid_, wid = __builtin_amdgcn_readfirstlane(tid >> 6), lane = tid & 63, wr = wid >> 2, wc = wid & 3, fr = lane & 15, fq = lane >> 4;
    int K_ = g.K; asm volatile("" : "+s"(K_));
    const int K = K_, nt = K / BK, LDA = g.lda, LDB = g.ldb;
    unsigned voffB[2]; unsigned va[2][2];
    const size_t kstep = (size_t)(BK * 2);
    const size_t hstep = (size_t)HALF * LDB * 2, hstepA = (size_t)HALF * LDA * 2;
#pragma unroll
    for (int i = 0; i < 2; ++i) { int R, C; stage_rc(tid * 16 + i * 8192, R, C); const int Rb = Epi::PERM ? ((R & ~31) + perm32(R & 31)) : R;
        voffB[i] = (unsigned)(Rb * LDB + C) * 2u;
        va[0][i] = (unsigned)(R * LDA + C) * 2u; va[1][i] = va[0][i] + (unsigned)hstepA; }
    const unsigned ldsw = (unsigned)wid * 1024u;
    const int aoff0 = lds_byte(wr * 64 + fr, FP8 ? 16 * fq : 8 * fq), aoff1 = lds_byte(wr * 64 + fr, FP8 ? 16 * fq + 8 : 8 * fq + 32);
    const int boff0 = lds_byte(wc * 32 + fr, FP8 ? 16 * fq : 8 * fq), boff1 = lds_byte(wc * 32 + fr, FP8 ? 16 * fq + 8 : 8 * fq + 32);
#define PG8_SA(b, h) (((b) * 2 + (h)) * HTB)
#define PG8_SB(b, h) ((4 + (b) * 2 + (h)) * HTB)
#define PG8_STAGEB(bufoff, gbase) do { _Pragma("unroll") for (int _i = 0; _i < 2; ++_i) \
        __builtin_amdgcn_global_load_lds((const unsigned*)((const char*)(gbase) + voffB[_i]), (LAS unsigned*)(lds + (bufoff) + ldsw + _i * 8192), 16, 0, 0); } while (0)
#define PG8_STAGEA(bufoff, gbase, vo, h) do { _Pragma("unroll") for (int _i = 0; _i < 2; ++_i) \
        __builtin_amdgcn_global_load_lds((const unsigned*)((const char*)(gbase) + (vo)[h][_i]), (LAS unsigned*)(lds + (bufoff) + ldsw + _i * 8192), 16, 0, 0); } while (0)
#define PG8_CAT8(p0, p1) __builtin_shufflevector(__builtin_bit_cast(v4i, *(const LAS bf16x8*)(p0)), __builtin_bit_cast(v4i, *(const LAS bf16x8*)(p1)), 0, 1, 2, 3, 4, 5, 6, 7)
#define PG8_LDA(dst, b, h) do { _Pragma("unroll") for (int m = 0; m < 4; ++m) { \
        if constexpr (FP8) dst##8[m] = PG8_CAT8(lds + PG8_SA(b, h) + aoff0 + m * 2048, lds + PG8_SA(b, h) + aoff0 + m * 2048 + 16);   \
        else { dst[m][0] = *(const LAS bf16x8*)(lds + PG8_SA(b, h) + aoff0 + m * 2048); dst[m][1] = *(const LAS bf16x8*)(lds + PG8_SA(b, h) + aoff1 + m * 2048); } } } while (0)
#define PG8_LDB(dst, b, h) do { _Pragma("unroll") for (int n = 0; n < 2; ++n) { \
        if constexpr (FP8) dst##8[n] = PG8_CAT8(lds + PG8_SB(b, h) + boff0 + n * 2048, lds + PG8_SB(b, h) + boff0 + n * 2048 + 16); \
        else { dst[n][0] = *(const LAS bf16x8*)(lds + PG8_SB(b, h) + boff0 + n * 2048); dst[n][1] = *(const LAS bf16x8*)(lds + PG8_SB(b, h) + boff1 + n * 2048); } } } while (0)
#define PG8_MMA(ai, bj, At, Bt) do { __builtin_amdgcn_s_setprio(1); _Pragma("unroll") for (int m = 0; m < 4; ++m) _Pragma("unroll") for (int n = 0; n < 2; ++n) { \
        if constexpr (FP8) asm volatile("v_mfma_scale_f32_16x16x128_f8f6f4 %0, %1, %2, %0, %3, %3 op_sel_hi:[0,0,0]" : "+v"(acc[ai][bj][m][n]) : "v"(Bt##8[n]), "v"(At##8[m]), "v"(sc8));   \
        else { _Pragma("unroll") for (int k = 0; k < 2; ++k) acc[ai][bj][m][n] = __builtin_amdgcn_mfma_f32_16x16x32_bf16(Bt[n][k], At[m][k], acc[ai][bj][m][n], 0, 0, 0); } } \
        __builtin_amdgcn_s_setprio(0); } while (0)
#define PG8_WAIT_V(n) asm volatile("s_waitcnt vmcnt(" #n ")" ::: "memory")
#define PG8_WAIT_L(n) asm volatile("s_waitcnt lgkmcnt(" #n ")" ::: "memory")
#define PG8_BAR __builtin_amdgcn_s_barrier()
#define PG8_SCHED __builtin_amdgcn_sched_barrier(0)
    int sc8 = 0x7f7f7f7f; asm volatile("" : "+v"(sc8));
    Unit cur, nxt; int ui = 0;
    typename Epi::Pre pre{};
#ifdef MK_STAGGER
    { const unsigned long long dt = (unsigned long long)((blockIdx.x >> 3) & 7) * MK_STAGGER, ts = __builtin_amdgcn_s_memrealtime(); while (__builtin_amdgcn_s_memrealtime() - ts < dt) __builtin_amdgcn_s_sleep(4); }
#endif
    S.start();
    if (!S.next(0, cur)) return;
    f32x4 acc[2][2][4][2];
#pragma unroll
    for (int a = 0; a < 2; ++a)
#pragma unroll
        for (int b = 0; b < 2; ++b)
#pragma unroll
            for (int m = 0; m < 4; ++m)
#pragma unroll
                for (int n = 0; n < 2; ++n) acc[a][b][m][n] = (f32x4){0.f, 0.f, 0.f, 0.f};
    bf16x8 At[4][2], B0[2][2], B1[2][2]; v8i At8[4], B08[2], B18[2];
    const char* cA; const char* cB = (const char*)g.Bt + ((size_t)cur.brow * LDB + cur.koff) * 2;
    if constexpr (GATHER) { cA = (const char*)g.A;
#pragma unroll
        for (int h = 0; h < 2; ++h)
#pragma unroll
            for (int i = 0; i < 2; ++i) { int R, C; stage_rc(tid * 16 + i * 8192, R, C); va[h][i] = (S.gather_row(cur, h * HALF + R) * (unsigned)LDA + (unsigned)C) * 2u; }
    } else cA = (const char*)g.A + ((size_t)cur.arow * LDA + cur.koff) * 2;
    PG8_STAGEB(PG8_SB(0, 0), cB); PG8_STAGEB(PG8_SB(0, 1), cB + hstep); PG8_STAGEA(PG8_SA(0, 0), cA, va, 0); PG8_STAGEA(PG8_SA(0, 1), cA, va, 1);
    if (wr == 1) PG8_BAR;
    PG8_WAIT_V(2); PG8_BAR;
    PG8_STAGEB(PG8_SB(1, 0), cB + kstep); PG8_STAGEA(PG8_SA(1, 0), cA + kstep, va, 0); PG8_STAGEB(PG8_SB(1, 1), cB + hstep + kstep);
    PG8_WAIT_V(6); PG8_BAR;
    for (;;) {
        bool has_next = false; const char* nA = cA; const char* nB = cB;
        unsigned vnx[2][2] = {{0u, 0u}, {0u, 0u}};
#pragma unroll 1
        for (int t = 0; t < nt; t += 2) {
            const bool last = (t == nt - 2);
            unsigned v2[2][2];
#pragma unroll
            for (int h = 0; h < 2; ++h)
#pragma unroll
                for (int i = 0; i < 2; ++i) v2[h][i] = va[h][i];
            if constexpr (GATHER) { if (t == nt - 4) {
                has_next = S.next(ui + 1, nxt);
                if (has_next) __builtin_amdgcn_global_load_lds((const unsigned*)S.gather_src(nxt, tid & 255), (LAS unsigned*)(lds + TOKT_OFF + (wid & 3) * 256), 4, 0, 0);
            } }
            if constexpr (Epi::DMA_PRE) { if (t == nt - 4) E.dma_pre(cur, tid, wid, lds); }
            if (last) {
                pre = E.pre(cur, wr, fr);
                if constexpr (!GATHER) has_next = S.next(ui + 1, nxt);
                if (has_next) { nB = (const char*)g.Bt + ((size_t)nxt.brow * LDB + nxt.koff) * 2;
                    if constexpr (GATHER) {
#pragma unroll
                        for (int h = 0; h < 2; ++h)
#pragma unroll
                            for (int i = 0; i < 2; ++i) { int R, C; stage_rc(tid * 16 + i * 8192, R, C); v2[h][i] = (((volatile LAS unsigned*)(lds + TOKT_OFF))[h * HALF + R] * (unsigned)LDA + (unsigned)C) * 2u; }
                    } else nA = (const char*)g.A + ((size_t)nxt.arow * LDA + nxt.koff) * 2;
                }
            }
            if constexpr (GATHER) { if (last) {
#pragma unroll
                for (int h = 0; h < 2; ++h)
#pragma unroll
                    for (int i = 0; i < 2; ++i) vnx[h][i] = v2[h][i]; } }
            const char* a1 = cA + (size_t)(t + 1) * kstep;
            const char* a2 = last ? nA : cA + (size_t)(t + 2) * kstep; const char* b2 = last ? nB : cB + (size_t)(t + 2) * kstep;
            const char* a3 = a2 + kstep; const char* b3 = b2 + kstep;
            PG8_LDB(B0, 0, 0); PG8_LDB(B1, 0, 1); PG8_SCHED; PG8_LDA(At, 0, 0); PG8_STAGEA(PG8_SA(1, 1), a1, va, 1);
            PG8_WAIT_V(8); PG8_WAIT_L(0); PG8_BAR; PG8_MMA(0, 0, At, B0); PG8_MMA(0, 1, At, B1); PG8_BAR; PG8_SCHED;
            PG8_LDA(At, 0, 1); PG8_STAGEB(PG8_SB(0, 0), b2); PG8_STAGEB(PG8_SB(0, 1), b2 + hstep); PG8_STAGEA(PG8_SA(0, 0), a2, v2, 0);
            PG8_WAIT_V(8); PG8_WAIT_L(0); PG8_BAR; PG8_MMA(1, 0, At, B0); PG8_MMA(1, 1, At, B1); PG8_BAR; PG8_SCHED;
            PG8_LDB(B0, 1, 0); PG8_LDB(B1, 1, 1); PG8_SCHED; PG8_LDA(At, 1, 0); PG8_STAGEA(PG8_SA(0, 1), a2, v2, 1);
            PG8_WAIT_V(8); PG8_WAIT_L(0); PG8_BAR; PG8_MMA(0, 0, At, B0); PG8_MMA(0, 1, At, B1); PG8_BAR; PG8_SCHED;
            PG8_LDA(At, 1, 1); PG8_STAGEB(PG8_SB(1, 0), b3); PG8_STAGEB(PG8_SB(1, 1), b3 + hstep); PG8_STAGEA(PG8_SA(1, 0), a3, v2, 0);
            PG8_WAIT_V(8); PG8_WAIT_L(0); PG8_BAR; PG8_MMA(1, 0, At, B0); PG8_MMA(1, 1, At, B1); PG8_BAR; PG8_SCHED;
        }
        if constexpr (FP8) asm volatile("s_nop 15\n\ts_nop 15\n\ts_nop 15\n\ts_nop 15" ::: "memory");
        if (wr == 0) PG8_BAR;
        const unsigned rf = S.refill_issue();
        E(acc, cur, wr, wc, fr, fq, lds, pre);
        S.refill_commit(ui, rf);
        if (!has_next) break;
#pragma unroll
        for (int a = 0; a < 2; ++a)
#pragma unroll
            for (int b = 0; b < 2; ++b)
#pragma unroll
                for (int m = 0; m < 4; ++m)
#pragma unroll
                    for (int n = 0; n < 2; ++n) acc[a][b][m][n] = (f32x4){0.f, 0.f, 0.f, 0.f};
        cur = nxt; cA = nA; cB = nB; ++ui;
        if constexpr (GATHER) {
#pragma unroll
            for (int h = 0; h < 2; ++h)
#pragma unroll
                for (int i = 0; i < 2; ++i) va[h][i] = vnx[h][i];
        }
        if (wr == 1) PG8_BAR;
    }
    PG8_WAIT_V(0);
    PG8_BAR;
#undef PG8_SA
#undef PG8_SB
#undef PG8_STAGEA
#undef PG8_STAGEB
#undef PG8_LDA
#undef PG8_LDB
#undef PG8_MMA
#undef PG8_WAIT_V
#undef PG8_WAIT_L
#undef PG8_BAR
#undef PG8_SCHED
}

template <class Epi, class Sched>
__device__ __forceinline__ void gemm_phase_ref(LAS unsigned char* lds, const Gemm g, const Sched& S, const Epi& E) {
    const int tid = threadIdx.x, wid = __builtin_amdgcn_readfirstlane(tid >> 6), lane = tid & 63, wr = wid >> 2, wc = wid & 3, fr = lane & 15, fq = lane >> 4;
    const int K = g.K, nt = K / BK;
    unsigned voffA[2], voffB[2];
#pragma unroll
    for (int i = 0; i < 2; ++i) { int R, C; stage_rc(tid * 16 + i * 8192, R, C); const int Rb = Epi::PERM ? ((R & ~31) + perm32(R & 31)) : R;
        voffA[i] = (unsigned)(R * K + C) * 2u; voffB[i] = (unsigned)(Rb * K + C) * 2u; }
    const size_t kstep = (size_t)(BK * 2), hstep = (size_t)HALF * K * 2, tstep = 2 * hstep;
    const unsigned ldsw = (unsigned)wid * 1024u;
    const int aoff = lds_byte(wr * 64 + fr, fq * 8), boff = lds_byte(wc * 32 + fr, fq * 8);
#define RSA(b, h) (((b) * 2 + (h)) * HTB)
#define RSB(b, h) ((4 + (b) * 2 + (h)) * HTB)
#define RSTAGE(bufoff, gbase, voff) do { _Pragma("unroll") for (int _i = 0; _i < 2; ++_i) \
        __builtin_amdgcn_global_load_lds((const unsigned*)((const char*)(gbase) + (voff)[_i]), (LAS unsigned*)(lds + (bufoff) + ldsw + _i * 8192), 16, 0, 0); } while (0)
#define RLDA(dst, b, h) do { _Pragma("unroll") for (int m = 0; m < 4; ++m) _Pragma("unroll") for (int k = 0; k < 2; ++k) dst[m][k] = *(const LAS bf16x8*)(lds + RSA(b, h) + aoff + m * 2048 + k * 1024); } while (0)
#define RLDB(dst, b, h) do { _Pragma("unroll") for (int n = 0; n < 2; ++n) _Pragma("unroll") for (int k = 0; k < 2; ++k) dst[n][k] = *(const LAS bf16x8*)(lds + RSB(b, h) + boff + n * 2048 + k * 1024); } while (0)
#define RMMA(ai, bj, At, Bt) do { __builtin_amdgcn_s_setprio(1); _Pragma("unroll") for (int m = 0; m < 4; ++m) _Pragma("unroll") for (int n = 0; n < 2; ++n) _Pragma("unroll") for (int k = 0; k < 2; ++k) \
        acc[ai][bj][m][n] = __builtin_amdgcn_mfma_f32_16x16x32_bf16(Bt[n][k], At[m][k], acc[ai][bj][m][n], 0, 0, 0); __builtin_amdgcn_s_setprio(0); } while (0)
#define RWV(n) asm volatile("s_waitcnt vmcnt(" #n ")" ::: "memory")
#define RWL(n) asm volatile("s_waitcnt lgkmcnt(" #n ")" ::: "memory")
#define RBAR __builtin_amdgcn_s_barrier()
#define RSCHED __builtin_amdgcn_sched_barrier(0)
    Unit cur, nxt; int ui = 0;
    if (!S.next(0, cur)) return;
    f32x4 acc[2][2][4][2];
#pragma unroll
    for (int a = 0; a < 2; ++a)
#pragma unroll
        for (int b = 0; b < 2; ++b)
#pragma unroll
            for (int m = 0; m < 4; ++m)
#pragma unroll
                for (int n = 0; n < 2; ++n) acc[a][b][m][n] = (f32x4){0.f, 0.f, 0.f, 0.f};
    bf16x8 At[4][2], B0[2][2], B1[2][2];
    const char* cA = (const char*)g.A + (size_t)cur.pm * tstep; const char* cB = (const char*)g.Bt + (size_t)cur.pn * tstep;
    RSTAGE(RSB(0, 0), cB, voffB); RSTAGE(RSB(0, 1), cB + hstep, voffB); RSTAGE(RSA(0, 0), cA, voffA); RSTAGE(RSA(0, 1), cA + hstep, voffA);
    if (wr == 1) RBAR;
    RWV(2); RBAR;
    RSTAGE(RSB(1, 0), cB + kstep, voffB); RSTAGE(RSA(1, 0), cA + kstep, voffA); RSTAGE(RSB(1, 1), cB + hstep + kstep, voffB);
    RWV(6); RBAR;
    for (;;) {
        const bool has_next = S.next(ui + 1, nxt);
        const char* nA = has_next ? (const char*)g.A + (size_t)nxt.pm * tstep : cA; const char* nB = has_next ? (const char*)g.Bt + (size_t)nxt.pn * tstep : cB;
        for (int t = 0; t < nt; t += 2) {
            const bool last = (t == nt - 2);
            const char* a1 = cA + (size_t)(t + 1) * kstep;
            const char* a2 = last ? nA : cA + (size_t)(t + 2) * kstep; const char* b2 = last ? nB : cB + (size_t)(t + 2) * kstep;
            const char* a3 = a2 + kstep; const char* b3 = b2 + kstep;
            RLDB(B0, 0, 0); RLDB(B1, 0, 1); RSCHED; RLDA(At, 0, 0); RSTAGE(RSA(1, 1), a1 + hstep, voffA);
            RWV(8); RWL(0); RBAR; RMMA(0, 0, At, B0); RMMA(0, 1, At, B1); RBAR; RSCHED;
            RLDA(At, 0, 1); RSTAGE(RSB(0, 0), b2, voffB); RSTAGE(RSB(0, 1), b2 + hstep, voffB); RSTAGE(RSA(0, 0), a2, voffA);
            RWV(8); RWL(0); RBAR; RMMA(1, 0, At, B0); RMMA(1, 1, At, B1); RBAR; RSCHED;
            RLDB(B0, 1, 0); RLDB(B1, 1, 1); RSCHED; RLDA(At, 1, 0); RSTAGE(RSA(0, 1), a2 + hstep, voffA);
            RWV(8); RWL(0); RBAR; RMMA(0, 0, At, B0); RMMA(0, 1, At, B1); RBAR; RSCHED;
            RLDA(At, 1, 1); RSTAGE(RSB(1, 0), b3, voffB); RSTAGE(RSB(1, 1), b3 + hstep, voffB); RSTAGE(RSA(1, 0), a3, voffA);
            RWV(8); RWL(0); RBAR; RMMA(1, 0, At, B0); RMMA(1, 1, At, B1); RBAR; RSCHED;
        }
        if (wr == 0) RBAR;
#pragma unroll
        for (int a = 0; a < 2; ++a)
#pragma unroll
            for (int b = 0; b < 2; ++b)
#pragma unroll
                for (int m = 0; m < 4; ++m)
#pragma unroll
                    for (int n = 0; n < 2; ++n) asm volatile("" :: "v"(acc[a][b][m][n]));
        if (!has_next) break;
#pragma unroll
        for (int a = 0; a < 2; ++a)
#pragma unroll
            for (int b = 0; b < 2; ++b)
#pragma unroll
                for (int m = 0; m < 4; ++m)
#pragma unroll
                    for (int n = 0; n < 2; ++n) acc[a][b][m][n] = (f32x4){0.f, 0.f, 0.f, 0.f};
        cur = nxt; cA = nA; cB = nB; ++ui;
        if (wr == 1) RBAR;
    }
    RWV(0);
    RBAR;
#undef RSA
#undef RSB
#undef RSTAGE
#undef RLDA
#undef RLDB
#undef RMMA
#undef RWV
#undef RWL
#undef RBAR
#undef RSCHED
}
}
struct PreNone { };
struct Pre8 { float v[8]; };
__device__ __forceinline__ unsigned pk4_fp8(float a, float b, float c, float d) { int w = __builtin_amdgcn_cvt_pk_fp8_f32(a, b, 0, false); w = __builtin_amdgcn_cvt_pk_fp8_f32(c, d, w, true); return (unsigned)w; }
template <bool F8>
struct EpiSwiGLU_T {
    static constexpr bool PERM = true;
    static constexpr bool DMA_PRE = F8;
    bf16_t* O; int ldo; const float* lrs; float wsc, osc;
    typedef PreNone Pre;
    __device__ __forceinline__ Pre pre(const pg8::Unit&, int, int) const { return Pre{}; }
    __device__ __forceinline__ void dma_pre(const pg8::Unit& u, int tid, int wid, LAS unsigned char* lds) const {
        __builtin_amdgcn_global_load_lds((const unsigned*)(lrs + (size_t)u.e * T + u.arow + (tid & 255)), (LAS unsigned*)(lds + LRST_OFF + (wid & 3) * 256), 4, 0, 0); }
    __device__ __forceinline__ void operator()(const f32x4 (&acc)[2][2][4][2], const pg8::Unit& u, int wr, int wc, int fr, int fq, LAS unsigned char* lds, const Pre&) const {
        struct { float v[8]; } pr;
#pragma unroll
        for (int i = 0; i < 8; ++i) {
            if constexpr (F8) pr.v[i] = ((const LAS float*)(lds + LRST_OFF))[(i >> 2) * 128 + (i & 3) * 16 + wr * 64 + fr];
            else pr.v[i] = lrs ? lrs[(size_t)u.e * T + u.arow + (i >> 2) * 128 + (i & 3) * 16 + wr * 64 + fr] : 1.f; }
        const int r0 = wr * 64 + fr, col0 = u.pn * 128 + wc * 32 + 8 * fq;
#pragma unroll
        for (int ai = 0; ai < 2; ++ai) {
#pragma unroll
            for (int m = 0; m < 4; ++m) {
                const float s = pr.v[ai * 4 + m] * wsc; float o[8];
#pragma unroll
                for (int n = 0; n < 2; ++n)
#pragma unroll
                    for (int j = 0; j < 4; ++j) { const float gv = acc[ai][0][m][n][j] * s, uv = acc[ai][1][m][n][j] * s; o[n * 4 + j] = silu_f(gv) * uv; }
                if constexpr (F8) { u32x2 w; w.x = pk4_fp8(o[0] * osc, o[1] * osc, o[2] * osc, o[3] * osc); w.y = pk4_fp8(o[4] * osc, o[5] * osc, o[6] * osc, o[7] * osc);
                    *(u32x2*)((unsigned char*)O + (size_t)(u.orow + ai * 128 + m * 16 + r0) * ldo + col0) = w; }
                else { u32x4 w; w.x = cvt_pk_bf16(o[0], o[1]); w.y = cvt_pk_bf16(o[2], o[3]); w.z = cvt_pk_bf16(o[4], o[5]); w.w = cvt_pk_bf16(o[6], o[7]);
                    *(u32x4*)(O + (size_t)(u.orow + ai * 128 + m * 16 + r0) * ldo + col0) = w; }
            }
        }
    }
};
typedef EpiSwiGLU_T<false> EpiSwiGLU;
struct EpiRes {
    static constexpr bool PERM = false;
    static constexpr bool DMA_PRE = false;
    float* H; bf16_t* HB; float* ssq; unsigned char* HB8;
    typedef PreNone Pre;
    __device__ __forceinline__ Pre pre(const pg8::Unit&, int, int) const { return Pre{}; }
    __device__ __forceinline__ void operator()(const f32x4 (&acc)[2][2][4][2], const pg8::Unit& u, int wr, int wc, int fr, int fq, LAS unsigned char*, const Pre&) const {
        const int r0 = u.orow + wr * 64 + fr, col0 = u.pn * 256 + wc * 32 + 4 * fq;
#pragma unroll
        for (int ai = 0; ai < 2; ++ai)
#pragma unroll
            for (int m = 0; m < 4; ++m) {
                const size_t off = (size_t)(r0 + ai * 128 + m * 16) * D + col0; float sq = 0.f;
#pragma unroll
                for (int bj = 0; bj < 2; ++bj)
#pragma unroll
                    for (int n = 0; n < 2; ++n) {
                        const f32x4 hv = *(const f32x4*)(H + off + bj * 128 + n * 16) + acc[ai][bj][m][n];
                        *(f32x4*)(H + off + bj * 128 + n * 16) = hv;
                        if (HB8) *(unsigned*)(HB8 + off + bj * 128 + n * 16) = pk4_fp8(hv[0], hv[1], hv[2], hv[3]);
                        else { u32x2 w; w.x = cvt_pk_bf16(hv[0], hv[1]); w.y = cvt_pk_bf16(hv[2], hv[3]); *(u32x2*)(HB + off + bj * 128 + n * 16) = w; }
                        sq += (hv[0] * hv[0] + hv[1] * hv[1]) + (hv[2] * hv[2] + hv[3] * hv[3]);
                    }
                if (ssq) { sq += __shfl_xor(sq, 16); sq += __shfl_xor(sq, 32);
                    if (fq == 0) ssq[(size_t)(r0 + ai * 128 + m * 16) * 16 + u.pn * 4 + wc] = sq; }
            }
    }
};
template <bool STORE>
struct EpiQKV_T {
    static constexpr bool PERM = true;
    static constexpr bool DMA_PRE = false;
    bf16_t* O; const float* ssq;
    typedef Pre8 Pre;
    __device__ __forceinline__ Pre pre(const pg8::Unit& u, int, int) const { Pre p; const int tid = threadIdx.x, row = tid >> 1, part = tid & 1;
        const f32x4* q = (const f32x4*)(ssq + (size_t)(u.orow + row) * 16 + part * 8); const f32x4 a = q[0], b = q[1];
        p.v[0] = a[0]; p.v[1] = a[1]; p.v[2] = a[2]; p.v[3] = a[3]; p.v[4] = b[0]; p.v[5] = b[1]; p.v[6] = b[2]; p.v[7] = b[3]; return p; }
    __device__ __forceinline__ void operator()(const f32x4 (&acc)[2][2][4][2], const pg8::Unit& u, int wr, int wc, int fr, int fq, LAS unsigned char* lds, const Pre& pr) const {
        LAS float* rtab = (LAS float*)(lds + RTAB_OFF);
        { const int tid = threadIdx.x, row = tid >> 1, part = tid & 1;
          float s = ((pr.v[0] + pr.v[1]) + (pr.v[2] + pr.v[3])) + ((pr.v[4] + pr.v[5]) + (pr.v[6] + pr.v[7]));
          s += __shfl_xor(s, 1);
          if (part == 0) rtab[row] = 1.0f / sqrtf(s * (1.f / D) + EPS); }
        asm volatile("s_waitcnt lgkmcnt(0)" ::: "memory"); __builtin_amdgcn_s_barrier(); asm volatile("" ::: "memory");
        const float qs = (u.pn * 256 < 3072) ? 0.125f * 1.4426950408889634f : 1.f;
        const int r0 = wr * 64 + fr, col0 = u.pn * 256 + wc * 32 + 8 * fq;
#pragma unroll
        for (int ai = 0; ai < 2; ++ai)
#pragma unroll
            for (int m = 0; m < 4; ++m) {
                const float s = rtab[ai * 128 + m * 16 + r0] * qs;
#pragma unroll
                for (int bj = 0; bj < 2; ++bj) {
                    const f32x4 v0 = acc[ai][bj][m][0] * s, v1 = acc[ai][bj][m][1] * s;
                    u32x4 w; w.x = cvt_pk_bf16(v0[0], v0[1]); w.y = cvt_pk_bf16(v0[2], v0[3]); w.z = cvt_pk_bf16(v1[0], v1[1]); w.w = cvt_pk_bf16(v1[2], v1[3]);
                    if (STORE) *(u32x4*)(O + (size_t)(u.orow + ai * 128 + m * 16 + r0) * QKV_LD + col0 + bj * 128) = w; else asm volatile("" :: "v"(w));
                }
            }
    }
};
typedef EpiQKV_T<true> EpiQKV;
struct EpiNull {
    static constexpr bool PERM = true;
    static constexpr bool DMA_PRE = false;
    typedef PreNone Pre;
    __device__ __forceinline__ Pre pre(const pg8::Unit&, int, int) const { return Pre{}; }
    __device__ __forceinline__ void operator()(const f32x4 (&acc)[2][2][4][2], const pg8::Unit& u, int wr, int wc, int fr, int fq, LAS unsigned char*, const Pre&) const {
#pragma unroll
        for (int ai = 0; ai < 2; ++ai)
#pragma unroll
            for (int bj = 0; bj < 2; ++bj)
#pragma unroll
                for (int m = 0; m < 4; ++m)
#pragma unroll
                    for (int n = 0; n < 2; ++n) asm volatile("" :: "v"(acc[ai][bj][m][n]));
    }
};
struct EpiY {
    static constexpr bool PERM = true;
    static constexpr bool DMA_PRE = false;
    bf16_t* Y; bf16_t* Y2; int c0rows; float ysc;
    typedef PreNone Pre;
    __device__ __forceinline__ Pre pre(const pg8::Unit&, int, int) const { return Pre{}; }
    __device__ __forceinline__ void operator()(const f32x4 (&acc)[2][2][4][2], const pg8::Unit& u, int wr, int wc, int fr, int fq, LAS unsigned char*, const Pre&) const {
        bf16_t* Yb = u.koff ? Y2 : Y;
        const int r0 = (u.koff ? u.orow - c0rows : u.orow) + wr * 64 + fr, col0 = u.pn * 256 + wc * 32 + 8 * fq;
#pragma unroll
        for (int ai = 0; ai < 2; ++ai)
#pragma unroll
            for (int m = 0; m < 4; ++m)
#pragma unroll
                for (int bj = 0; bj < 2; ++bj) {
                    const f32x4 v0 = acc[ai][bj][m][0] * ysc, v1 = acc[ai][bj][m][1] * ysc;
                    u32x4 w; w.x = cvt_pk_bf16(v0[0], v0[1]); w.y = cvt_pk_bf16(v0[2], v0[3]); w.z = cvt_pk_bf16(v1[0], v1[1]); w.w = cvt_pk_bf16(v1[2], v1[3]);
                    *(u32x4*)(Yb + (size_t)(r0 + ai * 128 + m * 16) * D + col0 + bj * 128) = w;
                }
    }
};

constexpr int MI_CNT = 0, MI_TB = 8, MI_NT = 17, MI_SPLIT0 = 18, MI_C1 = 19;
__device__ __forceinline__ void moe_info_build(LAS unsigned char* lds, const unsigned* ctl) {
    volatile LAS int* mi = (volatile LAS int*)(lds + SCR_OFF);
    if (threadIdx.x == 0) { int tb = 0;
        for (int e = 0; e < NE; ++e) { const int c = (int)__hip_atomic_load(ctl + CW_CNT + e, RLX_AGENT); mi[MI_CNT + e] = c; mi[MI_TB + e] = tb; tb += (c + 255) >> 8; }
        mi[MI_TB + NE] = tb; mi[MI_NT] = tb; const int c1 = tb > LAST_TILES ? tb - LAST_TILES : 0; mi[MI_C1] = c1; mi[MI_SPLIT0] = c1 * 256; }
    LDS_WAIT(); __syncthreads();
}
struct DynQ {
    unsigned* ctr; volatile LAS unsigned* slot;
    __device__ __forceinline__ void start() const { if (threadIdx.x == 0) { slot[0] = blockIdx.x; slot[1] = gridDim.x + atomicAdd(ctr, 1u); } LDS_WAIT(); __syncthreads(); }
#ifdef MK_STATICQ
    __device__ __forceinline__ int fetch(int i) const { return i * (int)gridDim.x + (int)blockIdx.x; }
#else
    __device__ __forceinline__ int fetch(int i) const { return __builtin_amdgcn_readfirstlane((int)slot[i & 3]); }
#endif
    __device__ __forceinline__ unsigned refill_issue() const { unsigned v = 0u; if (threadIdx.x == 0) v = gridDim.x + atomicAdd(ctr, 1u); return v; }
    __device__ __forceinline__ void refill_commit(int ui, unsigned v) const { if (threadIdx.x == 0) slot[(ui + 2) & 3] = v; }
};
template <int NN, bool G1>
struct MoeOrder {
    DynQ q; volatile LAS int* mi; int c0, ntc; const int* ltok;
    __device__ __forceinline__ void start() const { q.start(); }
    __device__ __forceinline__ unsigned refill_issue() const { return q.refill_issue(); }
    __device__ __forceinline__ void refill_commit(int ui, unsigned v) const { q.refill_commit(ui, v); }
    __device__ __forceinline__ bool next(int i, pg8::Unit& u) const {
        const int idx = q.fetch(i); if (idx >= ntc * NN) return false;
        const int grp = idx / (8 * NN), r = idx - grp * (8 * NN), gsz = (ntc - grp * 8) < 8 ? (ntc - grp * 8) : 8;
        const int pml = grp * 8 + r % gsz, pn = r / gsz, pmg = c0 + pml;
        int e = 0;
#pragma unroll
        for (int k = 1; k < NE; ++k) e += (pmg >= mi[MI_TB + k]) ? 1 : 0;
        e = __builtin_amdgcn_readfirstlane(e);
        u.pm = pmg; u.pn = pn; u.e = e; u.koff = 0;
        if (!G1 && NN == 8) { u.pn = pn & 3; u.koff = (pn >> 2) * (FF1 / 4); }
        const int pnb = u.pn;
        if (G1) { u.arow = (pmg - __builtin_amdgcn_readfirstlane(mi[MI_TB + e])) * 256; u.brow = e * (2 * FF1) + pn * 256; u.orow = pml * 256; }
        else { u.arow = pml * 256; u.brow = e * D + pnb * 256; u.orow = pmg * 256; }
        return true;
    }
    __device__ __forceinline__ const int* gather_src(const pg8::Unit& u, int r) const {
        const int lr = u.arow + r; const int c = mi[MI_CNT + u.e];
        return lr < c ? ltok + (size_t)u.e * T + lr : (const int*)((const char*)ltok + (WS_ZERO - WS_LTOK));
    }
    __device__ __forceinline__ unsigned gather_row(const pg8::Unit& u, int r) const {
        const int lr = u.arow + r; const int c = mi[MI_CNT + u.e];
        return lr < c ? (unsigned)ltok[(size_t)u.e * T + lr] : 0u;
    }
};
struct Args { const float* in[19]; float* out; unsigned char* ws; int ph_lo, ph_hi, li, pad; };
enum { I_X = 0, I_ANORM, I_APROJ, I_ASCALE, I_KVNORM, I_WKV, I_BNORM, I_WQ, I_WO, I_RELB, I_FFNORM, I_DWG, I_DWU, I_DWD, I_ROUTER, I_MWG, I_MWU, I_MWD, I_FNORM };
struct Frame {
    LAS unsigned char* lds; unsigned* ctl; int tid, lane, wave, G, bid;
    float* h; unsigned char* ws;
};
__device__ __forceinline__ void conv_item(const float* W, int ldw, const float* gain, bf16_t* WT, int K, int dst_row0, LAS float* scr, int k0, int n0, int lane) {
    float wv[32];
#pragma unroll
    for (int i = 0; i < 32; ++i) wv[i] = W[(size_t)(k0 + 2 * i + (lane >> 5)) * ldw + n0 + (lane & 31)];
    if (gain) {
#pragma unroll
        for (int i = 0; i < 32; ++i) wv[i] *= gain[k0 + 2 * i + (lane >> 5)];
    }
#pragma unroll
    for (int i = 0; i < 32; ++i) scr[(2 * i + (lane >> 5)) * 33 + (lane & 31)] = wv[i];
    LDS_WAIT(); asm volatile("" ::: "memory");
    const int c = lane & 7;
#pragma unroll
    for (int j = 0; j < 4; ++j) { const int n = (lane >> 3) + 8 * j; const LAS float* s = scr + (8 * c) * 33 + n;
        u32x4 o; o.x = pk2(s[0 * 33], s[1 * 33]); o.y = pk2(s[2 * 33], s[3 * 33]); o.z = pk2(s[4 * 33], s[5 * 33]); o.w = pk2(s[6 * 33], s[7 * 33]);
        *(u32x4*)(WT + (size_t)(dst_row0 + n) * K + k0 + 8 * c) = o; }
    LDS_WAIT(); asm volatile("" ::: "memory");
}
__device__ __forceinline__ void conv_job(const Frame& F, int& it0, const float* W, int K, int N, int ldw, const float* gain, bf16_t* WT, int mode, int row_off, LAS float* scr, int cg = 0) {
    const int nblk = N / 32, items = (K / 64) * nblk, NGW = (cg ? cg : F.G) * NWAVES;
    int it = it0;
    for (; it < items; it += NGW) {
        const int kb = it / nblk, nb = it - kb * nblk, n0 = nb * 32;
        const int dr = (mode == 0) ? (row_off + n0) : (row_off + (n0 >> 7) * 256 + (n0 & 127) + (mode == 2 ? 128 : 0));
        conv_item(W, ldw, gain, WT, K, dr, scr, kb * 64, n0, F.lane);
    }
    it0 = it - items;
}
__device__ __forceinline__ void conv_item8(const float* W, int ldw, const float* gain, float presc, unsigned char* WT8, int K, int dst_row0, LAS float* scr, int k0, int n0, int lane) {
    float wv[32];
#pragma unroll
    for (int i = 0; i < 32; ++i) wv[i] = W[(size_t)(k0 + 2 * i + (lane >> 5)) * ldw + n0 + (lane & 31)];
#pragma unroll
    for (int i = 0; i < 32; ++i) wv[i] *= gain ? gain[k0 + 2 * i + (lane >> 5)] * presc : presc;
#pragma unroll
    for (int i = 0; i < 32; ++i) scr[(2 * i + (lane >> 5)) * 33 + (lane & 31)] = wv[i];
    LDS_WAIT(); asm volatile("" ::: "memory");
    const int c = lane & 7;
#pragma unroll
    for (int j = 0; j < 4; ++j) { const int n = (lane >> 3) + 8 * j; const LAS float* s = scr + (8 * c) * 33 + n;
        u32x2 o; o.x = pk4_fp8(s[0 * 33], s[1 * 33], s[2 * 33], s[3 * 33]); o.y = pk4_fp8(s[4 * 33], s[5 * 33], s[6 * 33], s[7 * 33]);
        *(u32x2*)(WT8 + (size_t)(dst_row0 + n) * K + k0 + 8 * c) = o; }
    LDS_WAIT(); asm volatile("" ::: "memory");
}
__device__ __forceinline__ void conv_job8(const Frame& F, int& it0, const float* W, int K, int N, int ldw, const float* gain, float presc, unsigned char* WT8, int mode, int row_off, LAS float* scr) {
    const int nblk = N / 32, items = (K / 64) * nblk, NGW = F.G * NWAVES;
    int it = it0;
    for (; it < items; it += NGW) {
        const int kb = it / nblk, nb = it - kb * nblk, n0 = nb * 32;
        const int dr = (mode == 0) ? (row_off + n0) : (row_off + (n0 >> 7) * 256 + (n0 & 127) + (mode == 2 ? 128 : 0));
        conv_item8(W, ldw, gain, presc, WT8, K, dr, scr, kb * 64, n0, F.lane);
    }
    it0 = it - items;
}
__device__ __forceinline__ void conv_aproj(const Frame& F, const Args& A) {
    LAS float* scr = (LAS float*)(F.lds + RING_OFF + F.wave * 16384);
    int it = F.bid * NWAVES + F.wave;
    for (int g = 0; g < 4; ++g) conv_job(F, it, A.in[I_APROJ] + (size_t)g * 65536, 256, 256, 256, nullptr, (bf16_t*)(F.ws + WS_APT) + (size_t)g * 65536, 0, 0, scr);
}
__device__ __forceinline__ void conv_small(const Frame& F, const Args& A) {
    LAS float* scr = (LAS float*)(F.lds + RING_OFF + F.wave * 16384);
    int it = F.bid * NWAVES + F.wave;
    unsigned char* ws = F.ws;
    conv_job(F, it, A.in[I_DWG], D, FF0, FF0, nullptr, (bf16_t*)(ws + WS_WGU0), 1, 0, scr);
    conv_job(F, it, A.in[I_DWU], D, FF0, FF0, nullptr, (bf16_t*)(ws + WS_WGU0), 2, 0, scr);
}
__device__ __forceinline__ void conv_later(const Frame& F, const Args& A, int cb, int cg) {
    LAS float* scr = (LAS float*)(F.lds + RING_OFF + F.wave * 16384);
    int it = cb * NWAVES + F.wave;
    unsigned char* ws = F.ws;
    conv_job(F, it, A.in[I_DWD], FF0, D, D, nullptr, (bf16_t*)(ws + WS_WD0), 0, 0, scr, cg);
    conv_job(F, it, A.in[I_WQ], D, 3072, 3072, A.in[I_BNORM], (bf16_t*)(ws + WS_WQKV), 0, 0, scr, cg);
    conv_job(F, it, A.in[I_WKV], D, 6144, 6144, A.in[I_KVNORM], (bf16_t*)(ws + WS_WQKV), 0, 3072, scr, cg);
    conv_job(F, it, A.in[I_WO], D, D, D, nullptr, (bf16_t*)(ws + WS_WO), 0, 0, scr, cg);
}
#ifndef MK_CW
#define MK_CW 256
#endif
__device__ __forceinline__ void conv_moe(const Frame& F, const Args& A, int rep_ = 0) {
    constexpr int CW = MK_CW, NC = CW / 64, NSPL = 256 / CW, IPJ = 112 * NSPL, TOT = 24 * IPJ, TS = 144; const int lane = F.lane, w = F.wave; int par = 0;
#pragma unroll 1
#ifdef MK_CONV_BLOCKED
    for (int it = (F.bid * TOT) / F.G, ite = ((F.bid + 1) * TOT) / F.G; it < ite; ++it, par ^= 1) {
#else
    for (int it = F.bid; it < TOT; it += F.G, par ^= 1) {
#endif
        const int j = it / IPJ, r = it - j * IPJ, e = j / 3, kind = j - 3 * e;
        LAS unsigned char* tl = F.lds + RING_OFF + par * (CW * TS);
        float wv[16 * NC]; int kb, n0;
        if (kind < 2) { kb = r / (14 * NSPL); n0 = (r - kb * (14 * NSPL)) * CW; const int k0 = kb * 128 + 16 * w;
            const float* src = A.in[kind ? I_MWU : I_MWG] + (size_t)e * D * FF1 + (size_t)k0 * FF1 + n0 + lane;
            const float* g = A.in[I_FFNORM] + D + k0;
#pragma unroll
            for (int i = 0; i < 16; ++i)
#pragma unroll
                for (int c = 0; c < NC; ++c) wv[i * NC + c] = src[(size_t)i * FF1 + c * 64];
#pragma unroll
            for (int i = 0; i < 16; ++i) { const float gs = g[i] * WGU_PRESC;
#pragma unroll
                for (int c = 0; c < NC; ++c) wv[i * NC + c] *= gs; }
        } else { kb = r / (4 * NSPL); n0 = (r - kb * (4 * NSPL)) * CW; const int k0 = kb * 128 + 16 * w;
            const float* src = A.in[I_MWD] + (size_t)e * FF1 * D + (size_t)k0 * D + n0 + lane;
#pragma unroll
            for (int i = 0; i < 16; ++i)
#pragma unroll
                for (int c = 0; c < NC; ++c) wv[i * NC + c] = src[(size_t)i * D + c * 64];
#pragma unroll
            for (int i = 0; i < 16 * NC; ++i) wv[i] *= WD_PRESC;
        }
#pragma unroll
        for (int c = 0; c < NC; ++c) { u32x4 o;
            o.x = pk4_fp8(wv[0 * NC + c], wv[1 * NC + c], wv[2 * NC + c], wv[3 * NC + c]); o.y = pk4_fp8(wv[4 * NC + c], wv[5 * NC + c], wv[6 * NC + c], wv[7 * NC + c]);
            o.z = pk4_fp8(wv[8 * NC + c], wv[9 * NC + c], wv[10 * NC + c], wv[11 * NC + c]); o.w = pk4_fp8(wv[12 * NC + c], wv[13 * NC + c], wv[14 * NC + c], wv[15 * NC + c]);
            *(LAS u32x4*)(tl + (c * 64 + lane) * TS + 16 * w) = o; }
        LDS_WAIT(); __syncthreads();
#pragma unroll
        for (int q = 0; q < NC; ++q) { const int row = (8 * NC) * w + 8 * q + (lane >> 3), n = n0 + row;
            const u32x4 o = *(const LAS u32x4*)(tl + row * TS + 16 * (lane & 7));
            unsigned char* dst = (kind < 2) ? F.ws + WS_WGU1 + (size_t)e * 2 * FF1 * D + (size_t)((n >> 7) * 256 + (n & 127) + kind * 128) * D + kb * 128 + 16 * (lane & 7)
                                            : F.ws + WS_WD1 + (size_t)e * D * FF1 + (size_t)n * FF1 + kb * 128 + 16 * (lane & 7);
#ifdef MK_CONV_NOSTORE
            if (rep_ == 0 || (o.x == 0x12345678u && o.y == 0x9abcdef0u))
#endif
            *(u32x4*)dst = o; }
    }
    LDS_WAIT(); __syncthreads();
}

#ifdef MK_READ_LINEAR
__device__ __forceinline__ void conv_read_linear(const Frame& F, const Args& A) {
    const int NGW = F.G * NWAVES; float acc = 0.f;
    for (int arr = 0; arr < 3; ++arr) {
        const float* W = A.in[arr == 0 ? I_MWG : (arr == 1 ? I_MWU : I_MWD)];
        constexpr int CH = (MK_READ_LINEAR == 1 ? 32 : 16) * 64 * MK_READ_LINEAR;
        const int nch = (int)((size_t)NE * D * FF1 / CH);
        for (int c = F.bid * NWAVES + F.wave; c < nch; c += NGW) {
            const float* p = W + (size_t)c * CH + F.lane * MK_READ_LINEAR;
#if MK_READ_LINEAR == 1
            float v[32];
#pragma unroll
            for (int i = 0; i < 32; ++i) v[i] = p[i * 64];
#pragma unroll
            for (int i = 0; i < 32; ++i) acc += v[i];
#else
            f32x4 v[16];
#pragma unroll
            for (int i = 0; i < 16; ++i) v[i] = *(const f32x4*)(p + i * 256);
#pragma unroll
            for (int i = 0; i < 16; ++i) acc += v[i][0] + v[i][1] + v[i][2] + v[i][3];
#endif
        }
    }
    if (acc == 1.2345678f) F.ws[WS_ZERO + 1024] = 1;
}
#endif
__device__ __forceinline__ void mixer_phase(const Frame& F, const Args& A) {
    LAS float* rs = (LAS float*)(F.lds + 0);
    LAS float* xn = (LAS float*)(F.lds + 512);
    LAS bf16_t* pl = (LAS bf16_t*)(F.lds + 512 + 80896);
    LAS float* sw = (LAS float*)(F.lds + 512 + 80896 + 33792);
    int tid_ = F.tid; asm volatile("" : "+v"(tid_));
    const int tid = tid_, lane = tid & 63, w = F.wave, fr = lane & 15, fq = lane >> 4;
    const bf16_t* apt = (const bf16_t*)(F.ws + WS_APT);
    bf16_t* hn0 = (bf16_t*)(F.ws + WS_S0);
    for (int tile = F.bid; tile < T / 64; tile += F.G) {
        const int t0 = tile * 64, s0 = t0 % SEQ, halo = s0 ? 15 : 0, nrows = 64 + halo;
#pragma unroll 1
        for (int jb = w; jb < nrows; jb += 5 * NWAVES) {
            f32x4 rv[5][4];
#pragma unroll
            for (int u = 0; u < 5; ++u) { const int jj = jb + u * NWAVES, jc = jj < nrows ? jj : nrows - 1; const f32x4* p = (const f32x4*)(A.in[I_X] + (size_t)(t0 - halo + jc) * D);
#pragma unroll
                for (int q = 0; q < 4; ++q) rv[u][q] = p[lane + 64 * q]; }
#pragma unroll
            for (int u = 0; u < 5; ++u) { float s = 0.f;
#pragma unroll
                for (int q = 0; q < 4; ++q) { const f32x4 v = rv[u][q]; s += (v[0] * v[0] + v[1] * v[1]) + (v[2] * v[2] + v[3] * v[3]); }
                s = wave_sum(s);
                const int jj = jb + u * NWAVES;
                if (lane == 0 && jj < nrows) rs[jj] = 1.0f / sqrtf(s * (1.f / D) + EPS); }
        }
        LDS_WAIT(); __syncthreads();
        float ss[4] = {0.f, 0.f, 0.f, 0.f};
        for (int g = 0; g < 4; ++g) {
            { const f32x4 gn = *(const f32x4*)(A.in[I_ANORM] + g * 256 + 4 * lane);
              f32x4 xv[10];
#pragma unroll
              for (int u = 0; u < 10; ++u) { const int jj = w + u * NWAVES, jc = jj < nrows ? jj : nrows - 1; xv[u] = *(const f32x4*)(A.in[I_X] + (size_t)(t0 - halo + jc) * D + g * 256 + 4 * lane); }
#pragma unroll
              for (int u = 0; u < 10; ++u) { const int jj = w + u * NWAVES; if (jj < nrows) { const float r = rs[jj]; const f32x4 v = xv[u];
                  *(LAS f32x4*)(xn + jj * 256 + 4 * lane) = (f32x4){v[0] * r * gn[0], v[1] * r * gn[1], v[2] * r * gn[2], v[3] * r * gn[3]}; } } }
            LDS_WAIT(); __syncthreads();
            { const int c4 = (tid & 63) * 4, win = 2 << g;
#pragma unroll 1
              for (int i = 0; i < 8; ++i) { const int r = (tid >> 6) + 8 * i, s = s0 + r, cnt = (s + 1 < win) ? (s + 1) : win;
                  f32x4 a = {0.f, 0.f, 0.f, 0.f};
                  for (int jj = 0; jj < cnt; ++jj) a += *(const LAS f32x4*)(xn + (halo + r - jj) * 256 + c4);
                  const f32x4 self = *(const LAS f32x4*)(xn + (halo + r) * 256 + c4); const float inv = 1.f / (float)cnt;
                  u32x2 o; o.x = pk2(a[0] * inv - self[0], a[1] * inv - self[1]); o.y = pk2(a[2] * inv - self[2], a[3] * inv - self[3]);
                  *(LAS u32x2*)(pl + r * 264 + c4) = o; } }
            LDS_WAIT(); __syncthreads();
            f32x4 acc[4][2];
#pragma unroll
            for (int m = 0; m < 4; ++m) { acc[m][0] = (f32x4){0.f, 0.f, 0.f, 0.f}; acc[m][1] = (f32x4){0.f, 0.f, 0.f, 0.f}; }
#pragma unroll
            for (int ks = 0; ks < 8; ++ks) {
                bf16x8 bfr[2], afr[4];
#pragma unroll
                for (int n = 0; n < 2; ++n) bfr[n] = *(const bf16x8*)(apt + (size_t)g * 65536 + (size_t)(32 * w + 16 * n + fr) * 256 + 32 * ks + 8 * fq);
#pragma unroll
                for (int m = 0; m < 4; ++m) afr[m] = *(const LAS bf16x8*)(pl + (16 * m + fr) * 264 + 32 * ks + 8 * fq);
#pragma unroll
                for (int m = 0; m < 4; ++m)
#pragma unroll
                    for (int n = 0; n < 2; ++n) acc[m][n] = __builtin_amdgcn_mfma_f32_16x16x32_bf16(bfr[n], afr[m], acc[m][n], 0, 0, 0);
            }
#pragma unroll
            for (int m = 0; m < 4; ++m)
#pragma unroll
                for (int n = 0; n < 2; ++n) { const int col = g * 256 + 32 * w + 16 * n + 4 * fq; const size_t off = (size_t)(t0 + 16 * m + fr) * D + col;
                    const f32x4 sc = *(const f32x4*)(A.in[I_ASCALE] + col); const f32x4 hv = *(const f32x4*)(A.in[I_X] + off) + acc[m][n] * sc;
                    *(f32x4*)(F.h + off) = hv; ss[m] += (hv[0] * hv[0] + hv[1] * hv[1]) + (hv[2] * hv[2] + hv[3] * hv[3]); }
        }
#pragma unroll
        for (int m = 0; m < 4; ++m) { float s = ss[m]; s += __shfl_xor(s, 16); s += __shfl_xor(s, 32); if (fq == 0) sw[(16 * m + fr) * 8 + w] = s; }
        VM_WAIT(); LDS_WAIT(); __syncthreads();
#pragma unroll 1
        for (int jb = w; jb < 64; jb += 4 * NWAVES) {
            f32x4 hv[4][4];
#pragma unroll
            for (int u = 0; u < 4; ++u) { const f32x4* p = (const f32x4*)(F.h + (size_t)(t0 + jb + u * NWAVES) * D);
#pragma unroll
                for (int q = 0; q < 4; ++q) hv[u][q] = p[lane + 64 * q]; }
#pragma unroll
            for (int u = 0; u < 4; ++u) { const int jr = jb + u * NWAVES; float s = 0.f;
#pragma unroll
                for (int q = 0; q < 8; ++q) s += sw[jr * 8 + q];
                const float r1 = 1.0f / sqrtf(s * (1.f / D) + EPS);
                u32x2* o = (u32x2*)(hn0 + (size_t)(t0 + jr) * D);
#pragma unroll
                for (int q = 0; q < 4; ++q) { const f32x4 v = hv[u][q]; const f32x4 gn = *(const f32x4*)(A.in[I_FFNORM] + 4 * (lane + 64 * q));
                    u32x2 ov; ov.x = pk2(v[0] * r1 * gn[0], v[1] * r1 * gn[1]); ov.y = pk2(v[2] * r1 * gn[2], v[3] * r1 * gn[3]); o[lane + 64 * q] = ov; } }
        }
        LDS_WAIT(); __syncthreads();
    }
}

__device__ __forceinline__ void router_phase(const Frame& F, const Args& A) {
    volatile LAS int* li = (volatile LAS int*)(F.lds + 0);
    volatile LAS float* lf = (volatile LAS float*)(F.lds + 2048);
    int* ltok = (int*)(F.ws + WS_LTOK); float* lrs = (float*)(F.ws + WS_LRS); u32x4* tinfo = (u32x4*)(F.ws + WS_TOKINFO);
    int tid_ = F.tid; asm volatile("" : "+v"(tid_));
    const int tid = tid_, lane = tid & 63, w = F.wave;
    const float* gain = A.in[I_FFNORM] + D;
    f32x4 wa[4][4], wb[4][4];
#pragma unroll
    for (int q = 0; q < 4; ++q) { const int c0 = 4 * (lane + 64 * q); const f32x4 gn = *(const f32x4*)(gain + c0);
#pragma unroll
        for (int j = 0; j < 4; ++j) { wa[q][j] = *(const f32x4*)(A.in[I_ROUTER] + (size_t)(c0 + j) * 8) * gn[j]; wb[q][j] = *(const f32x4*)(A.in[I_ROUTER] + (size_t)(c0 + j) * 8 + 4) * gn[j]; } }
    if (F.bid == 0 && tid < 128) ((u32x4*)(F.ws + WS_ZERO))[tid] = (u32x4){0u, 0u, 0u, 0u};
    for (int tile = F.bid; tile < T / 64; tile += F.G) {
        const int t0 = tile * 64;
        if (tid < 8) li[tid] = 0;
        LDS_WAIT(); __syncthreads();
        f32x4 v[4], vn[4];
        { const f32x4* p = (const f32x4*)(F.h + (size_t)(t0 + 8 * w) * D);
#pragma unroll
          for (int q = 0; q < 4; ++q) vn[q] = p[lane + 64 * q]; }
#pragma unroll 1
        for (int k = 0; k < 8; ++k) {
            const int tl = 8 * w + k;
#pragma unroll
            for (int q = 0; q < 4; ++q) v[q] = vn[q];
            if (k < 7) { const f32x4* p = (const f32x4*)(F.h + (size_t)(t0 + tl + 1) * D);
#pragma unroll
                for (int q = 0; q < 4; ++q) vn[q] = p[lane + 64 * q]; }
            float s = 0.f; f32x4 la = {0.f, 0.f, 0.f, 0.f}, lb = {0.f, 0.f, 0.f, 0.f};
#pragma unroll
            for (int q = 0; q < 4; ++q) { s += (v[q][0] * v[q][0] + v[q][1] * v[q][1]) + (v[q][2] * v[q][2] + v[q][3] * v[q][3]);
#pragma unroll
                for (int j = 0; j < 4; ++j) { la += wa[q][j] * v[q][j]; lb += wb[q][j] * v[q][j]; } }
            float red[9] = {s, la[0], la[1], la[2], la[3], lb[0], lb[1], lb[2], lb[3]};
#pragma unroll
            for (int o = 1; o < 64; o <<= 1) {
#pragma unroll
                for (int e = 0; e < 9; ++e) red[e] += __shfl_xor(red[e], o); }
            if (lane == 0) {
                const float r = 1.0f / sqrtf(red[0] * (1.f / D) + EPS);
                float lg[8];
#pragma unroll
                for (int e = 0; e < 8; ++e) lg[e] = red[1 + e] * r;
                float b1 = lg[0]; int i1 = 0;
#pragma unroll
                for (int e = 1; e < 8; ++e) if (lg[e] > b1) { b1 = lg[e]; i1 = e; }
                float b2 = -3.0e38f; int i2 = 0;
#pragma unroll
                for (int e = 0; e < 8; ++e) if (e != i1 && lg[e] > b2) { b2 = lg[e]; i2 = e; }
                const float e2 = expf(b2 - b1), g1 = 1.f / (1.f + e2), g2 = e2 / (1.f + e2);
                const int r1 = __hip_atomic_fetch_add((LAS int*)&li[i1], 1, __ATOMIC_RELAXED, __HIP_MEMORY_SCOPE_WORKGROUP), r2 = __hip_atomic_fetch_add((LAS int*)&li[i2], 1, __ATOMIC_RELAXED, __HIP_MEMORY_SCOPE_WORKGROUP);
                li[16 + tl * 4 + 0] = i1; li[16 + tl * 4 + 1] = i2; li[16 + tl * 4 + 2] = r1; li[16 + tl * 4 + 3] = r2;
                lf[tl * 4 + 0] = g1; lf[tl * 4 + 1] = g2; lf[tl * 4 + 2] = r;
            }
        }
        LDS_WAIT(); __syncthreads();
        if (tid < 8) li[8 + tid] = (int)atomicAdd(F.ctl + CW_CNT + tid, (unsigned)li[tid]);
        LDS_WAIT(); __syncthreads();
        if (tid < 64) {
            const int i1 = li[16 + tid * 4 + 0], i2 = li[16 + tid * 4 + 1], s1 = li[8 + i1] + li[16 + tid * 4 + 2], s2 = li[8 + i2] + li[16 + tid * 4 + 3];
            const float g1 = lf[tid * 4 + 0], g2 = lf[tid * 4 + 1], r = lf[tid * 4 + 2];
            ltok[(size_t)i1 * T + s1] = t0 + tid; lrs[(size_t)i1 * T + s1] = r;
            ltok[(size_t)i2 * T + s2] = t0 + tid; lrs[(size_t)i2 * T + s2] = r;
            u32x4 ti; ti.x = (unsigned)(s1 << 3 | i1); ti.y = (unsigned)(s2 << 3 | i2); ti.z = __builtin_bit_cast(unsigned, g1); ti.w = __builtin_bit_cast(unsigned, g2);
            tinfo[t0 + tid] = ti;
        }
        LDS_WAIT(); __syncthreads();
    }
}

__device__ __forceinline__ void final_phase(const Frame& F, const Args& A) {
    volatile LAS int* mi = (volatile LAS int*)(F.lds + SCR_OFF);
    const u32x4* tinfo = (const u32x4*)(F.ws + WS_TOKINFO); const bf16_t* Y = (const bf16_t*)(F.ws + WS_Y);
    int lane_ = F.lane; asm volatile("" : "+v"(lane_));
    const int lane = lane_;
    f32x4 gn[4];
#pragma unroll
    for (int q = 0; q < 4; ++q) gn[q] = *(const f32x4*)(A.in[I_FNORM] + 4 * (lane + 64 * q));
    const int stride = F.G * NWAVES; int t = F.bid * NWAVES + F.wave;
    const bf16_t* Y2 = (const bf16_t*)(F.ws + WS_Y2); const bf16_t* ZR = (const bf16_t*)(F.ws + WS_ZERO);
    f32x4 hv[4], hn[4]; u32x2 ya[4], yb[4], yan[4], ybn[4], za[4], zb[4], zan[4], zbn[4]; float g1n = 0.f, g2n = 0.f;
#define FIN_ISSUE(tt, HV, YA, YB, ZA, ZB, G1, G2) do { const u32x4 ti = tinfo[tt]; const unsigned tx = ti.x, ty = ti.y, gz = ti.z, gw = ti.w; \
        const int e1 = tx & 7, s1 = tx >> 3, e2 = ty & 7, s2 = ty >> 3; G1 = __uint_as_float(gz); G2 = __uint_as_float(gw); \
        const size_t r1 = (size_t)mi[MI_TB + e1] * 256 + s1, r2 = (size_t)mi[MI_TB + e2] * 256 + s2; \
        const size_t sp0 = (size_t)mi[MI_SPLIT0]; const u32x2* z1_ = r1 >= sp0 ? (const u32x2*)(Y2 + (r1 - sp0) * D) : (const u32x2*)ZR; const u32x2* z2_ = r2 >= sp0 ? (const u32x2*)(Y2 + (r2 - sp0) * D) : (const u32x2*)ZR; \
        const f32x4* p_ = (const f32x4*)(F.h + (size_t)(tt) * D); const u32x2* y1_ = (const u32x2*)(Y + r1 * D); const u32x2* y2_ = (const u32x2*)(Y + r2 * D); \
        _Pragma("unroll") for (int q = 0; q < 4; ++q) { HV[q] = p_[lane + 64 * q]; YA[q] = y1_[lane + 64 * q]; YB[q] = y2_[lane + 64 * q]; } \
        if (r1 >= sp0) { _Pragma("unroll") for (int q = 0; q < 4; ++q) ZA[q] = z1_[lane + 64 * q]; } else { _Pragma("unroll") for (int q = 0; q < 4; ++q) ZA[q] = (u32x2){0u, 0u}; } \
        if (r2 >= sp0) { _Pragma("unroll") for (int q = 0; q < 4; ++q) ZB[q] = z2_[lane + 64 * q]; } else { _Pragma("unroll") for (int q = 0; q < 4; ++q) ZB[q] = (u32x2){0u, 0u}; } } while (0)
    if (t < T) FIN_ISSUE(t, hn, yan, ybn, zan, zbn, g1n, g2n);
    for (; t < T; t += stride) {
        const float g1 = g1n, g2 = g2n;
#pragma unroll
        for (int q = 0; q < 4; ++q) { hv[q] = hn[q]; ya[q] = yan[q]; yb[q] = ybn[q]; za[q] = zan[q]; zb[q] = zbn[q]; }
        if (t + stride < T) FIN_ISSUE(t + stride, hn, yan, ybn, zan, zbn, g1n, g2n);
        f32x4 v[4]; float s = 0.f;
#pragma unroll
        for (int q = 0; q < 4; ++q) { const u32x2 a = ya[q], b = yb[q], a2 = za[q], b2 = zb[q];
            f32x4 o;
            o[0] = hv[q][0] + g1 * (bf2f((unsigned short)(a.x & 0xffff)) + bf2f((unsigned short)(a2.x & 0xffff))) + g2 * (bf2f((unsigned short)(b.x & 0xffff)) + bf2f((unsigned short)(b2.x & 0xffff)));
            o[1] = hv[q][1] + g1 * (bf2f((unsigned short)(a.x >> 16)) + bf2f((unsigned short)(a2.x >> 16))) + g2 * (bf2f((unsigned short)(b.x >> 16)) + bf2f((unsigned short)(b2.x >> 16)));
            o[2] = hv[q][2] + g1 * (bf2f((unsigned short)(a.y & 0xffff)) + bf2f((unsigned short)(a2.y & 0xffff))) + g2 * (bf2f((unsigned short)(b.y & 0xffff)) + bf2f((unsigned short)(b2.y & 0xffff)));
            o[3] = hv[q][3] + g1 * (bf2f((unsigned short)(a.y >> 16)) + bf2f((unsigned short)(a2.y >> 16))) + g2 * (bf2f((unsigned short)(b.y >> 16)) + bf2f((unsigned short)(b2.y >> 16)));
            v[q] = o; s += (o[0] * o[0] + o[1] * o[1]) + (o[2] * o[2] + o[3] * o[3]); }
        s = wave_sum(s);
        const float r = 1.0f / sqrtf(s * (1.f / D) + EPS);
        f32x4* p = (f32x4*)(F.h + (size_t)t * D);
#pragma unroll
        for (int q = 0; q < 4; ++q) p[lane + 64 * q] = (f32x4){v[q][0] * r * gn[q][0], v[q][1] * r * gn[q][1], v[q][2] * r * gn[q][2], v[q][3] * r * gn[q][3]};
    }
#undef FIN_ISSUE
}

__device__ __forceinline__ int t5_bucket(int n) {
    if (n < 16) return n;
    int large = 16 + (int)(log((double)n / 16.0) / log(128.0) * 16.0);
    return large < 31 ? large : 31;
}
typedef float f32x16 __attribute__((ext_vector_type(16)));
typedef short s16x4 __attribute__((ext_vector_type(4)));
constexpr int AT_TAB = 0;
constexpr int AT_BKT = 7680;
constexpr int AT_CNT = 9472;
constexpr int AT_V = 10240;
constexpr float L2E = 1.4426950408889634f;
constexpr size_t WS_AST_O = WS_POOL + 291 * MiB;
constexpr size_t WS_AST_M = WS_AST_O + 64 * MiB;
static_assert(WS_AST_M + 4 * MiB <= WS_END, "attention scratch");
constexpr unsigned PITCHB = QKV_LD * 2;
__device__ __forceinline__ s16x4 vtr(const LAS unsigned char* p) { return __builtin_bit_cast(s16x4, __builtin_amdgcn_ds_read_tr16_b64_v4i16((LAS s16x4*)p)); }
__device__ __forceinline__ float max3f(float a, float b, float c) { return fmaxf(fmaxf(a, b), c); }

#define AT_LOADS(KF, VR, ub, koff, voff) do { const unsigned ub_ = (ub); \
        _Pragma("unroll") for (int d0 = 0; d0 < 4; ++d0) KF[d0] = __builtin_bit_cast(bf16x8, __builtin_amdgcn_raw_buffer_load_b128(rsrc, (koff) + 32 * d0, ub_, 0)); \
        _Pragma("unroll") for (int i = 0; i < 4; ++i) VR[i] = __builtin_bit_cast(u32x4, __builtin_amdgcn_raw_buffer_load_b128(rsrc, (voff)[i], ub_, 0)); } while (0)
#define AT_SCORE(KF, VR, QF, tla) \
        _Pragma("unroll") for (int i = 0; i < 4; ++i) *(LAS u32x4*)(vwr + i * 512) = VR[i]; \
        { const LAS float* tl_ = (const LAS float*)(tla); _Pragma("unroll") for (int r = 0; r < 16; ++r) s[r] = tl_[(r & 3) + 8 * (r >> 2)]; } \
        _Pragma("unroll") for (int d0 = 0; d0 < 4; ++d0) s = __builtin_amdgcn_mfma_f32_32x32x16_bf16(KF[d0], QF[d0], s, 0, 0, 0);
#define AT_SOFTPV() do { \
        float rm = fmaxf(max3f(max3f(s[0], s[1], s[2]), max3f(s[3], s[4], s[5]), max3f(s[6], s[7], s[8])), max3f(max3f(s[9], s[10], s[11]), max3f(s[12], s[13], s[14]), s[15])); \
        { auto rr = __builtin_amdgcn_permlane32_swap(__float_as_uint(rm), __float_as_uint(rm), false, false); rm = fmaxf(__uint_as_float(rr[0]), __uint_as_float(rr[1])); } \
        if (__any(rm > M)) { const float Mn = fmaxf(M, rm), al = __builtin_amdgcn_exp2f(M - Mn); M = Mn; l *= al; \
            _Pragma("unroll") for (int r = 0; r < 16; ++r) { o0[r] *= al; o1[r] *= al; } } \
        float ps0 = 0.f, ps1 = 0.f; \
        _Pragma("unroll") for (int r = 0; r < 16; r += 2) { s[r] = __builtin_amdgcn_exp2f(s[r] - M); s[r + 1] = __builtin_amdgcn_exp2f(s[r + 1] - M); ps0 += s[r]; ps1 += s[r + 1]; } \
        l += ps0 + ps1; \
        u32x4 pw0, pw1; \
        pw0.x = cvt_pk_bf16(s[0], s[1]); pw0.y = cvt_pk_bf16(s[2], s[3]); pw0.z = cvt_pk_bf16(s[4], s[5]); pw0.w = cvt_pk_bf16(s[6], s[7]); \
        pw1.x = cvt_pk_bf16(s[8], s[9]); pw1.y = cvt_pk_bf16(s[10], s[11]); pw1.z = cvt_pk_bf16(s[12], s[13]); pw1.w = cvt_pk_bf16(s[14], s[15]); \
        const bf16x8 pa0 = __builtin_bit_cast(bf16x8, pw0), pa1 = __builtin_bit_cast(bf16x8, pw1); \
        LDS_WAIT(); \
        { const s16x4 a0 = vtr(vrd), a1 = vtr(vrd + 512), b0 = vtr(vrd + 1024), b1 = vtr(vrd + 1536); \
          const bf16x8 v0 = (bf16x8){a0[0], a0[1], a0[2], a0[3], a1[0], a1[1], a1[2], a1[3]}, v1 = (bf16x8){b0[0], b0[1], b0[2], b0[3], b1[0], b1[1], b1[2], b1[3]}; \
          o0 = __builtin_amdgcn_mfma_f32_32x32x16_bf16(v0, pa0, o0, 0, 0, 0); o0 = __builtin_amdgcn_mfma_f32_32x32x16_bf16(v1, pa1, o0, 0, 0, 0); } \
        { const s16x4 a0 = vtr(vrd + 2048), a1 = vtr(vrd + 2560), b0 = vtr(vrd + 3072), b1 = vtr(vrd + 3584); \
          const bf16x8 v0 = (bf16x8){a0[0], a0[1], a0[2], a0[3], a1[0], a1[1], a1[2], a1[3]}, v1 = (bf16x8){b0[0], b0[1], b0[2], b0[3], b1[0], b1[1], b1[2], b1[3]}; \
          o1 = __builtin_amdgcn_mfma_f32_32x32x16_bf16(v0, pa0, o1, 0, 0, 0); o1 = __builtin_amdgcn_mfma_f32_32x32x16_bf16(v1, pa1, o1, 0, 0, 0); } \
    } while (0)

#ifdef MK_ATT_TS
#define AT_TS(k) do { __builtin_amdgcn_sched_barrier(0); unsigned long long t_; asm volatile("s_memtime %0\n\ts_waitcnt lgkmcnt(0)" : "=s"(t_) :: "memory"); ts_acc[k] += t_ - ts_prev; ts_prev = t_; __builtin_amdgcn_sched_barrier(0); } while (0)
#else
#define AT_TS(k) do { } while (0)
#endif
template <int MODE>
__device__ __forceinline__ void attn_phase(const Frame& F, const Args& A, unsigned long long* ts_out = nullptr) {
#ifdef MK_ATT_TS
    unsigned long long ts_acc[6] = {0, 0, 0, 0, 0, 0}, ts_prev = 0;
    { unsigned long long t_; asm volatile("s_memtime %0\n\ts_waitcnt lgkmcnt(0)" : "=s"(t_) :: "memory"); ts_prev = t_; }
#endif
    LAS float* tab = (LAS float*)(F.lds + AT_TAB);
    const char* qkvb = (const char*)(F.ws + WS_QKV); bf16_t* mo = (bf16_t*)(F.ws + (MODE == 0 ? WS_S0 : WS_S1));
    float* sto = (float*)(F.ws + WS_AST_O); float* stm = (float*)(F.ws + WS_AST_M);
    int lane_ = F.lane; asm volatile("" : "+v"(lane_));
    const int lane = lane_, w = F.wave, j = lane & 31, hi = lane >> 5;
    LAS unsigned char* vbuf = F.lds + AT_V + w * 4096;
    LAS unsigned char* vwr = vbuf + ((lane & 7) >> 2) * 2048 + (lane >> 3) * 64 + (lane & 3) * 16;
    const LAS unsigned char* vrd = vbuf + (4 * hi + ((lane & 15) >> 2)) * 64 + ((lane >> 4) & 1) * 32 + (lane & 3) * 8;
    volatile LAS int* bkt = (volatile LAS int*)(F.lds + AT_BKT);
    volatile LAS int* acnt = (volatile LAS int*)(F.lds + AT_CNT);
    for (int i = F.tid; i < 3 * 129; i += NTHREADS) { const int g = i / 129, m = i - g * 129; bkt[i] = t5_bucket(m * (g == 0 ? 1 : (g == 1 ? 4 : 16))); }
    LDS_WAIT(); __syncthreads();
    const __amdgpu_buffer_rsrc_t rsrc = __builtin_amdgcn_make_buffer_rsrc((void*)(F.ws + WS_QKV), 0, (int)((size_t)T * PITCHB), 0x00020000);
    for (int it = 0; ; ++it) {
        int b, h, cp;
        { const int u = ((F.G & 7) == 0) ? ((F.bid & 7) * (F.G >> 3) + (F.bid >> 3)) + it * F.G : F.bid + it * F.G;
          if (u >= 256) break;
          b = u >> 5; h = (u >> 1) & 15; cp = u & 1; }
        const int tb = b * SEQ;
        __syncthreads();
        if (F.tid < 4) acnt[F.tid] = 0;
        for (int i = F.tid; i < 3 * 640; i += NTHREADS) { const int g = i / 640, m = 383 - (i - g * 640);
            tab[i] = (m >= 0 && m <= 128) ? A.in[I_RELB][bkt[g * 129 + m] * 48 + g * 16 + h] * L2E : -1e30f; }
        LDS_WAIT(); __syncthreads();
        AT_TS(5);
        const int c = 2 * cp + (w & 1);
        f32x16 o0, o1, s; float M, l;
        bf16x8 kfA[4], kfB[4]; u32x4 vrA[4], vrB[4];
#pragma unroll 1
        for (int rd = 0; rd < 4; ++rd) {
            const int r16 = c + 4 * (w >> 1), nt = rd + 1;
            const size_t tq = (size_t)(tb + 16 * (32 * rd + j) + r16);
            bf16x8 qf[4];
            { const char* qp = qkvb + tq * PITCHB + (2 * 1024 + h * 64 + 8 * hi) * 2;
#pragma unroll
              for (int d0 = 0; d0 < 4; ++d0) qf[d0] = *(const bf16x8*)(qp + 32 * d0); }
            const unsigned koff = (unsigned)(16 * j) * PITCHB + (3072 + 2 * 1024 + h * 64 + 8 * hi) * 2;
            unsigned voff[4];
#pragma unroll
            for (int i = 0; i < 4; ++i) voff[i] = (unsigned)(16 * (8 * i + (lane >> 3))) * PITCHB + (6144 + 2 * 1024 + h * 64 + 8 * (lane & 7)) * 2;
            const unsigned ub = (unsigned)(tb + r16) * PITCHB, ustep = (unsigned)(16 * 32) * PITCHB;
            const LAS float* tla = tab + 2 * 640 + 383 - (32 * rd + j) + 4 * hi;
#pragma unroll
            for (int r = 0; r < 16; ++r) { o0[r] = 0.f; o1[r] = 0.f; }
            M = -1e29f; l = 0.f;
#define AT_LOADA(m, KF, VR) do { int m_ = (m); m_ = m_ < nt ? m_ : nt - 1; if (MODE == 1) m_ = 0; AT_LOADS(KF, VR, ub + (unsigned)m_ * ustep, koff, voff); } while (0)
            AT_LOADA(0, kfA, vrA); AT_LOADA(1, kfB, vrB);
            AT_TS(0);
            int n = 0;
#pragma unroll 1
            for (; n + 1 < nt; n += 2) {
                AT_SCORE(kfA, vrA, qf, tla + 32 * n)
                AT_LOADA(n + 2, kfA, vrA);
                AT_SOFTPV();
                AT_SCORE(kfB, vrB, qf, tla + 32 * (n + 1))
                AT_LOADA(n + 3, kfB, vrB);
                AT_SOFTPV();
            }
            if (n < nt) { AT_SCORE(kfA, vrA, qf, tla + 32 * n) AT_SOFTPV(); }
            AT_TS(1);
#undef AT_LOADA
            float* so = sto + ((tq * 16 + h) * 2 + hi) * 32;
#pragma unroll
            for (int r = 0; r < 16; r += 4) { *(f32x4*)(so + r) = (f32x4){o0[r], o0[r + 1], o0[r + 2], o0[r + 3]}; *(f32x4*)(so + 16 + r) = (f32x4){o1[r], o1[r + 1], o1[r + 2], o1[r + 3]}; }
            *(f32x2*)(stm + ((tq * 16 + h) * 2 + hi) * 2) = (f32x2){M, l};
            VM_WAIT();
            if (lane == 0) __hip_atomic_fetch_add((LAS int*)&acnt[rd], 1, __ATOMIC_RELAXED, __HIP_MEMORY_SCOPE_WORKGROUP);
            AT_TS(2);
        }
        AT_TS(3);
#pragma unroll 1
        for (int rd = 0; rd < 4; ++rd) {
            const int i0 = 32 * (4 * rd + (w >> 1));
            const int ktlo0 = (4 - i0 / 8) > 0 ? (4 - i0 / 8) : 0, n0 = 8 - ktlo0;
            const int ktlo1 = (4 - i0 / 32) > 0 ? (4 - i0 / 32) : 0, n1 = 5 - ktlo1, ntl = n0 + n1;
            const size_t tq = (size_t)(tb + 4 * (i0 + j) + c);
            bf16x8 qf0[4], qf1[4];
            { const char* qp = qkvb + tq * PITCHB + (h * 64 + 8 * hi) * 2;
#pragma unroll
              for (int d0 = 0; d0 < 4; ++d0) { qf0[d0] = *(const bf16x8*)(qp + 32 * d0); qf1[d0] = *(const bf16x8*)(qp + 2048 + 32 * d0); } }
            while (__builtin_amdgcn_readfirstlane(acnt[rd]) < NWAVES) __builtin_amdgcn_s_sleep(2);
            asm volatile("" ::: "memory");
            { const float* so = sto + ((tq * 16 + h) * 2 + hi) * 32;
#pragma unroll
              for (int r = 0; r < 16; r += 4) { const f32x4 a = *(const f32x4*)(so + r), bq = *(const f32x4*)(so + 16 + r);
                  o0[r] = a[0]; o0[r + 1] = a[1]; o0[r + 2] = a[2]; o0[r + 3] = a[3]; o1[r] = bq[0]; o1[r + 1] = bq[1]; o1[r + 2] = bq[2]; o1[r + 3] = bq[3]; }
              const f32x2 ml = *(const f32x2*)(stm + ((tq * 16 + h) * 2 + hi) * 2); M = ml[0]; l = ml[1]; }
            const int kb0 = 4 * i0 - 128 + 32 * ktlo0, ik1 = i0 - 128 + 32 * ktlo1;
            const unsigned koff0 = (unsigned)j * PITCHB + (3072 + h * 64 + 8 * hi) * 2, koff1 = (unsigned)(4 * j) * PITCHB + (3072 + 1024 + h * 64 + 8 * hi) * 2;
            unsigned voff0[4], voff1[4];
#pragma unroll
            for (int i = 0; i < 4; ++i) { voff0[i] = (unsigned)(8 * i + (lane >> 3)) * PITCHB + (6144 + h * 64 + 8 * (lane & 7)) * 2;
                                          voff1[i] = (unsigned)(4 * (8 * i + (lane >> 3))) * PITCHB + (6144 + 1024 + h * 64 + 8 * (lane & 7)) * 2; }
            const unsigned ub0 = (unsigned)(tb + kb0) * PITCHB, ub1 = (unsigned)(tb + 4 * ik1 + c) * PITCHB;
            const unsigned us0 = 32u * PITCHB, us1 = 128u * PITCHB;
            const LAS float* tla0 = tab + 383 - (4 * (i0 + j) + c - kb0) + 4 * hi;
            const LAS float* tla1 = tab + 640 + 383 - (i0 + j - ik1) + 4 * hi;
#define AT_LOADN(m, KF, VR) do { int m_ = (m); m_ = m_ < ntl ? m_ : ntl - 1; if (m_ < n0) AT_LOADS(KF, VR, ub0 + (unsigned)(MODE == 1 ? 0 : m_) * us0, koff0, voff0); else AT_LOADS(KF, VR, ub1 + (unsigned)(MODE == 1 ? 0 : m_ - n0) * us1, koff1, voff1); } while (0)
#define AT_STEPN(n, KF, VR, PF) do { const int n_ = (n); if (n_ < n0) { AT_SCORE(KF, VR, qf0, tla0 + 32 * n_) } else { AT_SCORE(KF, VR, qf1, tla1 + 32 * (n_ - n0)) } \
            if (PF) AT_LOADN(n_ + 2, KF, VR); AT_SOFTPV(); } while (0)
            AT_LOADN(0, kfA, vrA); AT_LOADN(1, kfB, vrB);
            AT_TS(0);
            int n = 0;
#pragma unroll 1
            for (; n + 1 < ntl; n += 2) { AT_STEPN(n, kfA, vrA, true); AT_STEPN(n + 1, kfB, vrB, true); }
            if (n < ntl) AT_STEPN(n, kfA, vrA, false);
            AT_TS(4);
#undef AT_STEPN
#undef AT_LOADN
            { auto rr = __builtin_amdgcn_permlane32_swap(__float_as_uint(l), __float_as_uint(l), false, false); l = __uint_as_float(rr[0]) + __uint_as_float(rr[1]); }
            const float il = 1.0f / l;
            bf16_t* op = mo + tq * D + h * 64 + 4 * hi;
#pragma unroll
            for (int gq = 0; gq < 4; ++gq) {
                u32x2 w0, w1;
                w0.x = cvt_pk_bf16(o0[4 * gq] * il, o0[4 * gq + 1] * il); w0.y = cvt_pk_bf16(o0[4 * gq + 2] * il, o0[4 * gq + 3] * il);
                w1.x = cvt_pk_bf16(o1[4 * gq] * il, o1[4 * gq + 1] * il); w1.y = cvt_pk_bf16(o1[4 * gq + 2] * il, o1[4 * gq + 3] * il);
                *(u32x2*)(op + 8 * gq) = w0; *(u32x2*)(op + 32 + 8 * gq) = w1;
            }
            AT_TS(2);
        }
    }
#ifdef MK_ATT_TS
    if (ts_out && F.tid == 0) { for (int k = 0; k < 6; ++k) ts_out[k] = ts_acc[k]; }
#endif
    __syncthreads();
}
#undef AT_LOADS
#undef AT_SCORE
#undef AT_SOFTPV
constexpr int PH_MIX = 0, PH_FF1 = 1, PH_FF2 = 2, PH_QKV = 3, PH_ATT = 4, PH_WO = 5, PH_ROUTE = 6, PH_MOE0 = 7, PH_FINAL = 10, PH_END = 11;

__global__ void __launch_bounds__(NTHREADS, 2) mk_fwd(Args args) {
    extern __shared__ __attribute__((aligned(16))) unsigned char lds_raw[];
    Frame F;
    F.lds = (LAS unsigned char*)lds_raw;
    F.tid = threadIdx.x; F.lane = F.tid & 63; F.wave = __builtin_amdgcn_readfirstlane(F.tid >> 6); F.G = gridDim.x; F.bid = blockIdx.x;
    F.ws = args.ws; F.ctl = (unsigned*)(args.ws + WS_CTL); F.h = args.out;
    volatile LAS unsigned* MISC = (volatile LAS unsigned*)(F.lds + MISC_OFF);
    for (int u = F.tid; u < 64; u += NTHREADS) MISC[u] = 0u;
    __syncthreads();
    XcdBarrier bar = xcd_barrier_post(F.ctl + CW_BAR + args.li * XCD_BAR_WORDS, MISC + 8);
    const int lo = args.ph_lo, hi = args.ph_hi;
#ifndef MK_MASK
#define MK_MASK 0xffffffffu
#endif
#define IN(k) (((MK_MASK >> (k)) & 1u) && lo <= (k) && (k) < hi)
#define SEAM(k) do { if (IN(k) && IN((k) + 1)) xcd_barrier(bar); } while (0)
    unsigned char* ws = args.ws;
    LAS unsigned char* ring = F.lds + RING_OFF;
#ifdef MK_PROBE_LO
    unsigned long long pr_t0 = 0, pr_t1 = 0;
#define PROBE_AT(k) do { if ((k) == MK_PROBE_LO) pr_t0 = __builtin_amdgcn_s_memrealtime(); if ((k) == MK_PROBE_HI) pr_t1 = __builtin_amdgcn_s_memrealtime(); } while (0)
#else
#define PROBE_AT(k) do { } while (0)
#endif

    PROBE_AT(0);
    if (IN(PH_MIX)) { conv_aproj(F, args); conv_small(F, args); VM_WAIT(); __syncthreads(); }
    PROBE_AT(20);
    if (IN(PH_MIX)) { xcd_barrier(bar); PROBE_AT(21); mixer_phase(F, args); }
    PROBE_AT(22);
    SEAM(PH_MIX);

    PROBE_AT(1);
    if (IN(PH_FF1)) {
        pg8::Gemm g{(const bf16_t*)(ws + WS_S0), (const bf16_t*)(ws + WS_WGU0), D, D, D}; pg8::StaticOrder S; S.init(T, 2 * FF0, F.G, F.bid);
        EpiSwiGLU E{(bf16_t*)(ws + WS_ACT0), ACT0_LD, nullptr, 1.f, 1.f};
        pg8::gemm_phase<EpiSwiGLU, pg8::StaticOrder, false>(ring, g, S, E);
        { const int units = (T / 256) * (2 * FF0 / 256), rem = units % F.G;
          if (rem == 0) conv_later(F, args, F.bid, F.G); else if (F.bid >= rem) conv_later(F, args, F.bid - rem, F.G - rem); }
    }
    SEAM(PH_FF1);
    PROBE_AT(2);
    if (IN(PH_FF2)) {
        pg8::Gemm g{(const bf16_t*)(ws + WS_ACT0), (const bf16_t*)(ws + WS_WD0), FF0, ACT0_LD, FF0}; pg8::StaticOrder S; S.init(T, D, F.G, F.bid);
        EpiRes E{F.h, (bf16_t*)(ws + WS_S1), (float*)(ws + WS_SSQ), nullptr};
        pg8::gemm_phase<EpiRes, pg8::StaticOrder, false>(ring, g, S, E);
    }
    SEAM(PH_FF2);
    PROBE_AT(3);
    if (IN(PH_QKV)) {
        pg8::Gemm g{(const bf16_t*)(ws + WS_S1), (const bf16_t*)(ws + WS_WQKV), D, D, D}; pg8::StaticOrder S; S.init(T, NQKV, F.G, F.bid);
        EpiQKV E{(bf16_t*)(ws + WS_QKV), (const float*)(ws + WS_SSQ)};
        pg8::gemm_phase<EpiQKV, pg8::StaticOrder, false>(ring, g, S, E);
#if defined(MK_QKV_EXTRA) && MK_QKV_EXTRA == 1
        pg8::gemm_phase<EpiQKV, pg8::StaticOrder, false>(ring, g, S, E);
#elif defined(MK_QKV_EXTRA) && MK_QKV_EXTRA == 4
        { EpiNull EN; pg8::gemm_phase_ref<EpiNull, pg8::StaticOrder>(ring, g, S, EN); }
#elif defined(MK_QKV_EXTRA) && MK_QKV_EXTRA == 3
        { EpiQKV_T<false> EN{(bf16_t*)(ws + WS_QKV), (const float*)(ws + WS_SSQ)}; pg8::gemm_phase<EpiQKV_T<false>, pg8::StaticOrder, false>(ring, g, S, EN); }
#elif defined(MK_QKV_EXTRA) && MK_QKV_EXTRA == 2
        { EpiNull EN; pg8::gemm_phase<EpiNull, pg8::StaticOrder, false>(ring, g, S, EN); }
#endif
    }
    SEAM(PH_QKV);
        PROBE_AT(4);
#ifdef MK_ATT_TS
    unsigned long long att_ts[6] = {0, 0, 0, 0, 0, 0};
    if (IN(PH_ATT)) { attn_phase<0>(F, args, att_ts);
#else
    if (IN(PH_ATT)) { attn_phase<0>(F, args);
#endif
#ifdef MK_ATT_EXTRA
        attn_phase<MK_ATT_EXTRA>(F, args);
#endif
    }
    SEAM(PH_ATT);
    PROBE_AT(5);
    if (IN(PH_WO)) {
        pg8::Gemm g{(const bf16_t*)(ws + WS_S0), (const bf16_t*)(ws + WS_WO), D, D, D}; pg8::StaticOrder S; S.init(T, D, F.G, F.bid);
        EpiRes E{F.h, (bf16_t*)(ws + WS_S1), nullptr, ws + WS_S1};
        pg8::gemm_phase<EpiRes, pg8::StaticOrder, false>(ring, g, S, E);
        conv_moe(F, args);
#ifdef MK_READ_LINEAR
        for (int rep = 0; rep < 2; ++rep) { __syncthreads(); conv_read_linear(F, args); }
#endif
#ifdef MK_CONV_EXTRA
        for (int rep = 0; rep < MK_CONV_EXTRA; ++rep) { __syncthreads(); conv_moe(F, args, rep + 1); }
#endif
    }
    SEAM(PH_WO);
    PROBE_AT(6);
    if (IN(PH_ROUTE)) { router_phase(F, args); }
    SEAM(PH_ROUTE);
#pragma unroll 1
    for (int j = 0; j < 3; ++j) {
        PROBE_AT(7 + j);
        if (IN(PH_MOE0 + j)) {
            moe_info_build(F.lds, F.ctl);
            volatile LAS int* mi = (volatile LAS int*)(F.lds + SCR_OFF);
            const int ntiles = __builtin_amdgcn_readfirstlane(mi[MI_NT]);
            const int c1s = __builtin_amdgcn_readfirstlane(mi[MI_C1]);
            if (j >= 1) {
                const int c0 = j == 1 ? 0 : c1s; const int ntc = j == 1 ? c1s : ntiles - c1s;
                EpiY E{(bf16_t*)(ws + WS_Y), (bf16_t*)(ws + WS_Y2), c0 * 256, 1.f / (WD_PRESC * ACT_PRESC)};
                if (j == 2) {
                    pg8::Gemm g{(const bf16_t*)(ws + WS_ACT1 + ACT1_B1), (const bf16_t*)(ws + WS_WD1), FF1 / 4, FF1 / 2, FF1 / 2};
                    MoeOrder<8, false> S{{F.ctl + CW_Q + 64 * (2 * j), MISC + 16}, mi, c0, ntc, nullptr};
                    pg8::gemm_phase<EpiY, MoeOrder<8, false>, false, true>(ring, g, S, E);
                } else {
                    pg8::Gemm g{(const bf16_t*)(ws + WS_ACT1), (const bf16_t*)(ws + WS_WD1), FF1 / 2, FF1 / 2, FF1 / 2};
                    MoeOrder<4, false> S{{F.ctl + CW_Q + 64 * (2 * j), MISC + 16}, mi, c0, ntc, nullptr};
                    pg8::gemm_phase<EpiY, MoeOrder<4, false>, false, true>(ring, g, S, E);
                }
            }
            if (j <= 1) {
                const int c0 = j == 0 ? 0 : c1s; const int ntc = j == 0 ? c1s : ntiles - c1s;
                pg8::Gemm g{(const bf16_t*)(ws + WS_S1), (const bf16_t*)(ws + WS_WGU1), D / 2, D / 2, D / 2};
                MoeOrder<28, true> S{{F.ctl + CW_Q + 64 * (2 * j + 1), MISC + 16}, mi, c0, ntc, (const int*)(ws + WS_LTOK)};
                EpiSwiGLU_T<true> E{(bf16_t*)(ws + WS_ACT1 + (j ? ACT1_B1 : (size_t)0)), FF1, (const float*)(ws + WS_LRS), 1.f / WGU_PRESC, ACT_PRESC};
                pg8::gemm_phase<EpiSwiGLU_T<true>, MoeOrder<28, true>, true, true>(ring, g, S, E);
#ifdef MK_G1_EXTRA
                if (j == 0) {
#pragma unroll 1
                    for (int rep = 0; rep < 2; ++rep) {
                        MoeOrder<28, true> S2{{F.ctl + CW_Q + 64 * (8 + rep), MISC + 16}, mi, c0, ntc, (const int*)(ws + WS_LTOK)};
#if MK_G1_EXTRA == 1
                        pg8::gemm_phase<EpiSwiGLU_T<true>, MoeOrder<28, true>, true, true>(ring, g, S2, E);
#else
                        EpiNull EN{};
                        pg8::gemm_phase<EpiNull, MoeOrder<28, true>, true, true>(ring, g, S2, EN);
#endif
                    }
                }
#endif
            }
        }
        SEAM(PH_MOE0 + j);
    }
#ifdef MK_EXTRA_BARS
    for (int i = 0; i < MK_EXTRA_BARS; ++i) xcd_barrier(bar);
#endif
    PROBE_AT(10);
    if (IN(PH_FINAL)) { moe_info_build(F.lds, F.ctl); final_phase(F, args); }
    PROBE_AT(11);
#ifdef MK_ATT_TS
    if (F.bid == 0 && F.wave == 0) { const unsigned long long dt = att_ts[MK_ATT_TS] / 5ull, ts = __builtin_amdgcn_s_memrealtime(); while (__builtin_amdgcn_s_memrealtime() - ts < dt) __builtin_amdgcn_s_sleep(8); }
#endif
#ifdef MK_PROBE_LO
    { const unsigned long long dt = (pr_t1 - pr_t0) * MK_PROBE_MULT, ts = __builtin_amdgcn_s_memrealtime(); while (__builtin_amdgcn_s_memrealtime() - ts < dt) __builtin_amdgcn_s_sleep(8); }
#endif
#undef IN
#undef SEAM
}
}
extern "C" void kernel_launch(void* const* d_in, const int* in_sizes, int n_in, void* d_out, int out_size, void* d_ws, size_t ws_size, hipStream_t stream) {
    static int grid = 0;
    if (grid == 0) {
        if (n_in != 19 || out_size != mk::T * mk::D || ws_size < mk::WS_END) { fprintf(stderr, "kernel_launch: unexpected shapes / workspace (%d inputs, out %d, ws %zu)\n", n_in, out_size, ws_size); grid = -1; return; }
        int dev = 0, cus = 0;
        if (hipGetDevice(&dev) != hipSuccess || hipDeviceGetAttribute(&cus, hipDeviceAttributeMultiprocessorCount, dev) != hipSuccess) { grid = -1; return; }
        if (hipFuncSetAttribute((const void*)mk::mk_fwd, hipFuncAttributeMaxDynamicSharedMemorySize, mk::LDS_BYTES) != hipSuccess) { fprintf(stderr, "kernel_launch: hipFuncSetAttribute failed\n"); grid = -1; return; }
        int per_cu = 0;
        if (hipOccupancyMaxActiveBlocksPerMultiprocessor(&per_cu, (const void*)mk::mk_fwd, mk::NTHREADS, mk::LDS_BYTES) != hipSuccess || per_cu < 1) { fprintf(stderr, "kernel_launch: occupancy query says %d blocks per CU\n", per_cu); }
        (void)hipGetLastError();
        grid = cus;
    }
    if (grid < 0) return;
    (void)hipMemsetAsync((char*)d_ws + mk::WS_CTL, 0, mk::CTL_ZERO_BYTES, stream);
    mk::Args a{};
    for (int i = 0; i < 19; ++i) a.in[i] = (const float*)d_in[i];
    a.out = (float*)d_out; a.ws = (unsigned char*)d_ws;
    a.ph_lo = 0; a.ph_hi = mk::PH_END; a.li = 0;
    hipLaunchKernelGGL(mk::mk_fwd, dim3(grid), dim3(mk::NTHREADS), mk::LDS_BYTES, stream, a);
}
```

```cpp
#include <hip/hip_runtime.h>
#include <cstdio>
#include <cstdint>
namespace mk {
#define LAS __attribute__((address_space(3)))
#define GAS __attribute__((address_space(1)))
typedef unsigned short bf16_t;
typedef short bf16x8 __attribute__((ext_vector_type(8)));
typedef float f32x4 __attribute__((ext_vector_type(4)));
typedef float f32x2 __attribute__((ext_vector_type(2)));
typedef unsigned u32x4 __attribute__((ext_vector_type(4)));
typedef unsigned u32x2 __attribute__((ext_vector_type(2)));

constexpr int T = 16384, D = 1024, SEQ = 2048, NBATCH = 8;
constexpr int FF0 = 2816, FF1 = 3584, NE = 8, NQKV = 9216;
constexpr int ACT0_LD = FF0 + 64;
constexpr int QKV_LD = NQKV + 64;
constexpr float EPS = 1e-6f;
constexpr float WGU_PRESC = 32.f, WD_PRESC = 64.f, ACT_PRESC = 4.f;
constexpr int NWAVES = 8, NTHREADS = 512;

constexpr size_t MiB = 1u << 20;
constexpr size_t WS_CTL = 0, CTL_ZERO_BYTES = 1 * MiB;
constexpr size_t WS_SSQ = 1 * MiB;
constexpr size_t WS_LTOK = 2 * MiB;
constexpr size_t WS_LRS = 2 * MiB + 512 * 1024;
constexpr size_t WS_TOKINFO = 3 * MiB;
constexpr size_t WS_ZERO = 3 * MiB + 256 * 1024;
constexpr size_t WS_APT = 3 * MiB + 512 * 1024;
constexpr size_t WS_WGU0 = 4 * MiB;
constexpr size_t WS_WD0 = 15 * MiB;
constexpr size_t WS_WQKV = WS_WD0 + (size_t)D * FF0 * 2;
constexpr size_t WS_WO = WS_WQKV + (size_t)NQKV * D * 2;
constexpr size_t WS_S0 = 41 * MiB;
constexpr size_t WS_S1 = 73 * MiB;
constexpr size_t WS_RSTD1 = 3 * MiB + 320 * 1024;
constexpr size_t WS_H8 = 362 * MiB;
constexpr size_t WS_POOL = 105 * MiB;
constexpr size_t WS_ACT0 = WS_POOL;
constexpr size_t WS_QKV = WS_POOL;
constexpr int LAST_TILES = 32;
constexpr int CH0_CAP = 136 - LAST_TILES;
constexpr size_t ACT1_B1 = (size_t)CH0_CAP * 256 * FF1;
constexpr size_t WS_ACT1 = WS_POOL;
constexpr size_t WS_Y = 4 * MiB;
constexpr size_t WS_Y2 = WS_ACT1 + ACT1_B1 + (size_t)LAST_TILES * 256 * FF1;
constexpr size_t WS_WGU1 = 306 * MiB;
constexpr size_t WS_WD1 = 418 * MiB;
constexpr size_t WS_END = 474 * MiB;
static_assert(WS_WO + (size_t)D * D * 2 <= WS_S0, "small weights");
static_assert(WS_Y2 + (size_t)LAST_TILES * 256 * D * 2 <= WS_WGU1 && WS_Y + (size_t)34816 * D * 2 <= WS_S1, "moe map");
static_assert(WS_WGU1 + (size_t)NE * 7168 * D * 2 <= WS_WD1 && WS_WD1 + (size_t)NE * D * FF1 * 2 <= WS_END, "moe weights");
static_assert(WS_QKV + (size_t)T * QKV_LD * 2 <= WS_END, "qkv");

constexpr int CW_TMO = 0;
constexpr int CW_CNT = 64;
constexpr int CW_Q = 128;
constexpr int CW_BAR = 4096;

constexpr int RING_OFF = 0, RING_BYTES = 131072;
constexpr int MISC_OFF = RING_BYTES;
constexpr int RTAB_OFF = MISC_OFF + 1024;
constexpr int SCR_OFF = MISC_OFF + 2048;
constexpr int TOKT_OFF = SCR_OFF + 1024;
constexpr int LRST_OFF = SCR_OFF + 2048;
constexpr int LDS_BYTES = 147456;

#define RLX_AGENT __ATOMIC_RELAXED, __HIP_MEMORY_SCOPE_AGENT
#define LDS_WAIT() asm volatile("s_waitcnt lgkmcnt(0)" ::: "memory")
#define VM_WAIT() asm volatile("s_waitcnt vmcnt(0)" ::: "memory")
__device__ __forceinline__ unsigned f2bf(float f) { unsigned u = __builtin_bit_cast(unsigned, f); return (u + 0x7fffu + ((u >> 16) & 1u)) >> 16; }
__device__ __forceinline__ unsigned pk2(float lo, float hi) { return f2bf(lo) | (f2bf(hi) << 16); }
__device__ __forceinline__ unsigned cvt_pk_bf16(float lo, float hi) { unsigned r; asm volatile("v_cvt_pk_bf16_f32 %0, %1, %2" : "=v"(r) : "v"(lo), "v"(hi)); return r; }
__device__ __forceinline__ float bf2f(unsigned short b) { return __builtin_bit_cast(float, ((unsigned)b) << 16); }
__device__ __forceinline__ float wave_sum(float v) {
#pragma unroll
    for (int o = 1; o < 64; o <<= 1) v += __shfl_xor(v, o);
    return v;
}
__device__ __forceinline__ float silu_f(float x) { return x * __builtin_amdgcn_rcpf(1.f + __builtin_amdgcn_exp2f(-1.4426950408889634f * x)); }
#define XB_TMO      128
#define XB_XCNT(j)  (256  + 64 * (j))
#define XB_XSUB(j)  (1280 + 64 * (j))
#define XB_XGEN(j)  (2304 + 64 * (j))
#define XB_TOP      3328
#define XB_TOPGEN   3392
#define XCD_BAR_WORDS 3456
#define XB_SPIN_CAP (1u << 18)
__device__ __forceinline__ unsigned xb_ld(unsigned* p)              { return __hip_atomic_load(p, __ATOMIC_RELAXED, __HIP_MEMORY_SCOPE_AGENT); }
__device__ __forceinline__ unsigned xb_add(unsigned* p, unsigned v) { return __hip_atomic_fetch_add(p, v, __ATOMIC_RELAXED, __HIP_MEMORY_SCOPE_AGENT); }
__device__ __forceinline__ unsigned xb_xcc_id() { return (unsigned)__builtin_amdgcn_s_getreg((3 << 11) | 20) & 0xFu; }
#define XB_SPIN(cond, bar) do { unsigned _sp = 0; while (cond) { __builtin_amdgcn_s_sleep(1); \
    if ((++_sp & 255u) == 0u) { if (xb_ld(&(bar)[XB_TMO])) break; if (_sp > XB_SPIN_CAP) { atomicAdd(&(bar)[XB_TMO], 1u); break; } } } } while (0)
struct XcdBarrier { unsigned* bar; unsigned x; volatile LAS unsigned* st; };
__device__ __forceinline__ XcdBarrier xcd_barrier_post(unsigned* bar, volatile LAS unsigned* st) {
    XcdBarrier b; b.bar = bar; b.x = xb_xcc_id(); b.st = st;
    if (threadIdx.x == 0) (void)xb_add(&bar[XB_XCNT(b.x)], 1u);
    return b;
}
__device__ __forceinline__ void xcd_barrier_complete(unsigned* bar, unsigned x, unsigned& nloc, unsigned& nx) {
    const unsigned G = gridDim.x * gridDim.y * gridDim.z;
    unsigned sum, cnt, mine, sp = 0u;
    for (;;) {
        sum = 0u; cnt = 0u; mine = 0u;
#pragma unroll
        for (unsigned j = 0; j < 16; ++j) { const unsigned c = xb_ld(&bar[XB_XCNT(j)]); sum += c; cnt += (c > 0u) ? 1u : 0u; mine = (j == x) ? c : mine; }
        if (sum == G) break;
        __builtin_amdgcn_s_sleep(1);
        if ((++sp & 255u) == 0u) { if (xb_ld(&bar[XB_TMO])) break; if (sp > XB_SPIN_CAP) { atomicAdd(&bar[XB_TMO], 1u); break; } }
    }
    nloc = mine > 0u ? mine : 1u; nx = cnt > 0u ? cnt : 1u;
}
__device__ __forceinline__ void xcd_barrier(const XcdBarrier& b) {
    asm volatile("s_waitcnt vmcnt(0)" ::: "memory");
    __syncthreads();
    if (threadIdx.x == 0) {
        unsigned* bar = b.bar;
        __builtin_amdgcn_s_waitcnt(0);
        unsigned nloc = b.st[0], nx = b.st[1];
        if (nloc == 0u) { xcd_barrier_complete(bar, b.x, nloc, nx); b.st[0] = nloc; b.st[1] = nx; }
        const unsigned old = xb_add(&bar[XB_XSUB(b.x)], 1u);
        const unsigned gen = old / nloc;
        if (old + 1u == (gen + 1u) * nloc) {
            __builtin_amdgcn_fence(__ATOMIC_RELEASE, "agent");
            asm volatile("s_waitcnt vmcnt(0)" ::: "memory");
            const unsigned og = xb_add(&bar[XB_TOP], 1u);
            const unsigned tg = og / nx;
            if (og + 1u == (tg + 1u) * nx) xb_add(&bar[XB_TOPGEN], 1u);
            else XB_SPIN(xb_ld(&bar[XB_TOPGEN]) == tg, bar);
            __builtin_amdgcn_fence(__ATOMIC_ACQUIRE, "agent");
            xb_add(&bar[XB_XGEN(b.x)], 1u);
            asm volatile("s_waitcnt vmcnt(0)" ::: "memory");
        } else {
            XB_SPIN(xb_ld(&bar[XB_XGEN(b.x)]) == gen, bar);
            __builtin_amdgcn_fence(__ATOMIC_ACQUIRE, "agent");
            asm volatile("s_waitcnt vmcnt(0)" ::: "memory");
        }
    }
    __syncthreads();
}
namespace pg8 {
typedef int v4i __attribute__((ext_vector_type(4)));
typedef int v8i __attribute__((ext_vector_type(8)));
constexpr int BM = 256, BK = 64, HALF = 128, HTB = HALF * BK * 2, STAGE_BYTES = 8 * HTB, NXCD = 8, WGM = 4;
__host__ __device__ __forceinline__ int lds_byte(int r, int c) { const int st = (r >> 4) * 2 + (c >> 5), rr = r & 15, cc = c & 31, ob = rr * 64 + cc * 2; return st * 1024 + (ob ^ (((ob >> 9) & 1) << 5)); }
__host__ __device__ __forceinline__ void stage_rc(int b, int& R, int& C) { const int st = b / 1024, sb = b % 1024, swz = sb ^ (((sb >> 9) & 1) << 5); R = (st >> 1) * 16 + swz / 64; C = (st & 1) * 32 + (swz % 64) / 2; }
__host__ __device__ __forceinline__ int perm32(int rho) { const int n = rho >> 4, i = rho & 15; return 8 * (i >> 2) + 4 * n + (i & 3); }

struct Unit { int pm, pn, arow, brow, e, orow, koff; };
struct Gemm { const bf16_t* A; const bf16_t* Bt; int K; int lda; int ldb; };

struct StaticOrder {
    int nM, nN, nwg, G, c;
    __device__ void init(int M, int N, int G_, int c_) { nM = M / BM; nN = N / BM; nwg = nM * nN; G = G_; c = c_; }
    __device__ __forceinline__ void start() const {}
    __device__ __forceinline__ bool next(int i, Unit& u) const {
        const long L = (long)i * G + c; if (L >= nwg) return false;
        int wgid = (int)L; { const int q = nwg / NXCD, r = nwg % NXCD, xcd = wgid % NXCD, off = wgid / NXCD; wgid = (xcd < r ? xcd * (q + 1) : r * (q + 1) + (xcd - r) * q) + off; }
        const int nig = WGM * nN, gid = wgid / nig, fm = gid * WGM, gsz = (nM - fm) < WGM ? (nM - fm) : WGM;
        u.pm = fm + ((wgid % nig) % gsz); u.pn = (wgid % nig) / gsz; u.arow = u.pm * BM; u.brow = u.pn * BM; u.e = 0; u.orow = u.arow; u.koff = 0; return true;
    }
    __device__ __forceinline__ unsigned refill_issue() const { return 0u; }
    __device__ __forceinline__ void refill_commit(int, unsigned) const {}
    __device__ __forceinline__ unsigned gather_row(const Unit&, int) const { return 0u; }
};

template <class Epi, class Sched, bool GATHER, bool FP8 = false>
__device__ __forceinline__ void gemm_phase(LAS unsigned char* lds, const Gemm g, Sched& S, const Epi& E) {
    int tid_ = threadIdx.x; asm volatile("" : "+v"(tid_));
    const int tid = tid_, wid = __builtin_amdgcn_readfirstlane(tid >> 6), lane = tid & 63, wr = wid >> 2, wc = wid & 3, fr = lane & 15, fq = lane >> 4;
    int K_ = g.K; asm volatile("" : "+s"(K_));
    const int K = K_, nt = K / BK, LDA = g.lda, LDB = g.ldb;
    unsigned voffB[2]; unsigned va[2][2];
    const size_t kstep = (size_t)(BK * 2);
    const size_t hstep = (size_t)HALF * LDB * 2, hstepA = (size_t)HALF * LDA * 2;
#pragma unroll
    for (int i = 0; i < 2; ++i) { int R, C; stage_rc(tid * 16 + i * 8192, R, C); const int Rb = Epi::PERM ? ((R & ~31) + perm32(R & 31)) : R;
        voffB[i] = (unsigned)(Rb * LDB + C) * 2u;
        va[0][i] = (unsigned)(R * LDA + C) * 2u; va[1][i] = va[0][i] + (unsigned)hstepA; }
    const unsigned ldsw = (unsigned)wid * 1024u;
    const int aoff0 = lds_byte(wr * 64 + fr, FP8 ? 16 * fq : 8 * fq), aoff1 = lds_byte(wr * 64 + fr, FP8 ? 16 * fq + 8 : 8 * fq + 32);
    const int boff0 = lds_byte(wc * 32 + fr, FP8 ? 16 * fq : 8 * fq), boff1 = lds_byte(wc * 32 + fr, FP8 ? 16 * fq + 8 : 8 * fq + 32);
#define PG8_SA(b, h) (((b) * 2 + (h)) * HTB)
#define PG8_SB(b, h) ((4 + (b) * 2 + (h)) * HTB)
#define PG8_STAGEB(bufoff, gbase) do { _Pragma("unroll") for (int _i = 0; _i < 2; ++_i) \
        __builtin_amdgcn_global_load_lds((const unsigned*)((const char*)(gbase) + voffB[_i]), (LAS unsigned*)(lds + (bufoff) + ldsw + _i * 8192), 16, 0, 0); } while (0)
#define PG8_STAGEA(bufoff, gbase, vo, h) do { _Pragma("unroll") for (int _i = 0; _i < 2; ++_i) \
        __builtin_amdgcn_global_load_lds((const unsigned*)((const char*)(gbase) + (vo)[h][_i]), (LAS unsigned*)(lds + (bufoff) + ldsw + _i * 8192), 16, 0, 0); } while (0)
#define PG8_CAT8(p0, p1) __builtin_shufflevector(__builtin_bit_cast(v4i, *(const LAS bf16x8*)(p0)), __builtin_bit_cast(v4i, *(const LAS bf16x8*)(p1)), 0, 1, 2, 3, 4, 5, 6, 7)
#define PG8_LDA(dst, b, h) do { _Pragma("unroll") for (int m = 0; m < 4; ++m) { \
        if constexpr (FP8) dst##8[m] = PG8_CAT8(lds + PG8_SA(b, h) + aoff0 + m * 2048, lds + PG8_SA(b, h) + aoff0 + m * 2048 + 16);   \
        else { dst[m][0] = *(const LAS bf16x8*)(lds + PG8_SA(b, h) + aoff0 + m * 2048); dst[m][1] = *(const LAS bf16x8*)(lds + PG8_SA(b, h) + aoff1 + m * 2048); } } } while (0)
#define PG8_LDB(dst, b, h) do { _Pragma("unroll") for (int n = 0; n < 2; ++n) { \
        if constexpr (FP8) dst##8[n] = PG8_CAT8(lds + PG8_SB(b, h) + boff0 + n * 2048, lds + PG8_SB(b, h) + boff0 + n * 2048 + 16); \
        else { dst[n][0] = *(const LAS bf16x8*)(lds + PG8_SB(b, h) + boff0 + n * 2048); dst[n][1] = *(const LAS bf16x8*)(lds + PG8_SB(b, h) + boff1 + n * 2048); } } } while (0)
#define PG8_MMA(ai, bj, At, Bt) do { __builtin_amdgcn_s_setprio(1); _Pragma("unroll") for (int m = 0; m < 4; ++m) _Pragma("unroll") for (int n = 0; n < 2; ++n) { \
        if constexpr (FP8) asm volatile("v_mfma_scale_f32_16x16x128_f8f6f4 %0, %1, %2, %0, %3, %3 op_sel_hi:[0,0,0]" : "+v"(acc[ai][bj][m][n]) : "v"(Bt##8[n]), "v"(At##8[m]), "v"(sc8));   \
        else { _Pragma("unroll") for (int k = 0; k < 2; ++k) acc[ai][bj][m][n] = __builtin_amdgcn_mfma_f32_16x16x32_bf16(Bt[n][k], At[m][k], acc[ai][bj][m][n], 0, 0, 0); } } \
        __builtin_amdgcn_s_setprio(0); } while (0)
#define PG8_WAIT_V(n) asm volatile("s_waitcnt vmcnt(" #n ")" ::: "memory")
#define PG8_WAIT_L(n) asm volatile("s_waitcnt lgkmcnt(" #n ")" ::: "memory")
#define PG8_BAR __builtin_amdgcn_s_barrier()
#define PG8_SCHED __builtin_amdgcn_sched_barrier(0)
    int sc8 = 0x7f7f7f7f; asm volatile("" : "+v"(sc8));
    Unit cur, nxt; int ui = 0;
    typename Epi::Pre pre{};
#ifdef MK_STAGGER
    { const unsigned long long dt = (unsigned long long)((blockIdx.x >> 3) & 7) * MK_STAGGER, ts = __builtin_amdgcn_s_memrealtime(); while (__builtin_amdgcn_s_memrealtime() - ts < dt) __builtin_amdgcn_s_sleep(4); }
#endif
    S.start();
    if (!S.next(0, cur)) return;
    f32x4 acc[2][2][4][2];
#pragma unroll
    for (int a = 0; a < 2; ++a)
#pragma unroll
        for (int b = 0; b < 2; ++b)
#pragma unroll
            for (int m = 0; m < 4; ++m)
#pragma unroll
                for (int n = 0; n < 2; ++n) acc[a][b][m][n] = (f32x4){0.f, 0.f, 0.f, 0.f};
    bf16x8 At[4][2], B0[2][2], B1[2][2]; v8i At8[4], B08[2], B18[2];
    const char* cA; const char* cB = (const char*)g.Bt + ((size_t)cur.brow * LDB + cur.koff) * 2;
    if constexpr (GATHER) { cA = (const char*)g.A;
#pragma unroll
        for (int h = 0; h < 2; ++h)
#pragma unroll
            for (int i = 0; i < 2; ++i) { int R, C; stage_rc(tid * 16 + i * 8192, R, C); va[h][i] = (S.gather_row(cur, h * HALF + R) * (unsigned)LDA + (unsigned)C) * 2u; }
    } else cA = (const char*)g.A + ((size_t)cur.arow * LDA + cur.koff) * 2;
    PG8_STAGEB(PG8_SB(0, 0), cB); PG8_STAGEB(PG8_SB(0, 1), cB + hstep); PG8_STAGEA(PG8_SA(0, 0), cA, va, 0); PG8_STAGEA(PG8_SA(0, 1), cA, va, 1);
    if (wr == 1) PG8_BAR;
    PG8_WAIT_V(2); PG8_BAR;
    PG8_STAGEB(PG8_SB(1, 0), cB + kstep); PG8_STAGEA(PG8_SA(1, 0), cA + kstep, va, 0); PG8_STAGEB(PG8_SB(1, 1), cB + hstep + kstep);
    PG8_WAIT_V(6); PG8_BAR;
    for (;;) {
        bool has_next = false; const char* nA = cA; const char* nB = cB;
        unsigned vnx[2][2] = {{0u, 0u}, {0u, 0u}};
#pragma unroll 1
        for (int t = 0; t < nt; t += 2) {
            const bool last = (t == nt - 2);
            unsigned v2[2][2];
#pragma unroll
            for (int h = 0; h < 2; ++h)
#pragma unroll
                for (int i = 0; i < 2; ++i) v2[h][i] = va[h][i];
            if constexpr (GATHER) { if (t == nt - 4) {
                has_next = S.next(ui + 1, nxt);
                if (has_next) __builtin_amdgcn_global_load_lds((const unsigned*)S.gather_src(nxt, tid & 255), (LAS unsigned*)(lds + TOKT_OFF + (wid & 3) * 256), 4, 0, 0);
            } }
            if constexpr (Epi::DMA_PRE) { if (t == nt - 4) E.dma_pre(cur, tid, wid, lds); }
            if (last) {
                pre = E.pre(cur, wr, fr);
                if constexpr (!GATHER) has_next = S.next(ui + 1, nxt);
                if (has_next) { nB = (const char*)g.Bt + ((size_t)nxt.brow * LDB + nxt.koff) * 2;
                    if constexpr (GATHER) {
#pragma unroll
                        for (int h = 0; h < 2; ++h)
#pragma unroll
                            for (int i = 0; i < 2; ++i) { int R, C; stage_rc(tid * 16 + i * 8192, R, C); v2[h][i] = (((volatile LAS unsigned*)(lds + TOKT_OFF))[h * HALF + R] * (unsigned)LDA + (unsigned)C) * 2u; }
                    } else nA = (const char*)g.A + ((size_t)nxt.arow * LDA + nxt.koff) * 2;
                }
            }
            if constexpr (GATHER) { if (last) {
#pragma unroll
                for (int h = 0; h < 2; ++h)
#pragma unroll
                    for (int i = 0; i < 2; ++i) vnx[h][i] = v2[h][i]; } }
            const char* a1 = cA + (size_t)(t + 1) * kstep;
            const char* a2 = last ? nA : cA + (size_t)(t + 2) * kstep; const char* b2 = last ? nB : cB + (size_t)(t + 2) * kstep;
            const char* a3 = a2 + kstep; const char* b3 = b2 + kstep;
            PG8_LDB(B0, 0, 0); PG8_LDB(B1, 0, 1); PG8_SCHED; PG8_LDA(At, 0, 0); PG8_STAGEA(PG8_SA(1, 1), a1, va, 1);
            PG8_WAIT_V(8); PG8_WAIT_L(0); PG8_BAR; PG8_MMA(0, 0, At, B0); PG8_MMA(0, 1, At, B1); PG8_BAR; PG8_SCHED;
            PG8_LDA(At, 0, 1); PG8_STAGEB(PG8_SB(0, 0), b2); PG8_STAGEB(PG8_SB(0, 1), b2 + hstep); PG8_STAGEA(PG8_SA(0, 0), a2, v2, 0);
            PG8_WAIT_V(8); PG8_WAIT_L(0); PG8_BAR; PG8_MMA(1, 0, At, B0); PG8_MMA(1, 1, At, B1); PG8_BAR; PG8_SCHED;
            PG8_LDB(B0, 1, 0); PG8_LDB(B1, 1, 1); PG8_SCHED; PG8_LDA(At, 1, 0); PG8_STAGEA(PG8_SA(0, 1), a2, v2, 1);
            PG8_WAIT_V(8); PG8_WAIT_L(0); PG8_BAR; PG8_MMA(0, 0, At, B0); PG8_MMA(0, 1, At, B1); PG8_BAR; PG8_SCHED;
            PG8_LDA(At, 1, 1); PG8_STAGEB(PG8_SB(1, 0), b3); PG8_STAGEB(PG8_SB(1, 1), b3 + hstep); PG8_STAGEA(PG8_SA(1, 0), a3, v2, 0);
            PG8_WAIT_V(8); PG8_WAIT_L(0); PG8_BAR; PG8_MMA(1, 0, At, B0); PG8_MMA(1, 1, At, B1); PG8_BAR; PG8_SCHED;
        }
        if constexpr (FP8) asm volatile("s_nop 15\n\ts_nop 15\n\ts_nop 15\n\ts_nop 15" ::: "memory");
        if (wr == 0) PG8_BAR;
        const unsigned rf = S.refill_issue();
        E(acc, cur, wr, wc, fr, fq, lds, pre);
        S.refill_commit(ui, rf);
        if (!has_next) break;
#pragma unroll
        for (int a = 0; a < 2; ++a)
#pragma unroll
            for (int b = 0; b < 2; ++b)
#pragma unroll
                for (int m = 0; m < 4; ++m)
#pragma unroll
                    for (int n = 0; n < 2; ++n) acc[a][b][m][n] = (f32x4){0.f, 0.f, 0.f, 0.f};
        cur = nxt; cA = nA; cB = nB; ++ui;
        if constexpr (GATHER) {
#pragma unroll
            for (int h = 0; h < 2; ++h)
#pragma unroll
                for (int i = 0; i < 2; ++i) va[h][i] = vnx[h][i];
        }
        if (wr == 1) PG8_BAR;
    }
    PG8_WAIT_V(0);
    PG8_BAR;
#undef PG8_SA
#undef PG8_SB
#undef PG8_STAGEA
#undef PG8_STAGEB
#undef PG8_LDA
#undef PG8_LDB
#undef PG8_MMA
#undef PG8_WAIT_V
#undef PG8_WAIT_L
#undef PG8_BAR
#undef PG8_SCHED
}

template <class Epi, class Sched>
__device__ __forceinline__ void gemm_phase_ref(LAS unsigned char* lds, const Gemm g, const Sched& S, const Epi& E) {
    const int tid = threadIdx.x, wid = __builtin_amdgcn_readfirstlane(tid >> 6), lane = tid & 63, wr = wid >> 2, wc = wid & 3, fr = lane & 15, fq = lane >> 4;
    const int K = g.K, nt = K / BK;
    unsigned voffA[2], voffB[2];
#pragma unroll
    for (int i = 0; i < 2; ++i) { int R, C; stage_rc(tid * 16 + i * 8192, R, C); const int Rb = Epi::PERM ? ((R & ~31) + perm32(R & 31)) : R;
        voffA[i] = (unsigned)(R * K + C) * 2u; voffB[i] = (unsigned)(Rb * K + C) * 2u; }
    const size_t kstep = (size_t)(BK * 2), hstep = (size_t)HALF * K * 2, tstep = 2 * hstep;
    const unsigned ldsw = (unsigned)wid * 1024u;
    const int aoff = lds_byte(wr * 64 + fr, fq * 8), boff = lds_byte(wc * 32 + fr, fq * 8);
#define RSA(b, h) (((b) * 2 + (h)) * HTB)
#define RSB(b, h) ((4 + (b) * 2 + (h)) * HTB)
#define RSTAGE(bufoff, gbase, voff) do { _Pragma("unroll") for (int _i = 0; _i < 2; ++_i) \
        __builtin_amdgcn_global_load_lds((const unsigned*)((const char*)(gbase) + (voff)[_i]), (LAS unsigned*)(lds + (bufoff) + ldsw + _i * 8192), 16, 0, 0); } while (0)
#define RLDA(dst, b, h) do { _Pragma("unroll") for (int m = 0; m < 4; ++m) _Pragma("unroll") for (int k = 0; k < 2; ++k) dst[m][k] = *(const LAS bf16x8*)(lds + RSA(b, h) + aoff + m * 2048 + k * 1024); } while (0)
#define RLDB(dst, b, h) do { _Pragma("unroll") for (int n = 0; n < 2; ++n) _Pragma("unroll") for (int k = 0; k < 2; ++k) dst[n][k] = *(const LAS bf16x8*)(lds + RSB(b, h) + boff + n * 2048 + k * 1024); } while (0)
#define RMMA(ai, bj, At, Bt) do { __builtin_amdgcn_s_setprio(1); _Pragma("unroll") for (int m = 0; m < 4; ++m) _Pragma("unroll") for (int n = 0; n < 2; ++n) _Pragma("unroll") for (int k = 0; k < 2; ++k) \
        acc[ai][bj][m][n] = __builtin_amdgcn_mfma_f32_16x16x32_bf16(Bt[n][k], At[m][k], acc[ai][bj][m][n], 0, 0, 0); __builtin_amdgcn_s_setprio(0); } while (0)
#define RWV(n) asm volatile("s_waitcnt vmcnt(" #n ")" ::: "memory")
#define RWL(n) asm volatile("s_waitcnt lgkmcnt(" #n ")" ::: "memory")
#define RBAR __builtin_amdgcn_s_barrier()
#define RSCHED __builtin_amdgcn_sched_barrier(0)
    Unit cur, nxt; int ui = 0;
    if (!S.next(0, cur)) return;
    f32x4 acc[2][2][4][2];
#pragma unroll
    for (int a = 0; a < 2; ++a)
#pragma unroll
        for (int b = 0; b < 2; ++b)
#pragma unroll
            for (int m = 0; m < 4; ++m)
#pragma unroll
                for (int n = 0; n < 2; ++n) acc[a][b][m][n] = (f32x4){0.f, 0.f, 0.f, 0.f};
    bf16x8 At[4][2], B0[2][2], B1[2][2];
    const char* cA = (const char*)g.A + (size_t)cur.pm * tstep; const char* cB = (const char*)g.Bt + (size_t)cur.pn * tstep;
    RSTAGE(RSB(0, 0), cB, voffB); RSTAGE(RSB(0, 1), cB + hstep, voffB); RSTAGE(RSA(0, 0), cA, voffA); RSTAGE(RSA(0, 1), cA + hstep, voffA);
    if (wr == 1) RBAR;
    RWV(2); RBAR;
    RSTAGE(RSB(1, 0), cB + kstep, voffB); RSTAGE(RSA(1, 0), cA + kstep, voffA); RSTAGE(RSB(1, 1), cB + hstep + kstep, voffB);
    RWV(6); RBAR;
    for (;;) {
        const bool has_next = S.next(ui + 1, nxt);
        const char* nA = has_next ? (const char*)g.A + (size_t)nxt.pm * tstep : cA; const char* nB = has_next ? (const char*)g.Bt + (size_t)nxt.pn * tstep : cB;
        for (int t = 0; t < nt; t += 2) {
            const bool last = (t == nt - 2);
            const char* a1 = cA + (size_t)(t + 1) * kstep;
            const char* a2 = last ? nA : cA + (size_t)(t + 2) * kstep; const char* b2 = last ? nB : cB + (size_t)(t + 2) * kstep;
            const char* a3 = a2 + kstep; const char* b3 = b2 + kstep;
            RLDB(B0, 0, 0); RLDB(B1, 0, 1); RSCHED; RLDA(At, 0, 0); RSTAGE(RSA(1, 1), a1 + hstep, voffA);
            RWV(8); RWL(0); RBAR; RMMA(0, 0, At, B0); RMMA(0, 1, At, B1); RBAR; RSCHED;
            RLDA(At, 0, 1); RSTAGE(RSB(0, 0), b2, voffB); RSTAGE(RSB(0, 1), b2 + hstep, voffB); RSTAGE(RSA(0, 0), a2, voffA);
            RWV(8); RWL(0); RBAR; RMMA(1, 0, At, B0); RMMA(1, 1, At, B1); RBAR; RSCHED;
            RLDB(B0, 1, 0); RLDB(B1, 1, 1); RSCHED; RLDA(At, 1, 0); RSTAGE(RSA(0, 1), a2 + hstep, voffA);
            RWV(8); RWL(0); RBAR; RMMA(0, 0, At, B0); RMMA(0, 1, At, B1); RBAR; RSCHED;
            RLDA(At, 1, 1); RSTAGE(RSB(1, 0), b3, voffB); RSTAGE(RSB(1, 1), b3 + hstep, voffB); RSTAGE(RSA(1, 0), a3, voffA);
            RWV(8); RWL(0); RBAR; RMMA(1, 0, At, B0); RMMA(1, 1, At, B1); RBAR; RSCHED;
        }
        if (wr == 0) RBAR;
#pragma unroll
        for (int a = 0; a < 2; ++a)
#pragma unroll
            for (int b = 0; b < 2; ++b)
#pragma unroll
                for (int m = 0; m < 4; ++m)
#pragma unroll
                    for (int n = 0; n < 2; ++n) asm volatile("" :: "v"(acc[a][b][m][n]));
        if (!has_next) break;
#pragma unroll
        for (int a = 0; a < 2; ++a)
#pragma unroll
            for (int b = 0; b < 2; ++b)
#pragma unroll
                for (int m = 0; m < 4; ++m)
#pragma unroll
                    for (int n = 0; n < 2; ++n) acc[a][b][m][n] = (f32x4){0.f, 0.f, 0.f, 0.f};
        cur = nxt; cA = nA; cB = nB; ++ui;
        if (wr == 1) RBAR;
    }
    RWV(0);
    RBAR;
#undef RSA
#undef RSB
#undef RSTAGE
#undef RLDA
#undef RLDB
#undef RMMA
#undef RWV
#undef RWL
#undef RBAR
#undef RSCHED
}
}
struct PreNone { };
struct Pre8 { float v[8]; };
__device__ __forceinline__ unsigned pk4_fp8(float a, float b, float c, float d) { int w = __builtin_amdgcn_cvt_pk_fp8_f32(a, b, 0, false); w = __builtin_amdgcn_cvt_pk_fp8_f32(c, d, w, true); return (unsigned)w; }
template <bool F8>
struct EpiSwiGLU_T {
    static constexpr bool PERM = true;
    static constexpr bool DMA_PRE = true;
    bf16_t* O; int ldo; const float* lrs; float wsc, osc;
    typedef PreNone Pre;
    __device__ __forceinline__ Pre pre(const pg8::Unit&, int, int) const { return Pre{}; }
    __device__ __forceinline__ void dma_pre(const pg8::Unit& u, int tid, int wid, LAS unsigned char* lds) const {
        __builtin_amdgcn_global_load_lds((const unsigned*)(lrs + (size_t)u.e * T + u.arow + (tid & 255)), (LAS unsigned*)(lds + LRST_OFF + (wid & 3) * 256), 4, 0, 0); }
    __device__ __forceinline__ void operator()(const f32x4 (&acc)[2][2][4][2], const pg8::Unit& u, int wr, int wc, int fr, int fq, LAS unsigned char* lds, const Pre&) const {
        struct { float v[8]; } pr;
#pragma unroll
        for (int i = 0; i < 8; ++i) {
            pr.v[i] = ((const LAS float*)(lds + LRST_OFF))[(i >> 2) * 128 + (i & 3) * 16 + wr * 64 + fr]; }
        const int r0 = wr * 64 + fr, col0 = u.pn * 128 + wc * 32 + 8 * fq;
#pragma unroll
        for (int ai = 0; ai < 2; ++ai) {
#pragma unroll
            for (int m = 0; m < 4; ++m) {
                const float s = pr.v[ai * 4 + m] * wsc; float o[8];
#pragma unroll
                for (int n = 0; n < 2; ++n)
#pragma unroll
                    for (int j = 0; j < 4; ++j) { const float gv = acc[ai][0][m][n][j] * s, uv = acc[ai][1][m][n][j] * s; o[n * 4 + j] = silu_f(gv) * uv; }
                if constexpr (F8) { u32x2 w; w.x = pk4_fp8(o[0] * osc, o[1] * osc, o[2] * osc, o[3] * osc); w.y = pk4_fp8(o[4] * osc, o[5] * osc, o[6] * osc, o[7] * osc);
                    *(u32x2*)((unsigned char*)O + (size_t)(u.orow + ai * 128 + m * 16 + r0) * ldo + col0) = w; }
                else { u32x4 w; w.x = cvt_pk_bf16(o[0], o[1]); w.y = cvt_pk_bf16(o[2], o[3]); w.z = cvt_pk_bf16(o[4], o[5]); w.w = cvt_pk_bf16(o[6], o[7]);
                    *(u32x4*)(O + (size_t)(u.orow + ai * 128 + m * 16 + r0) * ldo + col0) = w; }
            }
        }
    }
};
typedef EpiSwiGLU_T<false> EpiSwiGLU;
struct EpiRes {
    static constexpr bool PERM = true;
    static constexpr bool DMA_PRE = false;
    bf16_t* HB; float* ssq; unsigned char* HB8;
    typedef PreNone Pre;
    __device__ __forceinline__ Pre pre(const pg8::Unit&, int, int) const { return Pre{}; }
    __device__ __forceinline__ void operator()(const f32x4 (&acc)[2][2][4][2], const pg8::Unit& u, int wr, int wc, int fr, int fq, LAS unsigned char*, const Pre&) const {
        const int r0 = u.orow + wr * 64 + fr, col0 = u.pn * 256 + wc * 32 + 8 * fq;
#pragma unroll
        for (int ai = 0; ai < 2; ++ai)
#pragma unroll
            for (int m = 0; m < 4; ++m) {
                const size_t off = (size_t)(r0 + ai * 128 + m * 16) * D + col0; float sq = 0.f;
#pragma unroll
                for (int bj = 0; bj < 2; ++bj) {
                    const u32x4 hb = *(const u32x4*)(HB + off + bj * 128); const unsigned hw[4] = {hb.x, hb.y, hb.z, hb.w};
                    float hv[8]; unsigned ow[4];
#pragma unroll
                    for (int k = 0; k < 4; ++k) { hv[2 * k] = __uint_as_float(hw[k] << 16) + acc[ai][bj][m][k >> 1][(2 * k) & 3]; hv[2 * k + 1] = __uint_as_float(hw[k] & 0xffff0000u) + acc[ai][bj][m][k >> 1][(2 * k + 1) & 3];
                        ow[k] = cvt_pk_bf16(hv[2 * k], hv[2 * k + 1]); }
                    *(u32x4*)(HB + off + bj * 128) = (u32x4){ow[0], ow[1], ow[2], ow[3]};
                    if (HB8) { u32x2 w8; w8.x = pk4_fp8(hv[0], hv[1], hv[2], hv[3]); w8.y = pk4_fp8(hv[4], hv[5], hv[6], hv[7]); *(u32x2*)(HB8 + off + bj * 128) = w8; }
#pragma unroll
                    for (int k = 0; k < 4; ++k) { const float a = __uint_as_float(ow[k] << 16), b2 = __uint_as_float(ow[k] & 0xffff0000u); sq += a * a + b2 * b2; }
                }
                if (ssq) { sq += __shfl_xor(sq, 16); sq += __shfl_xor(sq, 32);
                    if (fq == 0) ssq[(size_t)(r0 + ai * 128 + m * 16) * 16 + u.pn * 4 + wc] = sq; }
            }
    }
};
template <bool STORE>
struct EpiQKV_T {
    static constexpr bool PERM = true;
    static constexpr bool DMA_PRE = false;
    bf16_t* O; const float* ssq;
    typedef Pre8 Pre;
    __device__ __forceinline__ Pre pre(const pg8::Unit& u, int, int) const { Pre p; const int tid = threadIdx.x, row = tid >> 1, part = tid & 1;
        const f32x4* q = (const f32x4*)(ssq + (size_t)(u.orow + row) * 16 + part * 8); const f32x4 a = q[0], b = q[1];
        p.v[0] = a[0]; p.v[1] = a[1]; p.v[2] = a[2]; p.v[3] = a[3]; p.v[4] = b[0]; p.v[5] = b[1]; p.v[6] = b[2]; p.v[7] = b[3]; return p; }
    __device__ __forceinline__ void operator()(const f32x4 (&acc)[2][2][4][2], const pg8::Unit& u, int wr, int wc, int fr, int fq, LAS unsigned char* lds, const Pre& pr) const {
        LAS float* rtab = (LAS float*)(lds + RTAB_OFF);
        { const int tid = threadIdx.x, row = tid >> 1, part = tid & 1;
          float s = ((pr.v[0] + pr.v[1]) + (pr.v[2] + pr.v[3])) + ((pr.v[4] + pr.v[5]) + (pr.v[6] + pr.v[7]));
          s += __shfl_xor(s, 1);
          if (part == 0) rtab[row] = 1.0f / sqrtf(s * (1.f / D) + EPS); }
        asm volatile("s_waitcnt lgkmcnt(0)" ::: "memory"); __builtin_amdgcn_s_barrier(); asm volatile("" ::: "memory");
        const float qs = (u.pn * 256 < 3072) ? 0.125f * 1.4426950408889634f : 1.f;
        const int r0 = wr * 64 + fr, col0 = u.pn * 256 + wc * 32 + 8 * fq;
#pragma unroll
        for (int ai = 0; ai < 2; ++ai)
#pragma unroll
            for (int m = 0; m < 4; ++m) {
                const float s = rtab[ai * 128 + m * 16 + r0] * qs;
#pragma unroll
                for (int bj = 0; bj < 2; ++bj) {
                    const f32x4 v0 = acc[ai][bj][m][0] * s, v1 = acc[ai][bj][m][1] * s;
                    u32x4 w; w.x = cvt_pk_bf16(v0[0], v0[1]); w.y = cvt_pk_bf16(v0[2], v0[3]); w.z = cvt_pk_bf16(v1[0], v1[1]); w.w = cvt_pk_bf16(v1[2], v1[3]);
                    if (STORE) *(u32x4*)(O + (size_t)(u.orow + ai * 128 + m * 16 + r0) * QKV_LD + col0 + bj * 128) = w; else asm volatile("" :: "v"(w));
                }
            }
    }
};
typedef EpiQKV_T<true> EpiQKV;
struct EpiNull {
    static constexpr bool PERM = true;
    static constexpr bool DMA_PRE = false;
    typedef PreNone Pre;
    __device__ __forceinline__ Pre pre(const pg8::Unit&, int, int) const { return Pre{}; }
    __device__ __forceinline__ void operator()(const f32x4 (&acc)[2][2][4][2], const pg8::Unit& u, int wr, int wc, int fr, int fq, LAS unsigned char*, const Pre&) const {
#pragma unroll
        for (int ai = 0; ai < 2; ++ai)
#pragma unroll
            for (int bj = 0; bj < 2; ++bj)
#pragma unroll
                for (int m = 0; m < 4; ++m)
#pragma unroll
                    for (int n = 0; n < 2; ++n) asm volatile("" :: "v"(acc[ai][bj][m][n]));
    }
};
struct EpiY {
    static constexpr bool PERM = true;
    static constexpr bool DMA_PRE = false;
    bf16_t* Y; bf16_t* Y2; int c0rows; float ysc;
    typedef PreNone Pre;
    __device__ __forceinline__ Pre pre(const pg8::Unit&, int, int) const { return Pre{}; }
    __device__ __forceinline__ void operator()(const f32x4 (&acc)[2][2][4][2], const pg8::Unit& u, int wr, int wc, int fr, int fq, LAS unsigned char*, const Pre&) const {
        bf16_t* Yb = u.koff ? Y2 : Y;
        const int r0 = (u.koff ? u.orow - c0rows : u.orow) + wr * 64 + fr, col0 = u.pn * 256 + wc * 32 + 8 * fq;
#pragma unroll
        for (int ai = 0; ai < 2; ++ai)
#pragma unroll
            for (int m = 0; m < 4; ++m)
#pragma unroll
                for (int bj = 0; bj < 2; ++bj) {
                    const f32x4 v0 = acc[ai][bj][m][0] * ysc, v1 = acc[ai][bj][m][1] * ysc;
                    u32x4 w; w.x = cvt_pk_bf16(v0[0], v0[1]); w.y = cvt_pk_bf16(v0[2], v0[3]); w.z = cvt_pk_bf16(v1[0], v1[1]); w.w = cvt_pk_bf16(v1[2], v1[3]);
                    *(u32x4*)(Yb + (size_t)(r0 + ai * 128 + m * 16) * D + col0 + bj * 128) = w;
                }
    }
};

constexpr int MI_CNT = 0, MI_TB = 8, MI_NT = 17, MI_SPLIT0 = 18, MI_C1 = 19;
__device__ __forceinline__ void moe_info_build(LAS unsigned char* lds, const unsigned* ctl) {
    volatile LAS int* mi = (volatile LAS int*)(lds + SCR_OFF);
    if (threadIdx.x == 0) { int tb = 0;
        for (int e = 0; e < NE; ++e) { const int c = (int)__hip_atomic_load(ctl + CW_CNT + e, RLX_AGENT); mi[MI_CNT + e] = c; mi[MI_TB + e] = tb; tb += (c + 255) >> 8; }
        mi[MI_TB + NE] = tb; mi[MI_NT] = tb; const int c1 = tb > LAST_TILES ? tb - LAST_TILES : 0; mi[MI_C1] = c1; mi[MI_SPLIT0] = c1 * 256; }
    LDS_WAIT(); __syncthreads();
}
struct DynQ {
    unsigned* ctr; volatile LAS unsigned* slot;
    __device__ __forceinline__ void start() const { if (threadIdx.x == 0) { slot[0] = blockIdx.x; slot[1] = gridDim.x + atomicAdd(ctr, 1u); } LDS_WAIT(); __syncthreads(); }
#ifdef MK_STATICQ
    __device__ __forceinline__ int fetch(int i) const { return i * (int)gridDim.x + (int)blockIdx.x; }
#else
    __device__ __forceinline__ int fetch(int i) const { return __builtin_amdgcn_readfirstlane((int)slot[i & 3]); }
#endif
    __device__ __forceinline__ unsigned refill_issue() const { unsigned v = 0u; if (threadIdx.x == 0) v = gridDim.x + atomicAdd(ctr, 1u); return v; }
    __device__ __forceinline__ void refill_commit(int ui, unsigned v) const { if (threadIdx.x == 0) slot[(ui + 2) & 3] = v; }
};
template <int NN, bool G1>
struct MoeOrder {
    DynQ q; volatile LAS int* mi; int c0, ntc; const int* ltok;
    __device__ __forceinline__ void start() const { q.start(); }
    __device__ __forceinline__ unsigned refill_issue() const { return q.refill_issue(); }
    __device__ __forceinline__ void refill_commit(int ui, unsigned v) const { q.refill_commit(ui, v); }
    __device__ __forceinline__ bool next(int i, pg8::Unit& u) const {
        const int idx = q.fetch(i); if (idx >= ntc * NN) return false;
        const int grp = idx / (8 * NN), r = idx - grp * (8 * NN), gsz = (ntc - grp * 8) < 8 ? (ntc - grp * 8) : 8;
        const int pml = grp * 8 + r % gsz, pn = r / gsz, pmg = c0 + pml;
        int e = 0;
#pragma unroll
        for (int k = 1; k < NE; ++k) e += (pmg >= mi[MI_TB + k]) ? 1 : 0;
        e = __builtin_amdgcn_readfirstlane(e);
        u.pm = pmg; u.pn = pn; u.e = e; u.koff = 0;
        if (!G1 && NN == 8) { u.pn = pn & 3; u.koff = (pn >> 2) * (FF1 / 4); }
        const int pnb = u.pn;
        if (G1) { u.arow = (pmg - __builtin_amdgcn_readfirstlane(mi[MI_TB + e])) * 256; u.brow = e * (2 * FF1) + pn * 256; u.orow = pml * 256; }
        else { u.arow = pml * 256; u.brow = e * D + pnb * 256; u.orow = pmg * 256; }
        return true;
    }
    __device__ __forceinline__ const int* gather_src(const pg8::Unit& u, int r) const {
        const int lr = u.arow + r; const int c = mi[MI_CNT + u.e];
        return lr < c ? ltok + (size_t)u.e * T + lr : (const int*)((const char*)ltok + (WS_ZERO - WS_LTOK));
    }
    __device__ __forceinline__ unsigned gather_row(const pg8::Unit& u, int r) const {
        const int lr = u.arow + r; const int c = mi[MI_CNT + u.e];
        return lr < c ? (unsigned)ltok[(size_t)u.e * T + lr] : 0u;
    }
};
struct Args { const float* in[19]; float* out; unsigned char* ws; int ph_lo, ph_hi, li, pad; };
enum { I_X = 0, I_ANORM, I_APROJ, I_ASCALE, I_KVNORM, I_WKV, I_BNORM, I_WQ, I_WO, I_RELB, I_FFNORM, I_DWG, I_DWU, I_DWD, I_ROUTER, I_MWG, I_MWU, I_MWD, I_FNORM };
struct Frame {
    LAS unsigned char* lds; unsigned* ctl; int tid, lane, wave, G, bid;
    float* h; unsigned char* ws;
};
__device__ __forceinline__ void conv_item(const float* W, int ldw, const float* gain, bf16_t* WT, int K, int dst_row0, LAS float* scr, int k0, int n0, int lane) {
    float wv[32];
#pragma unroll
    for (int i = 0; i < 32; ++i) wv[i] = W[(size_t)(k0 + 2 * i + (lane >> 5)) * ldw + n0 + (lane & 31)];
    if (gain) {
#pragma unroll
        for (int i = 0; i < 32; ++i) wv[i] *= gain[k0 + 2 * i + (lane >> 5)];
    }
#pragma unroll
    for (int i = 0; i < 32; ++i) scr[(2 * i + (lane >> 5)) * 33 + (lane & 31)] = wv[i];
    LDS_WAIT(); asm volatile("" ::: "memory");
    const int c = lane & 7;
#pragma unroll
    for (int j = 0; j < 4; ++j) { const int n = (lane >> 3) + 8 * j; const LAS float* s = scr + (8 * c) * 33 + n;
        u32x4 o; o.x = pk2(s[0 * 33], s[1 * 33]); o.y = pk2(s[2 * 33], s[3 * 33]); o.z = pk2(s[4 * 33], s[5 * 33]); o.w = pk2(s[6 * 33], s[7 * 33]);
        *(u32x4*)(WT + (size_t)(dst_row0 + n) * K + k0 + 8 * c) = o; }
    LDS_WAIT(); asm volatile("" ::: "memory");
}
__device__ __forceinline__ void conv_job(const Frame& F, int& it0, const float* W, int K, int N, int ldw, const float* gain, bf16_t* WT, int mode, int row_off, LAS float* scr, int cg = 0) {
    const int nblk = N / 32, items = (K / 64) * nblk, NGW = (cg ? cg : F.G) * NWAVES;
    int it = it0;
    for (; it < items; it += NGW) {
        const int kb = it / nblk, nb = it - kb * nblk, n0 = nb * 32;
        const int dr = (mode == 0) ? (row_off + n0) : (row_off + (n0 >> 7) * 256 + (n0 & 127) + (mode == 2 ? 128 : 0));
        conv_item(W, ldw, gain, WT, K, dr, scr, kb * 64, n0, F.lane);
    }
    it0 = it - items;
}
__device__ __forceinline__ void conv_item8(const float* W, int ldw, const float* gain, float presc, unsigned char* WT8, int K, int dst_row0, LAS float* scr, int k0, int n0, int lane) {
    float wv[32];
#pragma unroll
    for (int i = 0; i < 32; ++i) wv[i] = W[(size_t)(k0 + 2 * i + (lane >> 5)) * ldw + n0 + (lane & 31)];
#pragma unroll
    for (int i = 0; i < 32; ++i) wv[i] *= gain ? gain[k0 + 2 * i + (lane >> 5)] * presc : presc;
#pragma unroll
    for (int i = 0; i < 32; ++i) scr[(2 * i + (lane >> 5)) * 33 + (lane & 31)] = wv[i];
    LDS_WAIT(); asm volatile("" ::: "memory");
    const int c = lane & 7;
#pragma unroll
    for (int j = 0; j < 4; ++j) { const int n = (lane >> 3) + 8 * j; const LAS float* s = scr + (8 * c) * 33 + n;
        u32x2 o; o.x = pk4_fp8(s[0 * 33], s[1 * 33], s[2 * 33], s[3 * 33]); o.y = pk4_fp8(s[4 * 33], s[5 * 33], s[6 * 33], s[7 * 33]);
        *(u32x2*)(WT8 + (size_t)(dst_row0 + n) * K + k0 + 8 * c) = o; }
    LDS_WAIT(); asm volatile("" ::: "memory");
}
__device__ __forceinline__ void conv_job8(const Frame& F, int& it0, const float* W, int K, int N, int ldw, const float* gain, float presc, unsigned char* WT8, int mode, int row_off, LAS float* scr) {
    const int nblk = N / 32, items = (K / 64) * nblk, NGW = F.G * NWAVES;
    int it = it0;
    for (; it < items; it += NGW) {
        const int kb = it / nblk, nb = it - kb * nblk, n0 = nb * 32;
        const int dr = (mode == 0) ? (row_off + n0) : (row_off + (n0 >> 7) * 256 + (n0 & 127) + (mode == 2 ? 128 : 0));
        conv_item8(W, ldw, gain, presc, WT8, K, dr, scr, kb * 64, n0, F.lane);
    }
    it0 = it - items;
}
__device__ __forceinline__ void conv_aproj(const Frame& F, const Args& A) {
    LAS float* scr = (LAS float*)(F.lds + RING_OFF + F.wave * 16384);
    int it = F.bid * NWAVES + F.wave;
    for (int g = 0; g < 4; ++g) conv_job(F, it, A.in[I_APROJ] + (size_t)g * 65536, 256, 256, 256, nullptr, (bf16_t*)(F.ws + WS_APT) + (size_t)g * 65536, 0, 0, scr);
}
__device__ __forceinline__ void conv_small(const Frame& F, const Args& A) {
    LAS float* scr = (LAS float*)(F.lds + RING_OFF + F.wave * 16384);
    int it = F.bid * NWAVES + F.wave;
    unsigned char* ws = F.ws;
    conv_job(F, it, A.in[I_DWG], D, FF0, FF0, A.in[I_FFNORM], (bf16_t*)(ws + WS_WGU0), 1, 0, scr);
    conv_job(F, it, A.in[I_DWU], D, FF0, FF0, A.in[I_FFNORM], (bf16_t*)(ws + WS_WGU0), 2, 0, scr);
}
__device__ __forceinline__ void conv_later(const Frame& F, const Args& A, int cb, int cg) {
    LAS float* scr = (LAS float*)(F.lds + RING_OFF + F.wave * 16384);
    int it = cb * NWAVES + F.wave;
    unsigned char* ws = F.ws;
    conv_job(F, it, A.in[I_DWD], FF0, D, D, nullptr, (bf16_t*)(ws + WS_WD0), 0, 0, scr, cg);
    conv_job(F, it, A.in[I_WQ], D, 3072, 3072, A.in[I_BNORM], (bf16_t*)(ws + WS_WQKV), 0, 0, scr, cg);
    conv_job(F, it, A.in[I_WKV], D, 6144, 6144, A.in[I_KVNORM], (bf16_t*)(ws + WS_WQKV), 0, 3072, scr, cg);
    conv_job(F, it, A.in[I_WO], D, D, D, nullptr, (bf16_t*)(ws + WS_WO), 0, 0, scr, cg);
}
#ifndef MK_CW
#define MK_CW 256
#endif
__device__ __forceinline__ void conv_moe(const Frame& F, const Args& A, int rep_ = 0) {
    constexpr int CW = MK_CW, NC = CW / 64, NSPL = 256 / CW, IPJ = 112 * NSPL, TOT = 24 * IPJ, TS = 144; const int lane = F.lane, w = F.wave; int par = 0;
#pragma unroll 1
#ifdef MK_CONV_BLOCKED
    for (int it = (F.bid * TOT) / F.G, ite = ((F.bid + 1) * TOT) / F.G; it < ite; ++it, par ^= 1) {
#else
    for (int it = F.bid; it < TOT; it += F.G, par ^= 1) {
#endif
        const int j = it / IPJ, r = it - j * IPJ, e = j / 3, kind = j - 3 * e;
        LAS unsigned char* tl = F.lds + RING_OFF + par * (CW * TS);
        float wv[16 * NC]; int kb, n0;
        if (kind < 2) { kb = r / (14 * NSPL); n0 = (r - kb * (14 * NSPL)) * CW; const int k0 = kb * 128 + 16 * w;
            const float* src = A.in[kind ? I_MWU : I_MWG] + (size_t)e * D * FF1 + (size_t)k0 * FF1 + n0 + lane;
            const float* g = A.in[I_FFNORM] + D + k0;
#pragma unroll
            for (int i = 0; i < 16; ++i)
#pragma unroll
                for (int c = 0; c < NC; ++c) wv[i * NC + c] = src[(size_t)i * FF1 + c * 64];
#pragma unroll
            for (int i = 0; i < 16; ++i) { const float gs = g[i] * WGU_PRESC;
#pragma unroll
                for (int c = 0; c < NC; ++c) wv[i * NC + c] *= gs; }
        } else { kb = r / (4 * NSPL); n0 = (r - kb * (4 * NSPL)) * CW; const int k0 = kb * 128 + 16 * w;
            const float* src = A.in[I_MWD] + (size_t)e * FF1 * D + (size_t)k0 * D + n0 + lane;
#pragma unroll
            for (int i = 0; i < 16; ++i)
#pragma unroll
                for (int c = 0; c < NC; ++c) wv[i * NC + c] = src[(size_t)i * D + c * 64];
#pragma unroll
            for (int i = 0; i < 16 * NC; ++i) wv[i] *= WD_PRESC;
        }
#pragma unroll
        for (int c = 0; c < NC; ++c) { u32x4 o;
            o.x = pk4_fp8(wv[0 * NC + c], wv[1 * NC + c], wv[2 * NC + c], wv[3 * NC + c]); o.y = pk4_fp8(wv[4 * NC + c], wv[5 * NC + c], wv[6 * NC + c], wv[7 * NC + c]);
            o.z = pk4_fp8(wv[8 * NC + c], wv[9 * NC + c], wv[10 * NC + c], wv[11 * NC + c]); o.w = pk4_fp8(wv[12 * NC + c], wv[13 * NC + c], wv[14 * NC + c], wv[15 * NC + c]);
            *(LAS u32x4*)(tl + (c * 64 + lane) * TS + 16 * w) = o; }
        LDS_WAIT(); __syncthreads();
#pragma unroll
        for (int q = 0; q < NC; ++q) { const int row = (8 * NC) * w + 8 * q + (lane >> 3), n = n0 + row;
            const u32x4 o = *(const LAS u32x4*)(tl + row * TS + 16 * (lane & 7));
            unsigned char* dst = (kind < 2) ? F.ws + WS_WGU1 + (size_t)e * 2 * FF1 * D + (size_t)((n >> 7) * 256 + (n & 127) + kind * 128) * D + kb * 128 + 16 * (lane & 7)
                                            : F.ws + WS_WD1 + (size_t)e * D * FF1 + (size_t)n * FF1 + kb * 128 + 16 * (lane & 7);
#ifdef MK_CONV_NOSTORE
            if (rep_ == 0 || (o.x == 0x12345678u && o.y == 0x9abcdef0u))
#endif
            *(u32x4*)dst = o; }
    }
    LDS_WAIT(); __syncthreads();
}

#ifdef MK_READ_LINEAR
__device__ __forceinline__ void conv_read_linear(const Frame& F, const Args& A) {
    const int NGW = F.G * NWAVES; float acc = 0.f;
    for (int arr = 0; arr < 3; ++arr) {
        const float* W = A.in[arr == 0 ? I_MWG : (arr == 1 ? I_MWU : I_MWD)];
        constexpr int CH = (MK_READ_LINEAR == 1 ? 32 : 16) * 64 * MK_READ_LINEAR;
        const int nch = (int)((size_t)NE * D * FF1 / CH);
        for (int c = F.bid * NWAVES + F.wave; c < nch; c += NGW) {
            const float* p = W + (size_t)c * CH + F.lane * MK_READ_LINEAR;
#if MK_READ_LINEAR == 1
            float v[32];
#pragma unroll
            for (int i = 0; i < 32; ++i) v[i] = p[i * 64];
#pragma unroll
            for (int i = 0; i < 32; ++i) acc += v[i];
#else
            f32x4 v[16];
#pragma unroll
            for (int i = 0; i < 16; ++i) v[i] = *(const f32x4*)(p + i * 256);
#pragma unroll
            for (int i = 0; i < 16; ++i) acc += v[i][0] + v[i][1] + v[i][2] + v[i][3];
#endif
        }
    }
    if (acc == 1.2345678f) F.ws[WS_ZERO + 1024] = 1;
}
#endif
__device__ __forceinline__ void mixer_phase(const Frame& F, const Args& A) {
    LAS float* rs = (LAS float*)(F.lds + 0);
    LAS float* xn = (LAS float*)(F.lds + 512);
    LAS bf16_t* pl = (LAS bf16_t*)(F.lds + 512 + 80896);
    LAS float* sw = (LAS float*)(F.lds + 512 + 80896 + 33792);
    int tid_ = F.tid; asm volatile("" : "+v"(tid_));
    const int tid = tid_, lane = tid & 63, w = F.wave, fr = lane & 15, fq = lane >> 4;
    const bf16_t* apt = (const bf16_t*)(F.ws + WS_APT);
    bf16_t* hb = (bf16_t*)(F.ws + WS_S1); float* rstd1 = (float*)(F.ws + WS_RSTD1);
    for (int tile = F.bid; tile < T / 64; tile += F.G) {
        const int t0 = tile * 64, s0 = t0 % SEQ, halo = s0 ? 15 : 0, nrows = 64 + halo;
#pragma unroll 1
        for (int jb = w; jb < nrows; jb += 5 * NWAVES) {
            f32x4 rv[5][4];
#pragma unroll
            for (int u = 0; u < 5; ++u) { const int jj = jb + u * NWAVES, jc = jj < nrows ? jj : nrows - 1; const f32x4* p = (const f32x4*)(A.in[I_X] + (size_t)(t0 - halo + jc) * D);
#pragma unroll
                for (int q = 0; q < 4; ++q) rv[u][q] = p[lane + 64 * q]; }
#pragma unroll
            for (int u = 0; u < 5; ++u) { float s = 0.f;
#pragma unroll
                for (int q = 0; q < 4; ++q) { const f32x4 v = rv[u][q]; s += (v[0] * v[0] + v[1] * v[1]) + (v[2] * v[2] + v[3] * v[3]); }
                s = wave_sum(s);
                const int jj = jb + u * NWAVES;
                if (lane == 0 && jj < nrows) rs[jj] = 1.0f / sqrtf(s * (1.f / D) + EPS); }
        }
        LDS_WAIT(); __syncthreads();
        float ss[4] = {0.f, 0.f, 0.f, 0.f};
        for (int g = 0; g < 4; ++g) {
            { const f32x4 gn = *(const f32x4*)(A.in[I_ANORM] + g * 256 + 4 * lane);
              f32x4 xv[10];
#pragma unroll
              for (int u = 0; u < 10; ++u) { const int jj = w + u * NWAVES, jc = jj < nrows ? jj : nrows - 1; xv[u] = *(const f32x4*)(A.in[I_X] + (size_t)(t0 - halo + jc) * D + g * 256 + 4 * lane); }
#pragma unroll
              for (int u = 0; u < 10; ++u) { const int jj = w + u * NWAVES; if (jj < nrows) { const float r = rs[jj]; const f32x4 v = xv[u];
                  *(LAS f32x4*)(xn + jj * 256 + 4 * lane) = (f32x4){v[0] * r * gn[0], v[1] * r * gn[1], v[2] * r * gn[2], v[3] * r * gn[3]}; } } }
            LDS_WAIT(); __syncthreads();
            { const int c4 = (tid & 63) * 4, win = 2 << g;
#pragma unroll 1
              for (int i = 0; i < 8; ++i) { const int r = (tid >> 6) + 8 * i, s = s0 + r, cnt = (s + 1 < win) ? (s + 1) : win;
                  f32x4 a = {0.f, 0.f, 0.f, 0.f};
                  for (int jj = 0; jj < cnt; ++jj) a += *(const LAS f32x4*)(xn + (halo + r - jj) * 256 + c4);
                  const f32x4 self = *(const LAS f32x4*)(xn + (halo + r) * 256 + c4); const float inv = 1.f / (float)cnt;
                  u32x2 o; o.x = pk2(a[0] * inv - self[0], a[1] * inv - self[1]); o.y = pk2(a[2] * inv - self[2], a[3] * inv - self[3]);
                  *(LAS u32x2*)(pl + r * 264 + c4) = o; } }
            LDS_WAIT(); __syncthreads();
            f32x4 acc[4][2];
#pragma unroll
            for (int m = 0; m < 4; ++m) { acc[m][0] = (f32x4){0.f, 0.f, 0.f, 0.f}; acc[m][1] = (f32x4){0.f, 0.f, 0.f, 0.f}; }
#pragma unroll
            for (int ks = 0; ks < 8; ++ks) {
                bf16x8 bfr[2], afr[4];
#pragma unroll
                for (int n = 0; n < 2; ++n) bfr[n] = *(const bf16x8*)(apt + (size_t)g * 65536 + (size_t)(32 * w + 16 * n + fr) * 256 + 32 * ks + 8 * fq);
#pragma unroll
                for (int m = 0; m < 4; ++m) afr[m] = *(const LAS bf16x8*)(pl + (16 * m + fr) * 264 + 32 * ks + 8 * fq);
#pragma unroll
                for (int m = 0; m < 4; ++m)
#pragma unroll
                    for (int n = 0; n < 2; ++n) acc[m][n] = __builtin_amdgcn_mfma_f32_16x16x32_bf16(bfr[n], afr[m], acc[m][n], 0, 0, 0);
            }
#pragma unroll
            for (int m = 0; m < 4; ++m)
#pragma unroll
                for (int n = 0; n < 2; ++n) { const int col = g * 256 + 32 * w + 16 * n + 4 * fq; const size_t off = (size_t)(t0 + 16 * m + fr) * D + col;
                    const f32x4 sc = *(const f32x4*)(A.in[I_ASCALE] + col); const f32x4 hv = *(const f32x4*)(A.in[I_X] + off) + acc[m][n] * sc;
                    u32x2 ov; ov.x = cvt_pk_bf16(hv[0], hv[1]); ov.y = cvt_pk_bf16(hv[2], hv[3]); *(u32x2*)(hb + off) = ov;
                    const float a0 = __uint_as_float(ov.x << 16), a1 = __uint_as_float(ov.x & 0xffff0000u), a2 = __uint_as_float(ov.y << 16), a3 = __uint_as_float(ov.y & 0xffff0000u);
                    ss[m] += (a0 * a0 + a1 * a1) + (a2 * a2 + a3 * a3); }
        }
#pragma unroll
        for (int m = 0; m < 4; ++m) { float s = ss[m]; s += __shfl_xor(s, 16); s += __shfl_xor(s, 32); if (fq == 0) sw[(16 * m + fr) * 8 + w] = s; }
        LDS_WAIT(); __syncthreads();
        if (tid < 64) { float s = 0.f;
#pragma unroll
            for (int q = 0; q < 8; ++q) s += sw[tid * 8 + q];
            rstd1[t0 + tid] = 1.0f / sqrtf(s * (1.f / D) + EPS); }
        LDS_WAIT(); __syncthreads();
    }
}

__device__ __forceinline__ void router_phase(const Frame& F, const Args& A) {
    volatile LAS int* li = (volatile LAS int*)(F.lds + 0);
    volatile LAS float* lf = (volatile LAS float*)(F.lds + 2048);
    int* ltok = (int*)(F.ws + WS_LTOK); float* lrs = (float*)(F.ws + WS_LRS); u32x4* tinfo = (u32x4*)(F.ws + WS_TOKINFO);
    int tid_ = F.tid; asm volatile("" : "+v"(tid_));
    const int tid = tid_, lane = tid & 63, w = F.wave;
    const float* gain = A.in[I_FFNORM] + D;
    f32x4 wa[4][4], wb[4][4];
#pragma unroll
    for (int q = 0; q < 4; ++q) { const int c0 = 4 * (lane + 64 * q); const f32x4 gn = *(const f32x4*)(gain + c0);
#pragma unroll
        for (int j = 0; j < 4; ++j) { wa[q][j] = *(const f32x4*)(A.in[I_ROUTER] + (size_t)(c0 + j) * 8) * gn[j]; wb[q][j] = *(const f32x4*)(A.in[I_ROUTER] + (size_t)(c0 + j) * 8 + 4) * gn[j]; } }
    if (F.bid == 0 && tid < 128) ((u32x4*)(F.ws + WS_ZERO))[tid] = (u32x4){0u, 0u, 0u, 0u};
    for (int tile = F.bid; tile < T / 64; tile += F.G) {
        const int t0 = tile * 64;
        if (tid < 8) li[tid] = 0;
        LDS_WAIT(); __syncthreads();
        f32x4 v[4]; u32x2 vn[4];
        const bf16_t* hb = (const bf16_t*)(F.ws + WS_S1);
        { const u32x2* p = (const u32x2*)(hb + (size_t)(t0 + 8 * w) * D);
#pragma unroll
          for (int q = 0; q < 4; ++q) vn[q] = p[lane + 64 * q]; }
#pragma unroll 1
        for (int k = 0; k < 8; ++k) {
            const int tl = 8 * w + k;
#pragma unroll
            for (int q = 0; q < 4; ++q) v[q] = (f32x4){__uint_as_float(vn[q].x << 16), __uint_as_float(vn[q].x & 0xffff0000u), __uint_as_float(vn[q].y << 16), __uint_as_float(vn[q].y & 0xffff0000u)};
            if (k < 7) { const u32x2* p = (const u32x2*)(hb + (size_t)(t0 + tl + 1) * D);
#pragma unroll
                for (int q = 0; q < 4; ++q) vn[q] = p[lane + 64 * q]; }
            float s = 0.f; f32x4 la = {0.f, 0.f, 0.f, 0.f}, lb = {0.f, 0.f, 0.f, 0.f};
#pragma unroll
            for (int q = 0; q < 4; ++q) { s += (v[q][0] * v[q][0] + v[q][1] * v[q][1]) + (v[q][2] * v[q][2] + v[q][3] * v[q][3]);
#pragma unroll
                for (int j = 0; j < 4; ++j) { la += wa[q][j] * v[q][j]; lb += wb[q][j] * v[q][j]; } }
            float red[9] = {s, la[0], la[1], la[2], la[3], lb[0], lb[1], lb[2], lb[3]};
#pragma unroll
            for (int o = 1; o < 64; o <<= 1) {
#pragma unroll
                for (int e = 0; e < 9; ++e) red[e] += __shfl_xor(red[e], o); }
            if (lane == 0) {
                const float r = 1.0f / sqrtf(red[0] * (1.f / D) + EPS);
                float lg[8];
#pragma unroll
                for (int e = 0; e < 8; ++e) lg[e] = red[1 + e] * r;
                float b1 = lg[0]; int i1 = 0;
#pragma unroll
                for (int e = 1; e < 8; ++e) if (lg[e] > b1) { b1 = lg[e]; i1 = e; }
                float b2 = -3.0e38f; int i2 = 0;
#pragma unroll
                for (int e = 0; e < 8; ++e) if (e != i1 && lg[e] > b2) { b2 = lg[e]; i2 = e; }
                const float e2 = expf(b2 - b1), g1 = 1.f / (1.f + e2), g2 = e2 / (1.f + e2);
                const int r1 = __hip_atomic_fetch_add((LAS int*)&li[i1], 1, __ATOMIC_RELAXED, __HIP_MEMORY_SCOPE_WORKGROUP), r2 = __hip_atomic_fetch_add((LAS int*)&li[i2], 1, __ATOMIC_RELAXED, __HIP_MEMORY_SCOPE_WORKGROUP);
                li[16 + tl * 4 + 0] = i1; li[16 + tl * 4 + 1] = i2; li[16 + tl * 4 + 2] = r1; li[16 + tl * 4 + 3] = r2;
                lf[tl * 4 + 0] = g1; lf[tl * 4 + 1] = g2; lf[tl * 4 + 2] = r;
            }
        }
        LDS_WAIT(); __syncthreads();
        if (tid < 8) li[8 + tid] = (int)atomicAdd(F.ctl + CW_CNT + tid, (unsigned)li[tid]);
        LDS_WAIT(); __syncthreads();
        if (tid < 64) {
            const int i1 = li[16 + tid * 4 + 0], i2 = li[16 + tid * 4 + 1], s1 = li[8 + i1] + li[16 + tid * 4 + 2], s2 = li[8 + i2] + li[16 + tid * 4 + 3];
            const float g1 = lf[tid * 4 + 0], g2 = lf[tid * 4 + 1], r = lf[tid * 4 + 2];
            ltok[(size_t)i1 * T + s1] = t0 + tid; lrs[(size_t)i1 * T + s1] = r;
            ltok[(size_t)i2 * T + s2] = t0 + tid; lrs[(size_t)i2 * T + s2] = r;
            u32x4 ti; ti.x = (unsigned)(s1 << 3 | i1); ti.y = (unsigned)(s2 << 3 | i2); ti.z = __builtin_bit_cast(unsigned, g1); ti.w = __builtin_bit_cast(unsigned, g2);
            tinfo[t0 + tid] = ti;
        }
        LDS_WAIT(); __syncthreads();
    }
}

__device__ __forceinline__ void final_phase(const Frame& F, const Args& A) {
    volatile LAS int* mi = (volatile LAS int*)(F.lds + SCR_OFF);
    const u32x4* tinfo = (const u32x4*)(F.ws + WS_TOKINFO); const bf16_t* Y = (const bf16_t*)(F.ws + WS_Y);
    int lane_ = F.lane; asm volatile("" : "+v"(lane_));
    const int lane = lane_;
    f32x4 gn[4];
#pragma unroll
    for (int q = 0; q < 4; ++q) gn[q] = *(const f32x4*)(A.in[I_FNORM] + 4 * (lane + 64 * q));
    const int stride = F.G * NWAVES; int t = F.bid * NWAVES + F.wave;
    const bf16_t* Y2 = (const bf16_t*)(F.ws + WS_Y2); const bf16_t* ZR = (const bf16_t*)(F.ws + WS_ZERO);
    u32x2 hv[4], hn[4]; u32x2 ya[4], yb[4], yan[4], ybn[4], za[4], zb[4], zan[4], zbn[4]; float g1n = 0.f, g2n = 0.f;
#define FIN_ISSUE(tt, HV, YA, YB, ZA, ZB, G1, G2) do { const u32x4 ti = tinfo[tt]; const unsigned tx = ti.x, ty = ti.y, gz = ti.z, gw = ti.w; \
        const int e1 = tx & 7, s1 = tx >> 3, e2 = ty & 7, s2 = ty >> 3; G1 = __uint_as_float(gz); G2 = __uint_as_float(gw); \
        const size_t r1 = (size_t)mi[MI_TB + e1] * 256 + s1, r2 = (size_t)mi[MI_TB + e2] * 256 + s2; \
        const size_t sp0 = (size_t)mi[MI_SPLIT0]; const u32x2* z1_ = r1 >= sp0 ? (const u32x2*)(Y2 + (r1 - sp0) * D) : (const u32x2*)ZR; const u32x2* z2_ = r2 >= sp0 ? (const u32x2*)(Y2 + (r2 - sp0) * D) : (const u32x2*)ZR; \
        const u32x2* p_ = (const u32x2*)((const bf16_t*)(F.ws + WS_S1) + (size_t)(tt) * D); const u32x2* y1_ = (const u32x2*)(Y + r1 * D); const u32x2* y2_ = (const u32x2*)(Y + r2 * D); \
        _Pragma("unroll") for (int q = 0; q < 4; ++q) { HV[q] = p_[lane + 64 * q]; YA[q] = y1_[lane + 64 * q]; YB[q] = y2_[lane + 64 * q]; } \
        if (r1 >= sp0) { _Pragma("unroll") for (int q = 0; q < 4; ++q) ZA[q] = z1_[lane + 64 * q]; } else { _Pragma("unroll") for (int q = 0; q < 4; ++q) ZA[q] = (u32x2){0u, 0u}; } \
        if (r2 >= sp0) { _Pragma("unroll") for (int q = 0; q < 4; ++q) ZB[q] = z2_[lane + 64 * q]; } else { _Pragma("unroll") for (int q = 0; q < 4; ++q) ZB[q] = (u32x2){0u, 0u}; } } while (0)
    if (t < T) FIN_ISSUE(t, hn, yan, ybn, zan, zbn, g1n, g2n);
    for (; t < T; t += stride) {
        const float g1 = g1n, g2 = g2n;
#pragma unroll
        for (int q = 0; q < 4; ++q) { hv[q] = hn[q]; ya[q] = yan[q]; yb[q] = ybn[q]; za[q] = zan[q]; zb[q] = zbn[q]; }
        if (t + stride < T) FIN_ISSUE(t + stride, hn, yan, ybn, zan, zbn, g1n, g2n);
        f32x4 v[4]; float s = 0.f;
#pragma unroll
        for (int q = 0; q < 4; ++q) { const u32x2 a = ya[q], b = yb[q], a2 = za[q], b2 = zb[q];
            f32x4 o;
            o[0] = __uint_as_float(hv[q].x << 16) + g1 * (bf2f((unsigned short)(a.x & 0xffff)) + bf2f((unsigned short)(a2.x & 0xffff))) + g2 * (bf2f((unsigned short)(b.x & 0xffff)) + bf2f((unsigned short)(b2.x & 0xffff)));
            o[1] = __uint_as_float(hv[q].x & 0xffff0000u) + g1 * (bf2f((unsigned short)(a.x >> 16)) + bf2f((unsigned short)(a2.x >> 16))) + g2 * (bf2f((unsigned short)(b.x >> 16)) + bf2f((unsigned short)(b2.x >> 16)));
            o[2] = __uint_as_float(hv[q].y << 16) + g1 * (bf2f((unsigned short)(a.y & 0xffff)) + bf2f((unsigned short)(a2.y & 0xffff))) + g2 * (bf2f((unsigned short)(b.y & 0xffff)) + bf2f((unsigned short)(b2.y & 0xffff)));
            o[3] = __uint_as_float(hv[q].y & 0xffff0000u) + g1 * (bf2f((unsigned short)(a.y >> 16)) + bf2f((unsigned short)(a2.y >> 16))) + g2 * (bf2f((unsigned short)(b.y >> 16)) + bf2f((unsigned short)(b2.y >> 16)));
            v[q] = o; s += (o[0] * o[0] + o[1] * o[1]) + (o[2] * o[2] + o[3] * o[3]); }
        s = wave_sum(s);
        const float r = 1.0f / sqrtf(s * (1.f / D) + EPS);
        f32x4* p = (f32x4*)(F.h + (size_t)t * D);
#pragma unroll
        for (int q = 0; q < 4; ++q) p[lane + 64 * q] = (f32x4){v[q][0] * r * gn[q][0], v[q][1] * r * gn[q][1], v[q][2] * r * gn[q][2], v[q][3] * r * gn[q][3]};
    }
#undef FIN_ISSUE
}

__device__ __forceinline__ int t5_bucket(int n) {
    if (n < 16) return n;
    int large = 16 + (int)(log((double)n / 16.0) / log(128.0) * 16.0);
    return large < 31 ? large : 31;
}
typedef float f32x16 __attribute__((ext_vector_type(16)));
typedef short s16x4 __attribute__((ext_vector_type(4)));
constexpr int AT_TAB = 0;
constexpr int AT_BKT = 7680;
constexpr int AT_CNT = 9472;
constexpr int AT_V = 10240;
constexpr float L2E = 1.4426950408889634f;
constexpr size_t WS_AST_O = WS_POOL + 291 * MiB;
constexpr size_t WS_AST_M = WS_AST_O + 64 * MiB;
static_assert(WS_AST_M + 4 * MiB <= WS_END, "attention scratch");
constexpr unsigned PITCHB = QKV_LD * 2;
__device__ __forceinline__ s16x4 vtr(const LAS unsigned char* p) { return __builtin_bit_cast(s16x4, __builtin_amdgcn_ds_read_tr16_b64_v4i16((LAS s16x4*)p)); }
__device__ __forceinline__ float max3f(float a, float b, float c) { return fmaxf(fmaxf(a, b), c); }

#define AT_LOADS(KF, VR, ub, koff, voff) do { const unsigned ub_ = (ub); \
        _Pragma("unroll") for (int d0 = 0; d0 < 4; ++d0) KF[d0] = __builtin_bit_cast(bf16x8, __builtin_amdgcn_raw_buffer_load_b128(rsrc, (koff) + 32 * d0, ub_, 0)); \
        _Pragma("unroll") for (int i = 0; i < 4; ++i) VR[i] = __builtin_bit_cast(u32x4, __builtin_amdgcn_raw_buffer_load_b128(rsrc, (voff)[i], ub_, 0)); } while (0)
#define AT_SCORE(KF, VR, QF, tla) \
        _Pragma("unroll") for (int i = 0; i < 4; ++i) *(LAS u32x4*)(vwr + i * 512) = VR[i]; \
        { const LAS float* tl_ = (const LAS float*)(tla); _Pragma("unroll") for (int r = 0; r < 16; ++r) s[r] = tl_[(r & 3) + 8 * (r >> 2)]; } \
        _Pragma("unroll") for (int d0 = 0; d0 < 4; ++d0) s = __builtin_amdgcn_mfma_f32_32x32x16_bf16(KF[d0], QF[d0], s, 0, 0, 0);
#define AT_SOFTPV() do { \
        float rm = fmaxf(max3f(max3f(s[0], s[1], s[2]), max3f(s[3], s[4], s[5]), max3f(s[6], s[7], s[8])), max3f(max3f(s[9], s[10], s[11]), max3f(s[12], s[13], s[14]), s[15])); \
        { auto rr = __builtin_amdgcn_permlane32_swap(__float_as_uint(rm), __float_as_uint(rm), false, false); rm = fmaxf(__uint_as_float(rr[0]), __uint_as_float(rr[1])); } \
        if (__any(rm > M)) { const float Mn = fmaxf(M, rm), al = __builtin_amdgcn_exp2f(M - Mn); M = Mn; l *= al; \
            _Pragma("unroll") for (int r = 0; r < 16; ++r) { o0[r] *= al; o1[r] *= al; } } \
        float ps0 = 0.f, ps1 = 0.f; \
        _Pragma("unroll") for (int r = 0; r < 16; r += 2) { s[r] = __builtin_amdgcn_exp2f(s[r] - M); s[r + 1] = __builtin_amdgcn_exp2f(s[r + 1] - M); ps0 += s[r]; ps1 += s[r + 1]; } \
        l += ps0 + ps1; \
        u32x4 pw0, pw1; \
        pw0.x = cvt_pk_bf16(s[0], s[1]); pw0.y = cvt_pk_bf16(s[2], s[3]); pw0.z = cvt_pk_bf16(s[4], s[5]); pw0.w = cvt_pk_bf16(s[6], s[7]); \
        pw1.x = cvt_pk_bf16(s[8], s[9]); pw1.y = cvt_pk_bf16(s[10], s[11]); pw1.z = cvt_pk_bf16(s[12], s[13]); pw1.w = cvt_pk_bf16(s[14], s[15]); \
        const bf16x8 pa0 = __builtin_bit_cast(bf16x8, pw0), pa1 = __builtin_bit_cast(bf16x8, pw1); \
        LDS_WAIT(); \
        { const s16x4 a0 = vtr(vrd), a1 = vtr(vrd + 512), b0 = vtr(vrd + 1024), b1 = vtr(vrd + 1536); \
          const bf16x8 v0 = (bf16x8){a0[0], a0[1], a0[2], a0[3], a1[0], a1[1], a1[2], a1[3]}, v1 = (bf16x8){b0[0], b0[1], b0[2], b0[3], b1[0], b1[1], b1[2], b1[3]}; \
          o0 = __builtin_amdgcn_mfma_f32_32x32x16_bf16(v0, pa0, o0, 0, 0, 0); o0 = __builtin_amdgcn_mfma_f32_32x32x16_bf16(v1, pa1, o0, 0, 0, 0); } \
        { const s16x4 a0 = vtr(vrd + 2048), a1 = vtr(vrd + 2560), b0 = vtr(vrd + 3072), b1 = vtr(vrd + 3584); \
          const bf16x8 v0 = (bf16x8){a0[0], a0[1], a0[2], a0[3], a1[0], a1[1], a1[2], a1[3]}, v1 = (bf16x8){b0[0], b0[1], b0[2], b0[3], b1[0], b1[1], b1[2], b1[3]}; \
          o1 = __builtin_amdgcn_mfma_f32_32x32x16_bf16(v0, pa0, o1, 0, 0, 0); o1 = __builtin_amdgcn_mfma_f32_32x32x16_bf16(v1, pa1, o1, 0, 0, 0); } \
    } while (0)

#ifdef MK_ATT_TS
#define AT_TS(k) do { __builtin_amdgcn_sched_barrier(0); unsigned long long t_; asm volatile("s_memtime %0\n\ts_waitcnt lgkmcnt(0)" : "=s"(t_) :: "memory"); ts_acc[k] += t_ - ts_prev; ts_prev = t_; __builtin_amdgcn_sched_barrier(0); } while (0)
#else
#define AT_TS(k) do { } while (0)
#endif
template <int MODE>
__device__ __forceinline__ void attn_phase(const Frame& F, const Args& A, unsigned long long* ts_out = nullptr) {
#ifdef MK_ATT_TS
    unsigned long long ts_acc[6] = {0, 0, 0, 0, 0, 0}, ts_prev = 0;
    { unsigned long long t_; asm volatile("s_memtime %0\n\ts_waitcnt lgkmcnt(0)" : "=s"(t_) :: "memory"); ts_prev = t_; }
#endif
    LAS float* tab = (LAS float*)(F.lds + AT_TAB);
    const char* qkvb = (const char*)(F.ws + WS_QKV); bf16_t* mo = (bf16_t*)(F.ws + (MODE == 0 ? WS_S0 : WS_S1));
    float* sto = (float*)(F.ws + WS_AST_O); float* stm = (float*)(F.ws + WS_AST_M);
    int lane_ = F.lane; asm volatile("" : "+v"(lane_));
    const int lane = lane_, w = F.wave, j = lane & 31, hi = lane >> 5;
    LAS unsigned char* vbuf = F.lds + AT_V + w * 4096;
    LAS unsigned char* vwr = vbuf + ((lane & 7) >> 2) * 2048 + (lane >> 3) * 64 + (lane & 3) * 16;
    const LAS unsigned char* vrd = vbuf + (4 * hi + ((lane & 15) >> 2)) * 64 + ((lane >> 4) & 1) * 32 + (lane & 3) * 8;
    volatile LAS int* bkt = (volatile LAS int*)(F.lds + AT_BKT);
    volatile LAS int* acnt = (volatile LAS int*)(F.lds + AT_CNT);
    for (int i = F.tid; i < 3 * 129; i += NTHREADS) { const int g = i / 129, m = i - g * 129; bkt[i] = t5_bucket(m * (g == 0 ? 1 : (g == 1 ? 4 : 16))); }
    LDS_WAIT(); __syncthreads();
    const __amdgpu_buffer_rsrc_t rsrc = __builtin_amdgcn_make_buffer_rsrc((void*)(F.ws + WS_QKV), 0, (int)((size_t)T * PITCHB), 0x00020000);
    for (int it = 0; ; ++it) {
        int b, h, cp;
        { const int u = ((F.G & 7) == 0) ? ((F.bid & 7) * (F.G >> 3) + (F.bid >> 3)) + it * F.G : F.bid + it * F.G;
          if (u >= 256) break;
          b = u >> 5; h = (u >> 1) & 15; cp = u & 1; }
        const int tb = b * SEQ;
        __syncthreads();
        if (F.tid < 4) acnt[F.tid] = 0;
        for (int i = F.tid; i < 3 * 640; i += NTHREADS) { const int g = i / 640, m = 383 - (i - g * 640);
            tab[i] = (m >= 0 && m <= 128) ? A.in[I_RELB][bkt[g * 129 + m] * 48 + g * 16 + h] * L2E : -1e30f; }
        LDS_WAIT(); __syncthreads();
        AT_TS(5);
        const int c = 2 * cp + (w & 1);
        f32x16 o0, o1, s; float M, l;
        bf16x8 kfA[4], kfB[4]; u32x4 vrA[4], vrB[4];
#pragma unroll 1
        for (int rd = 0; rd < 4; ++rd) {
            const int r16 = c + 4 * (w >> 1), nt = rd + 1;
            const size_t tq = (size_t)(tb + 16 * (32 * rd + j) + r16);
            bf16x8 qf[4];
            { const char* qp = qkvb + tq * PITCHB + (2 * 1024 + h * 64 + 8 * hi) * 2;
#pragma unroll
              for (int d0 = 0; d0 < 4; ++d0) qf[d0] = *(const bf16x8*)(qp + 32 * d0); }
            const unsigned koff = (unsigned)(16 * j) * PITCHB + (3072 + 2 * 1024 + h * 64 + 8 * hi) * 2;
            unsigned voff[4];
#pragma unroll
            for (int i = 0; i < 4; ++i) voff[i] = (unsigned)(16 * (8 * i + (lane >> 3))) * PITCHB + (6144 + 2 * 1024 + h * 64 + 8 * (lane & 7)) * 2;
            const unsigned ub = (unsigned)(tb + r16) * PITCHB, ustep = (unsigned)(16 * 32) * PITCHB;
            const LAS float* tla = tab + 2 * 640 + 383 - (32 * rd + j) + 4 * hi;
#pragma unroll
            for (int r = 0; r < 16; ++r) { o0[r] = 0.f; o1[r] = 0.f; }
            M = -1e29f; l = 0.f;
#define AT_LOADA(m, KF, VR) do { int m_ = (m); m_ = m_ < nt ? m_ : nt - 1; if (MODE == 1) m_ = 0; AT_LOADS(KF, VR, ub + (unsigned)m_ * ustep, koff, voff); } while (0)
            AT_LOADA(0, kfA, vrA); AT_LOADA(1, kfB, vrB);
            AT_TS(0);
            int n = 0;
#pragma unroll 1
            for (; n + 1 < nt; n += 2) {
                AT_SCORE(kfA, vrA, qf, tla + 32 * n)
                AT_LOADA(n + 2, kfA, vrA);
                AT_SOFTPV();
                AT_SCORE(kfB, vrB, qf, tla + 32 * (n + 1))
                AT_LOADA(n + 3, kfB, vrB);
                AT_SOFTPV();
            }
            if (n < nt) { AT_SCORE(kfA, vrA, qf, tla + 32 * n) AT_SOFTPV(); }
            AT_TS(1);
#undef AT_LOADA
            float* so = sto + ((tq * 16 + h) * 2 + hi) * 32;
#pragma unroll
            for (int r = 0; r < 16; r += 4) { *(f32x4*)(so + r) = (f32x4){o0[r], o0[r + 1], o0[r + 2], o0[r + 3]}; *(f32x4*)(so + 16 + r) = (f32x4){o1[r], o1[r + 1], o1[r + 2], o1[r + 3]}; }
            *(f32x2*)(stm + ((tq * 16 + h) * 2 + hi) * 2) = (f32x2){M, l};
            VM_WAIT();
            if (lane == 0) __hip_atomic_fetch_add((LAS int*)&acnt[rd], 1, __ATOMIC_RELAXED, __HIP_MEMORY_SCOPE_WORKGROUP);
            AT_TS(2);
        }
        AT_TS(3);
#pragma unroll 1
        for (int rd = 0; rd < 4; ++rd) {
            const int i0 = 32 * (4 * rd + (w >> 1));
            const int ktlo0 = (4 - i0 / 8) > 0 ? (4 - i0 / 8) : 0, n0 = 8 - ktlo0;
            const int ktlo1 = (4 - i0 / 32) > 0 ? (4 - i0 / 32) : 0, n1 = 5 - ktlo1, ntl = n0 + n1;
            const size_t tq = (size_t)(tb + 4 * (i0 + j) + c);
            bf16x8 qf0[4], qf1[4];
            { const char* qp = qkvb + tq * PITCHB + (h * 64 + 8 * hi) * 2;
#pragma unroll
              for (int d0 = 0; d0 < 4; ++d0) { qf0[d0] = *(const bf16x8*)(qp + 32 * d0); qf1[d0] = *(const bf16x8*)(qp + 2048 + 32 * d0); } }
            while (__builtin_amdgcn_readfirstlane(acnt[rd]) < NWAVES) __builtin_amdgcn_s_sleep(2);
            asm volatile("" ::: "memory");
            { const float* so = sto + ((tq * 16 + h) * 2 + hi) * 32;
#pragma unroll
              for (int r = 0; r < 16; r += 4) { const f32x4 a = *(const f32x4*)(so + r), bq = *(const f32x4*)(so + 16 + r);
                  o0[r] = a[0]; o0[r + 1] = a[1]; o0[r + 2] = a[2]; o0[r + 3] = a[3]; o1[r] = bq[0]; o1[r + 1] = bq[1]; o1[r + 2] = bq[2]; o1[r + 3] = bq[3]; }
              const f32x2 ml = *(const f32x2*)(stm + ((tq * 16 + h) * 2 + hi) * 2); M = ml[0]; l = ml[1]; }
            const int kb0 = 4 * i0 - 128 + 32 * ktlo0, ik1 = i0 - 128 + 32 * ktlo1;
            const unsigned koff0 = (unsigned)j * PITCHB + (3072 + h * 64 + 8 * hi) * 2, koff1 = (unsigned)(4 * j) * PITCHB + (3072 + 1024 + h * 64 + 8 * hi) * 2;
            unsigned voff0[4], voff1[4];
#pragma unroll
            for (int i = 0; i < 4; ++i) { voff0[i] = (unsigned)(8 * i + (lane >> 3)) * PITCHB + (6144 + h * 64 + 8 * (lane & 7)) * 2;
                                          voff1[i] = (unsigned)(4 * (8 * i + (lane >> 3))) * PITCHB + (6144 + 1024 + h * 64 + 8 * (lane & 7)) * 2; }
            const unsigned ub0 = (unsigned)(tb + kb0) * PITCHB, ub1 = (unsigned)(tb + 4 * ik1 + c) * PITCHB;
            const unsigned us0 = 32u * PITCHB, us1 = 128u * PITCHB;
            const LAS float* tla0 = tab + 383 - (4 * (i0 + j) + c - kb0) + 4 * hi;
            const LAS float* tla1 = tab + 640 + 383 - (i0 + j - ik1) + 4 * hi;
#define AT_LOADN(m, KF, VR) do { int m_ = (m); m_ = m_ < ntl ? m_ : ntl - 1; if (m_ < n0) AT_LOADS(KF, VR, ub0 + (unsigned)(MODE == 1 ? 0 : m_) * us0, koff0, voff0); else AT_LOADS(KF, VR, ub1 + (unsigned)(MODE == 1 ? 0 : m_ - n0) * us1, koff1, voff1); } while (0)
#define AT_STEPN(n, KF, VR, PF) do { const int n_ = (n); if (n_ < n0) { AT_SCORE(KF, VR, qf0, tla0 + 32 * n_) } else { AT_SCORE(KF, VR, qf1, tla1 + 32 * (n_ - n0)) } \
            if (PF) AT_LOADN(n_ + 2, KF, VR); AT_SOFTPV(); } while (0)
            AT_LOADN(0, kfA, vrA); AT_LOADN(1, kfB, vrB);
            AT_TS(0);
            int n = 0;
#pragma unroll 1
            for (; n + 1 < ntl; n += 2) { AT_STEPN(n, kfA, vrA, true); AT_STEPN(n + 1, kfB, vrB, true); }
            if (n < ntl) AT_STEPN(n, kfA, vrA, false);
            AT_TS(4);
#undef AT_STEPN
#undef AT_LOADN
            { auto rr = __builtin_amdgcn_permlane32_swap(__float_as_uint(l), __float_as_uint(l), false, false); l = __uint_as_float(rr[0]) + __uint_as_float(rr[1]); }
            const float il = 1.0f / l;
            bf16_t* op = mo + tq * D + h * 64 + 4 * hi;
#pragma unroll
            for (int gq = 0; gq < 4; ++gq) {
                u32x2 w0, w1;
                w0.x = cvt_pk_bf16(o0[4 * gq] * il, o0[4 * gq + 1] * il); w0.y = cvt_pk_bf16(o0[4 * gq + 2] * il, o0[4 * gq + 3] * il);
                w1.x = cvt_pk_bf16(o1[4 * gq] * il, o1[4 * gq + 1] * il); w1.y = cvt_pk_bf16(o1[4 * gq + 2] * il, o1[4 * gq + 3] * il);
                *(u32x2*)(op + 8 * gq) = w0; *(u32x2*)(op + 32 + 8 * gq) = w1;
            }
            AT_TS(2);
        }
    }
#ifdef MK_ATT_TS
    if (ts_out && F.tid == 0) { for (int k = 0; k < 6; ++k) ts_out[k] = ts_acc[k]; }
#endif
    __syncthreads();
}
#undef AT_LOADS
#undef AT_SCORE
#undef AT_SOFTPV
constexpr int PH_MIX = 0, PH_FF1 = 1, PH_FF2 = 2, PH_QKV = 3, PH_ATT = 4, PH_WO = 5, PH_ROUTE = 6, PH_MOE0 = 7, PH_FINAL = 10, PH_END = 11;

__global__ void __launch_bounds__(NTHREADS, 2) mk_fwd(Args args) {
    extern __shared__ __attribute__((aligned(16))) unsigned char lds_raw[];
    Frame F;
    F.lds = (LAS unsigned char*)lds_raw;
    F.tid = threadIdx.x; F.lane = F.tid & 63; F.wave = __builtin_amdgcn_readfirstlane(F.tid >> 6); F.G = gridDim.x; F.bid = blockIdx.x;
    F.ws = args.ws; F.ctl = (unsigned*)(args.ws + WS_CTL); F.h = args.out;
    volatile LAS unsigned* MISC = (volatile LAS unsigned*)(F.lds + MISC_OFF);
    for (int u = F.tid; u < 64; u += NTHREADS) MISC[u] = 0u;
    __syncthreads();
    XcdBarrier bar = xcd_barrier_post(F.ctl + CW_BAR + args.li * XCD_BAR_WORDS, MISC + 8);
    const int lo = args.ph_lo, hi = args.ph_hi;
#ifndef MK_MASK
#define MK_MASK 0xffffffffu
#endif
#define IN(k) (((MK_MASK >> (k)) & 1u) && lo <= (k) && (k) < hi)
#define SEAM(k) do { if (IN(k) && IN((k) + 1)) xcd_barrier(bar); } while (0)
    unsigned char* ws = args.ws;
    LAS unsigned char* ring = F.lds + RING_OFF;
#ifdef MK_PROBE_LO
    unsigned long long pr_t0 = 0, pr_t1 = 0;
#define PROBE_AT(k) do { if ((k) == MK_PROBE_LO) pr_t0 = __builtin_amdgcn_s_memrealtime(); if ((k) == MK_PROBE_HI) pr_t1 = __builtin_amdgcn_s_memrealtime(); } while (0)
#else
#define PROBE_AT(k) do { } while (0)
#endif

    PROBE_AT(0);
    if (IN(PH_MIX)) { conv_aproj(F, args); conv_small(F, args); VM_WAIT(); __syncthreads(); }
    PROBE_AT(20);
    if (IN(PH_MIX)) { xcd_barrier(bar); PROBE_AT(21); mixer_phase(F, args); }
    PROBE_AT(22);
    SEAM(PH_MIX);

    PROBE_AT(1);
    if (IN(PH_FF1)) {
        pg8::Gemm g{(const bf16_t*)(ws + WS_S1), (const bf16_t*)(ws + WS_WGU0), D, D, D}; pg8::StaticOrder S; S.init(T, 2 * FF0, F.G, F.bid);
        EpiSwiGLU E{(bf16_t*)(ws + WS_ACT0), ACT0_LD, (const float*)(ws + WS_RSTD1), 1.f, 1.f};
        pg8::gemm_phase<EpiSwiGLU, pg8::StaticOrder, false>(ring, g, S, E);
        { const int units = (T / 256) * (2 * FF0 / 256), rem = units % F.G;
          if (rem == 0) conv_later(F, args, F.bid, F.G); else if (F.bid >= rem) conv_later(F, args, F.bid - rem, F.G - rem); }
    }
    SEAM(PH_FF1);
    PROBE_AT(2);
    if (IN(PH_FF2)) {
        pg8::Gemm g{(const bf16_t*)(ws + WS_ACT0), (const bf16_t*)(ws + WS_WD0), FF0, ACT0_LD, FF0}; pg8::StaticOrder S; S.init(T, D, F.G, F.bid);
        EpiRes E{(bf16_t*)(ws + WS_S1), (float*)(ws + WS_SSQ), nullptr};
        pg8::gemm_phase<EpiRes, pg8::StaticOrder, false>(ring, g, S, E);
    }
    SEAM(PH_FF2);
    PROBE_AT(3);
    if (IN(PH_QKV)) {
        pg8::Gemm g{(const bf16_t*)(ws + WS_S1), (const bf16_t*)(ws + WS_WQKV), D, D, D}; pg8::StaticOrder S; S.init(T, NQKV, F.G, F.bid);
        EpiQKV E{(bf16_t*)(ws + WS_QKV), (const float*)(ws + WS_SSQ)};
        pg8::gemm_phase<EpiQKV, pg8::StaticOrder, false>(ring, g, S, E);
#if defined(MK_QKV_EXTRA) && MK_QKV_EXTRA == 1
        pg8::gemm_phase<EpiQKV, pg8::StaticOrder, false>(ring, g, S, E);
#elif defined(MK_QKV_EXTRA) && MK_QKV_EXTRA == 4
        { EpiNull EN; pg8::gemm_phase_ref<EpiNull, pg8::StaticOrder>(ring, g, S, EN); }
#elif defined(MK_QKV_EXTRA) && MK_QKV_EXTRA == 3
        { EpiQKV_T<false> EN{(bf16_t*)(ws + WS_QKV), (const float*)(ws + WS_SSQ)}; pg8::gemm_phase<EpiQKV_T<false>, pg8::StaticOrder, false>(ring, g, S, EN); }
#elif defined(MK_QKV_EXTRA) && MK_QKV_EXTRA == 2
        { EpiNull EN; pg8::gemm_phase<EpiNull, pg8::StaticOrder, false>(ring, g, S, EN); }
#endif
    }
    SEAM(PH_QKV);
        PROBE_AT(4);
#ifdef MK_ATT_TS
    unsigned long long att_ts[6] = {0, 0, 0, 0, 0, 0};
    if (IN(PH_ATT)) { attn_phase<0>(F, args, att_ts);
#else
    if (IN(PH_ATT)) { attn_phase<0>(F, args);
#endif
#ifdef MK_ATT_EXTRA
        attn_phase<MK_ATT_EXTRA>(F, args);
#endif
    }
    SEAM(PH_ATT);
    PROBE_AT(5);
    if (IN(PH_WO)) {
        pg8::Gemm g{(const bf16_t*)(ws + WS_S0), (const bf16_t*)(ws + WS_WO), D, D, D}; pg8::StaticOrder S; S.init(T, D, F.G, F.bid);
        EpiRes E{(bf16_t*)(ws + WS_S1), nullptr, ws + WS_H8};
        pg8::gemm_phase<EpiRes, pg8::StaticOrder, false>(ring, g, S, E);
        conv_moe(F, args);
#ifdef MK_READ_LINEAR
        for (int rep = 0; rep < 2; ++rep) { __syncthreads(); conv_read_linear(F, args); }
#endif
#ifdef MK_CONV_EXTRA
        for (int rep = 0; rep < MK_CONV_EXTRA; ++rep) { __syncthreads(); conv_moe(F, args, rep + 1); }
#endif
    }
    SEAM(PH_WO);
    PROBE_AT(6);
    if (IN(PH_ROUTE)) { router_phase(F, args); }
    SEAM(PH_ROUTE);
#pragma unroll 1
    for (int j = 0; j < 3; ++j) {
        PROBE_AT(7 + j);
        if (IN(PH_MOE0 + j)) {
            moe_info_build(F.lds, F.ctl);
            volatile LAS int* mi = (volatile LAS int*)(F.lds + SCR_OFF);
            const int ntiles = __builtin_amdgcn_readfirstlane(mi[MI_NT]);
            const int c1s = __builtin_amdgcn_readfirstlane(mi[MI_C1]);
            if (j >= 1) {
                const int c0 = j == 1 ? 0 : c1s; const int ntc = j == 1 ? c1s : ntiles - c1s;
                EpiY E{(bf16_t*)(ws + WS_Y), (bf16_t*)(ws + WS_Y2), c0 * 256, 1.f / (WD_PRESC * ACT_PRESC)};
                if (j == 2) {
                    pg8::Gemm g{(const bf16_t*)(ws + WS_ACT1 + ACT1_B1), (const bf16_t*)(ws + WS_WD1), FF1 / 4, FF1 / 2, FF1 / 2};
                    MoeOrder<8, false> S{{F.ctl + CW_Q + 64 * (2 * j), MISC + 16}, mi, c0, ntc, nullptr};
                    pg8::gemm_phase<EpiY, MoeOrder<8, false>, false, true>(ring, g, S, E);
                } else {
                    pg8::Gemm g{(const bf16_t*)(ws + WS_ACT1), (const bf16_t*)(ws + WS_WD1), FF1 / 2, FF1 / 2, FF1 / 2};
                    MoeOrder<4, false> S{{F.ctl + CW_Q + 64 * (2 * j), MISC + 16}, mi, c0, ntc, nullptr};
                    pg8::gemm_phase<EpiY, MoeOrder<4, false>, false, true>(ring, g, S, E);
                }
            }
            if (j <= 1) {
                const int c0 = j == 0 ? 0 : c1s; const int ntc = j == 0 ? c1s : ntiles - c1s;
                pg8::Gemm g{(const bf16_t*)(ws + WS_H8), (const bf16_t*)(ws + WS_WGU1), D / 2, D / 2, D / 2};
                MoeOrder<28, true> S{{F.ctl + CW_Q + 64 * (2 * j + 1), MISC + 16}, mi, c0, ntc, (const int*)(ws + WS_LTOK)};
                EpiSwiGLU_T<true> E{(bf16_t*)(ws + WS_ACT1 + (j ? ACT1_B1 : (size_t)0)), FF1, (const float*)(ws + WS_LRS), 1.f / WGU_PRESC, ACT_PRESC};
                pg8::gemm_phase<EpiSwiGLU_T<true>, MoeOrder<28, true>, true, true>(ring, g, S, E);
#ifdef MK_G1_EXTRA
                if (j == 0) {
#pragma unroll 1
                    for (int rep = 0; rep < 2; ++rep) {
                        MoeOrder<28, true> S2{{F.ctl + CW_Q + 64 * (8 + rep), MISC + 16}, mi, c0, ntc, (const int*)(ws + WS_LTOK)};
#if MK_G1_EXTRA == 1
                        pg8::gemm_phase<EpiSwiGLU_T<true>, MoeOrder<28, true>, true, true>(ring, g, S2, E);
#else
                        EpiNull EN{};
                        pg8::gemm_phase<EpiNull, MoeOrder<28, true>, true, true>(ring, g, S2, EN);
#endif
                    }
                }
#endif
            }
        }
        SEAM(PH_MOE0 + j);
    }
#ifdef MK_EXTRA_BARS
    for (int i = 0; i < MK_EXTRA_BARS; ++i) xcd_barrier(bar);
#endif
    PROBE_AT(10);
    if (IN(PH_FINAL)) { moe_info_build(F.lds, F.ctl); final_phase(F, args); }
    PROBE_AT(11);
#ifdef MK_ATT_TS
    if (F.bid == 0 && F.wave == 0) { const unsigned long long dt = att_ts[MK_ATT_TS] / 5ull, ts = __builtin_amdgcn_s_memrealtime(); while (__builtin_amdgcn_s_memrealtime() - ts < dt) __builtin_amdgcn_s_sleep(8); }
#endif
#ifdef MK_PROBE_LO
    { const unsigned long long dt = (pr_t1 - pr_t0) * MK_PROBE_MULT, ts = __builtin_amdgcn_s_memrealtime(); while (__builtin_amdgcn_s_memrealtime() - ts < dt) __builtin_amdgcn_s_sleep(8); }
#endif
#undef IN
#undef SEAM
}
}
extern "C" void kernel_launch(void* const* d_in, const int* in_sizes, int n_in, void* d_out, int out_size, void* d_ws, size_t ws_size, hipStream_t stream) {
    static int grid = 0;
    if (grid == 0) {
        if (n_in != 19 || out_size != mk::T * mk::D || ws_size < mk::WS_END) { fprintf(stderr, "kernel_launch: unexpected shapes / workspace (%d inputs, out %d, ws %zu)\n", n_in, out_size, ws_size); grid = -1; return; }
        int dev = 0, cus = 0;
        if (hipGetDevice(&dev) != hipSuccess || hipDeviceGetAttribute(&cus, hipDeviceAttributeMultiprocessorCount, dev) != hipSuccess) { grid = -1; return; }
        if (hipFuncSetAttribute((const void*)mk::mk_fwd, hipFuncAttributeMaxDynamicSharedMemorySize, mk::LDS_BYTES) != hipSuccess) { fprintf(stderr, "kernel_launch: hipFuncSetAttribute failed\n"); grid = -1; return; }
        int per_cu = 0;
        if (hipOccupancyMaxActiveBlocksPerMultiprocessor(&per_cu, (const void*)mk::mk_fwd, mk::NTHREADS, mk::LDS_BYTES) != hipSuccess || per_cu < 1) { fprintf(stderr, "kernel_launch: occupancy query says %d blocks per CU\n", per_cu); }
        (void)hipGetLastError();
        grid = cus;
    }
    if (grid < 0) return;
    (void)hipMemsetAsync((char*)d_ws + mk::WS_CTL, 0, mk::CTL_ZERO_BYTES, stream);
    mk::Args a{};
    for (int i = 0; i < 19; ++i) a.in[i] = (const float*)d_in[i];
    a.out = (float*)d_out; a.ws = (unsigned char*)d_ws;
    a.ph_lo = 0; a.ph_hi = mk::PH_END; a.li = 0;
    hipLaunchKernelGGL(mk::mk_fwd, dim3(grid), dim3(mk::NTHREADS), mk::LDS_BYTES, stream, a);
}
```

```cpp
#include <hip/hip_runtime.h>
#include <cstdio>
#include <cstdint>
namespace mk {
#define LAS __attribute__((address_space(3)))
#define GAS __attribute__((address_space(1)))
typedef unsigned short bf16_t;
typedef short bf16x8 __attribute__((ext_vector_type(8)));
typedef float f32x4 __attribute__((ext_vector_type(4)));
typedef float f32x2 __attribute__((ext_vector_type(2)));
typedef unsigned u32x4 __attribute__((ext_vector_type(4)));
typedef unsigned u32x2 __attribute__((ext_vector_type(2)));

constexpr int T = 16384, D = 1024, SEQ = 2048, NBATCH = 8;
constexpr int FF0 = 2816, FF1 = 3584, NE = 8, NQKV = 9216;
constexpr int ACT0_LD = FF0 + 64;
constexpr int QKV_LD = NQKV + 64;
constexpr float EPS = 1e-6f;
constexpr float WGU_PRESC = 32.f, WD_PRESC = 64.f, ACT_PRESC = 4.f;
constexpr int NWAVES = 8, NTHREADS = 512;

constexpr size_t MiB = 1u << 20;
constexpr size_t WS_CTL = 0, CTL_ZERO_BYTES = 64 * 1024;
constexpr size_t WS_SSQ = 1 * MiB;
constexpr size_t WS_LTOK = 2 * MiB;
constexpr size_t WS_LRS = 2 * MiB + 512 * 1024;
constexpr size_t WS_TOKINFO = 3 * MiB;
constexpr size_t WS_ZERO = 3 * MiB + 256 * 1024;
constexpr size_t WS_APT = 3 * MiB + 512 * 1024;
constexpr size_t WS_WGU0 = 4 * MiB;
constexpr size_t WS_WD0 = 15 * MiB;
constexpr size_t WS_WQKV = WS_WD0 + (size_t)D * FF0 * 2;
constexpr size_t WS_WO = WS_WQKV + (size_t)NQKV * D * 2;
constexpr size_t WS_S0 = 41 * MiB;
constexpr size_t WS_S1 = 73 * MiB;
constexpr size_t WS_RSTD1 = 3 * MiB + 320 * 1024;
constexpr size_t WS_RT = 3 * MiB + 384 * 1024;
constexpr size_t WS_H8 = 362 * MiB;
constexpr size_t WS_POOL = 105 * MiB;
constexpr size_t WS_ACT0 = WS_POOL;
constexpr size_t WS_QKV = WS_POOL;
constexpr int LAST_TILES = 32;
constexpr int CH0_CAP = 110;
constexpr size_t ACT1_B1 = (size_t)CH0_CAP * 256 * FF1;
constexpr size_t WS_ACT1 = WS_POOL;
constexpr size_t WS_Y = 4 * MiB;
constexpr size_t WS_Y2 = WS_ACT1 + ACT1_B1 + (size_t)LAST_TILES * 256 * FF1;
constexpr size_t WS_WGU1 = 306 * MiB;
constexpr size_t WS_WD1 = 418 * MiB;
constexpr size_t WS_END = 474 * MiB;
static_assert(WS_WO + (size_t)D * D * 2 <= WS_S0, "small weights");
static_assert(WS_Y2 + (size_t)LAST_TILES * 256 * D * 2 <= WS_WGU1 && WS_Y + (size_t)34816 * D * 2 <= WS_S1, "moe map");
static_assert(WS_WGU1 + (size_t)NE * 7168 * D * 2 <= WS_WD1 && WS_WD1 + (size_t)NE * D * FF1 * 2 <= WS_END, "moe weights");
static_assert(WS_QKV + (size_t)T * QKV_LD * 2 <= WS_END, "qkv");

constexpr int CW_TMO = 0;
constexpr int CW_CNT = 64;
constexpr int CW_Q = 128;
constexpr int CW_BAR = 4096;

constexpr int RING_OFF = 0, RING_BYTES = 131072;
constexpr int MISC_OFF = RING_BYTES;
constexpr int RTAB_OFF = MISC_OFF + 1024;
constexpr int SCR_OFF = MISC_OFF + 2048;
constexpr int TOKT_OFF = SCR_OFF + 1024;
constexpr int LRST_OFF = SCR_OFF + 2048;
constexpr int XP_OFF = SCR_OFF + 3072;
constexpr int LDS_BYTES = 147456;

#define RLX_AGENT __ATOMIC_RELAXED, __HIP_MEMORY_SCOPE_AGENT
#define LDS_WAIT() asm volatile("s_waitcnt lgkmcnt(0)" ::: "memory")
#define VM_WAIT() asm volatile("s_waitcnt vmcnt(0)" ::: "memory")
__device__ __forceinline__ unsigned f2bf(float f) { unsigned u = __builtin_bit_cast(unsigned, f); return (u + 0x7fffu + ((u >> 16) & 1u)) >> 16; }
__device__ __forceinline__ unsigned pk2(float lo, float hi) { return f2bf(lo) | (f2bf(hi) << 16); }
__device__ __forceinline__ unsigned cvt_pk_bf16(float lo, float hi) { unsigned r; asm volatile("v_cvt_pk_bf16_f32 %0, %1, %2" : "=v"(r) : "v"(lo), "v"(hi)); return r; }
__device__ __forceinline__ float bf2f(unsigned short b) { return __builtin_bit_cast(float, ((unsigned)b) << 16); }
__device__ __forceinline__ float wave_sum(float v) {
#pragma unroll
    for (int o = 1; o < 64; o <<= 1) v += __shfl_xor(v, o);
    return v;
}
__device__ __forceinline__ float silu_f(float x) { return x * __builtin_amdgcn_rcpf(1.f + __builtin_amdgcn_exp2f(-1.4426950408889634f * x)); }
#define XB_TMO      128
#define XB_XCNT(j)  (256  + 64 * (j))
#define XB_XSUB(j)  (1280 + 64 * (j))
#define XB_XGEN(j)  (2304 + 64 * (j))
#define XB_TOP      3328
#define XB_TOPGEN   3392
#define XCD_BAR_WORDS 3456
#define XB_SPIN_CAP (1u << 18)
__device__ __forceinline__ unsigned xb_ld(unsigned* p)              { return __hip_atomic_load(p, __ATOMIC_RELAXED, __HIP_MEMORY_SCOPE_AGENT); }
__device__ __forceinline__ unsigned xb_add(unsigned* p, unsigned v) { return __hip_atomic_fetch_add(p, v, __ATOMIC_RELAXED, __HIP_MEMORY_SCOPE_AGENT); }
__device__ __forceinline__ unsigned xb_xcc_id() { return (unsigned)__builtin_amdgcn_s_getreg((3 << 11) | 20) & 0xFu; }
#define XB_SPIN(cond, bar) do { unsigned _sp = 0; while (cond) { __builtin_amdgcn_s_sleep(1); \
    if ((++_sp & 255u) == 0u) { if (xb_ld(&(bar)[XB_TMO])) break; if (_sp > XB_SPIN_CAP) { atomicAdd(&(bar)[XB_TMO], 1u); break; } } } } while (0)
struct XcdBarrier { unsigned* bar; unsigned x; volatile LAS unsigned* st; };
__device__ __forceinline__ XcdBarrier xcd_barrier_post(unsigned* bar, volatile LAS unsigned* st) {
    XcdBarrier b; b.bar = bar; b.x = xb_xcc_id(); b.st = st;
    if (threadIdx.x == 0) (void)xb_add(&bar[XB_XCNT(b.x)], 1u);
    return b;
}
__device__ __forceinline__ void xcd_barrier_complete(unsigned* bar, unsigned x, unsigned& nloc, unsigned& nx) {
    const unsigned G = gridDim.x * gridDim.y * gridDim.z;
    unsigned sum, cnt, mine, sp = 0u;
    for (;;) {
        sum = 0u; cnt = 0u; mine = 0u;
#pragma unroll
        for (unsigned j = 0; j < 16; ++j) { const unsigned c = xb_ld(&bar[XB_XCNT(j)]); sum += c; cnt += (c > 0u) ? 1u : 0u; mine = (j == x) ? c : mine; }
        if (sum == G) break;
        __builtin_amdgcn_s_sleep(1);
        if ((++sp & 255u) == 0u) { if (xb_ld(&bar[XB_TMO])) break; if (sp > XB_SPIN_CAP) { atomicAdd(&bar[XB_TMO], 1u); break; } }
    }
    nloc = mine > 0u ? mine : 1u; nx = cnt > 0u ? cnt : 1u;
}
__device__ __forceinline__ void xcd_barrier(const XcdBarrier& b) {
    asm volatile("s_waitcnt vmcnt(0)" ::: "memory");
    __syncthreads();
    if (threadIdx.x == 0) {
        unsigned* bar = b.bar;
        __builtin_amdgcn_s_waitcnt(0);
        unsigned nloc = b.st[0], nx = b.st[1];
        if (nloc == 0u) { xcd_barrier_complete(bar, b.x, nloc, nx); b.st[0] = nloc; b.st[1] = nx; }
        const unsigned old = xb_add(&bar[XB_XSUB(b.x)], 1u);
        const unsigned gen = old / nloc;
        if (old + 1u == (gen + 1u) * nloc) {
            __builtin_amdgcn_fence(__ATOMIC_RELEASE, "agent");
            asm volatile("s_waitcnt vmcnt(0)" ::: "memory");
            const unsigned og = xb_add(&bar[XB_TOP], 1u);
            const unsigned tg = og / nx;
            if (og + 1u == (tg + 1u) * nx) xb_add(&bar[XB_TOPGEN], 1u);
            else XB_SPIN(xb_ld(&bar[XB_TOPGEN]) == tg, bar);
            __builtin_amdgcn_fence(__ATOMIC_ACQUIRE, "agent");
            xb_add(&bar[XB_XGEN(b.x)], 1u);
            asm volatile("s_waitcnt vmcnt(0)" ::: "memory");
        } else {
            XB_SPIN(xb_ld(&bar[XB_XGEN(b.x)]) == gen, bar);
            __builtin_amdgcn_fence(__ATOMIC_ACQUIRE, "agent");
            asm volatile("s_waitcnt vmcnt(0)" ::: "memory");
        }
    }
    __syncthreads();
}
namespace pg8 {
typedef int v4i __attribute__((ext_vector_type(4)));
typedef int v8i __attribute__((ext_vector_type(8)));
constexpr int BM = 256, BK = 64, HALF = 128, HTB = HALF * BK * 2, STAGE_BYTES = 8 * HTB, NXCD = 8, WGM = 4;
__host__ __device__ __forceinline__ int lds_byte(int r, int c) { const int st = (r >> 4) * 2 + (c >> 5), rr = r & 15, cc = c & 31, ob = rr * 64 + cc * 2; return st * 1024 + (ob ^ (((ob >> 9) & 1) << 5)); }
__host__ __device__ __forceinline__ void stage_rc(int b, int& R, int& C) { const int st = b / 1024, sb = b % 1024, swz = sb ^ (((sb >> 9) & 1) << 5); R = (st >> 1) * 16 + swz / 64; C = (st & 1) * 32 + (swz % 64) / 2; }
__host__ __device__ __forceinline__ int perm32(int rho) { const int n = rho >> 4, i = rho & 15; return 8 * (i >> 2) + 4 * n + (i & 3); }

struct Unit { int pm, pn, arow, brow, e, orow, koff; };
struct Gemm { const bf16_t* A; const bf16_t* Bt; int K; int lda; int ldb; };

struct StaticOrder {
    int nM, nN, nwg, G, c;
    __device__ void init(int M, int N, int G_, int c_) { nM = M / BM; nN = N / BM; nwg = nM * nN; G = G_; c = c_; }
    __device__ __forceinline__ unsigned start() const { return 0u; }
    __device__ __forceinline__ void start_commit(unsigned) const {}
    __device__ __forceinline__ bool next(int i, Unit& u) const {
        const long L = (long)i * G + c; if (L >= nwg) return false;
        int wgid = (int)L; { const int q = nwg / NXCD, r = nwg % NXCD, xcd = wgid % NXCD, off = wgid / NXCD; wgid = (xcd < r ? xcd * (q + 1) : r * (q + 1) + (xcd - r) * q) + off; }
        const int nig = WGM * nN, gid = wgid / nig, fm = gid * WGM, gsz = (nM - fm) < WGM ? (nM - fm) : WGM;
        u.pm = fm + ((wgid % nig) % gsz); u.pn = (wgid % nig) / gsz; u.arow = u.pm * BM; u.brow = u.pn * BM; u.e = 0; u.orow = u.arow; u.koff = 0; return true;
    }
    __device__ __forceinline__ unsigned refill_issue() const { return 0u; }
    __device__ __forceinline__ void refill_commit(int, unsigned) const {}
    __device__ __forceinline__ unsigned gather_row(const Unit&, int) const { return 0u; }
};

template <class Epi, class Sched, bool GATHER, bool FP8 = false>
__device__ __forceinline__ void gemm_phase(LAS unsigned char* lds, const Gemm g, Sched& S, const Epi& E) {
    int tid_ = threadIdx.x; asm volatile("" : "+v"(tid_));
    const int tid = tid_, wid = __builtin_amdgcn_readfirstlane(tid >> 6), lane = tid & 63, wr = wid >> 2, wc = wid & 3, fr = lane & 15, fq = lane >> 4;
    int K_ = g.K; asm volatile("" : "+s"(K_));
    const int K = K_, nt = K / BK, LDA = g.lda, LDB = g.ldb;
    unsigned voffB[2]; unsigned va[2][2];
    const size_t kstep = (size_t)(BK * 2);
    const size_t hstep = (size_t)HALF * LDB * 2, hstepA = (size_t)HALF * LDA * 2;
#pragma unroll
    for (int i = 0; i < 2; ++i) { int R, C; stage_rc(tid * 16 + i * 8192, R, C); const int Rb = Epi::PERM ? ((R & ~31) + perm32(R & 31)) : R;
        voffB[i] = (unsigned)(Rb * LDB + C) * 2u;
        va[0][i] = (unsigned)(R * LDA + C) * 2u; va[1][i] = va[0][i] + (unsigned)hstepA; }
    const unsigned ldsw = (unsigned)wid * 1024u;
    const int aoff0 = lds_byte(wr * 64 + fr, FP8 ? 16 * fq : 8 * fq), aoff1 = lds_byte(wr * 64 + fr, FP8 ? 16 * fq + 8 : 8 * fq + 32);
    const int boff0 = lds_byte(wc * 32 + fr, FP8 ? 16 * fq : 8 * fq), boff1 = lds_byte(wc * 32 + fr, FP8 ? 16 * fq + 8 : 8 * fq + 32);
#define PG8_SA(b, h) (((b) * 2 + (h)) * HTB)
#define PG8_SB(b, h) ((4 + (b) * 2 + (h)) * HTB)
#define PG8_STAGEB(bufoff, gbase) do { _Pragma("unroll") for (int _i = 0; _i < 2; ++_i) \
        __builtin_amdgcn_global_load_lds((const unsigned*)((const char*)(gbase) + voffB[_i]), (LAS unsigned*)(lds + (bufoff) + ldsw + _i * 8192), 16, 0, 0); } while (0)
#define PG8_STAGEA(bufoff, gbase, vo, h) do { _Pragma("unroll") for (int _i = 0; _i < 2; ++_i) \
        __builtin_amdgcn_global_load_lds((const unsigned*)((const char*)(gbase) + (vo)[h][_i]), (LAS unsigned*)(lds + (bufoff) + ldsw + _i * 8192), 16, 0, 0); } while (0)
#define PG8_CAT8(p0, p1) __builtin_shufflevector(__builtin_bit_cast(v4i, *(const LAS bf16x8*)(p0)), __builtin_bit_cast(v4i, *(const LAS bf16x8*)(p1)), 0, 1, 2, 3, 4, 5, 6, 7)
#define PG8_LDA(dst, b, h) do { _Pragma("unroll") for (int m = 0; m < 4; ++m) { \
        if constexpr (FP8) dst##8[m] = PG8_CAT8(lds + PG8_SA(b, h) + aoff0 + m * 2048, lds + PG8_SA(b, h) + aoff0 + m * 2048 + 16);   \
        else { dst[m][0] = *(const LAS bf16x8*)(lds + PG8_SA(b, h) + aoff0 + m * 2048); dst[m][1] = *(const LAS bf16x8*)(lds + PG8_SA(b, h) + aoff1 + m * 2048); } } } while (0)
#define PG8_LDB(dst, b, h) do { _Pragma("unroll") for (int n = 0; n < 2; ++n) { \
        if constexpr (FP8) dst##8[n] = PG8_CAT8(lds + PG8_SB(b, h) + boff0 + n * 2048, lds + PG8_SB(b, h) + boff0 + n * 2048 + 16); \
        else { dst[n][0] = *(const LAS bf16x8*)(lds + PG8_SB(b, h) + boff0 + n * 2048); dst[n][1] = *(const LAS bf16x8*)(lds + PG8_SB(b, h) + boff1 + n * 2048); } } } while (0)
#define PG8_MMA(ai, bj, At, Bt) do { __builtin_amdgcn_s_setprio(1); _Pragma("unroll") for (int m = 0; m < 4; ++m) _Pragma("unroll") for (int n = 0; n < 2; ++n) { \
        if constexpr (FP8) asm volatile("v_mfma_f32_16x16x128_f8f6f4 %0, %1, %2, %0" : "+v"(acc[ai][bj][m][n]) : "v"(Bt##8[n]), "v"(At##8[m]));   \
        else { _Pragma("unroll") for (int k = 0; k < 2; ++k) acc[ai][bj][m][n] = __builtin_amdgcn_mfma_f32_16x16x32_bf16(Bt[n][k], At[m][k], acc[ai][bj][m][n], 0, 0, 0); } } \
        __builtin_amdgcn_s_setprio(0); } while (0)
#define PG8_MMA0(ai, bj, At, Bt) do { __builtin_amdgcn_s_setprio(1); _Pragma("unroll") for (int m = 0; m < 4; ++m) _Pragma("unroll") for (int n = 0; n < 2; ++n) { \
        if constexpr (FP8) asm volatile("v_mfma_f32_16x16x128_f8f6f4 %0, %1, %2, 0" : "=&v"(acc[ai][bj][m][n]) : "v"(Bt##8[n]), "v"(At##8[m])); \
        else { acc[ai][bj][m][n] = __builtin_amdgcn_mfma_f32_16x16x32_bf16(Bt[n][0], At[m][0], (f32x4){0.f, 0.f, 0.f, 0.f}, 0, 0, 0); acc[ai][bj][m][n] = __builtin_amdgcn_mfma_f32_16x16x32_bf16(Bt[n][1], At[m][1], acc[ai][bj][m][n], 0, 0, 0); } } \
        __builtin_amdgcn_s_setprio(0); } while (0)
#define PG8_WAIT_V(n) asm volatile("s_waitcnt vmcnt(" #n ")" ::: "memory")
#define PG8_WAIT_L(n) asm volatile("s_waitcnt lgkmcnt(" #n ")" ::: "memory")
#define PG8_BAR __builtin_amdgcn_s_barrier()
#define PG8_SCHED __builtin_amdgcn_sched_barrier(0)
    Unit cur, nxt; int ui = 0;
    typename Epi::Pre pre{};
#ifdef MK_STAGGER
    { const unsigned long long dt = (unsigned long long)((blockIdx.x >> 3) & 7) * MK_STAGGER, ts = __builtin_amdgcn_s_memrealtime(); while (__builtin_amdgcn_s_memrealtime() - ts < dt) __builtin_amdgcn_s_sleep(4); }
#endif
    const unsigned tk0 = S.start();
    if (!S.next(0, cur)) return;
    f32x4 acc[2][2][4][2];
    bf16x8 At[4][2], B0[2][2], B1[2][2]; v8i At8[4], B08[2], B18[2];
    const char* cA; const char* cB = (const char*)g.Bt + ((size_t)cur.brow * LDB + cur.koff) * 2;
    if constexpr (GATHER) { cA = (const char*)g.A;
#pragma unroll
        for (int h = 0; h < 2; ++h)
#pragma unroll
            for (int i = 0; i < 2; ++i) { int R, C; stage_rc(tid * 16 + i * 8192, R, C); va[h][i] = (S.gather_row(cur, h * HALF + R) * (unsigned)LDA + (unsigned)C) * 2u; }
    } else cA = (const char*)g.A + ((size_t)cur.arow * LDA + cur.koff) * 2;
    PG8_STAGEB(PG8_SB(0, 0), cB); PG8_STAGEB(PG8_SB(0, 1), cB + hstep); PG8_STAGEA(PG8_SA(0, 0), cA, va, 0); PG8_STAGEA(PG8_SA(0, 1), cA, va, 1);
    if (wr == 1) PG8_BAR;
    PG8_WAIT_V(2); PG8_BAR;
    PG8_STAGEB(PG8_SB(1, 0), cB + kstep); PG8_STAGEA(PG8_SA(1, 0), cA + kstep, va, 0); PG8_STAGEB(PG8_SB(1, 1), cB + hstep + kstep);
    PG8_WAIT_V(6); PG8_BAR;
    S.start_commit(tk0);
    for (;;) {
        bool has_next = false; const char* nA = cA; const char* nB = cB;
        unsigned vnx[2][2] = {{0u, 0u}, {0u, 0u}};
#pragma unroll 1
        for (int t = 0; t < nt; t += 2) {
            const bool last = (t == nt - 2);
            unsigned v2[2][2];
#pragma unroll
            for (int h = 0; h < 2; ++h)
#pragma unroll
                for (int i = 0; i < 2; ++i) v2[h][i] = va[h][i];
            if constexpr (GATHER) { if (t == nt - 4) {
                has_next = S.next(ui + 1, nxt);
                if (has_next) __builtin_amdgcn_global_load_lds((const unsigned*)S.gather_src(nxt, tid & 255), (LAS unsigned*)(lds + TOKT_OFF + (wid & 3) * 256), 4, 0, 0);
            } }
            if constexpr (Epi::DMA_PRE) { if (t == nt - 4) E.dma_pre(cur, tid, wid, lds); }
            if (last) {
                pre = E.pre(cur, wr, fr);
                if constexpr (!GATHER) has_next = S.next(ui + 1, nxt);
                if (has_next) { nB = (const char*)g.Bt + ((size_t)nxt.brow * LDB + nxt.koff) * 2;
                    if constexpr (GATHER) {
#pragma unroll
                        for (int h = 0; h < 2; ++h)
#pragma unroll
                            for (int i = 0; i < 2; ++i) { int R, C; stage_rc(tid * 16 + i * 8192, R, C); v2[h][i] = (((volatile LAS unsigned*)(lds + TOKT_OFF))[h * HALF + R] * (unsigned)LDA + (unsigned)C) * 2u; }
                    } else nA = (const char*)g.A + ((size_t)nxt.arow * LDA + nxt.koff) * 2;
                }
            }
            if constexpr (GATHER) { if (last) {
#pragma unroll
                for (int h = 0; h < 2; ++h)
#pragma unroll
                    for (int i = 0; i < 2; ++i) vnx[h][i] = v2[h][i]; } }
            const char* a1 = cA + (size_t)(t + 1) * kstep;
            const char* a2 = last ? nA : cA + (size_t)(t + 2) * kstep; const char* b2 = last ? nB : cB + (size_t)(t + 2) * kstep;
            const char* a3 = a2 + kstep; const char* b3 = b2 + kstep;
            PG8_LDB(B0, 0, 0); PG8_LDB(B1, 0, 1); PG8_SCHED; PG8_LDA(At, 0, 0); PG8_STAGEA(PG8_SA(1, 1), a1, va, 1);
            PG8_WAIT_V(8); PG8_WAIT_L(0); PG8_BAR; if (t == 0) { PG8_MMA0(0, 0, At, B0); PG8_MMA0(0, 1, At, B1); } else { PG8_MMA(0, 0, At, B0); PG8_MMA(0, 1, At, B1); } PG8_BAR; PG8_SCHED;
            PG8_LDA(At, 0, 1); PG8_STAGEB(PG8_SB(0, 0), b2); PG8_STAGEB(PG8_SB(0, 1), b2 + hstep); PG8_STAGEA(PG8_SA(0, 0), a2, v2, 0);
            PG8_WAIT_V(8); PG8_WAIT_L(0); PG8_BAR; if (t == 0) { PG8_MMA0(1, 0, At, B0); PG8_MMA0(1, 1, At, B1); } else { PG8_MMA(1, 0, At, B0); PG8_MMA(1, 1, At, B1); } PG8_BAR; PG8_SCHED;
            PG8_LDB(B0, 1, 0); PG8_LDB(B1, 1, 1); PG8_SCHED; PG8_LDA(At, 1, 0); PG8_STAGEA(PG8_SA(0, 1), a2, v2, 1);
            PG8_WAIT_V(8); PG8_WAIT_L(0); PG8_BAR; PG8_MMA(0, 0, At, B0); PG8_MMA(0, 1, At, B1); PG8_BAR; PG8_SCHED;
            PG8_LDA(At, 1, 1); PG8_STAGEB(PG8_SB(1, 0), b3); PG8_STAGEB(PG8_SB(1, 1), b3 + hstep); PG8_STAGEA(PG8_SA(1, 0), a3, v2, 0);
            PG8_WAIT_V(8); PG8_WAIT_L(0); PG8_BAR; PG8_MMA(1, 0, At, B0); PG8_MMA(1, 1, At, B1); PG8_BAR; PG8_SCHED;
        }
        if constexpr (FP8) asm volatile("s_nop 15\n\ts_nop 15\n\ts_nop 15\n\ts_nop 15" ::: "memory");
        if (wr == 0) PG8_BAR;
        const unsigned rf = S.refill_issue();
        E(acc, cur, wr, wc, fr, fq, lds, pre);
        S.refill_commit(ui, rf);
        if (!has_next) break;
        cur = nxt; cA = nA; cB = nB; ++ui;
        if constexpr (GATHER) {
#pragma unroll
            for (int h = 0; h < 2; ++h)
#pragma unroll
                for (int i = 0; i < 2; ++i) va[h][i] = vnx[h][i];
        }
        if (wr == 1) PG8_BAR;
    }
    PG8_WAIT_V(0);
    PG8_BAR;
#undef PG8_SA
#undef PG8_SB
#undef PG8_STAGEA
#undef PG8_STAGEB
#undef PG8_LDA
#undef PG8_LDB
#undef PG8_MMA
#undef PG8_WAIT_V
#undef PG8_WAIT_L
#undef PG8_BAR
#undef PG8_SCHED
}

template <class Epi, class Sched>
__device__ __forceinline__ void gemm_phase_ref(LAS unsigned char* lds, const Gemm g, const Sched& S, const Epi& E) {
    const int tid = threadIdx.x, wid = __builtin_amdgcn_readfirstlane(tid >> 6), lane = tid & 63, wr = wid >> 2, wc = wid & 3, fr = lane & 15, fq = lane >> 4;
    const int K = g.K, nt = K / BK;
    unsigned voffA[2], voffB[2];
#pragma unroll
    for (int i = 0; i < 2; ++i) { int R, C; stage_rc(tid * 16 + i * 8192, R, C); const int Rb = Epi::PERM ? ((R & ~31) + perm32(R & 31)) : R;
        voffA[i] = (unsigned)(R * K + C) * 2u; voffB[i] = (unsigned)(Rb * K + C) * 2u; }
    const size_t kstep = (size_t)(BK * 2), hstep = (size_t)HALF * K * 2, tstep = 2 * hstep;
    const unsigned ldsw = (unsigned)wid * 1024u;
    const int aoff = lds_byte(wr * 64 + fr, fq * 8), boff = lds_byte(wc * 32 + fr, fq * 8);
#define RSA(b, h) (((b) * 2 + (h)) * HTB)
#define RSB(b, h) ((4 + (b) * 2 + (h)) * HTB)
#define RSTAGE(bufoff, gbase, voff) do { _Pragma("unroll") for (int _i = 0; _i < 2; ++_i) \
        __builtin_amdgcn_global_load_lds((const unsigned*)((const char*)(gbase) + (voff)[_i]), (LAS unsigned*)(lds + (bufoff) + ldsw + _i * 8192), 16, 0, 0); } while (0)
#define RLDA(dst, b, h) do { _Pragma("unroll") for (int m = 0; m < 4; ++m) _Pragma("unroll") for (int k = 0; k < 2; ++k) dst[m][k] = *(const LAS bf16x8*)(lds + RSA(b, h) + aoff + m * 2048 + k * 1024); } while (0)
#define RLDB(dst, b, h) do { _Pragma("unroll") for (int n = 0; n < 2; ++n) _Pragma("unroll") for (int k = 0; k < 2; ++k) dst[n][k] = *(const LAS bf16x8*)(lds + RSB(b, h) + boff + n * 2048 + k * 1024); } while (0)
#define RMMA(ai, bj, At, Bt) do { __builtin_amdgcn_s_setprio(1); _Pragma("unroll") for (int m = 0; m < 4; ++m) _Pragma("unroll") for (int n = 0; n < 2; ++n) _Pragma("unroll") for (int k = 0; k < 2; ++k) \
        acc[ai][bj][m][n] = __builtin_amdgcn_mfma_f32_16x16x32_bf16(Bt[n][k], At[m][k], acc[ai][bj][m][n], 0, 0, 0); __builtin_amdgcn_s_setprio(0); } while (0)
#define RWV(n) asm volatile("s_waitcnt vmcnt(" #n ")" ::: "memory")
#define RWL(n) asm volatile("s_waitcnt lgkmcnt(" #n ")" ::: "memory")
#define RBAR __builtin_amdgcn_s_barrier()
#define RSCHED __builtin_amdgcn_sched_barrier(0)
    Unit cur, nxt; int ui = 0;
    if (!S.next(0, cur)) return;
    f32x4 acc[2][2][4][2];
#pragma unroll
    for (int a = 0; a < 2; ++a)
#pragma unroll
        for (int b = 0; b < 2; ++b)
#pragma unroll
            for (int m = 0; m < 4; ++m)
#pragma unroll
                for (int n = 0; n < 2; ++n) acc[a][b][m][n] = (f32x4){0.f, 0.f, 0.f, 0.f};
    bf16x8 At[4][2], B0[2][2], B1[2][2];
    const char* cA = (const char*)g.A + (size_t)cur.pm * tstep; const char* cB = (const char*)g.Bt + (size_t)cur.pn * tstep;
    RSTAGE(RSB(0, 0), cB, voffB); RSTAGE(RSB(0, 1), cB + hstep, voffB); RSTAGE(RSA(0, 0), cA, voffA); RSTAGE(RSA(0, 1), cA + hstep, voffA);
    if (wr == 1) RBAR;
    RWV(2); RBAR;
    RSTAGE(RSB(1, 0), cB + kstep, voffB); RSTAGE(RSA(1, 0), cA + kstep, voffA); RSTAGE(RSB(1, 1), cB + hstep + kstep, voffB);
    RWV(6); RBAR;
    for (;;) {
        const bool has_next = S.next(ui + 1, nxt);
        const char* nA = has_next ? (const char*)g.A + (size_t)nxt.pm * tstep : cA; const char* nB = has_next ? (const char*)g.Bt + (size_t)nxt.pn * tstep : cB;
        for (int t = 0; t < nt; t += 2) {
            const bool last = (t == nt - 2);
            const char* a1 = cA + (size_t)(t + 1) * kstep;
            const char* a2 = last ? nA : cA + (size_t)(t + 2) * kstep; const char* b2 = last ? nB : cB + (size_t)(t + 2) * kstep;
            const char* a3 = a2 + kstep; const char* b3 = b2 + kstep;
            RLDB(B0, 0, 0); RLDB(B1, 0, 1); RSCHED; RLDA(At, 0, 0); RSTAGE(RSA(1, 1), a1 + hstep, voffA);
            RWV(8); RWL(0); RBAR; RMMA(0, 0, At, B0); RMMA(0, 1, At, B1); RBAR; RSCHED;
            RLDA(At, 0, 1); RSTAGE(RSB(0, 0), b2, voffB); RSTAGE(RSB(0, 1), b2 + hstep, voffB); RSTAGE(RSA(0, 0), a2, voffA);
            RWV(8); RWL(0); RBAR; RMMA(1, 0, At, B0); RMMA(1, 1, At, B1); RBAR; RSCHED;
            RLDB(B0, 1, 0); RLDB(B1, 1, 1); RSCHED; RLDA(At, 1, 0); RSTAGE(RSA(0, 1), a2 + hstep, voffA);
            RWV(8); RWL(0); RBAR; RMMA(0, 0, At, B0); RMMA(0, 1, At, B1); RBAR; RSCHED;
            RLDA(At, 1, 1); RSTAGE(RSB(1, 0), b3, voffB); RSTAGE(RSB(1, 1), b3 + hstep, voffB); RSTAGE(RSA(1, 0), a3, voffA);
            RWV(8); RWL(0); RBAR; RMMA(1, 0, At, B0); RMMA(1, 1, At, B1); RBAR; RSCHED;
        }
        if (wr == 0) RBAR;
#pragma unroll
        for (int a = 0; a < 2; ++a)
#pragma unroll
            for (int b = 0; b < 2; ++b)
#pragma unroll
                for (int m = 0; m < 4; ++m)
#pragma unroll
                    for (int n = 0; n < 2; ++n) asm volatile("" :: "v"(acc[a][b][m][n]));
        if (!has_next) break;
#pragma unroll
        for (int a = 0; a < 2; ++a)
#pragma unroll
            for (int b = 0; b < 2; ++b)
#pragma unroll
                for (int m = 0; m < 4; ++m)
#pragma unroll
                    for (int n = 0; n < 2; ++n) acc[a][b][m][n] = (f32x4){0.f, 0.f, 0.f, 0.f};
        cur = nxt; cA = nA; cB = nB; ++ui;
        if (wr == 1) RBAR;
    }
    RWV(0);
    RBAR;
#undef RSA
#undef RSB
#undef RSTAGE
#undef RLDA
#undef RLDB
#undef RMMA
#undef RWV
#undef RWL
#undef RBAR
#undef RSCHED
}
}
struct PreNone { };
__device__ __forceinline__ u32x4 quad_xpose(LAS unsigned char* lds, u32x4 w) {
    const int lane = threadIdx.x & 63, wid = threadIdx.x >> 6;
    LAS unsigned char* st = lds + XP_OFF + wid * 1280;
    *(LAS u32x4*)(st + (lane & 15) * 80 + (lane >> 4) * 16) = w;
    asm volatile("s_waitcnt lgkmcnt(0)" ::: "memory");
    return *(const LAS u32x4*)(st + (lane >> 2) * 80 + (lane & 3) * 16);
}
struct Pre8 { float v[8]; };
__device__ __forceinline__ unsigned pk4_fp8(float a, float b, float c, float d) { int w = __builtin_amdgcn_cvt_pk_fp8_f32(a, b, 0, false); w = __builtin_amdgcn_cvt_pk_fp8_f32(c, d, w, true); return (unsigned)w; }
__device__ __forceinline__ u32x4 quad_xpose8(LAS unsigned char* lds, u32x2 w0, u32x2 w1) {
    const int lane = threadIdx.x & 63, wid = threadIdx.x >> 6;
    LAS unsigned char* st = lds + XP_OFF + wid * 1280;
    *(LAS u32x2*)(st + (lane & 15) * 40 + (lane >> 4) * 8) = w0; *(LAS u32x2*)(st + (16 + (lane & 15)) * 40 + (lane >> 4) * 8) = w1;
    asm volatile("s_waitcnt lgkmcnt(0)" ::: "memory");
    const LAS u32x2* q = (const LAS u32x2*)(st + (lane >> 1) * 40 + (lane & 1) * 16); const u32x2 a = q[0], b = q[1];
    return (u32x4){a.x, a.y, b.x, b.y};
}
template <bool F8>
struct EpiSwiGLU_T {
    static constexpr bool PERM = true;
    #ifdef MK_FF1_NODMA
    static constexpr bool DMA_PRE = F8;
#else
    static constexpr bool DMA_PRE = true;
#endif
    static constexpr int NST = F8 ? 4 : 8;
    bf16_t* O; int ldo; const float* lrs; float wsc, osc;
    typedef PreNone Pre;
    __device__ __forceinline__ Pre pre(const pg8::Unit&, int, int) const { return Pre{}; }
    __device__ __forceinline__ void dma_pre(const pg8::Unit& u, int tid, int wid, LAS unsigned char* lds) const {
        __builtin_amdgcn_global_load_lds((const unsigned*)(lrs + (size_t)u.e * T + u.arow + (tid & 255)), (LAS unsigned*)(lds + LRST_OFF + (wid & 3) * 256), 4, 0, 0); }
    __device__ __forceinline__ void operator()(const f32x4 (&acc)[2][2][4][2], const pg8::Unit& u, int wr, int wc, int fr, int fq, LAS unsigned char* lds, const Pre&) const {
        struct { float v[8]; } pr;
#pragma unroll
        for (int i = 0; i < 8; ++i) {
#ifdef MK_FF1_NODMA
            if constexpr (!F8) pr.v[i] = lrs[(size_t)u.e * T + u.arow + (i >> 2) * 128 + (i & 3) * 16 + wr * 64 + fr]; else
#endif
            pr.v[i] = ((const LAS float*)(lds + LRST_OFF))[(i >> 2) * 128 + (i & 3) * 16 + wr * 64 + fr]; }
        const int lane = fr + 16 * fq;
        unsigned char* ob = (unsigned char*)O + (F8 ? (size_t)(u.orow + wr * 64 + (lane >> 1)) * ldo + u.pn * 128 + wc * 32 + 16 * (lane & 1)
                                                    : ((size_t)(u.orow + wr * 64 + (lane >> 2)) * ldo + u.pn * 128 + wc * 32 + 8 * (lane & 3)) * 2);
#pragma unroll
        for (int ai = 0; ai < 2; ++ai) {
            u32x2 w8[4];
#pragma unroll
            for (int m = 0; m < 4; ++m) {
                const float s = pr.v[ai * 4 + m] * wsc, s2 = -1.4426950408889634f * s, s3 = s * s * (F8 ? osc : 1.f); float o[8];
#pragma unroll
                for (int n = 0; n < 2; ++n)
#pragma unroll
                    for (int j = 0; j < 4; j += 2) {
                        const f32x2 g2 = {acc[ai][0][m][n][j], acc[ai][0][m][n][j + 1]}, u2 = {acc[ai][1][m][n][j], acc[ai][1][m][n][j + 1]};
                        const f32x2 t2 = g2 * s2; f32x2 e2 = {__builtin_amdgcn_exp2f(t2[0]), __builtin_amdgcn_exp2f(t2[1])};
                        e2 = e2 + 1.f; const f32x2 r2 = {__builtin_amdgcn_rcpf(e2[0]), __builtin_amdgcn_rcpf(e2[1])};
                        const f32x2 o2 = ((g2 * u2) * s3) * r2; o[n * 4 + j] = o2[0]; o[n * 4 + j + 1] = o2[1]; }
                if constexpr (F8) { w8[m].x = pk4_fp8(o[0], o[1], o[2], o[3]); w8[m].y = pk4_fp8(o[4], o[5], o[6], o[7]); }
                else { u32x4 w; w.x = cvt_pk_bf16(o[0], o[1]); w.y = cvt_pk_bf16(o[2], o[3]); w.z = cvt_pk_bf16(o[4], o[5]); w.w = cvt_pk_bf16(o[6], o[7]);
                    w = quad_xpose(lds, w);
                    *(u32x4*)(ob + (size_t)(ai * 128 + m * 16) * ldo * 2) = w; }
            }
            if constexpr (F8) {
#pragma unroll
                for (int mp = 0; mp < 2; ++mp) { const u32x4 w = quad_xpose8(lds, w8[2 * mp], w8[2 * mp + 1]);
                    *(u32x4*)(ob + (size_t)(ai * 128 + mp * 32) * ldo) = w; }
            }
        }
    }
};
typedef EpiSwiGLU_T<false> EpiSwiGLU;
struct EpiRes {
    static constexpr bool PERM = true;
    static constexpr bool DMA_PRE = false;
    static constexpr int NST = 0;
    bf16_t* HB; float* ssq; unsigned char* HB8;
    typedef PreNone Pre;
    __device__ __forceinline__ Pre pre(const pg8::Unit&, int, int) const { return Pre{}; }
    __device__ __forceinline__ void operator()(const f32x4 (&acc)[2][2][4][2], const pg8::Unit& u, int wr, int wc, int fr, int fq, LAS unsigned char* lds, const Pre&) const {
        const int lane = fr + 16 * fq, rT = u.orow + wr * 64 + (lane >> 2), cT = u.pn * 256 + wc * 32 + 8 * (lane & 3);
#pragma unroll
        for (int ai = 0; ai < 2; ++ai)
#pragma unroll
            for (int m = 0; m < 4; ++m) {
                const size_t off = (size_t)(rT + ai * 128 + m * 16) * D + cT; float sq = 0.f;
#pragma unroll
                for (int bj = 0; bj < 2; ++bj) {
                    const u32x4 hb = *(const u32x4*)(HB + off + bj * 128);
                    u32x4 dw; dw.x = cvt_pk_bf16(acc[ai][bj][m][0][0], acc[ai][bj][m][0][1]); dw.y = cvt_pk_bf16(acc[ai][bj][m][0][2], acc[ai][bj][m][0][3]);
                    dw.z = cvt_pk_bf16(acc[ai][bj][m][1][0], acc[ai][bj][m][1][1]); dw.w = cvt_pk_bf16(acc[ai][bj][m][1][2], acc[ai][bj][m][1][3]);
                    dw = quad_xpose(lds, dw);
                    const unsigned hw[4] = {hb.x, hb.y, hb.z, hb.w}, dv[4] = {dw.x, dw.y, dw.z, dw.w};
                    float hv[8]; unsigned ow[4];
#pragma unroll
                    for (int k = 0; k < 4; ++k) { hv[2 * k] = __uint_as_float(hw[k] << 16) + __uint_as_float(dv[k] << 16); hv[2 * k + 1] = __uint_as_float(hw[k] & 0xffff0000u) + __uint_as_float(dv[k] & 0xffff0000u);
                        ow[k] = cvt_pk_bf16(hv[2 * k], hv[2 * k + 1]); }
                    *(u32x4*)(HB + off + bj * 128) = (u32x4){ow[0], ow[1], ow[2], ow[3]};
                    if (HB8) { u32x2 w8; w8.x = pk4_fp8(hv[0], hv[1], hv[2], hv[3]); w8.y = pk4_fp8(hv[4], hv[5], hv[6], hv[7]); *(u32x2*)(HB8 + off + bj * 128) = w8; }
#pragma unroll
                    for (int k = 0; k < 4; ++k) { const float a = __uint_as_float(ow[k] << 16), b2 = __uint_as_float(ow[k] & 0xffff0000u); sq += a * a + b2 * b2; }
                }
                if (ssq) { sq += __shfl_xor(sq, 1); sq += __shfl_xor(sq, 2);
                    if ((lane & 3) == 0) ssq[(size_t)(rT + ai * 128 + m * 16) * 16 + u.pn * 4 + wc] = sq; }
            }
    }
};
template <bool STORE>
struct EpiQKV_T {
    static constexpr bool PERM = true;
    static constexpr bool DMA_PRE = false;
    static constexpr int NST = STORE ? 16 : 0;
    bf16_t* O; const float* ssq;
    typedef Pre8 Pre;
    __device__ __forceinline__ Pre pre(const pg8::Unit& u, int, int) const { Pre p; const int tid = threadIdx.x, row = tid >> 1, part = tid & 1;
        const f32x4* q = (const f32x4*)(ssq + (size_t)(u.orow + row) * 16 + part * 8); const f32x4 a = q[0], b = q[1];
        p.v[0] = a[0]; p.v[1] = a[1]; p.v[2] = a[2]; p.v[3] = a[3]; p.v[4] = b[0]; p.v[5] = b[1]; p.v[6] = b[2]; p.v[7] = b[3]; return p; }
    __device__ __forceinline__ void operator()(const f32x4 (&acc)[2][2][4][2], const pg8::Unit& u, int wr, int wc, int fr, int fq, LAS unsigned char* lds, const Pre& pr) const {
        LAS float* rtab = (LAS float*)(lds + RTAB_OFF);
        { const int tid = threadIdx.x, row = tid >> 1, part = tid & 1;
          float s = ((pr.v[0] + pr.v[1]) + (pr.v[2] + pr.v[3])) + ((pr.v[4] + pr.v[5]) + (pr.v[6] + pr.v[7]));
          s += __shfl_xor(s, 1);
          if (part == 0) rtab[row] = 1.0f / sqrtf(s * (1.f / D) + EPS); }
        asm volatile("s_waitcnt lgkmcnt(0)" ::: "memory"); __builtin_amdgcn_s_barrier(); asm volatile("" ::: "memory");
        const float qs = (u.pn * 256 < 3072) ? 0.125f * 1.4426950408889634f : 1.f;
        const int r0 = wr * 64 + fr, lane = fr + 16 * fq;
        bf16_t* ob = O + (size_t)(u.orow + wr * 64 + (lane >> 2)) * QKV_LD + u.pn * 256 + wc * 32 + 8 * (lane & 3);
#pragma unroll
        for (int ai = 0; ai < 2; ++ai)
#pragma unroll
            for (int m = 0; m < 4; ++m) {
                const float s = rtab[ai * 128 + m * 16 + r0] * qs;
#pragma unroll
                for (int bj = 0; bj < 2; ++bj) {
                    const f32x4 v0 = acc[ai][bj][m][0] * s, v1 = acc[ai][bj][m][1] * s;
                    u32x4 w; w.x = cvt_pk_bf16(v0[0], v0[1]); w.y = cvt_pk_bf16(v0[2], v0[3]); w.z = cvt_pk_bf16(v1[0], v1[1]); w.w = cvt_pk_bf16(v1[2], v1[3]);
                    w = quad_xpose(lds, w);
                    if (STORE) *(u32x4*)(ob + (size_t)(ai * 128 + m * 16) * QKV_LD + bj * 128) = w; else asm volatile("" :: "v"(w));
                }
            }
    }
};
typedef EpiQKV_T<true> EpiQKV;
struct EpiNull {
    static constexpr bool PERM = true;
    static constexpr bool DMA_PRE = false;
    static constexpr int NST = 0;
    typedef PreNone Pre;
    __device__ __forceinline__ Pre pre(const pg8::Unit&, int, int) const { return Pre{}; }
    __device__ __forceinline__ void operator()(const f32x4 (&acc)[2][2][4][2], const pg8::Unit& u, int wr, int wc, int fr, int fq, LAS unsigned char*, const Pre&) const {
#pragma unroll
        for (int ai = 0; ai < 2; ++ai)
#pragma unroll
            for (int bj = 0; bj < 2; ++bj)
#pragma unroll
                for (int m = 0; m < 4; ++m)
#pragma unroll
                    for (int n = 0; n < 2; ++n) asm volatile("" :: "v"(acc[ai][bj][m][n]));
    }
};
struct EpiY {
    static constexpr bool PERM = true;
    static constexpr bool DMA_PRE = false;
    static constexpr int NST = 16;
    bf16_t* Y; bf16_t* Y2; int c0rows; float ysc;
    typedef PreNone Pre;
    __device__ __forceinline__ Pre pre(const pg8::Unit&, int, int) const { return Pre{}; }
    __device__ __forceinline__ void operator()(const f32x4 (&acc)[2][2][4][2], const pg8::Unit& u, int wr, int wc, int fr, int fq, LAS unsigned char* lds, const Pre&) const {
        bf16_t* Yb = u.koff ? Y2 : Y; const int lane = fr + 16 * fq;
        bf16_t* ob = Yb + (size_t)((u.koff ? u.orow - c0rows : u.orow) + wr * 64 + (lane >> 2)) * D + u.pn * 256 + wc * 32 + 8 * (lane & 3);
#pragma unroll
        for (int ai = 0; ai < 2; ++ai)
#pragma unroll
            for (int m = 0; m < 4; ++m)
#pragma unroll
                for (int bj = 0; bj < 2; ++bj) {
                    const f32x4 v0 = acc[ai][bj][m][0] * ysc, v1 = acc[ai][bj][m][1] * ysc;
                    u32x4 w; w.x = cvt_pk_bf16(v0[0], v0[1]); w.y = cvt_pk_bf16(v0[2], v0[3]); w.z = cvt_pk_bf16(v1[0], v1[1]); w.w = cvt_pk_bf16(v1[2], v1[3]);
                    w = quad_xpose(lds, w);
                    *(u32x4*)(ob + (size_t)(ai * 128 + m * 16) * D + bj * 128) = w;
                }
    }
};

constexpr int MI_CNT = 0, MI_TB = 8, MI_NT = 17, MI_SPLIT0 = 18, MI_C1 = 19;
__device__ __forceinline__ void moe_info_build(LAS unsigned char* lds, const unsigned* ctl) {
    volatile LAS int* mi = (volatile LAS int*)(lds + SCR_OFF);
    if (threadIdx.x == 0) { int tb = 0; int cn[NE];
#pragma unroll
        for (int e = 0; e < NE; ++e) cn[e] = (int)__hip_atomic_load(ctl + CW_CNT + e, RLX_AGENT);
#pragma unroll
        for (int e = 0; e < NE; ++e) { const int c = cn[e]; mi[MI_CNT + e] = c; mi[MI_TB + e] = tb; tb += (c + 255) >> 8; }
        mi[MI_TB + NE] = tb; mi[MI_NT] = tb; int c1 = tb > LAST_TILES ? tb - LAST_TILES : 0;
        { const int G = (int)gridDim.x, rounds = (c1 * 28 + G - 1) / G; int t = (rounds * G) / 28; t = t < tb - 1 ? t : tb - 1; t = t < CH0_CAP - 1 ? t : CH0_CAP - 1; if (t > c1) c1 = t; }
        mi[MI_C1] = c1; mi[MI_SPLIT0] = c1 * 256; }
    LDS_WAIT(); __syncthreads();
}
struct DynQ {
    unsigned* ctr; volatile LAS unsigned* slot;
    __device__ __forceinline__ unsigned start() const { unsigned v = 0u; if (threadIdx.x == 0) { slot[0] = blockIdx.x; v = gridDim.x + atomicAdd(ctr, 1u); } LDS_WAIT(); __syncthreads(); return v; }
    __device__ __forceinline__ void start_commit(unsigned v) const { if (threadIdx.x == 0) slot[1] = v; }
#ifdef MK_STATICQ
    __device__ __forceinline__ int fetch(int i) const { return i * (int)gridDim.x + (int)blockIdx.x; }
#else
    __device__ __forceinline__ int fetch(int i) const { return __builtin_amdgcn_readfirstlane((int)slot[i & 3]); }
#endif
    __device__ __forceinline__ unsigned refill_issue() const { unsigned v = 0u; if (threadIdx.x == 0) v = gridDim.x + atomicAdd(ctr, 1u); return v; }
    __device__ __forceinline__ void refill_commit(int ui, unsigned v) const { if (threadIdx.x == 0) slot[(ui + 2) & 3] = v; }
};
template <int NN, bool G1>
struct MoeOrder {
    DynQ q; volatile LAS int* mi; int c0, ntc; const int* ltok;
    __device__ __forceinline__ unsigned start() const { return q.start(); }
    __device__ __forceinline__ void start_commit(unsigned v) const { q.start_commit(v); }
    __device__ __forceinline__ unsigned refill_issue() const { return q.refill_issue(); }
    __device__ __forceinline__ void refill_commit(int ui, unsigned v) const { q.refill_commit(ui, v); }
    __device__ __forceinline__ bool next(int i, pg8::Unit& u) const {
        const int idx = q.fetch(i); if (idx >= ntc * NN) return false;
        constexpr int GT = G1 ? 16 : 8;
        const int grp = idx / (GT * NN), r = idx - grp * (GT * NN), gsz = (ntc - grp * GT) < GT ? (ntc - grp * GT) : GT;
        const int pml = grp * GT + r % gsz, pn = r / gsz, pmg = c0 + pml;
        int e = 0;
#pragma unroll
        for (int k = 1; k < NE; ++k) e += (pmg >= mi[MI_TB + k]) ? 1 : 0;
        e = __builtin_amdgcn_readfirstlane(e);
        u.pm = pmg; u.pn = pn; u.e = e; u.koff = 0;
        if (!G1 && NN == 8) { u.pn = pn & 3; u.koff = (pn >> 2) * (FF1 / 4); }
        const int pnb = u.pn;
        if (G1) { u.arow = (pmg - __builtin_amdgcn_readfirstlane(mi[MI_TB + e])) * 256; u.brow = e * (2 * FF1) + pn * 256; u.orow = pml * 256; }
        else { u.arow = pml * 256; u.brow = e * D + pnb * 256; u.orow = pmg * 256; }
        return true;
    }
    __device__ __forceinline__ const int* gather_src(const pg8::Unit& u, int r) const {
        const int lr = u.arow + r; const int c = mi[MI_CNT + u.e];
        return lr < c ? ltok + (size_t)u.e * T + lr : (const int*)((const char*)ltok + (WS_ZERO - WS_LTOK));
    }
    __device__ __forceinline__ unsigned gather_row(const pg8::Unit& u, int r) const {
        const int lr = u.arow + r; const int c = mi[MI_CNT + u.e];
        return lr < c ? (unsigned)ltok[(size_t)u.e * T + lr] : 0u;
    }
};
struct Args { const float* in[19]; float* out; unsigned char* ws; int ph_lo, ph_hi, li, pad; };
enum { I_X = 0, I_ANORM, I_APROJ, I_ASCALE, I_KVNORM, I_WKV, I_BNORM, I_WQ, I_WO, I_RELB, I_FFNORM, I_DWG, I_DWU, I_DWD, I_ROUTER, I_MWG, I_MWU, I_MWD, I_FNORM };
struct Frame {
    LAS unsigned char* lds; unsigned* ctl; int tid, lane, wave, G, bid;
    float* h; unsigned char* ws;
};
__device__ __forceinline__ void conv_item(const float* W, int ldw, const float* gain, bf16_t* WT, int K, int dst_row0, LAS float* scr, int k0, int n0, int lane) {
    float wv[32];
#pragma unroll
    for (int i = 0; i < 32; ++i) wv[i] = __builtin_nontemporal_load(W + (size_t)(k0 + 2 * i + (lane >> 5)) * ldw + n0 + (lane & 31));
    if (gain) {
#pragma unroll
        for (int i = 0; i < 32; ++i) wv[i] *= gain[k0 + 2 * i + (lane >> 5)];
    }
#pragma unroll
    for (int i = 0; i < 32; ++i) scr[(2 * i + (lane >> 5)) * 33 + (lane & 31)] = wv[i];
    LDS_WAIT(); asm volatile("" ::: "memory");
    const int c = lane & 7;
#pragma unroll
    for (int j = 0; j < 4; ++j) { const int n = (lane >> 3) + 8 * j; const LAS float* s = scr + (8 * c) * 33 + n;
        u32x4 o; o.x = pk2(s[0 * 33], s[1 * 33]); o.y = pk2(s[2 * 33], s[3 * 33]); o.z = pk2(s[4 * 33], s[5 * 33]); o.w = pk2(s[6 * 33], s[7 * 33]);
        *(u32x4*)(WT + (size_t)(dst_row0 + n) * K + k0 + 8 * c) = o; }
    LDS_WAIT(); asm volatile("" ::: "memory");
}
__device__ __forceinline__ void conv_job(const Frame& F, int& it0, const float* W, int K, int N, int ldw, const float* gain, bf16_t* WT, int mode, int row_off, LAS float* scr, int cg = 0) {
    const int nblk = N / 32, items = (K / 64) * nblk, NGW = (cg ? cg : F.G) * NWAVES;
    int it = it0;
    for (; it < items; it += NGW) {
        const int kb = it / nblk, nb = it - kb * nblk, n0 = nb * 32;
        const int dr = (mode == 0) ? (row_off + n0) : (row_off + (n0 >> 7) * 256 + (n0 & 127) + (mode == 2 ? 128 : 0));
        conv_item(W, ldw, gain, WT, K, dr, scr, kb * 64, n0, F.lane);
    }
    it0 = it - items;
}
__device__ __forceinline__ void conv_item8(const float* W, int ldw, const float* gain, float presc, unsigned char* WT8, int K, int dst_row0, LAS float* scr, int k0, int n0, int lane) {
    float wv[32];
#pragma unroll
    for (int i = 0; i < 32; ++i) wv[i] = W[(size_t)(k0 + 2 * i + (lane >> 5)) * ldw + n0 + (lane & 31)];
#pragma unroll
    for (int i = 0; i < 32; ++i) wv[i] *= gain ? gain[k0 + 2 * i + (lane >> 5)] * presc : presc;
#pragma unroll
    for (int i = 0; i < 32; ++i) scr[(2 * i + (lane >> 5)) * 33 + (lane & 31)] = wv[i];
    LDS_WAIT(); asm volatile("" ::: "memory");
    const int c = lane & 7;
#pragma unroll
    for (int j = 0; j < 4; ++j) { const int n = (lane >> 3) + 8 * j; const LAS float* s = scr + (8 * c) * 33 + n;
        u32x2 o; o.x = pk4_fp8(s[0 * 33], s[1 * 33], s[2 * 33], s[3 * 33]); o.y = pk4_fp8(s[4 * 33], s[5 * 33], s[6 * 33], s[7 * 33]);
        *(u32x2*)(WT8 + (size_t)(dst_row0 + n) * K + k0 + 8 * c) = o; }
    LDS_WAIT(); asm volatile("" ::: "memory");
}
__device__ __forceinline__ void conv_job8(const Frame& F, int& it0, const float* W, int K, int N, int ldw, const float* gain, float presc, unsigned char* WT8, int mode, int row_off, LAS float* scr) {
    const int nblk = N / 32, items = (K / 64) * nblk, NGW = F.G * NWAVES;
    int it = it0;
    for (; it < items; it += NGW) {
        const int kb = it / nblk, nb = it - kb * nblk, n0 = nb * 32;
        const int dr = (mode == 0) ? (row_off + n0) : (row_off + (n0 >> 7) * 256 + (n0 & 127) + (mode == 2 ? 128 : 0));
        conv_item8(W, ldw, gain, presc, WT8, K, dr, scr, kb * 64, n0, F.lane);
    }
    it0 = it - items;
}
__device__ __forceinline__ void conv_aproj(const Frame& F, const Args& A) {
    for (int p = F.bid * NTHREADS + F.tid; p < 4 * 8 * 8 * 2 * 64; p += F.G * NTHREADS) {
        const int lane = p & 63, nh = (p >> 6) & 1, ks = (p >> 7) & 7, w = (p >> 10) & 7, g = p >> 13, fr = lane & 15, fq = lane >> 4;
        const float* src = A.in[I_APROJ] + (size_t)g * 65536 + (size_t)(32 * ks + 8 * fq) * 256 + 32 * w + 16 * nh + fr;
        float v[8];
#pragma unroll
        for (int e = 0; e < 8; ++e) v[e] = src[e * 256];
        u32x4 o; o.x = pk2(v[0], v[1]); o.y = pk2(v[2], v[3]); o.z = pk2(v[4], v[5]); o.w = pk2(v[6], v[7]);
        ((u32x4*)(F.ws + WS_APT))[p] = o;
    }
}
__device__ __forceinline__ void conv_small(const Frame& F, const Args& A) {
    LAS float* scr = (LAS float*)(F.lds + RING_OFF + F.wave * 16384);
    int it = F.bid * NWAVES + F.wave;
    unsigned char* ws = F.ws;
    conv_job(F, it, A.in[I_DWG], D, FF0, FF0, A.in[I_FFNORM], (bf16_t*)(ws + WS_WGU0), 1, 0, scr);
    conv_job(F, it, A.in[I_DWU], D, FF0, FF0, A.in[I_FFNORM], (bf16_t*)(ws + WS_WGU0), 2, 0, scr);
}
__device__ __forceinline__ void conv_later(const Frame& F, const Args& A, int cb, int cg) {
    LAS float* scr = (LAS float*)(F.lds + RING_OFF + F.wave * 16384);
    int it = cb * NWAVES + F.wave;
    unsigned char* ws = F.ws;
    conv_job(F, it, A.in[I_DWD], FF0, D, D, nullptr, (bf16_t*)(ws + WS_WD0), 0, 0, scr, cg);
    conv_job(F, it, A.in[I_WQ], D, 3072, 3072, A.in[I_BNORM], (bf16_t*)(ws + WS_WQKV), 0, 0, scr, cg);
    conv_job(F, it, A.in[I_WKV], D, 6144, 6144, A.in[I_KVNORM], (bf16_t*)(ws + WS_WQKV), 0, 3072, scr, cg);
    conv_job(F, it, A.in[I_WO], D, D, D, nullptr, (bf16_t*)(ws + WS_WO), 0, 0, scr, cg);
}
#ifndef MK_CW
#define MK_CW 256
#endif
__device__ __forceinline__ void conv_moe(const Frame& F, const Args& A, int rep_ = 0) {
    if (F.bid < 4) {
        const int P = F.bid * NTHREADS + F.tid, ln = P & 63, half = (P >> 6) & 1, jj = (P >> 7) & 3, q = P >> 9, c = 4 * (ln + 64 * q) + jj;
        const f32x4 wv = *(const f32x4*)(A.in[I_ROUTER] + (size_t)c * 8 + 4 * half); const float gn = A.in[I_FFNORM][D + c];
        ((f32x4*)(F.ws + WS_RT))[P] = wv * gn;
    }
    constexpr int CW = MK_CW, NC = CW / 64, NSPL = 256 / CW, IPJ = 112 * NSPL, TOT = 24 * IPJ, TS = 144; const int lane = F.lane, w = F.wave; int par = 0;
    unsigned* tkc = F.ctl + CW_Q + 64 * 14; volatile LAS int* tks = (volatile LAS int*)(F.lds + SCR_OFF + 512);
    if (F.tid == 0) tks[0] = (int)atomicAdd(tkc, 1u);
    LDS_WAIT(); __syncthreads();
    int it = tks[0];
#pragma unroll 1
    for (; it < TOT; par ^= 1) {
        unsigned nxt_ = 0u; if (F.tid == 0) nxt_ = atomicAdd(tkc, 1u);
        const int j = it / IPJ, r = it - j * IPJ, e = j / 3, kind = j - 3 * e;
        LAS unsigned char* tl = F.lds + RING_OFF + par * (CW * TS);
        float wv[16 * NC]; int kb, n0;
        if (kind < 2) { kb = r / (14 * NSPL); n0 = (r - kb * (14 * NSPL)) * CW; const int k0 = kb * 128 + 16 * w;
            const float* src = A.in[kind ? I_MWU : I_MWG] + (size_t)e * D * FF1 + (size_t)k0 * FF1 + n0 + lane;
            const float* g = A.in[I_FFNORM] + D + k0;
#pragma unroll
            for (int i = 0; i < 16; ++i)
#pragma unroll
                for (int c = 0; c < NC; ++c) wv[i * NC + c] = __builtin_nontemporal_load(src + (size_t)i * FF1 + c * 64);
#pragma unroll
            for (int i = 0; i < 16; ++i) { const float gs = g[i] * WGU_PRESC;
#pragma unroll
                for (int c = 0; c < NC; ++c) wv[i * NC + c] *= gs; }
        } else { kb = r / (4 * NSPL); n0 = (r - kb * (4 * NSPL)) * CW; const int k0 = kb * 128 + 16 * w;
            const float* src = A.in[I_MWD] + (size_t)e * FF1 * D + (size_t)k0 * D + n0 + lane;
#pragma unroll
            for (int i = 0; i < 16; ++i)
#pragma unroll
                for (int c = 0; c < NC; ++c) wv[i * NC + c] = __builtin_nontemporal_load(src + (size_t)i * D + c * 64);
#pragma unroll
            for (int i = 0; i < 16 * NC; ++i) wv[i] *= WD_PRESC;
        }
#pragma unroll
        for (int c = 0; c < NC; ++c) { u32x4 o;
            o.x = pk4_fp8(wv[0 * NC + c], wv[1 * NC + c], wv[2 * NC + c], wv[3 * NC + c]); o.y = pk4_fp8(wv[4 * NC + c], wv[5 * NC + c], wv[6 * NC + c], wv[7 * NC + c]);
            o.z = pk4_fp8(wv[8 * NC + c], wv[9 * NC + c], wv[10 * NC + c], wv[11 * NC + c]); o.w = pk4_fp8(wv[12 * NC + c], wv[13 * NC + c], wv[14 * NC + c], wv[15 * NC + c]);
            *(LAS u32x4*)(tl + (c * 64 + lane) * TS + 16 * w) = o; }
        LDS_WAIT(); __syncthreads();
#pragma unroll
        for (int q = 0; q < NC; ++q) { const int row = (8 * NC) * w + 8 * q + (lane >> 3), n = n0 + row;
            const u32x4 o = *(const LAS u32x4*)(tl + row * TS + 16 * (lane & 7));
            unsigned char* dst = (kind < 2) ? F.ws + WS_WGU1 + (size_t)e * 2 * FF1 * D + (size_t)((n >> 7) * 256 + (n & 127) + kind * 128) * D + kb * 128 + 16 * (lane & 7)
                                            : F.ws + WS_WD1 + (size_t)e * D * FF1 + (size_t)n * FF1 + kb * 128 + 16 * (lane & 7);
#ifdef MK_CONV_NOSTORE
            if (rep_ == 0 || (o.x == 0x12345678u && o.y == 0x9abcdef0u))
#endif
            *(u32x4*)dst = o; }
        if (F.tid == 0) tks[0] = (int)nxt_;
        LDS_WAIT(); __syncthreads();
        it = tks[0];
    }
    LDS_WAIT(); __syncthreads();
}

#ifdef MK_READ_LINEAR
__device__ __forceinline__ void conv_read_linear(const Frame& F, const Args& A) {
    const int NGW = F.G * NWAVES; float acc = 0.f;
    for (int arr = 0; arr < 3; ++arr) {
        const float* W = A.in[arr == 0 ? I_MWG : (arr == 1 ? I_MWU : I_MWD)];
        constexpr int CH = (MK_READ_LINEAR == 1 ? 32 : 16) * 64 * MK_READ_LINEAR;
        const int nch = (int)((size_t)NE * D * FF1 / CH);
        for (int c = F.bid * NWAVES + F.wave; c < nch; c += NGW) {
            const float* p = W + (size_t)c * CH + F.lane * MK_READ_LINEAR;
#if MK_READ_LINEAR == 1
            float v[32];
#pragma unroll
            for (int i = 0; i < 32; ++i) v[i] = p[i * 64];
#pragma unroll
            for (int i = 0; i < 32; ++i) acc += v[i];
#else
            f32x4 v[16];
#pragma unroll
            for (int i = 0; i < 16; ++i) v[i] = *(const f32x4*)(p + i * 256);
#pragma unroll
            for (int i = 0; i < 16; ++i) acc += v[i][0] + v[i][1] + v[i][2] + v[i][3];
#endif
        }
    }
    if (acc == 1.2345678f) F.ws[WS_ZERO + 1024] = 1;
}
#endif
__device__ __forceinline__ void mixer_phase(const Frame& F, const Args& A) {
    LAS float* rs = (LAS float*)(F.lds + 0);
    LAS float* xn = (LAS float*)(F.lds + 512);
    LAS bf16_t* pl = (LAS bf16_t*)(F.lds + 512 + 80896);
    LAS float* sw = (LAS float*)(F.lds + 512 + 80896 + 33792);
    int tid_ = F.tid; asm volatile("" : "+v"(tid_));
    const int tid = tid_, lane = tid & 63, w = F.wave, fr = lane & 15, fq = lane >> 4;
    const bf16_t* apt = (const bf16_t*)(F.ws + WS_APT);
    bf16_t* hb = (bf16_t*)(F.ws + WS_S1); float* rstd1 = (float*)(F.ws + WS_RSTD1);
    for (int tile = F.bid; tile < T / 64; tile += F.G) {
        const int t0 = tile * 64, s0 = t0 % SEQ, halo = s0 ? 15 : 0, nrows = 64 + halo;
#pragma unroll 1
        for (int jb = w; jb < nrows; jb += 5 * NWAVES) {
            f32x4 rv[5][4];
#pragma unroll
            for (int u = 0; u < 5; ++u) { const int jj = jb + u * NWAVES, jc = jj < nrows ? jj : nrows - 1; const f32x4* p = (const f32x4*)(A.in[I_X] + (size_t)(t0 - halo + jc) * D);
#pragma unroll
                for (int q = 0; q < 4; ++q) rv[u][q] = p[lane + 64 * q]; }
#pragma unroll
            for (int u = 0; u < 5; ++u) { float s = 0.f;
#pragma unroll
                for (int q = 0; q < 4; ++q) { const f32x4 v = rv[u][q]; s += (v[0] * v[0] + v[1] * v[1]) + (v[2] * v[2] + v[3] * v[3]); }
                s = wave_sum(s);
                const int jj = jb + u * NWAVES;
                if (lane == 0 && jj < nrows) rs[jj] = 1.0f / sqrtf(s * (1.f / D) + EPS); }
        }
        LDS_WAIT(); __syncthreads();
        float ss[4] = {0.f, 0.f, 0.f, 0.f};
        for (int g = 0; g < 4; ++g) {
            { const f32x4 gn = *(const f32x4*)(A.in[I_ANORM] + g * 256 + 4 * lane);
              f32x4 xv[10];
#pragma unroll
              for (int u = 0; u < 10; ++u) { const int jj = w + u * NWAVES, jc = jj < nrows ? jj : nrows - 1; xv[u] = *(const f32x4*)(A.in[I_X] + (size_t)(t0 - halo + jc) * D + g * 256 + 4 * lane); }
#pragma unroll
              for (int u = 0; u < 10; ++u) { const int jj = w + u * NWAVES; if (jj < nrows) { const float r = rs[jj]; const f32x4 v = xv[u];
                  *(LAS f32x4*)(xn + jj * 256 + 4 * lane) = (f32x4){v[0] * r * gn[0], v[1] * r * gn[1], v[2] * r * gn[2], v[3] * r * gn[3]}; } } }
            LDS_WAIT(); __syncthreads();
            { const int c4 = (tid & 63) * 4, win = 2 << g, r0 = 8 * (tid >> 6);
              f32x4 a = {0.f, 0.f, 0.f, 0.f};
              { const int s = s0 + r0, cnt = (s + 1 < win) ? (s + 1) : win;
                for (int jj = 0; jj < cnt; ++jj) a += *(const LAS f32x4*)(xn + (halo + r0 - jj) * 256 + c4); }
#pragma unroll 1
              for (int i = 0; i < 8; ++i) { const int r = r0 + i, s = s0 + r, cnt = (s + 1 < win) ? (s + 1) : win;
                  const f32x4 self = *(const LAS f32x4*)(xn + (halo + r) * 256 + c4);
                  if (i > 0) { a += self; if (s >= win) a -= *(const LAS f32x4*)(xn + (halo + r - win) * 256 + c4); }
                  const float inv = 1.f / (float)cnt;
                  u32x2 o; o.x = pk2(a[0] * inv - self[0], a[1] * inv - self[1]); o.y = pk2(a[2] * inv - self[2], a[3] * inv - self[3]);
                  *(LAS u32x2*)(pl + r * 264 + c4) = o; } }
            LDS_WAIT(); __syncthreads();
            f32x4 acc[4][2];
#pragma unroll
            for (int m = 0; m < 4; ++m) { acc[m][0] = (f32x4){0.f, 0.f, 0.f, 0.f}; acc[m][1] = (f32x4){0.f, 0.f, 0.f, 0.f}; }
#pragma unroll
            for (int ks = 0; ks < 8; ++ks) {
                bf16x8 bfr[2], afr[4];
#pragma unroll
                for (int n = 0; n < 2; ++n) bfr[n] = *(const bf16x8*)(apt + (size_t)((((g * 8 + w) * 8 + ks) * 2 + n) * 64 + lane) * 8);
#pragma unroll
                for (int m = 0; m < 4; ++m) afr[m] = *(const LAS bf16x8*)(pl + (16 * m + fr) * 264 + 32 * ks + 8 * fq);
#pragma unroll
                for (int m = 0; m < 4; ++m)
#pragma unroll
                    for (int n = 0; n < 2; ++n) acc[m][n] = __builtin_amdgcn_mfma_f32_16x16x32_bf16(bfr[n], afr[m], acc[m][n], 0, 0, 0);
            }
#pragma unroll
            for (int m = 0; m < 4; ++m)
#pragma unroll
                for (int n = 0; n < 2; ++n) { const int col = g * 256 + 32 * w + 16 * n + 4 * fq; const size_t off = (size_t)(t0 + 16 * m + fr) * D + col;
                    const f32x4 sc = *(const f32x4*)(A.in[I_ASCALE] + col); const f32x4 hv = __builtin_nontemporal_load((const f32x4*)(A.in[I_X] + off)) + acc[m][n] * sc;
                    u32x2 ov; ov.x = cvt_pk_bf16(hv[0], hv[1]); ov.y = cvt_pk_bf16(hv[2], hv[3]); *(u32x2*)(hb + off) = ov;
                    const float a0 = __uint_as_float(ov.x << 16), a1 = __uint_as_float(ov.x & 0xffff0000u), a2 = __uint_as_float(ov.y << 16), a3 = __uint_as_float(ov.y & 0xffff0000u);
                    ss[m] += (a0 * a0 + a1 * a1) + (a2 * a2 + a3 * a3); }
        }
#pragma unroll
        for (int m = 0; m < 4; ++m) { float s = ss[m]; s += __shfl_xor(s, 16); s += __shfl_xor(s, 32); if (fq == 0) sw[(16 * m + fr) * 8 + w] = s; }
        LDS_WAIT(); __syncthreads();
        if (tid < 64) { float s = 0.f;
#pragma unroll
            for (int q = 0; q < 8; ++q) s += sw[tid * 8 + q];
            rstd1[t0 + tid] = 1.0f / sqrtf(s * (1.f / D) + EPS); }
        LDS_WAIT(); __syncthreads();
    }
}

__device__ __forceinline__ void router_phase(const Frame& F, const Args& A) {
    volatile LAS int* li = (volatile LAS int*)(F.lds + 0);
    volatile LAS float* lf = (volatile LAS float*)(F.lds + 2048);
    volatile LAS float* rq = (volatile LAS float*)(F.lds + 4096);
    int* ltok = (int*)(F.ws + WS_LTOK); float* lrs = (float*)(F.ws + WS_LRS); u32x4* tinfo = (u32x4*)(F.ws + WS_TOKINFO);
    int tid_ = F.tid; asm volatile("" : "+v"(tid_));
    const int tid = tid_, lane = tid & 63, w = F.wave;
    f32x4 wa[4][4], wb[4][4];
    { const f32x4* rt = (const f32x4*)(F.ws + WS_RT);
#pragma unroll
      for (int q = 0; q < 4; ++q)
#pragma unroll
          for (int j = 0; j < 4; ++j) { wa[q][j] = rt[((q * 4 + j) * 2 + 0) * 64 + lane]; wb[q][j] = rt[((q * 4 + j) * 2 + 1) * 64 + lane]; } }
    if (F.bid == 0 && tid < 128) ((u32x4*)(F.ws + WS_ZERO))[tid] = (u32x4){0u, 0u, 0u, 0u};
    for (int tile = F.bid; tile < T / 64; tile += F.G) {
        const int t0 = tile * 64;
        if (tid < 8) li[tid] = 0;
        LDS_WAIT(); __syncthreads();
        f32x4 v[4]; u32x2 vn[4];
        const bf16_t* hb = (const bf16_t*)(F.ws + WS_S1);
        { const u32x2* p = (const u32x2*)(hb + (size_t)(t0 + 8 * w) * D);
#pragma unroll
          for (int q = 0; q < 4; ++q) vn[q] = __builtin_nontemporal_load(p + lane + 64 * q); }
#pragma unroll 1
        for (int k = 0; k < 8; ++k) {
            const int tl = 8 * w + k;
#pragma unroll
            for (int q = 0; q < 4; ++q) v[q] = (f32x4){__uint_as_float(vn[q].x << 16), __uint_as_float(vn[q].x & 0xffff0000u), __uint_as_float(vn[q].y << 16), __uint_as_float(vn[q].y & 0xffff0000u)};
            if (k < 7) { const u32x2* p = (const u32x2*)(hb + (size_t)(t0 + tl + 1) * D);
#pragma unroll
                for (int q = 0; q < 4; ++q) vn[q] = __builtin_nontemporal_load(p + lane + 64 * q); }
            float s = 0.f; f32x4 la = {0.f, 0.f, 0.f, 0.f}, lb = {0.f, 0.f, 0.f, 0.f};
#pragma unroll
            for (int q = 0; q < 4; ++q) { s += (v[q][0] * v[q][0] + v[q][1] * v[q][1]) + (v[q][2] * v[q][2] + v[q][3] * v[q][3]);
#pragma unroll
                for (int j = 0; j < 4; ++j) { la += wa[q][j] * v[q][j]; lb += wb[q][j] * v[q][j]; } }
            float red[9] = {s, la[0], la[1], la[2], la[3], lb[0], lb[1], lb[2], lb[3]};
#pragma unroll
            for (int o = 1; o < 64; o <<= 1) {
#pragma unroll
                for (int e = 0; e < 9; ++e) red[e] += __shfl_xor(red[e], o); }
            if (lane == 0) {
#pragma unroll
                for (int e = 0; e < 9; ++e) rq[tl * 9 + e] = red[e]; }
        }
        LDS_WAIT();
        if (lane < 8) { const int tl = 8 * w + lane;
            const float r = 1.0f / sqrtf(rq[tl * 9] * (1.f / D) + EPS);
            float lg[8];
#pragma unroll
            for (int e = 0; e < 8; ++e) lg[e] = rq[tl * 9 + 1 + e] * r;
            float b1 = lg[0]; int i1 = 0;
#pragma unroll
            for (int e = 1; e < 8; ++e) if (lg[e] > b1) { b1 = lg[e]; i1 = e; }
            float b2 = -3.0e38f; int i2 = 0;
#pragma unroll
            for (int e = 0; e < 8; ++e) if (e != i1 && lg[e] > b2) { b2 = lg[e]; i2 = e; }
            const float e2 = expf(b2 - b1), g1 = 1.f / (1.f + e2), g2 = e2 / (1.f + e2);
            const int r1 = __hip_atomic_fetch_add((LAS int*)&li[i1], 1, __ATOMIC_RELAXED, __HIP_MEMORY_SCOPE_WORKGROUP), r2 = __hip_atomic_fetch_add((LAS int*)&li[i2], 1, __ATOMIC_RELAXED, __HIP_MEMORY_SCOPE_WORKGROUP);
            li[16 + tl * 4 + 0] = i1; li[16 + tl * 4 + 1] = i2; li[16 + tl * 4 + 2] = r1; li[16 + tl * 4 + 3] = r2;
            lf[tl * 4 + 0] = g1; lf[tl * 4 + 1] = g2; lf[tl * 4 + 2] = r;
        }
        LDS_WAIT(); __syncthreads();
        if (tid < 8) li[8 + tid] = (int)atomicAdd(F.ctl + CW_CNT + tid, (unsigned)li[tid]);
        LDS_WAIT(); __syncthreads();
        if (tid < 64) {
            const int i1 = li[16 + tid * 4 + 0], i2 = li[16 + tid * 4 + 1], s1 = li[8 + i1] + li[16 + tid * 4 + 2], s2 = li[8 + i2] + li[16 + tid * 4 + 3];
            const float g1 = lf[tid * 4 + 0], g2 = lf[tid * 4 + 1], r = lf[tid * 4 + 2];
            ltok[(size_t)i1 * T + s1] = t0 + tid; lrs[(size_t)i1 * T + s1] = r;
            ltok[(size_t)i2 * T + s2] = t0 + tid; lrs[(size_t)i2 * T + s2] = r;
            u32x4 ti; ti.x = (unsigned)(s1 << 3 | i1); ti.y = (unsigned)(s2 << 3 | i2); ti.z = __builtin_bit_cast(unsigned, g1); ti.w = __builtin_bit_cast(unsigned, g2);
            tinfo[t0 + tid] = ti;
        }
        LDS_WAIT(); __syncthreads();
    }
}

__device__ __forceinline__ void final_phase(const Frame& F, const Args& A) {
    volatile LAS int* mi = (volatile LAS int*)(F.lds + SCR_OFF);
    const u32x4* tinfo = (const u32x4*)(F.ws + WS_TOKINFO); const bf16_t* Y = (const bf16_t*)(F.ws + WS_Y);
    int lane_ = F.lane; asm volatile("" : "+v"(lane_));
    const int lane = lane_;
    f32x4 gn[4];
#pragma unroll
    for (int q = 0; q < 4; ++q) gn[q] = *(const f32x4*)(A.in[I_FNORM] + 4 * (lane + 64 * q));
    const int stride = F.G * NWAVES; int t = F.bid * NWAVES + F.wave;
    const bf16_t* Y2 = (const bf16_t*)(F.ws + WS_Y2); const bf16_t* ZR = (const bf16_t*)(F.ws + WS_ZERO);
    u32x2 hv[4], hn[4]; u32x2 ya[4], yb[4], yan[4], ybn[4], za[4], zb[4], zan[4], zbn[4]; float g1n = 0.f, g2n = 0.f;
#define FIN_ISSUE(tt, HV, YA, YB, ZA, ZB, G1, G2) do { const u32x4 ti = __builtin_nontemporal_load(tinfo + (tt)); const unsigned tx = ti.x, ty = ti.y, gz = ti.z, gw = ti.w; \
        const int e1 = tx & 7, s1 = tx >> 3, e2 = ty & 7, s2 = ty >> 3; G1 = __uint_as_float(gz); G2 = __uint_as_float(gw); \
        const size_t r1 = (size_t)mi[MI_TB + e1] * 256 + s1, r2 = (size_t)mi[MI_TB + e2] * 256 + s2; \
        const size_t sp0 = (size_t)mi[MI_SPLIT0]; const u32x2* z1_ = r1 >= sp0 ? (const u32x2*)(Y2 + (r1 - sp0) * D) : (const u32x2*)ZR; const u32x2* z2_ = r2 >= sp0 ? (const u32x2*)(Y2 + (r2 - sp0) * D) : (const u32x2*)ZR; \
        const u32x2* p_ = (const u32x2*)((const bf16_t*)(F.ws + WS_S1) + (size_t)(tt) * D); const u32x2* y1_ = (const u32x2*)(Y + r1 * D); const u32x2* y2_ = (const u32x2*)(Y + r2 * D); \
        _Pragma("unroll") for (int q = 0; q < 4; ++q) { HV[q] = __builtin_nontemporal_load(p_ + lane + 64 * q); YA[q] = __builtin_nontemporal_load(y1_ + lane + 64 * q); YB[q] = __builtin_nontemporal_load(y2_ + lane + 64 * q); }   \
        if (r1 >= sp0) { _Pragma("unroll") for (int q = 0; q < 4; ++q) ZA[q] = __builtin_nontemporal_load(z1_ + lane + 64 * q); } else { _Pragma("unroll") for (int q = 0; q < 4; ++q) ZA[q] = (u32x2){0u, 0u}; } \
        if (r2 >= sp0) { _Pragma("unroll") for (int q = 0; q < 4; ++q) ZB[q] = __builtin_nontemporal_load(z2_ + lane + 64 * q); } else { _Pragma("unroll") for (int q = 0; q < 4; ++q) ZB[q] = (u32x2){0u, 0u}; } } while (0)
    if (t < T) FIN_ISSUE(t, hn, yan, ybn, zan, zbn, g1n, g2n);
    for (; t < T; t += stride) {
        const float g1 = g1n, g2 = g2n;
#pragma unroll
        for (int q = 0; q < 4; ++q) { hv[q] = hn[q]; ya[q] = yan[q]; yb[q] = ybn[q]; za[q] = zan[q]; zb[q] = zbn[q]; }
        if (t + stride < T) FIN_ISSUE(t + stride, hn, yan, ybn, zan, zbn, g1n, g2n);
        f32x4 v[4]; float s = 0.f;
#pragma unroll
        for (int q = 0; q < 4; ++q) { const u32x2 a = ya[q], b = yb[q], a2 = za[q], b2 = zb[q];
            f32x4 o;
            o[0] = __uint_as_float(hv[q].x << 16) + g1 * (bf2f((unsigned short)(a.x & 0xffff)) + bf2f((unsigned short)(a2.x & 0xffff))) + g2 * (bf2f((unsigned short)(b.x & 0xffff)) + bf2f((unsigned short)(b2.x & 0xffff)));
            o[1] = __uint_as_float(hv[q].x & 0xffff0000u) + g1 * (bf2f((unsigned short)(a.x >> 16)) + bf2f((unsigned short)(a2.x >> 16))) + g2 * (bf2f((unsigned short)(b.x >> 16)) + bf2f((unsigned short)(b2.x >> 16)));
            o[2] = __uint_as_float(hv[q].y << 16) + g1 * (bf2f((unsigned short)(a.y & 0xffff)) + bf2f((unsigned short)(a2.y & 0xffff))) + g2 * (bf2f((unsigned short)(b.y & 0xffff)) + bf2f((unsigned short)(b2.y & 0xffff)));
            o[3] = __uint_as_float(hv[q].y & 0xffff0000u) + g1 * (bf2f((unsigned short)(a.y >> 16)) + bf2f((unsigned short)(a2.y >> 16))) + g2 * (bf2f((unsigned short)(b.y >> 16)) + bf2f((unsigned short)(b2.y >> 16)));
            v[q] = o; s += (o[0] * o[0] + o[1] * o[1]) + (o[2] * o[2] + o[3] * o[3]); }
        s = wave_sum(s);
        const float r = 1.0f / sqrtf(s * (1.f / D) + EPS);
        f32x4* p = (f32x4*)(F.h + (size_t)t * D);
#pragma unroll
        for (int q = 0; q < 4; ++q) __builtin_nontemporal_store((f32x4){v[q][0] * r * gn[q][0], v[q][1] * r * gn[q][1], v[q][2] * r * gn[q][2], v[q][3] * r * gn[q][3]}, p + lane + 64 * q);
    }
#undef FIN_ISSUE
}

__device__ __forceinline__ int t5_bucket(int n) {
    if (n < 16) return n;
    int large = 16 + (int)(log((double)n / 16.0) / log(128.0) * 16.0);
    return large < 31 ? large : 31;
}
typedef float f32x16 __attribute__((ext_vector_type(16)));
typedef short s16x4 __attribute__((ext_vector_type(4)));
constexpr int AT_TAB = 0;
constexpr int AT_BKT = 7680;
constexpr int AT_CNT = 9472;
constexpr int AT_V = 10240;
constexpr int AT_VH = 2048 + 128, AT_VS = 4352;
constexpr int AT_K = AT_V + 8 * AT_VS;
constexpr int AT_KS = 144;
constexpr float L2E = 1.4426950408889634f;
constexpr float AT_THR = 8.f;
constexpr size_t WS_AST_O = WS_POOL + 291 * MiB;
constexpr size_t WS_AST_M = WS_AST_O + 64 * MiB;
static_assert(WS_AST_M + 4 * MiB <= WS_END, "attention scratch");
constexpr unsigned PITCHB = QKV_LD * 2;
__device__ __forceinline__ s16x4 vtr(const LAS unsigned char* p) { return __builtin_bit_cast(s16x4, __builtin_amdgcn_ds_read_tr16_b64_v4i16((LAS s16x4*)p)); }
__device__ __forceinline__ float max3f(float a, float b, float c) { return fmaxf(fmaxf(a, b), c); }

#define AT_LOADS(KR, VR, ub, kvo) do { const unsigned ub_ = (ub); if (MODE == 7 && at_inloop) break; \
        _Pragma("unroll") for (int i = 0; i < 4; ++i) KR[i] = __builtin_bit_cast(u32x4, __builtin_amdgcn_raw_buffer_load_b128(rsrc, (kvo)[i], ub_, 0)); \
        _Pragma("unroll") for (int i = 0; i < 4; ++i) VR[i] = __builtin_bit_cast(u32x4, __builtin_amdgcn_raw_buffer_load_b128(rsrc, (kvo)[i], ub_ + 6144u, 0)); } while (0)
#define AT_SCORE(KR, VR, QF, tla) \
        _Pragma("unroll") for (int i = 0; i < 4; ++i) { *(LAS u32x4*)(kwr + i * (8 * AT_KS)) = KR[i]; *(LAS u32x4*)(vwr + i * 512) = VR[i]; } \
        { const LAS float* tl_ = (const LAS float*)(tla); _Pragma("unroll") for (int r = 0; r < 16; ++r) s[r] = tl_[(r & 3) + 8 * (r >> 2)]; } \
        LDS_WAIT(); \
        { bf16x8 kf_[4]; _Pragma("unroll") for (int d0 = 0; d0 < 4; ++d0) kf_[d0] = *(const LAS bf16x8*)(krd + 32 * d0); \
          if (MODE != 5) { _Pragma("unroll") for (int d0 = 0; d0 < 4; ++d0) s = __builtin_amdgcn_mfma_f32_32x32x16_bf16(kf_[d0], QF[d0], s, 0, 0, 0); } \
          else { _Pragma("unroll") for (int d0 = 0; d0 < 4; ++d0) { s[d0] += __builtin_bit_cast(float, (int)kf_[d0][0] | ((int)QF[d0][1] << 16)); } } }
#define AT_QLOAD(QF, dil, ubq, colb, jrow) do { u32x4 qr_[4]; \
        _Pragma("unroll") for (int i = 0; i < 4; ++i) qr_[i] = __builtin_bit_cast(u32x4, __builtin_amdgcn_raw_buffer_load_b128(rsrc, (unsigned)((dil) * (8 * i + (lane >> 3))) * PITCHB + ((colb) + h * 64 + 8 * (lane & 7)) * 2, (ubq), 2));   \
        _Pragma("unroll") for (int i = 0; i < 4; ++i) *(LAS u32x4*)(kwr + i * (8 * AT_KS)) = qr_[i]; \
        LDS_WAIT(); \
        _Pragma("unroll") for (int d0 = 0; d0 < 4; ++d0) QF[d0] = *(const LAS bf16x8*)(kbuf + (jrow) * AT_KS + 16 * hi + 32 * d0); \
        LDS_WAIT(); } while (0)
#define AT_SOFTPV() do { if (MODE == 6) { o0[0] += s[0]; break; } \
        float rm = fmaxf(max3f(max3f(s[0], s[1], s[2]), max3f(s[3], s[4], s[5]), max3f(s[6], s[7], s[8])), max3f(max3f(s[9], s[10], s[11]), max3f(s[12], s[13], s[14]), s[15])); \
        { auto rr = __builtin_amdgcn_permlane32_swap(__float_as_uint(rm), __float_as_uint(rm), false, false); rm = fmaxf(__uint_as_float(rr[0]), __uint_as_float(rr[1])); } \
        if (__any(rm > M + AT_THR)) { const float Mn = fmaxf(M, rm), al = __builtin_amdgcn_exp2f(M - Mn); M = Mn; l *= al;   \
            _Pragma("unroll") for (int r = 0; r < 16; ++r) { o0[r] *= al; o1[r] *= al; } } \
        float ps0 = 0.f, ps1 = 0.f; \
        _Pragma("unroll") for (int r = 0; r < 16; r += 2) { if (MODE != 3) { s[r] = __builtin_amdgcn_exp2f(s[r] - M); s[r + 1] = __builtin_amdgcn_exp2f(s[r + 1] - M); } else { s[r] = s[r] - M; s[r + 1] = s[r + 1] - M; } ps0 += s[r]; ps1 += s[r + 1]; } \
        l += ps0 + ps1; \
        u32x4 pw0, pw1; \
        pw0.x = cvt_pk_bf16(s[0], s[1]); pw0.y = cvt_pk_bf16(s[2], s[3]); pw0.z = cvt_pk_bf16(s[4], s[5]); pw0.w = cvt_pk_bf16(s[6], s[7]); \
        pw1.x = cvt_pk_bf16(s[8], s[9]); pw1.y = cvt_pk_bf16(s[10], s[11]); pw1.z = cvt_pk_bf16(s[12], s[13]); pw1.w = cvt_pk_bf16(s[14], s[15]); \
        const bf16x8 pa0 = __builtin_bit_cast(bf16x8, pw0), pa1 = __builtin_bit_cast(bf16x8, pw1); \
        LDS_WAIT(); \
        if (MODE == 4) { o0[0] += __builtin_bit_cast(float, pw0.x); o1[0] += __builtin_bit_cast(float, pw1.y); } else { \
        { const s16x4 a0 = vtr(vrd), a1 = vtr(vrd + 512), b0 = vtr(vrd + 1024), b1 = vtr(vrd + 1536); \
          const bf16x8 v0 = (bf16x8){a0[0], a0[1], a0[2], a0[3], a1[0], a1[1], a1[2], a1[3]}, v1 = (bf16x8){b0[0], b0[1], b0[2], b0[3], b1[0], b1[1], b1[2], b1[3]}; \
          o0 = __builtin_amdgcn_mfma_f32_32x32x16_bf16(v0, pa0, o0, 0, 0, 0); o0 = __builtin_amdgcn_mfma_f32_32x32x16_bf16(v1, pa1, o0, 0, 0, 0); } \
        { const s16x4 a0 = vtr(vrd + AT_VH), a1 = vtr(vrd + AT_VH + 512), b0 = vtr(vrd + AT_VH + 1024), b1 = vtr(vrd + AT_VH + 1536); \
          const bf16x8 v0 = (bf16x8){a0[0], a0[1], a0[2], a0[3], a1[0], a1[1], a1[2], a1[3]}, v1 = (bf16x8){b0[0], b0[1], b0[2], b0[3], b1[0], b1[1], b1[2], b1[3]}; \
          o1 = __builtin_amdgcn_mfma_f32_32x32x16_bf16(v0, pa0, o1, 0, 0, 0); o1 = __builtin_amdgcn_mfma_f32_32x32x16_bf16(v1, pa1, o1, 0, 0, 0); } } \
    } while (0)

#ifdef MK_ATT_TS
#define AT_TS(k) do { __builtin_amdgcn_sched_barrier(0); unsigned long long t_; asm volatile("s_memtime %0\n\ts_waitcnt lgkmcnt(0)" : "=s"(t_) :: "memory"); ts_acc[k] += t_ - ts_prev; ts_prev = t_; __builtin_amdgcn_sched_barrier(0); } while (0)
#else
#define AT_TS(k) do { } while (0)
#endif
template <int MODE>
__device__ __forceinline__ void attn_phase(const Frame& F, const Args& A, unsigned long long* ts_out = nullptr) {
#ifdef MK_ATT_TS
    unsigned long long ts_acc[6] = {0, 0, 0, 0, 0, 0}, ts_prev = 0;
    { unsigned long long t_; asm volatile("s_memtime %0\n\ts_waitcnt lgkmcnt(0)" : "=s"(t_) :: "memory"); ts_prev = t_; }
#endif
    LAS float* tab = (LAS float*)(F.lds + AT_TAB);
    const char* qkvb = (const char*)(F.ws + WS_QKV); bf16_t* mo = (bf16_t*)(F.ws + (MODE == 0 ? WS_S0 : WS_WGU0));
    float* sto = (float*)(F.ws + WS_AST_O); float* stm = (float*)(F.ws + WS_AST_M);
    int lane_ = F.lane; asm volatile("" : "+v"(lane_));
    const int lane = lane_, w = F.wave, j = lane & 31, hi = lane >> 5;
    LAS unsigned char* vbuf = F.lds + AT_V + w * AT_VS;
    LAS unsigned char* vwr = vbuf + ((lane & 7) >> 2) * AT_VH + (lane >> 3) * 64 + (lane & 3) * 16;
    LAS unsigned char* kbuf = F.lds + AT_K + w * (32 * AT_KS);
    LAS unsigned char* kwr = kbuf + (lane >> 3) * AT_KS + (lane & 7) * 16;
    const LAS unsigned char* krd = kbuf + j * AT_KS + 16 * hi;
    const LAS unsigned char* vrd = vbuf + (4 * hi + ((lane & 15) >> 2)) * 64 + ((lane >> 4) & 1) * 32 + (lane & 3) * 8;
    volatile LAS int* bkt = (volatile LAS int*)(F.lds + AT_BKT);
    volatile LAS int* acnt = (volatile LAS int*)(F.lds + AT_CNT);
    for (int i = F.tid; i < 3 * 129; i += NTHREADS) { const int g = i / 129, m = i - g * 129; bkt[i] = t5_bucket(m * (g == 0 ? 1 : (g == 1 ? 4 : 16))); }
    LDS_WAIT(); __syncthreads();
    const __amdgpu_buffer_rsrc_t rsrc = __builtin_amdgcn_make_buffer_rsrc((void*)(F.ws + WS_QKV), 0, (int)((size_t)T * PITCHB), 0x00020000);
    for (int it = 0; ; ++it) {
        int b, h, cp;
        { const int u = ((F.G & 7) == 0) ? ((F.bid & 7) * (F.G >> 3) + (F.bid >> 3)) + it * F.G : F.bid + it * F.G;
          if (u >= 256) break;
          b = u >> 5; h = (u >> 1) & 15; cp = u & 1; }
        const int tb = b * SEQ;
        __syncthreads();
        if (F.tid < 4) acnt[F.tid] = 0;
        { float tv[4];
#pragma unroll
          for (int u = 0; u < 4; ++u) { const int i = F.tid + u * NTHREADS, ic = i < 3 * 640 ? i : 3 * 640 - 1, g = ic / 640, m = 383 - (ic - g * 640), mc = m < 0 ? 0 : (m > 128 ? 128 : m);
              const float bv = A.in[I_RELB][bkt[g * 129 + mc] * 48 + g * 16 + h]; tv[u] = (m >= 0 && m <= 128) ? bv * L2E : -1e30f; }
#pragma unroll
          for (int u = 0; u < 4; ++u) { const int i = F.tid + u * NTHREADS; if (i < 3 * 640) tab[i] = tv[u]; } }
        LDS_WAIT(); __syncthreads();
        AT_TS(5);
        const int c = 2 * cp + (w & 1);
        f32x16 o0, o1, s; float M, l;
        u32x4 kfA[4], kfB[4]; u32x4 vrA[4], vrB[4]; bool at_inloop = false;
#pragma unroll 1
        for (int rd = 0; rd < 4; ++rd) {
            const int r16 = c + 4 * (w >> 1), nt = rd + 1;
            const size_t tq = (size_t)(tb + 16 * (32 * rd + j) + r16);
            bf16x8 qf[4];
            AT_QLOAD(qf, 16, (unsigned)(tb + 16 * 32 * rd + r16) * PITCHB, 2 * 1024, j);
            unsigned kvo[4];
#pragma unroll
            for (int i = 0; i < 4; ++i) kvo[i] = (unsigned)(16 * (8 * i + (lane >> 3))) * PITCHB + (3072 + 2 * 1024 + h * 64 + 8 * (lane & 7)) * 2;
            const unsigned ub = (unsigned)(tb + r16) * PITCHB, ustep = (unsigned)(16 * 32) * PITCHB;
            const LAS float* tla = tab + 2 * 640 + 383 - (32 * rd + j) + 4 * hi;
#pragma unroll
            for (int r = 0; r < 16; ++r) { o0[r] = 0.f; o1[r] = 0.f; }
            M = -1e29f; l = 0.f;
#define AT_LOADA(m, KF, VR) do { int m_ = (m); m_ = m_ < nt ? m_ : nt - 1; if (MODE == 1) m_ = 0; AT_LOADS(KF, VR, ub + (unsigned)m_ * ustep, kvo); } while (0)
            at_inloop = false; AT_LOADA(0, kfA, vrA); __builtin_amdgcn_sched_barrier(0); AT_LOADA(1, kfB, vrB); __builtin_amdgcn_sched_barrier(0); at_inloop = true;
            AT_TS(0);
            int n = 0;
#pragma unroll 1
            for (; n + 1 < nt; n += 2) {
                AT_SCORE(kfA, vrA, qf, tla + 32 * n)
                AT_LOADA(n + 2, kfA, vrA);
                AT_SOFTPV();
                AT_SCORE(kfB, vrB, qf, tla + 32 * (n + 1))
                AT_LOADA(n + 3, kfB, vrB);
                AT_SOFTPV();
            }
            if (n < nt) { AT_SCORE(kfA, vrA, qf, tla + 32 * n) AT_SOFTPV(); }
            AT_TS(1);
#undef AT_LOADA
            const size_t blk = (size_t)(((b * 16 + h) * 16 + r16) * 4 + rd);
            float* so = sto + blk * 2048 + lane * 4;
#pragma unroll
            for (int r = 0; r < 16; r += 4) { *(f32x4*)(so + (r >> 2) * 256) = (f32x4){o0[r], o0[r + 1], o0[r + 2], o0[r + 3]}; *(f32x4*)(so + (4 + (r >> 2)) * 256) = (f32x4){o1[r], o1[r + 1], o1[r + 2], o1[r + 3]}; }
            *(f32x2*)(stm + (blk * 64 + lane) * 2) = (f32x2){M, l};
            VM_WAIT();
            if (lane == 0) __hip_atomic_fetch_add((LAS int*)&acnt[rd], 1, __ATOMIC_RELAXED, __HIP_MEMORY_SCOPE_WORKGROUP);
            AT_TS(2);
        }
        AT_TS(3);
#pragma unroll 1
        for (int rd = 0; rd < 4; ++rd) {
            const int i0 = 32 * (4 * rd + (w >> 1));
            const int ktlo0 = (4 - i0 / 8) > 0 ? (4 - i0 / 8) : 0, n0 = 8 - ktlo0;
            const int ktlo1 = (4 - i0 / 32) > 0 ? (4 - i0 / 32) : 0, n1 = 5 - ktlo1, ntl = n0 + n1;
            const int jq = 4 * (j & 7) + (j >> 3);
            const size_t tq = (size_t)(tb + 4 * (i0 + jq) + c);
            bf16x8 qf0[4], qf1[4];
            AT_QLOAD(qf0, 4, (unsigned)(tb + 4 * i0 + c) * PITCHB, 0, jq); AT_QLOAD(qf1, 4, (unsigned)(tb + 4 * i0 + c) * PITCHB, 1024, jq);
            while (__builtin_amdgcn_readfirstlane(acnt[rd]) < NWAVES) __builtin_amdgcn_s_sleep(2);
            asm volatile("" ::: "memory");
            const size_t blk = (size_t)(((b * 16 + h) * 16 + 4 * (j >> 3) + c) * 4 + rd); const int laneA = 32 * hi + 8 * (w >> 1) + (j & 7);
            { const float* so = sto + blk * 2048 + laneA * 4;
#pragma unroll
              for (int r = 0; r < 16; r += 4) { const f32x4 a = __builtin_nontemporal_load((const f32x4*)(so + (r >> 2) * 256)), bq = __builtin_nontemporal_load((const f32x4*)(so + (4 + (r >> 2)) * 256));
                  o0[r] = a[0]; o0[r + 1] = a[1]; o0[r + 2] = a[2]; o0[r + 3] = a[3]; o1[r] = bq[0]; o1[r + 1] = bq[1]; o1[r + 2] = bq[2]; o1[r + 3] = bq[3]; }
              const f32x2 ml = *(const f32x2*)(stm + (blk * 64 + laneA) * 2); M = ml[0]; l = ml[1]; }
            const int kb0 = 4 * i0 - 128 + 32 * ktlo0, ik1 = i0 - 128 + 32 * ktlo1;
            unsigned kvo0[4], kvo1[4];
#pragma unroll
            for (int i = 0; i < 4; ++i) { kvo0[i] = (unsigned)(8 * i + (lane >> 3)) * PITCHB + (3072 + h * 64 + 8 * (lane & 7)) * 2;
                                          kvo1[i] = (unsigned)(4 * (8 * i + (lane >> 3))) * PITCHB + (3072 + 1024 + h * 64 + 8 * (lane & 7)) * 2; }
            const unsigned ub0 = (unsigned)(tb + kb0) * PITCHB, ub1 = (unsigned)(tb + 4 * ik1 + c) * PITCHB;
            const unsigned us0 = 32u * PITCHB, us1 = 128u * PITCHB;
            const LAS float* tla0 = tab + 383 - (4 * (i0 + jq) + c - kb0) + 4 * hi;
            const LAS float* tla1 = tab + 640 + 383 - (i0 + jq - ik1) + 4 * hi;
#define AT_LOADN(m, KF, VR) do { int m_ = (m); m_ = m_ < ntl ? m_ : ntl - 1; const bool d1_ = m_ < n0; \
            const unsigned ubs_ = d1_ ? ub0 + (unsigned)(MODE == 1 ? 0 : m_) * us0 : ub1 + (unsigned)(MODE == 1 ? 0 : m_ - n0) * us1; \
            unsigned vo_[4]; \
            _Pragma("unroll") for (int i_ = 0; i_ < 4; ++i_) vo_[i_] = d1_ ? kvo0[i_] : kvo1[i_]; \
            AT_LOADS(KF, VR, ubs_, vo_); } while (0)
#define AT_STEPN(n, KF, VR, PF) do { const int n_ = (n); if (n_ < n0) { AT_SCORE(KF, VR, qf0, tla0 + 32 * n_) } else { AT_SCORE(KF, VR, qf1, tla1 + 32 * (n_ - n0)) } \
            if (PF) AT_LOADN(n_ + 2, KF, VR); AT_SOFTPV(); } while (0)
            at_inloop = false; AT_LOADN(0, kfA, vrA); __builtin_amdgcn_sched_barrier(0); AT_LOADN(1, kfB, vrB); __builtin_amdgcn_sched_barrier(0); at_inloop = true;
            AT_TS(0);
            int n = 0;
#pragma unroll 1
            for (; n + 1 < ntl; n += 2) { AT_STEPN(n, kfA, vrA, true); AT_STEPN(n + 1, kfB, vrB, true); }
            if (n < ntl) AT_STEPN(n, kfA, vrA, false);
            AT_TS(4);
#undef AT_STEPN
#undef AT_LOADN
            { auto rr = __builtin_amdgcn_permlane32_swap(__float_as_uint(l), __float_as_uint(l), false, false); l = __uint_as_float(rr[0]) + __uint_as_float(rr[1]); }
            const float il = 1.0f / l;
#pragma unroll
            for (int gq = 0; gq < 4; ++gq) {
                u32x2 w0, w1;
                w0.x = cvt_pk_bf16(o0[4 * gq] * il, o0[4 * gq + 1] * il); w0.y = cvt_pk_bf16(o0[4 * gq + 2] * il, o0[4 * gq + 3] * il);
                w1.x = cvt_pk_bf16(o1[4 * gq] * il, o1[4 * gq + 1] * il); w1.y = cvt_pk_bf16(o1[4 * gq + 2] * il, o1[4 * gq + 3] * il);
                *(LAS u32x2*)(kbuf + jq * AT_KS + 8 * hi + 16 * gq) = w0; *(LAS u32x2*)(kbuf + jq * AT_KS + 64 + 8 * hi + 16 * gq) = w1;
            }
            LDS_WAIT();
#pragma unroll
            for (int i = 0; i < 4; ++i) { const int r = 8 * i + (lane >> 3);
                const u32x4 v = *(const LAS u32x4*)(kbuf + r * AT_KS + 16 * (lane & 7));
                *(u32x4*)(mo + (size_t)(tb + 4 * (i0 + r) + c) * D + h * 64 + 8 * (lane & 7)) = v; }
            LDS_WAIT();
            AT_TS(2);
        }
    }
#ifdef MK_ATT_TS
    if (ts_out && F.tid == 0) { for (int k = 0; k < 6; ++k) ts_out[k] = ts_acc[k]; }
#endif
    __syncthreads();
}
#undef AT_LOADS
#undef AT_SCORE
#undef AT_SOFTPV
constexpr int PH_MIX = 0, PH_FF1 = 1, PH_FF2 = 2, PH_QKV = 3, PH_ATT = 4, PH_WO = 5, PH_ROUTE = 6, PH_MOE0 = 7, PH_FINAL = 10, PH_END = 11;

__global__ void __launch_bounds__(NTHREADS, 2) mk_fwd(Args args) {
    extern __shared__ __attribute__((aligned(16))) unsigned char lds_raw[];
    Frame F;
    F.lds = (LAS unsigned char*)lds_raw;
    F.tid = threadIdx.x; F.lane = F.tid & 63; F.wave = __builtin_amdgcn_readfirstlane(F.tid >> 6); F.G = gridDim.x; F.bid = blockIdx.x;
    F.ws = args.ws; F.ctl = (unsigned*)(args.ws + WS_CTL); F.h = args.out;
    volatile LAS unsigned* MISC = (volatile LAS unsigned*)(F.lds + MISC_OFF);
    for (int u = F.tid; u < 64; u += NTHREADS) MISC[u] = 0u;
    __syncthreads();
    XcdBarrier bar = xcd_barrier_post(F.ctl + CW_BAR + args.li * XCD_BAR_WORDS, MISC + 8);
    const int lo = args.ph_lo, hi = args.ph_hi;
#ifndef MK_MASK
#define MK_MASK 0xffffffffu
#endif
#define IN(k) (((MK_MASK >> (k)) & 1u) && lo <= (k) && (k) < hi)
#define SEAM(k) do { if (IN(k) && IN((k) + 1)) xcd_barrier(bar); } while (0)
    unsigned char* ws = args.ws;
    LAS unsigned char* ring = F.lds + RING_OFF;
#ifdef MK_PROBE_LO
    unsigned long long pr_t0 = 0, pr_t1 = 0;
#define PROBE_AT(k) do { if ((k) == MK_PROBE_LO) pr_t0 = __builtin_amdgcn_s_memrealtime(); if ((k) == MK_PROBE_HI) pr_t1 = __builtin_amdgcn_s_memrealtime(); } while (0)
#else
#define PROBE_AT(k) do { } while (0)
#endif

    PROBE_AT(0);
    if (IN(PH_MIX)) { conv_aproj(F, args); conv_small(F, args); VM_WAIT(); __syncthreads(); }
    PROBE_AT(20);
    if (IN(PH_MIX)) { xcd_barrier(bar); PROBE_AT(21); mixer_phase(F, args); }
    PROBE_AT(22);
    SEAM(PH_MIX);

    PROBE_AT(1);
    if (IN(PH_FF1)) {
        pg8::Gemm g{(const bf16_t*)(ws + WS_S1), (const bf16_t*)(ws + WS_WGU0), D, D, D}; pg8::StaticOrder S; S.init(T, 2 * FF0, F.G, F.bid);
        EpiSwiGLU E{(bf16_t*)(ws + WS_ACT0), ACT0_LD, (const float*)(ws + WS_RSTD1), 1.f, 1.f};
        pg8::gemm_phase<EpiSwiGLU, pg8::StaticOrder, false>(ring, g, S, E);
        { const int units = (T / 256) * (2 * FF0 / 256), rem = units % F.G;
          if (rem == 0) conv_later(F, args, F.bid, F.G); else if (F.bid >= rem) conv_later(F, args, F.bid - rem, F.G - rem); }
    }
    SEAM(PH_FF1);
    PROBE_AT(2);
    if (IN(PH_FF2)) {
        pg8::Gemm g{(const bf16_t*)(ws + WS_ACT0), (const bf16_t*)(ws + WS_WD0), FF0, ACT0_LD, FF0}; pg8::StaticOrder S; S.init(T, D, F.G, F.bid);
        EpiRes E{(bf16_t*)(ws + WS_S1), (float*)(ws + WS_SSQ), nullptr};
        pg8::gemm_phase<EpiRes, pg8::StaticOrder, false>(ring, g, S, E);
    }
    SEAM(PH_FF2);
    PROBE_AT(3);
    if (IN(PH_QKV)) {
        pg8::Gemm g{(const bf16_t*)(ws + WS_S1), (const bf16_t*)(ws + WS_WQKV), D, D, D}; pg8::StaticOrder S; S.init(T, NQKV, F.G, F.bid);
        EpiQKV E{(bf16_t*)(ws + WS_QKV), (const float*)(ws + WS_SSQ)};
        pg8::gemm_phase<EpiQKV, pg8::StaticOrder, false>(ring, g, S, E);
#if defined(MK_QKV_EXTRA) && MK_QKV_EXTRA == 1
        pg8::gemm_phase<EpiQKV, pg8::StaticOrder, false>(ring, g, S, E);
#elif defined(MK_QKV_EXTRA) && MK_QKV_EXTRA == 4
        { EpiNull EN; pg8::gemm_phase_ref<EpiNull, pg8::StaticOrder>(ring, g, S, EN); }
#elif defined(MK_QKV_EXTRA) && MK_QKV_EXTRA == 3
        { EpiQKV_T<false> EN{(bf16_t*)(ws + WS_QKV), (const float*)(ws + WS_SSQ)}; pg8::gemm_phase<EpiQKV_T<false>, pg8::StaticOrder, false>(ring, g, S, EN); }
#elif defined(MK_QKV_EXTRA) && MK_QKV_EXTRA == 2
        { EpiNull EN; pg8::gemm_phase<EpiNull, pg8::StaticOrder, false>(ring, g, S, EN); }
#endif
    }
    SEAM(PH_QKV);
        PROBE_AT(4);
#ifdef MK_ATT_TS
    unsigned long long att_ts[6] = {0, 0, 0, 0, 0, 0};
    if (IN(PH_ATT)) { attn_phase<0>(F, args, att_ts);
#else
    if (IN(PH_ATT)) { attn_phase<0>(F, args);
#endif
#ifdef MK_ATT_EXTRA
        attn_phase<MK_ATT_EXTRA>(F, args);
#endif
    }
    SEAM(PH_ATT);
    PROBE_AT(5);
    if (IN(PH_WO)) {
        const int gh = (F.G >= 2 && (F.G & 1) == 0) ? F.G / 2 : F.G;
        if (F.bid < gh) {
            pg8::Gemm g{(const bf16_t*)(ws + WS_S0), (const bf16_t*)(ws + WS_WO), D, D, D}; pg8::StaticOrder S; S.init(T, D, gh, F.bid);
            EpiRes E{(bf16_t*)(ws + WS_S1), nullptr, ws + WS_H8};
            pg8::gemm_phase<EpiRes, pg8::StaticOrder, false>(ring, g, S, E);
        }
        conv_moe(F, args);
#ifdef MK_READ_LINEAR
        for (int rep = 0; rep < 2; ++rep) { __syncthreads(); conv_read_linear(F, args); }
#endif
#ifdef MK_CONV_EXTRA
        for (int rep = 0; rep < MK_CONV_EXTRA; ++rep) { __syncthreads(); conv_moe(F, args, rep + 1); }
#endif
    }
    SEAM(PH_WO);
    PROBE_AT(6);
    if (IN(PH_ROUTE)) { router_phase(F, args); }
    SEAM(PH_ROUTE);
#pragma unroll 1
    for (int j = 0; j < 3; ++j) {
        PROBE_AT(7 + j);
        if (IN(PH_MOE0 + j)) {
            moe_info_build(F.lds, F.ctl);
            volatile LAS int* mi = (volatile LAS int*)(F.lds + SCR_OFF);
            const int ntiles = __builtin_amdgcn_readfirstlane(mi[MI_NT]);
            const int c1s = __builtin_amdgcn_readfirstlane(mi[MI_C1]);
            if (j >= 1) {
                const int c0 = j == 1 ? 0 : c1s; const int ntc = j == 1 ? c1s : ntiles - c1s;
                EpiY E{(bf16_t*)(ws + WS_Y), (bf16_t*)(ws + WS_Y2), c0 * 256, 1.f / (WD_PRESC * ACT_PRESC)};
                if (j == 2) {
                    pg8::Gemm g{(const bf16_t*)(ws + WS_ACT1 + ACT1_B1), (const bf16_t*)(ws + WS_WD1), FF1 / 4, FF1 / 2, FF1 / 2};
                    MoeOrder<8, false> S{{F.ctl + CW_Q + 64 * (2 * j), MISC + 16}, mi, c0, ntc, nullptr};
                    pg8::gemm_phase<EpiY, MoeOrder<8, false>, false, true>(ring, g, S, E);
                } else {
                    pg8::Gemm g{(const bf16_t*)(ws + WS_ACT1), (const bf16_t*)(ws + WS_WD1), FF1 / 2, FF1 / 2, FF1 / 2};
                    MoeOrder<4, false> S{{F.ctl + CW_Q + 64 * (2 * j), MISC + 16}, mi, c0, ntc, nullptr};
                    pg8::gemm_phase<EpiY, MoeOrder<4, false>, false, true>(ring, g, S, E);
                }
            }
            if (j <= 1) {
                const int c0 = j == 0 ? 0 : c1s; const int ntc = j == 0 ? c1s : ntiles - c1s;
                pg8::Gemm g{(const bf16_t*)(ws + WS_H8), (const bf16_t*)(ws + WS_WGU1), D / 2, D / 2, D / 2};
                MoeOrder<28, true> S{{F.ctl + CW_Q + 64 * (2 * j + 1), MISC + 16}, mi, c0, ntc, (const int*)(ws + WS_LTOK)};
                EpiSwiGLU_T<true> E{(bf16_t*)(ws + WS_ACT1 + (j ? ACT1_B1 : (size_t)0)), FF1, (const float*)(ws + WS_LRS), 1.f / WGU_PRESC, ACT_PRESC};
                pg8::gemm_phase<EpiSwiGLU_T<true>, MoeOrder<28, true>, true, true>(ring, g, S, E);
#ifdef MK_G1_EXTRA
                if (j == 0) {
#pragma unroll 1
                    for (int rep = 0; rep < 2; ++rep) {
                        MoeOrder<28, true> S2{{F.ctl + CW_Q + 64 * (8 + rep), MISC + 16}, mi, c0, ntc, (const int*)(ws + WS_LTOK)};
#if MK_G1_EXTRA == 1
                        pg8::gemm_phase<EpiSwiGLU_T<true>, MoeOrder<28, true>, true, true>(ring, g, S2, E);
#else
                        EpiNull EN{};
                        pg8::gemm_phase<EpiNull, MoeOrder<28, true>, true, true>(ring, g, S2, EN);
#endif
                    }
                }
#endif
            }
        }
        SEAM(PH_MOE0 + j);
    }
#ifdef MK_EXTRA_BARS
    for (int i = 0; i < MK_EXTRA_BARS; ++i) xcd_barrier(bar);
#endif
    PROBE_AT(10);
    if (IN(PH_FINAL)) { moe_info_build(F.lds, F.ctl); final_phase(F, args); }
    PROBE_AT(11);
#ifdef MK_ATT_TS
    if (F.bid == 0 && F.wave == 0) { const unsigned long long dt = att_ts[MK_ATT_TS] / 5ull, ts = __builtin_amdgcn_s_memrealtime(); while (__builtin_amdgcn_s_memrealtime() - ts < dt) __builtin_amdgcn_s_sleep(8); }
#endif
#ifdef MK_PROBE_LO
    { const unsigned long long dt = (pr_t1 - pr_t0) * MK_PROBE_MULT, ts = __builtin_amdgcn_s_memrealtime(); while (__builtin_amdgcn_s_memrealtime() - ts < dt) __builtin_amdgcn_s_sleep(8); }
#endif
#undef IN
#undef SEAM
}
}
extern "C" void kernel_launch(void* const* d_in, const int* in_sizes, int n_in, void* d_out, int out_size, void* d_ws, size_t ws_size, hipStream_t stream) {
    static int grid = 0;
    if (grid == 0) {
        if (n_in != 19 || out_size != mk::T * mk::D || ws_size < mk::WS_END) { fprintf(stderr, "kernel_launch: unexpected shapes / workspace (%d inputs, out %d, ws %zu)\n", n_in, out_size, ws_size); grid = -1; return; }
        int dev = 0, cus = 0;
        if (hipGetDevice(&dev) != hipSuccess || hipDeviceGetAttribute(&cus, hipDeviceAttributeMultiprocessorCount, dev) != hipSuccess) { grid = -1; return; }
        if (hipFuncSetAttribute((const void*)mk::mk_fwd, hipFuncAttributeMaxDynamicSharedMemorySize, mk::LDS_BYTES) != hipSuccess) { fprintf(stderr, "kernel_launch: hipFuncSetAttribute failed\n"); grid = -1; return; }
        int per_cu = 0;
        if (hipOccupancyMaxActiveBlocksPerMultiprocessor(&per_cu, (const void*)mk::mk_fwd, mk::NTHREADS, mk::LDS_BYTES) != hipSuccess || per_cu < 1) { fprintf(stderr, "kernel_launch: occupancy query says %d blocks per CU\n", per_cu); }
        (void)hipGetLastError();
        grid = cus;
    }
    if (grid < 0) return;
    (void)hipMemsetAsync((char*)d_ws + mk::WS_CTL, 0, mk::CTL_ZERO_BYTES, stream);
    mk::Args a{};
    for (int i = 0; i < 19; ++i) a.in[i] = (const float*)d_in[i];
    a.out = (float*)d_out; a.ws = (unsigned char*)d_ws;
    a.ph_lo = 0; a.ph_hi = mk::PH_END; a.li = 0;
    hipLaunchKernelGGL(mk::mk_fwd, dim3(grid), dim3(mk::NTHREADS), mk::LDS_BYTES, stream, a);
}
```
